# Optimizing an MI355X kernel written in HIP

```python
import math
import jax, jax.numpy as jnp
from jax import lax
import numpy as np

D_MODEL = 1024
BATCH = 8
SEQ = 4096
DEPTH = 1

HEAD_DIM = 64
A_Q_HEADS = 8
A_KV_HEADS = 2
B_HEADS = 8
D_MIX = (A_Q_HEADS + B_HEADS) * HEAD_DIM
A_Q_W = A_Q_HEADS * HEAD_DIM
A_KV_W = A_KV_HEADS * HEAD_DIM
B_W = B_HEADS * HEAD_DIM
D_IN = A_Q_W + 2 * A_KV_W + 3 * B_W
WINDOW = 128
BLOCK = 128
ROT_DIMS = HEAD_DIM // 4
ROPE_THETA = 500000.0
GRID_W = 64
NA_ROWS_MAX = 8
NA_COLS = 16
N_EXPERTS = 32
TOP_K = 4
D_FF = 1024
SWIGLU_LIMIT = 7.0
SWIGLU_ALPHA = 1.702
MOE_BLOCK = 128
EPS = 1e-5
NEG = -1e30

kernel_name = "hybrid_swa_natten_moe_adaln"


def rms_norm(x):
    xf = x.astype(jnp.float32)
    return (xf * lax.rsqrt(jnp.mean(xf * xf, axis=-1, keepdims=True) + EPS)).astype(x.dtype)


def modulate(xn, shift, scale):
    return xn * (1.0 + scale[:, None, :]) + shift[:, None, :]


def apply_partial_rope(x, seq_len):
    half = ROT_DIMS // 2
    pos = jnp.arange(seq_len, dtype=jnp.float32)
    inv_freq = ROPE_THETA ** (-jnp.arange(0, ROT_DIMS, 2, dtype=jnp.float32) / ROT_DIMS)
    ang = pos[:, None] * inv_freq[None, :]
    cos = jnp.cos(ang)[None, :, None, :].astype(x.dtype)
    sin = jnp.sin(ang)[None, :, None, :].astype(x.dtype)
    x1 = x[..., :half]
    x2 = x[..., half:ROT_DIMS]
    return jnp.concatenate([x1 * cos - x2 * sin, x2 * cos + x1 * sin, x[..., ROT_DIMS:]], axis=-1)


def windowed_gqa_sink(q, k, v, sink):
    b, s, hq, d = q.shape
    hkv = k.shape[2]
    g = hq // hkv
    nb = s // BLOCK
    qb = q.reshape(b, nb, BLOCK, hkv, g, d)
    pad = ((0, 0), (BLOCK, BLOCK), (0, 0), (0, 0))
    kp = jnp.pad(k, pad).reshape(b, nb + 2, BLOCK, hkv, d)
    vp = jnp.pad(v, pad).reshape(b, nb + 2, BLOCK, hkv, d)
    kb = jnp.concatenate([kp[:, :-2], kp[:, 1:-1], kp[:, 2:]], axis=2)
    vb = jnp.concatenate([vp[:, :-2], vp[:, 1:-1], vp[:, 2:]], axis=2)
    qi = jnp.arange(BLOCK)
    kj = jnp.arange(3 * BLOCK)
    rel = kj[None, :] - BLOCK - qi[:, None]
    band = jnp.abs(rel) <= WINDOW
    kpos = jnp.arange(nb)[:, None] * BLOCK - BLOCK + kj[None, :]
    inb = (kpos >= 0) & (kpos < s)
    mask = band[None, :, :] & inb[:, None, :]
    scores = jnp.einsum('bnqhgd,bnkhd->bnhgqk', qb, kb).astype(jnp.float32) * (d ** -0.5)
    scores = jnp.where(mask[None, :, None, None], scores, NEG)
    sink_l = sink.astype(jnp.float32).reshape(hkv, g)[None, None, :, :, None, None]
    m = jnp.maximum(jnp.max(scores, axis=-1, keepdims=True), sink_l)
    p = jnp.exp(scores - m)
    denom = jnp.sum(p, axis=-1, keepdims=True) + jnp.exp(sink_l - m)
    out = jnp.einsum('bnhgqk,bnkhd->bnqhgd', (p / denom).astype(v.dtype), vb)
    return out.reshape(b, s, hq, d)


def neighbourhood_attn(q, k, v, rpb):
    b, s, h, d = q.shape
    rows = s // GRID_W
    kr = min(NA_ROWS_MAX, rows)
    kc = NA_COLS
    qg = q.reshape(b, rows, GRID_W, h, d)
    kg = k.reshape(b, rows, GRID_W, h, d)
    vg = v.reshape(b, rows, GRID_W, h, d)
    r = jnp.arange(rows)
    row_start = jnp.clip(r - kr // 2, 0, rows - kr)
    row_idx = row_start[:, None] + jnp.arange(kr)[None, :]
    kw = kg[:, row_idx].reshape(b, rows, kr * GRID_W, h, d)
    vw = vg[:, row_idx].reshape(b, rows, kr * GRID_W, h, d)
    col = jnp.arange(GRID_W)
    col_start = jnp.clip(col - kc // 2, 0, GRID_W - kc)
    col_mask = (col[None, :] >= col_start[:, None]) & (col[None, :] < col_start[:, None] + kc)
    mask = jnp.tile(col_mask, (1, kr))
    row_off = row_idx - r[:, None]
    col_off = jnp.clip(col[None, :] - col[:, None], -(kc - 1), kc - 1)
    bias = rpb[:, row_off[:, None, :, None] + (NA_ROWS_MAX - 1),
               col_off[None, :, None, :] + (NA_COLS - 1)]
    bias = bias.reshape(h, rows, GRID_W, kr * GRID_W).astype(jnp.float32)
    scores = jnp.einsum('brqhd,brkhd->bhrqk', qg, kw).astype(jnp.float32) * (d ** -0.5) + bias[None]
    scores = jnp.where(mask[None, None, None], scores, NEG)
    p = jax.nn.softmax(scores, axis=-1)
    out = jnp.einsum('bhrqk,brkhd->brqhd', p.astype(v.dtype), vw)
    return out.reshape(b, s, h, d)


def moe_ffn(h, w_router, b_router, w_gate_up, b_gate_up, w_down, b_down):
    b, s, d = h.shape
    t = b * s
    xt = h.reshape(t, d)
    logits = (xt @ w_router + b_router).astype(jnp.float32)
    top_val, top_idx = lax.top_k(logits, TOP_K)
    gates = jax.nn.softmax(top_val, axis=-1)
    a = t * TOP_K
    e_flat = top_idx.reshape(a)
    tok_flat = jnp.repeat(jnp.arange(t, dtype=jnp.int32), TOP_K)
    g_flat = gates.reshape(a)
    order = jnp.argsort(e_flat)
    e_sorted = e_flat[order]
    tok_sorted = tok_flat[order]
    g_sorted = g_flat[order]
    counts = jnp.bincount(e_flat, length=N_EXPERTS)
    starts = jnp.cumsum(counts) - counts
    padded = ((counts + MOE_BLOCK - 1) // MOE_BLOCK) * MOE_BLOCK
    pends = jnp.cumsum(padded)
    pstarts = pends - padded
    dest = pstarts[e_sorted] + (jnp.arange(a) - starts[e_sorted])
    n_slots = a + N_EXPERTS * MOE_BLOCK
    n_blk = n_slots // MOE_BLOCK
    slot_tok = jnp.full((n_slots,), t, dtype=jnp.int32).at[dest].set(tok_sorted)
    slot_gate = jnp.zeros((n_slots,), jnp.float32).at[dest].set(g_sorted)
    blk_expert = jnp.minimum(
        jnp.searchsorted(pends, jnp.arange(n_blk) * MOE_BLOCK, side='right'), N_EXPERTS - 1)
    x_pad = jnp.concatenate([xt, jnp.zeros((1, d), xt.dtype)], axis=0)
    xs = x_pad[slot_tok].reshape(n_blk, MOE_BLOCK, d)

    def expert_block(args):
        xb, e = args
        gu = xb @ w_gate_up[e] + b_gate_up[e]
        gate = jnp.minimum(gu[:, :D_FF], SWIGLU_LIMIT)
        up = jnp.clip(gu[:, D_FF:], -SWIGLU_LIMIT, SWIGLU_LIMIT)
        glu = gate * jax.nn.sigmoid(SWIGLU_ALPHA * gate)
        return ((up + 1.0) * glu) @ w_down[e] + b_down[e]

    ys = lax.map(expert_block, (xs, blk_expert)).reshape(n_slots, d)
    y = jax.ops.segment_sum(ys * slot_gate[:, None].astype(ys.dtype), slot_tok, num_segments=t + 1)[:t]
    return y.reshape(b, s, d)


def setup_inputs(seed: int = 0) -> dict:
    key = jax.random.key(seed)
    ks = jax.random.split(key, 20)
    f32 = jnp.float32
    nrm = lambda k, shape, sc: jax.random.normal(k, shape, f32) * sc
    return {
        "x": nrm(ks[0], (BATCH, SEQ, D_MODEL), 1.0),
        "c": nrm(ks[1], (BATCH, D_MODEL), 1.0),
        "w_ada": nrm(ks[2], (DEPTH, D_MODEL, 6 * D_MODEL), D_MODEL ** -0.5),
        "b_ada": nrm(ks[3], (DEPTH, 6 * D_MODEL), 0.02),
        "w_in": nrm(ks[4], (DEPTH, D_MODEL, D_IN), D_MODEL ** -0.5),
        "sink": nrm(ks[5], (DEPTH, A_Q_HEADS), 1.0),
        "rpb": nrm(ks[6], (DEPTH, B_HEADS, 2 * NA_ROWS_MAX - 1, 2 * NA_COLS - 1), 0.5),
        "g_out_a": 1.0 + nrm(ks[7], (DEPTH, A_Q_W), 0.02),
        "g_out_b": 1.0 + nrm(ks[8], (DEPTH, B_W), 0.02),
        "w_out": nrm(ks[9], (DEPTH, D_MIX, D_MODEL), D_MIX ** -0.5),
        "w_router": nrm(ks[10], (DEPTH, D_MODEL, N_EXPERTS), D_MODEL ** -0.5),
        "b_router": nrm(ks[11], (DEPTH, N_EXPERTS), 0.01),
        "w_gate_up": nrm(ks[12], (DEPTH, N_EXPERTS, D_MODEL, 2 * D_FF), D_MODEL ** -0.5),
        "b_gate_up": nrm(ks[13], (DEPTH, N_EXPERTS, 2 * D_FF), 0.01),
        "w_down": nrm(ks[14], (DEPTH, N_EXPERTS, D_FF, D_MODEL), D_FF ** -0.5),
        "b_down": nrm(ks[15], (DEPTH, N_EXPERTS, D_MODEL), 0.01),
        "g_final": 1.0 + nrm(ks[16], (D_MODEL,), 0.02),
    }


def reference(x, c, w_ada, b_ada, w_in, sink, rpb, g_out_a, g_out_b, w_out,
              w_router, b_router, w_gate_up, b_gate_up, w_down, b_down, g_final):
    b, s, _ = x.shape
    c_act = jax.nn.silu(c)
    for l in range(DEPTH):
        mod = c_act @ w_ada[l] + b_ada[l]
        shift_m, scale_m, gate_m, shift_f, scale_f, gate_f = jnp.split(mod, 6, axis=-1)

        h = modulate(rms_norm(x), shift_m, scale_m)
        proj = h @ w_in[l]
        qa, ka, va, qb, kb, vb = jnp.split(
            proj, np.cumsum([A_Q_W, A_KV_W, A_KV_W, B_W, B_W]).tolist(), axis=-1)
        qa = apply_partial_rope(qa.reshape(b, s, A_Q_HEADS, HEAD_DIM), s)
        ka = apply_partial_rope(ka.reshape(b, s, A_KV_HEADS, HEAD_DIM), s)
        va = va.reshape(b, s, A_KV_HEADS, HEAD_DIM)
        oa = windowed_gqa_sink(qa, ka, va, sink[l]).reshape(b, s, A_Q_W)
        ob = neighbourhood_attn(qb.reshape(b, s, B_HEADS, HEAD_DIM),
                                kb.reshape(b, s, B_HEADS, HEAD_DIM),
                                vb.reshape(b, s, B_HEADS, HEAD_DIM), rpb[l]).reshape(b, s, B_W)
        mixed = jnp.concatenate([rms_norm(oa) * g_out_a[l], rms_norm(ob) * g_out_b[l]], axis=-1)
        x = x + gate_m[:, None, :] * (mixed @ w_out[l])

        h = modulate(rms_norm(x), shift_f, scale_f)
        y = moe_ffn(h, w_router[l], b_router[l], w_gate_up[l], b_gate_up[l], w_down[l], b_down[l])
        x = x + gate_f[:, None, :] * y
    return rms_norm(x) * g_final
```

```cpp
#define DBG_STAGE 9
#include <hip/hip_runtime.h>
#include <cstdio>
#include <cstdint>
#include <cmath>

constexpr int DM = 1024, NB = 8, SEQ = 4096, NTOK = NB * SEQ;
constexpr int HD = 64, AQH = 8, AKVH = 2, BH = 8;
constexpr int AQW = 512, AKVW = 128, BW = 512, DIN = 2304;
constexpr int OFF_QA = 0, OFF_KA = 512, OFF_VA = 640, OFF_QB = 768, OFF_KB = 1280, OFF_VB = 1792;
constexpr int WIN = 128, GW = 64, NAR = 8, NAC = 16, NE = 32, TOPK = 4, DFF = 1024;
constexpr float EPS = 1e-5f;
constexpr size_t MiB = 1u << 20;

#define GAS __attribute__((address_space(1)))
#define LAS __attribute__((address_space(3)))
typedef unsigned short bf16_t;
typedef short bf16x8 __attribute__((ext_vector_type(8)));
typedef float f32x4 __attribute__((ext_vector_type(4)));
typedef float f32x2 __attribute__((ext_vector_type(2)));
typedef float f32x16 __attribute__((ext_vector_type(16)));
typedef unsigned u32x4 __attribute__((ext_vector_type(4)));
typedef unsigned u32x2 __attribute__((ext_vector_type(2)));
typedef GAS unsigned gu32;
#define RLX_AGENT __ATOMIC_RELAXED, __HIP_MEMORY_SCOPE_AGENT
#define LDS_WAIT() asm volatile("s_waitcnt lgkmcnt(0)" ::: "memory")
#define VM_WAIT() asm volatile("s_waitcnt vmcnt(0)" ::: "memory")
__device__ __forceinline__ unsigned cvt_pk_bf16(float lo, float hi) { unsigned r; asm volatile("v_cvt_pk_bf16_f32 %0, %1, %2" : "=v"(r) : "v"(lo), "v"(hi)); return r; }
__device__ __forceinline__ unsigned f2bf(float f) { unsigned u = __builtin_bit_cast(unsigned, f); return (u + 0x7fffu + ((u >> 16) & 1u)) >> 16; }
__device__ __forceinline__ unsigned pk2(float lo, float hi) { return f2bf(lo) | (f2bf(hi) << 16); }
__device__ __forceinline__ float bf2f(unsigned h) { return __builtin_bit_cast(float, h << 16); }

constexpr int NWAVES = 8;
constexpr float C2 = 0.125f * 1.4426950408889634f;
constexpr float LOG2E = 1.4426950408889634f;
constexpr int NSLOT_MAX = 139264;

constexpr size_t WS_CTL = 0, CTL_ZERO_BYTES = 1 * MiB;
constexpr size_t WS_MOD = 1 * MiB;
constexpr size_t WS_ROPE = WS_MOD + 256 * 1024;
constexpr size_t WS_WR = WS_ROPE + 256 * 1024;
constexpr size_t WS_SSQ = 2 * MiB;
constexpr size_t WS_TKE = 3 * MiB;
constexpr size_t WS_TKG = 4 * MiB;
constexpr size_t WS_LIST = 5 * MiB;
constexpr size_t WS_WIN = 10 * MiB;
constexpr size_t WS_WOUT = 15 * MiB;
constexpr size_t WS_WGU = 17 * MiB;
constexpr size_t WS_WD = 145 * MiB;
constexpr size_t WS_XN = 209 * MiB;
constexpr size_t WS_PROJ = 273 * MiB;
constexpr size_t WS_O = 417 * MiB;
constexpr size_t WS_YS = 209 * MiB;
constexpr size_t WS_ACT = 481 * MiB;
constexpr size_t WS_MK_END = 753 * MiB;
constexpr int CW_TMO = 0, CW_CNT = 64  , CW_BAR = 4096;

constexpr int RING_BYTES = 131072;
constexpr int LDSCTL_OFF = RING_BYTES, MISC_OFF = LDSCTL_OFF + 320;
constexpr int TAB_OFF = LDSCTL_OFF + 1024;
constexpr int LDS_BYTES = 147456;

namespace pg8 {
constexpr int BM = 256, BK = 64, HALF = 128, HTB = HALF * BK * 2, NXCD = 8, WGM = 8;
__host__ __device__ __forceinline__ int lds_byte(int r, int c) { const int st = (r >> 4) * 2 + (c >> 5), rr = r & 15, cc = c & 31, ob = rr * 64 + cc * 2; return st * 1024 + (ob ^ (((ob >> 9) & 1) << 5)); }
__host__ __device__ __forceinline__ void stage_rc(int b, int& R, int& C) { const int st = b / 1024, sb = b % 1024, swz = sb ^ (((sb >> 9) & 1) << 5); R = (st >> 1) * 16 + swz / 64; C = (st & 1) * 32 + (swz % 64) / 2; }
__host__ __device__ __forceinline__ int perm32(int rho) { const int n = rho >> 4, i = rho & 15; return 8 * (i >> 2) + 4 * n + (i & 3); }

struct Unit { int pm, pn, e, aux; };

struct DenseOrder {
    const char* A; const char* Bt; int K; int nM, nN, nwg, G, c;
    __device__ void init(const void* A_, const void* Bt_, int M, int N, int K_, int G_, int c_) { A = (const char*)A_; Bt = (const char*)Bt_; K = K_; nM = M / BM; nN = N / BM; nwg = nM * nN; G = G_; c = c_; }
    __device__ bool next(int i, Unit& u) const {
        const long L = (long)i * G + c; if (L >= nwg) return false;
        int wgid = (int)L; { const int q = nwg / NXCD, r = nwg % NXCD, xcd = wgid % NXCD, off = wgid / NXCD; wgid = (xcd < r ? xcd * (q + 1) : r * (q + 1) + (xcd - r) * q) + off; }
        const int nig = WGM * nN, gid = wgid / nig, fm = gid * WGM, gsz = (nM - fm) < WGM ? (nM - fm) : WGM;
        u.pm = fm + ((wgid % nig) % gsz); u.pn = (wgid % nig) / gsz; u.e = 0; u.aux = 0; return true;
    }
    __device__ __forceinline__ const char* abase() const { return A; }
    __device__ __forceinline__ const char* bbase(const Unit& u) const { return Bt + (size_t)u.pn * BM * K * 2; }
    __device__ __forceinline__ void aoffs(const Unit& u, const int (&R)[2], const int (&C)[2], unsigned (&off)[4]) const {
#pragma unroll
        for (int h = 0; h < 2; ++h)
#pragma unroll
            for (int i = 0; i < 2; ++i) off[h * 2 + i] = (unsigned)((u.pm * BM + h * HALF + R[i]) * K + C[i]) * 2u;
    }
};

#define PG8_LAS __attribute__((address_space(3)))
template <class Epi, class Sched, bool ALIGN_EPI>
__device__ __forceinline__ void gemm_phase(PG8_LAS unsigned char* lds, const int K, const Sched& S, const Epi& E) {
    const int tid = threadIdx.x, wid = __builtin_amdgcn_readfirstlane(tid >> 6), lane = tid & 63, wr = wid >> 2, wc = wid & 3, fr = lane & 15, fq = lane >> 4;
    const int nt = K / BK;
    int sR[2], sC[2]; unsigned voffB[2];
#pragma unroll
    for (int i = 0; i < 2; ++i) { int R, C; stage_rc(tid * 16 + i * 8192, R, C); sR[i] = R; sC[i] = C; const int Rb = Epi::PERM ? ((R & ~31) + perm32(R & 31)) : R; voffB[i] = (unsigned)(Rb * K + C) * 2u; }
    const size_t kstep = (size_t)(BK * 2);
    const size_t hstepB = (size_t)HALF * K * 2;
    const unsigned ldsw = (unsigned)wid * 1024u;
    const int aoff = lds_byte(wr * 64 + fr, fq * 8), boff = lds_byte(wc * 32 + fr, fq * 8);
    const char* const gA = S.abase();
#define PG8_SA(b, h) (((b) * 2 + (h)) * HTB)
#define PG8_SB(b, h) ((4 + (b) * 2 + (h)) * HTB)
#define PG8_STAGE(bufoff, gbase, voff) do { _Pragma("unroll") for (int _i = 0; _i < 2; ++_i) \
        __builtin_amdgcn_global_load_lds((const unsigned*)((const char*)(gbase) + (voff)[_i]), (PG8_LAS unsigned*)(lds + (bufoff) + ldsw + _i * 8192), 16, 0, 0); } while (0)
#define PG8_STAGEA(bufoff, offs, h, kb) do { _Pragma("unroll") for (int _i = 0; _i < 2; ++_i) \
        __builtin_amdgcn_global_load_lds((const unsigned*)(gA + (offs)[(h) * 2 + _i] + (kb)), (PG8_LAS unsigned*)(lds + (bufoff) + ldsw + _i * 8192), 16, 0, 0); } while (0)
#define PG8_LDA(dst, b, h) do { _Pragma("unroll") for (int m = 0; m < 4; ++m) _Pragma("unroll") for (int k = 0; k < 2; ++k) dst[m][k] = *(const PG8_LAS bf16x8*)(lds + PG8_SA(b, h) + aoff + m * 2048 + k * 1024); } while (0)
#define PG8_LDB(dst, b, h) do { _Pragma("unroll") for (int n = 0; n < 2; ++n) _Pragma("unroll") for (int k = 0; k < 2; ++k) dst[n][k] = *(const PG8_LAS bf16x8*)(lds + PG8_SB(b, h) + boff + n * 2048 + k * 1024); } while (0)
#define PG8_MMA(ai, bj, At, Bt) do { __builtin_amdgcn_s_setprio(1); _Pragma("unroll") for (int m = 0; m < 4; ++m) _Pragma("unroll") for (int n = 0; n < 2; ++n) _Pragma("unroll") for (int k = 0; k < 2; ++k) \
        acc[ai][bj][m][n] = __builtin_amdgcn_mfma_f32_16x16x32_bf16(Bt[n][k], At[m][k], acc[ai][bj][m][n], 0, 0, 0); __builtin_amdgcn_s_setprio(0); } while (0)
#define PG8_WAIT_V(n) asm volatile("s_waitcnt vmcnt(" #n ")" ::: "memory")
#define PG8_WAIT_L(n) asm volatile("s_waitcnt lgkmcnt(" #n ")" ::: "memory")
#define PG8_BAR __builtin_amdgcn_s_barrier()
#define PG8_SCHED __builtin_amdgcn_sched_barrier(0)
    Unit cur, nxt; int ui = 0;
    if (!S.next(0, cur)) return;
    f32x4 acc[2][2][4][2];
#pragma unroll
    for (int a = 0; a < 2; ++a)
#pragma unroll
        for (int b = 0; b < 2; ++b)
#pragma unroll
            for (int m = 0; m < 4; ++m)
#pragma unroll
                for (int n = 0; n < 2; ++n) acc[a][b][m][n] = (f32x4){0.f, 0.f, 0.f, 0.f};
    bf16x8 At[4][2], B0[2][2], B1[2][2];
    unsigned cO[4], nO[4];
    S.aoffs(cur, sR, sC, cO);
    const char* cB = S.bbase(cur);
    PG8_STAGE(PG8_SB(0, 0), cB, voffB); PG8_STAGE(PG8_SB(0, 1), cB + hstepB, voffB); PG8_STAGEA(PG8_SA(0, 0), cO, 0, 0); PG8_STAGEA(PG8_SA(0, 1), cO, 1, 0);
    if (wr == 1) PG8_BAR;
    PG8_WAIT_V(2); PG8_BAR;
    PG8_STAGE(PG8_SB(1, 0), cB + kstep, voffB); PG8_STAGEA(PG8_SA(1, 0), cO, 0, kstep); PG8_STAGE(PG8_SB(1, 1), cB + hstepB + kstep, voffB);
    PG8_WAIT_V(6); PG8_BAR;
    for (;;) {
        const bool has_next = S.next(ui + 1, nxt);
        const char* nB = cB;
#pragma unroll
        for (int i = 0; i < 4; ++i) nO[i] = cO[i];
        if (has_next) { nB = S.bbase(nxt); S.aoffs(nxt, sR, sC, nO); }
        for (int t = 0; t < nt; t += 2) {
            const bool last = (t == nt - 2);
            if constexpr (Epi::MID) { if (t == nt / 2) E.mid(acc, cur, wr, fr); }
            const size_t k1 = (size_t)(t + 1) * kstep;
            const size_t k2 = last ? 0 : (size_t)(t + 2) * kstep, k3 = k2 + kstep;
            const char* b2 = (last ? nB : cB) + k2; const char* b3 = b2 + kstep;
            unsigned o2[4];
#pragma unroll
            for (int i = 0; i < 4; ++i) o2[i] = last ? nO[i] : cO[i];
            PG8_LDB(B0, 0, 0); PG8_LDB(B1, 0, 1); PG8_SCHED; PG8_LDA(At, 0, 0); PG8_STAGEA(PG8_SA(1, 1), cO, 1, k1);
            PG8_WAIT_V(8); PG8_WAIT_L(0); PG8_BAR; PG8_MMA(0, 0, At, B0); PG8_MMA(0, 1, At, B1); PG8_BAR; PG8_SCHED;
            PG8_LDA(At, 0, 1); PG8_STAGE(PG8_SB(0, 0), b2, voffB); PG8_STAGE(PG8_SB(0, 1), b2 + hstepB, voffB); PG8_STAGEA(PG8_SA(0, 0), o2, 0, k2);
            PG8_WAIT_V(8); PG8_WAIT_L(0); PG8_BAR; PG8_MMA(1, 0, At, B0); PG8_MMA(1, 1, At, B1); PG8_BAR; PG8_SCHED;
            PG8_LDB(B0, 1, 0); PG8_LDB(B1, 1, 1); PG8_SCHED; PG8_LDA(At, 1, 0); PG8_STAGEA(PG8_SA(0, 1), o2, 1, k2);
            PG8_WAIT_V(8); PG8_WAIT_L(0); PG8_BAR; PG8_MMA(0, 0, At, B0); PG8_MMA(0, 1, At, B1); PG8_BAR; PG8_SCHED;
            PG8_LDA(At, 1, 1); PG8_STAGE(PG8_SB(1, 0), b3, voffB); PG8_STAGE(PG8_SB(1, 1), b3 + hstepB, voffB); PG8_STAGEA(PG8_SA(1, 0), o2, 0, k3);
            PG8_WAIT_V(8); PG8_WAIT_L(0); PG8_BAR; PG8_MMA(1, 0, At, B0); PG8_MMA(1, 1, At, B1); PG8_BAR; PG8_SCHED;
        }
        if constexpr (ALIGN_EPI) { if (wr == 0) PG8_BAR; }
        E(acc, cur, wr, wc, fr, fq);
        if (!has_next) break;
#pragma unroll
        for (int a = 0; a < 2; ++a)
#pragma unroll
            for (int b = 0; b < 2; ++b)
#pragma unroll
                for (int m = 0; m < 4; ++m)
#pragma unroll
                    for (int n = 0; n < 2; ++n) acc[a][b][m][n] = (f32x4){0.f, 0.f, 0.f, 0.f};
        cur = nxt; cB = nB;
#pragma unroll
        for (int i = 0; i < 4; ++i) cO[i] = nO[i];
        ++ui;
        if constexpr (ALIGN_EPI) { if (wr == 1) PG8_BAR; }
    }
    PG8_WAIT_V(0);
    if constexpr (!ALIGN_EPI) { if (wr == 0) PG8_BAR; }
    PG8_BAR;
#undef PG8_SA
#undef PG8_SB
#undef PG8_STAGE
#undef PG8_STAGEA
#undef PG8_LDA
#undef PG8_LDB
#undef PG8_MMA
#undef PG8_WAIT_V
#undef PG8_WAIT_L
#undef PG8_BAR
#undef PG8_SCHED
}
}
#define XB_TMO      128
#define XB_XCNT(j)  (256  + 64 * (j))
#define XB_XSUB(j)  (1280 + 64 * (j))
#define XB_XGEN(j)  (2304 + 64 * (j))
#define XB_TOP      3328
#define XB_TOPGEN   3392
#define XCD_BAR_WORDS 3456
#define XB_SPIN_CAP (1u << 18)
__device__ __forceinline__ unsigned xb_ld(unsigned* p)              { return __hip_atomic_load(p, __ATOMIC_RELAXED, __HIP_MEMORY_SCOPE_AGENT); }
__device__ __forceinline__ unsigned xb_add(unsigned* p, unsigned v) { return __hip_atomic_fetch_add(p, v, __ATOMIC_RELAXED, __HIP_MEMORY_SCOPE_AGENT); }
__device__ __forceinline__ unsigned xb_xcc_id() { return (unsigned)__builtin_amdgcn_s_getreg((3 << 11) | 20) & 0xFu; }
#define XB_SPIN(cond, bar) do { unsigned _sp = 0; while (cond) { __builtin_amdgcn_s_sleep(1); \
    if ((++_sp & 255u) == 0u) { if (xb_ld(&(bar)[XB_TMO])) break; if (_sp > XB_SPIN_CAP) { atomicAdd(&(bar)[XB_TMO], 1u); break; } } } } while (0)
struct XcdBarrier { unsigned* bar; unsigned x; volatile LAS unsigned* st; };
__device__ __forceinline__ XcdBarrier xcd_barrier_post(unsigned* bar, volatile LAS unsigned* st) {
    XcdBarrier b; b.bar = bar; b.x = xb_xcc_id(); b.st = st;
    if (threadIdx.x == 0) (void)xb_add(&bar[XB_XCNT(b.x)], 1u);
    return b;
}
__device__ __forceinline__ void xcd_barrier_complete(unsigned* bar, unsigned x, unsigned& nloc, unsigned& nx) {
    const unsigned G = gridDim.x * gridDim.y * gridDim.z;
    unsigned sum, cnt, mine, sp = 0u;
    for (;;) {
        sum = 0u; cnt = 0u; mine = 0u;
#pragma unroll
        for (unsigned j = 0; j < 16; ++j) { const unsigned c = xb_ld(&bar[XB_XCNT(j)]); sum += c; cnt += (c > 0u) ? 1u : 0u; mine = (j == x) ? c : mine; }
        if (sum == G) break;
        __builtin_amdgcn_s_sleep(1);
        if ((++sp & 255u) == 0u) { if (xb_ld(&bar[XB_TMO])) break; if (sp > XB_SPIN_CAP) { atomicAdd(&bar[XB_TMO], 1u); break; } }
    }
    nloc = mine > 0u ? mine : 1u; nx = cnt > 0u ? cnt : 1u;
}
__device__ __forceinline__ void xcd_barrier(const XcdBarrier& b) {
    asm volatile("s_waitcnt vmcnt(0)" ::: "memory");
    __syncthreads();
    if (threadIdx.x == 0) {
        unsigned* bar = b.bar;
        __builtin_amdgcn_s_waitcnt(0);
        unsigned nloc = b.st[0], nx = b.st[1];
        if (nloc == 0u) { xcd_barrier_complete(bar, b.x, nloc, nx); b.st[0] = nloc; b.st[1] = nx; }
        const unsigned old = xb_add(&bar[XB_XSUB(b.x)], 1u);
        const unsigned gen = old / nloc;
        if (old + 1u == (gen + 1u) * nloc) {
            __builtin_amdgcn_fence(__ATOMIC_RELEASE, "agent");
            asm volatile("s_waitcnt vmcnt(0)" ::: "memory");
            const unsigned og = xb_add(&bar[XB_TOP], 1u);
            const unsigned tg = og / nx;
            if (og + 1u == (tg + 1u) * nx) xb_add(&bar[XB_TOPGEN], 1u);
            else XB_SPIN(xb_ld(&bar[XB_TOPGEN]) == tg, bar);
            __builtin_amdgcn_fence(__ATOMIC_ACQUIRE, "agent");
            xb_add(&bar[XB_XGEN(b.x)], 1u);
            asm volatile("s_waitcnt vmcnt(0)" ::: "memory");
        } else {
            XB_SPIN(xb_ld(&bar[XB_XGEN(b.x)]) == gen, bar);
            __builtin_amdgcn_fence(__ATOMIC_ACQUIRE, "agent");
            asm volatile("s_waitcnt vmcnt(0)" ::: "memory");
        }
    }
    __syncthreads();
}

struct Frame {
    LAS unsigned char* lds;
    volatile LAS unsigned* MISC;
    gu32* ctl;
    int tid, lane, wave, vcu, G;
    const float *x, *c, *w_ada, *b_ada, *w_in, *sink, *rpb, *ga, *gb, *w_out, *w_router, *b_router, *w_gu, *b_gu, *w_down, *b_down, *g_final;
    float* out;
    float *mod, *rope, *ssq, *tkg;
    int *tke, *list;
    bf16_t *wr_t, *win_t, *wout_t, *wgu_t, *wd_t, *XN, *PROJ, *O, *YS, *ACT;
};
__device__ __forceinline__ float wave_sum(float v) {
#pragma unroll
    for (int o = 1; o < 64; o <<= 1) v += __shfl_xor(v, o);
    return v;
}

__device__ __forceinline__ void p0_transpose_item(const float* W, int N, int Kd, bf16_t* WT, int k0, int n0, int drow0, const float* ga, const float* gb, LAS float* scr, int lane) {
#pragma unroll 8
    for (int i = 0; i < 32; ++i) { const int kk = 2 * i + (lane >> 5); float w = W[(size_t)(k0 + kk) * N + n0 + (lane & 31)];
        if (ga) { const int k = k0 + kk; w *= (k < 512 ? ga[k] : gb[k - 512]); }
        scr[kk * 33 + (lane & 31)] = w; }
    LDS_WAIT(); asm volatile("" ::: "memory");
    const int c = lane & 7;
#pragma unroll
    for (int j = 0; j < 4; ++j) { const int n = (lane >> 3) + 8 * j; const LAS float* s = scr + (8 * c) * 33 + n;
        u32x4 o; o.x = pk2(s[0 * 33], s[1 * 33]); o.y = pk2(s[2 * 33], s[3 * 33]); o.z = pk2(s[4 * 33], s[5 * 33]); o.w = pk2(s[6 * 33], s[7 * 33]);
        *(GAS u32x4*)(WT + (size_t)(drow0 + n) * Kd + k0 + 8 * c) = o; }
    LDS_WAIT(); asm volatile("" ::: "memory");
}
__device__ __forceinline__ void p0_prologue(Frame& F) {
    const int gt = blockIdx.x * (NWAVES * 64) + F.tid;
    if (blockIdx.x < 6 * DM / 32) {
        LAS float* sc = (LAS float*)F.lds;
        LAS float* red = (LAS float*)(F.lds + 32768);
        for (int i = F.tid; i < NB * DM; i += NWAVES * 64) { const float v = F.c[i]; sc[i] = v / (1.f + __expf(-v)); }
        __syncthreads();
        const int col = F.tid & 31, ks = F.tid >> 5, n = blockIdx.x * 32 + col;
        float a[NB];
#pragma unroll
        for (int b = 0; b < NB; ++b) a[b] = 0.f;
        for (int k = ks * 64; k < ks * 64 + 64; ++k) { const float w = F.w_ada[(size_t)k * 6 * DM + n];
#pragma unroll
            for (int b = 0; b < NB; ++b) a[b] += sc[b * DM + k] * w; }
#pragma unroll
        for (int b = 0; b < NB; ++b) red[(ks * NB + b) * 32 + col] = a[b];
        __syncthreads();
        if (F.tid < 256) { const int b = F.tid >> 5; float s = F.b_ada[n];
#pragma unroll
            for (int q = 0; q < 16; ++q) s += red[(q * NB + b) * 32 + col];
            F.mod[b * 6 * DM + n] = s; }
        __syncthreads();
    }
    if (gt < SEQ * 8) {
        const int pos = gt >> 3, i = gt & 7;
        const float invf[8] = {1.0f, 0.1939227432012558f, 0.03760603070259094f, 0.007292664609849453f, 0.0014142135623842478f, 0.00027424818836152554f, 5.3182957344688475e-05f, 1.0313385246263351e-05f};
        float inv = invf[0];
#pragma unroll
        for (int q = 1; q < 8; ++q) inv = (i == q) ? invf[q] : inv;
        const float angf = (float)pos * inv;
        const double ang = (double)angf, twopi = 6.283185307179586476925287;
        const double r = ang - __builtin_rint(ang / twopi) * twopi, r2 = r * r;
        double cs = 1.0, sn = r, tc = 1.0, ts = r;
#pragma unroll 1
        for (int q = 1; q <= 20; ++q) { tc = -tc * r2 / (double)((2 * q - 1) * (2 * q)); ts = -ts * r2 / (double)((2 * q) * (2 * q + 1)); cs += tc; sn += ts; }
        F.rope[gt] = (float)cs; F.rope[SEQ * 8 + gt] = (float)sn;
    }
    if (gt < NE * DM) { const int e = gt >> 10, k = gt & 1023; const float w = F.w_router[k * NE + e]; const unsigned hi = f2bf(w); const unsigned lo = f2bf(w - bf2f(hi));
        F.wr_t[gt] = (bf16_t)hi; F.wr_t[NE * DM + gt] = (bf16_t)lo; }
    if (gt < NTOK * 2) F.ssq[gt] = 0.f;
    LAS float* scr = (LAS float*)(F.lds + F.wave * 16384);
    const int gw = F.vcu * NWAVES + F.wave, NGW = F.G * NWAVES;
    constexpr int I_IN = 16 * (DIN / 32), I_OUT = 16 * (DM / 32), I_GU1 = 16 * (2 * DFF / 32), I_GU = NE * I_GU1, I_D1 = (DFF / 64) * (DM / 32), I_D = NE * I_D1;
    constexpr int NITEMS = I_IN + I_OUT + I_GU + I_D;
    for (int it = gw; it < NITEMS; it += NGW) {
        int r = it;
        if (r < I_IN) { const int nb = r % (DIN / 32), kb = r / (DIN / 32); p0_transpose_item(F.w_in, DIN, DM, F.win_t, kb * 64, nb * 32, nb * 32, nullptr, nullptr, scr, F.lane); continue; } r -= I_IN;
        if (r < I_OUT) { const int nb = r % (DM / 32), kb = r / (DM / 32); p0_transpose_item(F.w_out, DM, DM, F.wout_t, kb * 64, nb * 32, nb * 32, F.ga, F.gb, scr, F.lane); continue; } r -= I_OUT;
        if (r < I_GU) { const int e = r / I_GU1, q = r % I_GU1, nb = q % (2 * DFF / 32), kb = q / (2 * DFF / 32), n0 = nb * 32;
            const int f = n0 & (DFF - 1), drow0 = (f >> 7) * 256 + (n0 >= DFF ? 128 : 0) + (f & 127);
            p0_transpose_item(F.w_gu + (size_t)e * DM * 2 * DFF, 2 * DFF, DM, F.wgu_t + (size_t)e * 2 * DFF * DM, kb * 64, n0, drow0, nullptr, nullptr, scr, F.lane); continue; } r -= I_GU;
        { const int e = r / I_D1, q = r % I_D1, nb = q % (DM / 32), kb = q / (DM / 32);
            p0_transpose_item(F.w_down + (size_t)e * DFF * DM, DM, DFF, F.wd_t + (size_t)e * DM * DFF, kb * 64, nb * 32, nb * 32, nullptr, nullptr, scr, F.lane); }
    }
}
__device__ __forceinline__ void p1_xn(Frame& F) {
    const int gw = F.vcu * NWAVES + F.wave, NGW = F.G * NWAVES;
    for (int chunk = gw; chunk < NTOK / 16; chunk += NGW) {
        const int m0 = chunk * 16, b = m0 / SEQ;
        f32x4 s1[4], sh[4];
#pragma unroll
        for (int j = 0; j < 4; ++j) { s1[j] = *(const GAS f32x4*)(F.mod + b * 6 * DM + DM + 4 * F.lane + 256 * j) + 1.0f; sh[j] = *(const GAS f32x4*)(F.mod + b * 6 * DM + 4 * F.lane + 256 * j); }
        for (int r = 0; r < 16; ++r) {
            const GAS f32x4* xr = (const GAS f32x4*)(F.x + (size_t)(m0 + r) * DM) + F.lane;
            f32x4 v[4]; float s = 0.f;
#pragma unroll
            for (int j = 0; j < 4; ++j) { v[j] = xr[64 * j]; s += (v[j].x * v[j].x + v[j].y * v[j].y) + (v[j].z * v[j].z + v[j].w * v[j].w); }
            const float rstd = 1.f / sqrtf(wave_sum(s) * (1.f / DM) + EPS);
            GAS unsigned long long* o8 = (GAS unsigned long long*)(F.XN + (size_t)(m0 + r) * DM) + F.lane;
#pragma unroll
            for (int j = 0; j < 4; ++j) { const f32x4 h = v[j] * rstd * s1[j] + sh[j];
                o8[64 * j] = (unsigned long long)pk2(h.x, h.y) | ((unsigned long long)pk2(h.z, h.w) << 32); }
        }
    }
}
struct EpiProj {
    static constexpr bool PERM = true, MID = false;
    bf16_t* O; const float* rope;
    __device__ __forceinline__ void mid(f32x4 (&)[2][2][4][2], const pg8::Unit&, int, int) const {}
    __device__ __forceinline__ void operator()(const f32x4 (&acc)[2][2][4][2], const pg8::Unit& u, int wr, int wc, int fr, int fq) const {
        const int row0 = u.pm * 256 + wr * 64 + fr, col0 = u.pn * 256 + wc * 32 + 8 * fq;
        const float sc = (u.pn < 2 || u.pn == 3 || u.pn == 4) ? C2 : 1.f;
#pragma unroll
        for (int ai = 0; ai < 2; ++ai)
#pragma unroll
            for (int m = 0; m < 4; ++m) { const int row = row0 + ai * 128 + m * 16; bf16_t* rowp = O + (size_t)row * DIN + col0;
#pragma unroll
                for (int bj = 0; bj < 2; ++bj) { f32x4 v0 = acc[ai][bj][m][0], v1 = acc[ai][bj][m][1];
                    const bool rope_tile = (u.pn < 2) || (u.pn == 2 && bj == 0);
                    if (rope_tile && (wc & 1) == 0) {
                        f32x4 o0, o1;
#pragma unroll
                        for (int q = 0; q < 4; ++q) { o0[q] = __shfl_xor(v0[q], 16); o1[q] = __shfl_xor(v1[q], 16); }
                        if (fq < 2) { const int pos = row & (SEQ - 1);
                            const f32x4 c0 = *(const GAS f32x4*)(rope + pos * 8), c1 = *(const GAS f32x4*)(rope + pos * 8 + 4);
                            const f32x4 s0 = *(const GAS f32x4*)(rope + SEQ * 8 + pos * 8), s1 = *(const GAS f32x4*)(rope + SEQ * 8 + pos * 8 + 4);
                            const float sg = fq == 0 ? -1.f : 1.f;
                            v0 = v0 * c0 + (o0 * sg) * s0; v1 = v1 * c1 + (o1 * sg) * s1; }
                    }
                    v0 = v0 * sc; v1 = v1 * sc;
                    u32x4 w; w.x = cvt_pk_bf16(v0[0], v0[1]); w.y = cvt_pk_bf16(v0[2], v0[3]); w.z = cvt_pk_bf16(v1[0], v1[1]); w.w = cvt_pk_bf16(v1[2], v1[3]);
                    *(GAS u32x4*)(rowp + bj * 128) = w; } }
    }
};
__device__ __forceinline__ int crow(int r, int hi) { return (r & 3) + 8 * (r >> 2) + 4 * hi; }
typedef short v4i16_t __attribute__((ext_vector_type(4)));
__device__ __forceinline__ v4i16_t vtr(const LAS unsigned char* p) { return __builtin_amdgcn_ds_read_tr16_b64_v4i16((LAS v4i16_t*)p); }
__device__ __forceinline__ float max3f(float a, float b, float c) { return __builtin_fmaxf(__builtin_fmaxf(a, b), c); }
__device__ __forceinline__ void dma_k(const bf16_t* Ktile  , LAS unsigned char* slot, int p, int lane) {
    __builtin_amdgcn_global_load_lds((const unsigned*)(Ktile + (size_t)lane * DIN + p * 8), (LAS unsigned*)(slot + p * 1024), 16, 0, 0);
}
__device__ __forceinline__ void dma_v(const bf16_t* Vtile, LAS unsigned char* slot, int p, int lane) {
    __builtin_amdgcn_global_load_lds((const unsigned*)(Vtile + (size_t)(16 * (p & 3) + (lane >> 2)) * DIN + (p >> 2) * 32 + (lane & 3) * 8), (LAS unsigned*)(slot + p * 1024), 16, 0, 0);
}
struct AttnState { float m, l; f32x16 o[2]; };
template <class MB>
__device__ __forceinline__ void attn_tile(const LAS unsigned char* Ks, const LAS unsigned char* Vs, const bf16x8 (&qr)[4], AttnState& st, int r32, int hi, int lane, const MB& mb) {
    f32x16 p0, p1;
#pragma unroll
    for (int r = 0; r < 16; ++r) { p0[r] = 0.f; p1[r] = 0.f; }
    const LAS unsigned char* kb = Ks + hi * 1024 + r32 * 16;
#pragma unroll
    for (int d0 = 0; d0 < 4; ++d0) {
        const bf16x8 a0 = *(const LAS bf16x8*)(kb + d0 * 2048), a1 = *(const LAS bf16x8*)(kb + d0 * 2048 + 512);
        p0 = __builtin_amdgcn_mfma_f32_32x32x16_bf16(a0, qr[d0], p0, 0, 0, 0);
        p1 = __builtin_amdgcn_mfma_f32_32x32x16_bf16(a1, qr[d0], p1, 0, 0, 0);
    }
    mb(p0, p1, r32, hi);
    float a = max3f(p0[0], p0[1], p1[0]), b = max3f(p0[2], p0[3], p1[1]); a = max3f(a, p1[2], p1[3]);
#pragma unroll
    for (int r = 4; r < 16; r += 4) { a = max3f(a, p0[r], p0[r + 1]); b = max3f(b, p0[r + 2], p0[r + 3]); a = max3f(a, p1[r], p1[r + 1]); b = max3f(b, p1[r + 2], p1[r + 3]); }
    float rm = __builtin_fmaxf(a, b);
    rm = __builtin_fmaxf(rm, __shfl_xor(rm, 32));
    const float mn = __builtin_fmaxf(st.m, rm), f = __builtin_amdgcn_exp2f(st.m - mn);
    st.m = mn;
    float ls = 0.f;
#pragma unroll
    for (int r = 0; r < 16; ++r) { p0[r] = __builtin_amdgcn_exp2f(p0[r] - mn); p1[r] = __builtin_amdgcn_exp2f(p1[r] - mn); ls += p0[r] + p1[r]; }
    st.l = st.l * f + ls;
#pragma unroll
    for (int r = 0; r < 16; ++r) { st.o[0][r] *= f; st.o[1][r] *= f; }
    u32x4 pw[4];
#pragma unroll
    for (int q = 0; q < 4; ++q) { pw[0][q] = cvt_pk_bf16(p0[2 * q], p0[2 * q + 1]); pw[1][q] = cvt_pk_bf16(p0[8 + 2 * q], p0[8 + 2 * q + 1]);
                                  pw[2][q] = cvt_pk_bf16(p1[2 * q], p1[2 * q + 1]); pw[3][q] = cvt_pk_bf16(p1[8 + 2 * q], p1[8 + 2 * q + 1]); }
    const LAS unsigned char* vb = Vs + ((lane >> 4) & 1) * 32 + (lane & 3) * 8 + (4 * hi + ((lane & 15) >> 2)) * 64;
#pragma unroll
    for (int d0 = 0; d0 < 2; ++d0)
#pragma unroll
        for (int s = 0; s < 4; ++s) {
            const v4i16_t lo = vtr(vb + d0 * 4096 + s * 1024), hh = vtr(vb + d0 * 4096 + s * 1024 + 512);
            const bf16x8 vf = (bf16x8){lo[0], lo[1], lo[2], lo[3], hh[0], hh[1], hh[2], hh[3]};
            st.o[d0] = __builtin_amdgcn_mfma_f32_32x32x16_bf16(vf, __builtin_bit_cast(bf16x8, pw[s]), st.o[d0], 0, 0, 0);
        }
}
__device__ __forceinline__ void attn_finish(AttnState& st, bf16_t* Orow  , float* ssqp, int hi) {
    float l = st.l; l += __shfl_xor(l, 32);
    const float inv = 1.0f / l;
    float sq = 0.f;
#pragma unroll
    for (int d0 = 0; d0 < 2; ++d0)
#pragma unroll
        for (int rg = 0; rg < 4; ++rg) {
            const float v0 = st.o[d0][4 * rg] * inv, v1 = st.o[d0][4 * rg + 1] * inv, v2 = st.o[d0][4 * rg + 2] * inv, v3 = st.o[d0][4 * rg + 3] * inv;
            sq += (v0 * v0 + v1 * v1) + (v2 * v2 + v3 * v3);
            u32x2 w; w.x = cvt_pk_bf16(v0, v1); w.y = cvt_pk_bf16(v2, v3);
            *(GAS u32x2*)(Orow + 32 * d0 + 8 * rg + 4 * hi) = w;
        }
    sq += __shfl_xor(sq, 32);
    if (hi == 0) atomicAdd(ssqp, sq);
}
struct MbNone { __device__ __forceinline__ void operator()(f32x16&, f32x16&, int, int) const {} };
struct MbBandLo { int qi;
    __device__ __forceinline__ void operator()(f32x16& p0, f32x16& p1, int, int hi) const {
#pragma unroll
        for (int r = 0; r < 16; ++r) { const int kj = crow(r, hi); p0[r] = (kj >= qi) ? p0[r] : -1e30f; p1[r] = (kj + 32 >= qi) ? p1[r] : -1e30f; } } };
struct MbBandHi { int qi;
    __device__ __forceinline__ void operator()(f32x16& p0, f32x16& p1, int, int hi) const {
#pragma unroll
        for (int r = 0; r < 16; ++r) { const int kj = crow(r, hi); p0[r] = (kj <= qi) ? p0[r] : -1e30f; p1[r] = (kj + 32 <= qi) ? p1[r] : -1e30f; } } };
struct MbNeigh { const LAS float* tab; int qc, cs;
    __device__ __forceinline__ void operator()(f32x16& p0, f32x16& p1, int, int hi) const {
#pragma unroll
        for (int r = 0; r < 16; ++r) { const int kc = crow(r, hi);
            { const int dc = kc - qc + 15; const float bv = tab[dc & 31]; p0[r] = (kc >= cs && kc < cs + 16) ? p0[r] + bv : -1e30f; }
            { const int dc = kc + 32 - qc + 15; const float bv = tab[dc & 31]; p1[r] = (kc + 32 >= cs && kc + 32 < cs + 16) ? p1[r] + bv : -1e30f; } } } };

__device__ __forceinline__ void attn_a_phase(Frame& F) {
    const int wave = F.wave, lane = F.lane, r32 = lane & 31, hi = lane >> 5, g = wave >> 1, qh = wave & 1;
    for (int u = F.vcu; u < NB * AKVH * (SEQ / 64); u += F.G) {
        const int qblk = u % (SEQ / 64), kvh = (u / (SEQ / 64)) % AKVH, b = u / ((SEQ / 64) * AKVH);
        const int q0 = qblk * 64, h = kvh * 4 + g;
        const bf16_t* base = F.PROJ + (size_t)b * SEQ * DIN;
        asm volatile("s_waitcnt lgkmcnt(0)" ::: "memory"); __builtin_amdgcn_s_barrier();
#pragma unroll
        for (int t = 0; t < 5; ++t) { const int k0 = q0 - 128 + 64 * t;
            if (k0 >= 0 && k0 < SEQ) { dma_k(base + (size_t)k0 * DIN + OFF_KA + kvh * HD, F.lds + t * 8192, wave, lane); dma_v(base + (size_t)k0 * DIN + OFF_VA + kvh * HD, F.lds + 40960 + t * 8192, wave, lane); } }
        const bf16_t* qp = base + (size_t)(q0 + qh * 32 + r32) * DIN + OFF_QA + h * HD + hi * 8;
        bf16x8 qr[4];
#pragma unroll
        for (int d0 = 0; d0 < 4; ++d0) qr[d0] = *(const GAS bf16x8*)(qp + d0 * 16);
        AttnState st; st.m = F.sink[h] * LOG2E; st.l = (hi == 0) ? 1.f : 0.f;
#pragma unroll
        for (int r = 0; r < 16; ++r) { st.o[0][r] = 0.f; st.o[1][r] = 0.f; }
        asm volatile("s_waitcnt vmcnt(0)" ::: "memory"); __builtin_amdgcn_s_barrier();
        const int qi = qh * 32 + r32;
        if (q0 - 128 >= 0) attn_tile(F.lds, F.lds + 40960, qr, st, r32, hi, lane, MbBandLo{qi});
        if (q0 - 64 >= 0) attn_tile(F.lds + 8192, F.lds + 40960 + 8192, qr, st, r32, hi, lane, MbNone{});
        attn_tile(F.lds + 2 * 8192, F.lds + 40960 + 2 * 8192, qr, st, r32, hi, lane, MbNone{});
        if (q0 + 64 < SEQ) attn_tile(F.lds + 3 * 8192, F.lds + 40960 + 3 * 8192, qr, st, r32, hi, lane, MbNone{});
        if (q0 + 128 < SEQ) attn_tile(F.lds + 4 * 8192, F.lds + 40960 + 4 * 8192, qr, st, r32, hi, lane, MbBandHi{qi});
        const int tok = b * SEQ + q0 + qi;
        attn_finish(st, F.O + (size_t)tok * DM + h * HD, F.ssq + tok * 2, hi);
    }
}
constexpr int NTAB_OFF = LDSCTL_OFF + 2048;
__device__ __forceinline__ void attn_b_phase(Frame& F) {
    const int wave = F.wave, lane = F.lane, r32 = lane & 31, hi = lane >> 5, hj = wave >> 1, qh = wave & 1;
    LAS float* tab = (LAS float*)(F.lds + NTAB_OFF);
    int cur_hg = -1;
    for (int u = F.vcu; u < NB * 2 * GW; u += F.G) {
        const int r = u % GW, hg = (u / GW) % 2, b = u / (GW * 2);
        const int head = hg * 4 + hj, rs = min(max(r - NAR / 2, 0), GW - NAR);
        const bf16_t* base = F.PROJ + (size_t)b * SEQ * DIN;
        asm volatile("s_waitcnt lgkmcnt(0)" ::: "memory"); __builtin_amdgcn_s_barrier();
        if (hg != cur_hg) { cur_hg = hg;
            for (int i = F.tid; i < 4 * 15 * 32; i += NWAVES * 64) { const int dc = i & 31, ro = (i >> 5) % 15, hh = i / (15 * 32);
                tab[i] = (dc < 31) ? F.rpb[((hg * 4 + hh) * 15 + ro) * 31 + dc] * LOG2E : 0.f; }
            asm volatile("s_waitcnt lgkmcnt(0)" ::: "memory"); }
#define NB_DMA(t) do { const int _bs = ((t) & 1) * 65536 + hj * 16384; const bf16_t* _kr = base + (size_t)((rs + (t)) * GW) * DIN; \
        _Pragma("unroll") for (int _p = 0; _p < 4; ++_p) { dma_k(_kr + OFF_KB + head * HD, F.lds + _bs, 4 * qh + _p, lane); dma_v(_kr + OFF_VB + head * HD, F.lds + _bs + 8192, 4 * qh + _p, lane); } } while (0)
        NB_DMA(0);
        const int qc = qh * 32 + r32, cs = min(max(qc - NAC / 2, 0), GW - NAC);
        const bf16_t* qp = base + (size_t)(r * GW + qc) * DIN + OFF_QB + head * HD + hi * 8;
        bf16x8 qr[4];
#pragma unroll
        for (int d0 = 0; d0 < 4; ++d0) qr[d0] = *(const GAS bf16x8*)(qp + d0 * 16);
        AttnState st; st.m = -1e30f; st.l = 0.f;
#pragma unroll
        for (int q = 0; q < 16; ++q) { st.o[0][q] = 0.f; st.o[1][q] = 0.f; }
        for (int t = 0; t < NAR; ++t) {
            if (t + 1 < NAR) { NB_DMA(t + 1); asm volatile("s_waitcnt vmcnt(8)" ::: "memory"); }
            else asm volatile("s_waitcnt vmcnt(0)" ::: "memory");
            __builtin_amdgcn_s_barrier();
            const LAS unsigned char* ks = F.lds + (t & 1) * 65536 + hj * 16384;
            attn_tile(ks, ks + 8192, qr, st, r32, hi, lane, MbNeigh{tab + (hj * 15 + (rs + t - r + NAR - 1)) * 32, qc, cs});
            asm volatile("s_waitcnt lgkmcnt(0)" ::: "memory"); __builtin_amdgcn_s_barrier();
        }
#undef NB_DMA
        const int tok = b * SEQ + r * GW + qc;
        attn_finish(st, F.O + (size_t)tok * DM + AQW + head * HD, F.ssq + tok * 2 + 1, hi);
    }
}
struct EpiX1 {
    static constexpr bool PERM = false, MID = true;
    const float* x; float* x1; const float* mod; const float* ssq;
    __device__ __forceinline__ void mid(f32x4 (&acc)[2][2][4][2], const pg8::Unit& u, int wr, int fr) const {
#pragma unroll
        for (int ai = 0; ai < 2; ++ai)
#pragma unroll
            for (int m = 0; m < 4; ++m) { const int row = u.pm * 256 + ai * 128 + wr * 64 + m * 16 + fr;
                const f32x2 s = *(const GAS f32x2*)(ssq + row * 2);
                const float f = sqrtf((s.y * (1.f / 512.f) + EPS) / (s.x * (1.f / 512.f) + EPS));
#pragma unroll
                for (int bj = 0; bj < 2; ++bj)
#pragma unroll
                    for (int n = 0; n < 2; ++n) acc[ai][bj][m][n] *= f; }
    }
    __device__ __forceinline__ void operator()(const f32x4 (&acc)[2][2][4][2], const pg8::Unit& u, int wr, int wc, int fr, int fq) const {
        const int b = (u.pm * 256) / SEQ, col0 = u.pn * 256 + wc * 32 + 4 * fq;
        f32x4 gm[2][2];
#pragma unroll
        for (int bj = 0; bj < 2; ++bj)
#pragma unroll
            for (int n = 0; n < 2; ++n) gm[bj][n] = *(const GAS f32x4*)(mod + b * 6 * DM + 2 * DM + col0 + bj * 128 + n * 16);
#pragma unroll
        for (int ai = 0; ai < 2; ++ai)
#pragma unroll
            for (int m = 0; m < 4; ++m) { const int row = u.pm * 256 + ai * 128 + wr * 64 + m * 16 + fr;
                const float rb = 1.0f / sqrtf(ssq[row * 2 + 1] * (1.f / 512.f) + EPS);
                const size_t off = (size_t)row * DM + col0;
#pragma unroll
                for (int bj = 0; bj < 2; ++bj)
#pragma unroll
                    for (int n = 0; n < 2; ++n) { const f32x4 xr = *(const GAS f32x4*)(x + off + bj * 128 + n * 16);
                        *(GAS f32x4*)(x1 + off + bj * 128 + n * 16) = xr + gm[bj][n] * (acc[ai][bj][m][n] * rb); } }
    }
};

__device__ __forceinline__ void router_phase(Frame& F) {
    const int wave = F.wave, lane = F.lane, r32 = lane & 31, hi = lane >> 5;
    bf16x8 wh[8], wl[8];
#pragma unroll
    for (int c = 0; c < 8; ++c) { const bf16_t* p = F.wr_t + r32 * DM + 128 * wave + 16 * c + 8 * hi; wh[c] = *(const GAS bf16x8*)p; wl[c] = *(const GAS bf16x8*)(p + NE * DM); }
    LAS float* part = (LAS float*)(F.lds);
    LAS float* R = (LAS float*)(F.lds + 1024);
    LAS float* L = (LAS float*)(F.lds + 1024 + 32768);
    LAS int* lcnt = (LAS int*)(F.lds + 1024 + 32768 + 4352);
    const float* x1 = F.out;
    for (int it = F.vcu; it < NTOK / 32; it += F.G) {
        const int t0 = it * 32, b = t0 / SEQ, tok = t0 + r32;
        const float* xp = x1 + (size_t)tok * DM + 128 * wave + 8 * hi;
        f32x4 xa[8], xb[8]; float s = 0.f;
#pragma unroll
        for (int c = 0; c < 8; ++c) { xa[c] = *(const GAS f32x4*)(xp + 16 * c); xb[c] = *(const GAS f32x4*)(xp + 16 * c + 4);
            s += (xa[c].x * xa[c].x + xa[c].y * xa[c].y) + (xa[c].z * xa[c].z + xa[c].w * xa[c].w) + (xb[c].x * xb[c].x + xb[c].y * xb[c].y) + (xb[c].z * xb[c].z + xb[c].w * xb[c].w); }
        s += __shfl_xor(s, 32);
        if (hi == 0) part[wave * 32 + r32] = s;
        if (F.tid < 32) lcnt[F.tid] = 0;
        asm volatile("s_waitcnt lgkmcnt(0)" ::: "memory"); __builtin_amdgcn_s_barrier(); asm volatile("" ::: "memory");
        float tot = 0.f;
#pragma unroll
        for (int w = 0; w < 8; ++w) tot += part[w * 32 + r32];
        const float rstd = 1.0f / sqrtf(tot * (1.f / DM) + EPS);
        f32x16 acc;
#pragma unroll
        for (int r = 0; r < 16; ++r) acc[r] = 0.f;
        const float* mp = F.mod + b * 6 * DM + 128 * wave + 8 * hi;
        bf16_t* xnp = F.XN + (size_t)tok * DM + 128 * wave + 8 * hi;
#pragma unroll
        for (int c = 0; c < 8; ++c) {
            const f32x4 sc0 = *(const GAS f32x4*)(mp + 4 * DM + 16 * c), sc1 = *(const GAS f32x4*)(mp + 4 * DM + 16 * c + 4);
            const f32x4 sh0 = *(const GAS f32x4*)(mp + 3 * DM + 16 * c), sh1 = *(const GAS f32x4*)(mp + 3 * DM + 16 * c + 4);
            const f32x4 h0 = xa[c] * rstd * (sc0 + 1.0f) + sh0, h1 = xb[c] * rstd * (sc1 + 1.0f) + sh1;
            u32x4 hw; hw.x = pk2(h0.x, h0.y); hw.y = pk2(h0.z, h0.w); hw.z = pk2(h1.x, h1.y); hw.w = pk2(h1.z, h1.w);
            u32x4 lw;
            lw.x = pk2(h0.x - bf2f(hw.x & 0xffffu), h0.y - bf2f(hw.x >> 16)); lw.y = pk2(h0.z - bf2f(hw.y & 0xffffu), h0.w - bf2f(hw.y >> 16));
            lw.z = pk2(h1.x - bf2f(hw.z & 0xffffu), h1.y - bf2f(hw.z >> 16)); lw.w = pk2(h1.z - bf2f(hw.w & 0xffffu), h1.w - bf2f(hw.w >> 16));
            *(GAS u32x4*)(xnp + 16 * c) = hw;
            const bf16x8 hf = __builtin_bit_cast(bf16x8, hw), lf = __builtin_bit_cast(bf16x8, lw);
            acc = __builtin_amdgcn_mfma_f32_32x32x16_bf16(hf, wh[c], acc, 0, 0, 0);
            acc = __builtin_amdgcn_mfma_f32_32x32x16_bf16(lf, wh[c], acc, 0, 0, 0);
            acc = __builtin_amdgcn_mfma_f32_32x32x16_bf16(hf, wl[c], acc, 0, 0, 0);
        }
#pragma unroll
        for (int r = 0; r < 16; ++r) R[wave * 1024 + crow(r, hi) * 32 + r32] = acc[r];
        asm volatile("s_waitcnt lgkmcnt(0)" ::: "memory"); __builtin_amdgcn_s_barrier(); asm volatile("" ::: "memory");
#pragma unroll
        for (int q = 0; q < 2; ++q) { const int idx = F.tid * 2 + q, tk = idx >> 5, e = idx & 31; float v = F.b_router[e];
#pragma unroll
            for (int w = 0; w < 8; ++w) v += R[w * 1024 + idx];
            L[tk * 33 + e] = v; }
        asm volatile("s_waitcnt lgkmcnt(0)" ::: "memory"); __builtin_amdgcn_s_barrier(); asm volatile("" ::: "memory");
        if (wave == 0) {
            int sel[TOPK]; float gt[TOPK]; int lpos[TOPK];
            if (lane < 32) {
                float v[NE];
#pragma unroll
                for (int j = 0; j < NE; ++j) v[j] = L[lane * 33 + j];
                unsigned used = 0u; float sv[TOPK];
#pragma unroll
                for (int kk = 0; kk < TOPK; ++kk) { float best = -INFINITY; int bi = 0;
#pragma unroll
                    for (int j = 0; j < NE; ++j) { const bool ok = !((used >> j) & 1u) && (v[j] > best); best = ok ? v[j] : best; bi = ok ? j : bi; }
                    used |= 1u << bi; sel[kk] = bi; sv[kk] = best; }
                float den = 0.f;
#pragma unroll
                for (int kk = 0; kk < TOPK; ++kk) { gt[kk] = __expf(sv[kk] - sv[0]); den += gt[kk]; }
                const float rden = 1.0f / den;
#pragma unroll
                for (int kk = 0; kk < TOPK; ++kk) { gt[kk] *= rden; lpos[kk] = __hip_atomic_fetch_add(lcnt + sel[kk], 1, __ATOMIC_RELAXED, __HIP_MEMORY_SCOPE_WORKGROUP); }
            }
            asm volatile("s_waitcnt lgkmcnt(0)" ::: "memory");
            if (lane < 32) { const int n = lcnt[lane]; int base = 0;
                if (n > 0) base = (int)__hip_atomic_fetch_add((unsigned*)(F.ctl + CW_CNT + lane * 64), (unsigned)n, __ATOMIC_RELAXED, __HIP_MEMORY_SCOPE_AGENT);
                lcnt[32 + lane] = base; }
            asm volatile("s_waitcnt vmcnt(0) lgkmcnt(0)" ::: "memory");
            if (lane < 32) {
                const int t = t0 + lane;
#pragma unroll
                for (int kk = 0; kk < TOPK; ++kk) { const int e = sel[kk], pos = lcnt[32 + e] + lpos[kk];
                    F.tke[t * 4 + kk] = e * 65536 + pos; F.tkg[t * 4 + kk] = gt[kk]; F.list[e * NTOK + pos] = t; }
            }
        }
    }
}

__device__ __forceinline__ void moe_table(Frame& F) {
    LAS int* tab = (LAS int*)(F.lds + TAB_OFF);
    if (F.tid == 0) { int s = 0;
        for (int e = 0; e < NE; ++e) { const int c = (int)__hip_atomic_load((unsigned*)(F.ctl + CW_CNT + e * 64), __ATOMIC_RELAXED, __HIP_MEMORY_SCOPE_AGENT); tab[e] = s; tab[40 + e] = c; s += (c + 255) >> 8; }
        tab[32] = s; }
    asm volatile("s_waitcnt vmcnt(0) lgkmcnt(0)" ::: "memory"); __syncthreads();
}
template <bool GATHER>
struct MoeOrder {
    const char* A; const char* Bt; const int* list; const LAS int* tab; int K, N, nN, G, c;
    __device__ bool next(int i, pg8::Unit& u) const {
        const int L = i * G + c; if (L >= tab[32] * nN) return false;
        int e = 0;
#pragma unroll 1
        for (int q = 1; q < NE; ++q) e = (L >= tab[q] * nN) ? q : e;
        const int nm = tab[e + 1] - tab[e], ql = L - tab[e] * nN;
        u.e = e; u.pn = ql / nm; u.aux = ql % nm; u.pm = tab[e] + u.aux; return true;
    }
    __device__ __forceinline__ const char* abase() const { return A; }
    __device__ __forceinline__ const char* bbase(const pg8::Unit& u) const { return Bt + ((size_t)u.e * N + (size_t)u.pn * 256) * K * 2; }
    __device__ __forceinline__ void aoffs(const pg8::Unit& u, const int (&R)[2], const int (&C)[2], unsigned (&off)[4]) const {
        if (GATHER) { const int cnt = tab[40 + u.e];
#pragma unroll
            for (int h = 0; h < 2; ++h)
#pragma unroll
                for (int i = 0; i < 2; ++i) { int mi = u.aux * 256 + h * 128 + R[i]; mi = mi < cnt ? mi : cnt - 1; const int tk = list[u.e * NTOK + mi]; off[h * 2 + i] = (unsigned)(tk * K + C[i]) * 2u; }
        } else {
#pragma unroll
            for (int h = 0; h < 2; ++h)
#pragma unroll
                for (int i = 0; i < 2; ++i) off[h * 2 + i] = (unsigned)((u.pm * 256 + h * 128 + R[i]) * K + C[i]) * 2u;
        }
    }
};
struct EpiSwiglu {
    static constexpr bool PERM = true, MID = false;
    bf16_t* act; const float* bgu;
    __device__ __forceinline__ void mid(f32x4 (&)[2][2][4][2], const pg8::Unit&, int, int) const {}
    __device__ __forceinline__ void operator()(const f32x4 (&acc)[2][2][4][2], const pg8::Unit& u, int wr, int wc, int fr, int fq) const {
        const int f0 = u.pn * 128 + wc * 32 + 8 * fq, row0 = u.pm * 256 + wr * 64 + fr;
        const float* bp = bgu + (size_t)u.e * 2 * DFF + f0;
        const f32x4 bg0 = *(const GAS f32x4*)bp, bg1 = *(const GAS f32x4*)(bp + 4), bu0 = *(const GAS f32x4*)(bp + DFF), bu1 = *(const GAS f32x4*)(bp + DFF + 4);
#pragma unroll
        for (int ai = 0; ai < 2; ++ai)
#pragma unroll
            for (int m = 0; m < 4; ++m) { const int row = row0 + ai * 128 + m * 16;
                float o[8];
#pragma unroll
                for (int q = 0; q < 8; ++q) { float g = (q < 4 ? acc[ai][0][m][0][q] + bg0[q] : acc[ai][0][m][1][q - 4] + bg1[q - 4]);
                    float up = (q < 4 ? acc[ai][1][m][0][q] + bu0[q] : acc[ai][1][m][1][q - 4] + bu1[q - 4]);
                    g = __builtin_fminf(g, 7.f); up = __builtin_fminf(__builtin_fmaxf(up, -7.f), 7.f);
                    const float glu = g * __builtin_amdgcn_rcpf(1.f + __builtin_amdgcn_exp2f(-1.702f * LOG2E * g));
                    o[q] = (up + 1.f) * glu; }
                u32x4 w; w.x = cvt_pk_bf16(o[0], o[1]); w.y = cvt_pk_bf16(o[2], o[3]); w.z = cvt_pk_bf16(o[4], o[5]); w.w = cvt_pk_bf16(o[6], o[7]);
                *(GAS u32x4*)(act + (size_t)row * DFF + f0) = w; }
    }
};
struct EpiYs {
    static constexpr bool PERM = true, MID = false;
    bf16_t* ys; const float* bd;
    __device__ __forceinline__ void mid(f32x4 (&)[2][2][4][2], const pg8::Unit&, int, int) const {}
    __device__ __forceinline__ void operator()(const f32x4 (&acc)[2][2][4][2], const pg8::Unit& u, int wr, int wc, int fr, int fq) const {
        const int col0 = u.pn * 256 + wc * 32 + 8 * fq, row0 = u.pm * 256 + wr * 64 + fr;
        f32x4 bv[2][2];
#pragma unroll
        for (int bj = 0; bj < 2; ++bj)
#pragma unroll
            for (int n = 0; n < 2; ++n) bv[bj][n] = *(const GAS f32x4*)(bd + (size_t)u.e * DM + col0 + bj * 128 + 4 * n);
#pragma unroll
        for (int ai = 0; ai < 2; ++ai)
#pragma unroll
            for (int m = 0; m < 4; ++m) { bf16_t* rowp = ys + (size_t)(row0 + ai * 128 + m * 16) * DM + col0;
#pragma unroll
                for (int bj = 0; bj < 2; ++bj) { const f32x4 v0 = acc[ai][bj][m][0] + bv[bj][0], v1 = acc[ai][bj][m][1] + bv[bj][1];
                    u32x4 w; w.x = cvt_pk_bf16(v0[0], v0[1]); w.y = cvt_pk_bf16(v0[2], v0[3]); w.z = cvt_pk_bf16(v1[0], v1[1]); w.w = cvt_pk_bf16(v1[2], v1[3]);
                    *(GAS u32x4*)(rowp + bj * 128) = w; } }
    }
};
__device__ __forceinline__ void final_phase(Frame& F) {
    const LAS int* tab = (const LAS int*)(F.lds + TAB_OFF);
    const int gw = F.vcu * NWAVES + F.wave, NGW = F.G * NWAVES, lane = F.lane;
    f32x4 gf[4];
#pragma unroll
    for (int j = 0; j < 4; ++j) gf[j] = *(const GAS f32x4*)(F.g_final + 4 * lane + 256 * j);
    for (int chunk = gw; chunk < NTOK / 16; chunk += NGW) {
        const int m0 = chunk * 16, b = m0 / SEQ;
        f32x4 gfm[4];
#pragma unroll
        for (int j = 0; j < 4; ++j) gfm[j] = *(const GAS f32x4*)(F.mod + b * 6 * DM + 5 * DM + 4 * lane + 256 * j);
        for (int r = 0; r < 16; ++r) { const int t = m0 + r;
            const GAS f32x4* xr = (const GAS f32x4*)(F.out + (size_t)t * DM) + lane;
            f32x4 y[4];
#pragma unroll
            for (int j = 0; j < 4; ++j) y[j] = (f32x4){0.f, 0.f, 0.f, 0.f};
#pragma unroll
            for (int kk = 0; kk < TOPK; ++kk) { const int ep = F.tke[t * 4 + kk]; const float g = F.tkg[t * 4 + kk]; const int slot = tab[ep >> 16] * 256 + (ep & 0xffff);
                const GAS u32x2* yr = (const GAS u32x2*)(F.YS + (size_t)slot * DM) + lane;
#pragma unroll
                for (int j = 0; j < 4; ++j) { const u32x2 w = yr[64 * j];
                    y[j] += (f32x4){bf2f(w.x & 0xffffu), bf2f(w.x >> 16), bf2f(w.y & 0xffffu), bf2f(w.y >> 16)} * g; } }
            f32x4 v[4]; float s = 0.f;
#pragma unroll
            for (int j = 0; j < 4; ++j) { v[j] = xr[64 * j] + gfm[j] * y[j]; s += (v[j].x * v[j].x + v[j].y * v[j].y) + (v[j].z * v[j].z + v[j].w * v[j].w); }
            const float rstd = 1.f / sqrtf(wave_sum(s) * (1.f / DM) + EPS);
            GAS f32x4* orow = (GAS f32x4*)(F.out + (size_t)t * DM) + lane;
#pragma unroll
            for (int j = 0; j < 4; ++j) orow[64 * j] = v[j] * rstd * gf[j];
        }
    }
}
struct MkArgs { const float* in[17]; float* out; unsigned char* ws; int ph_lo, ph_hi; };
#ifndef DBG_STAGE
#define DBG_STAGE 9
#endif
constexpr int N_PHASES = DBG_STAGE;
__global__ void __launch_bounds__(NWAVES * 64, 2) mk_fwd(MkArgs args) {
    extern __shared__ __attribute__((aligned(16))) unsigned char lds[];
    Frame F;
    F.lds = (LAS unsigned char*)lds;
    F.MISC = (volatile LAS unsigned*)(F.lds + MISC_OFF);
    F.tid = threadIdx.x; F.lane = F.tid & 63; F.wave = __builtin_amdgcn_readfirstlane(F.tid >> 6);
    F.G = gridDim.x; { const int bx = blockIdx.x; F.vcu = (F.G % 8 == 0) ? (bx % 8) * (F.G / 8) + bx / 8 : bx; }
    unsigned char* ws = args.ws;
    F.ctl = (gu32*)(ws + WS_CTL);
    F.x = args.in[0]; F.c = args.in[1]; F.w_ada = args.in[2]; F.b_ada = args.in[3]; F.w_in = args.in[4]; F.sink = args.in[5]; F.rpb = args.in[6]; F.ga = args.in[7]; F.gb = args.in[8];
    F.w_out = args.in[9]; F.w_router = args.in[10]; F.b_router = args.in[11]; F.w_gu = args.in[12]; F.b_gu = args.in[13]; F.w_down = args.in[14]; F.b_down = args.in[15]; F.g_final = args.in[16];
    F.out = args.out;
    F.mod = (float*)(ws + WS_MOD); F.rope = (float*)(ws + WS_ROPE); F.ssq = (float*)(ws + WS_SSQ); F.tkg = (float*)(ws + WS_TKG); F.tke = (int*)(ws + WS_TKE); F.list = (int*)(ws + WS_LIST);
    F.wr_t = (bf16_t*)(ws + WS_WR); F.win_t = (bf16_t*)(ws + WS_WIN); F.wout_t = (bf16_t*)(ws + WS_WOUT); F.wgu_t = (bf16_t*)(ws + WS_WGU); F.wd_t = (bf16_t*)(ws + WS_WD);
    F.XN = (bf16_t*)(ws + WS_XN); F.PROJ = (bf16_t*)(ws + WS_PROJ); F.O = (bf16_t*)(ws + WS_O); F.YS = (bf16_t*)(ws + WS_YS); F.ACT = (bf16_t*)(ws + WS_ACT);
    for (int u = F.tid; u < (LDS_BYTES - LDSCTL_OFF) / 4; u += NWAVES * 64) ((LAS unsigned*)(F.lds + LDSCTL_OFF))[u] = 0u;
    __syncthreads();
    const int lo = args.ph_lo, hi = args.ph_hi;
    XcdBarrier bar; bar.bar = (unsigned*)(F.ctl + CW_BAR); bar.x = 0; bar.st = nullptr;
    if (hi - lo > 1) bar = xcd_barrier_post((unsigned*)(F.ctl + CW_BAR), F.MISC + 8);
#define IN(k) (lo <= (k) && (k) < hi)
#define SEAM(k) do { if (IN(k) && IN((k) + 1)) xcd_barrier(bar); } while (0)
    if (IN(0)) { p0_prologue(F); } SEAM(0);
    if (IN(1)) { p1_xn(F); } SEAM(1);
    if (IN(2)) {
        pg8::DenseOrder S; S.init(F.XN, F.win_t, NTOK, DIN, DM, F.G, (int)blockIdx.x);
        EpiProj E{F.PROJ, F.rope};
        pg8::gemm_phase<EpiProj, pg8::DenseOrder, true>(F.lds, DM, S, E);
    } SEAM(2);
    if (IN(3)) { attn_a_phase(F); attn_b_phase(F); } SEAM(3);
    if (IN(4)) {
        pg8::DenseOrder S; S.init(F.O, F.wout_t, NTOK, DM, DM, F.G, (int)blockIdx.x);
        EpiX1 E{F.x, F.out, F.mod, F.ssq};
        pg8::gemm_phase<EpiX1, pg8::DenseOrder, true>(F.lds, DM, S, E);
    } SEAM(4);
    if (IN(5)) { router_phase(F); } SEAM(5);
    if (IN(6)) {
        moe_table(F);
        MoeOrder<true> S{(const char*)F.XN, (const char*)F.wgu_t, F.list, (const LAS int*)(F.lds + TAB_OFF), DM, 2 * DFF, 2 * DFF / 256, F.G, F.vcu};
        EpiSwiglu E{F.ACT, F.b_gu};
        pg8::gemm_phase<EpiSwiglu, MoeOrder<true>, true>(F.lds, DM, S, E);
    } SEAM(6);
    if (IN(7)) {
        moe_table(F);
        MoeOrder<false> S{(const char*)F.ACT, (const char*)F.wd_t, nullptr, (const LAS int*)(F.lds + TAB_OFF), DFF, DM, DM / 256, F.G, F.vcu};
        EpiYs E{F.YS, F.b_down};
        pg8::gemm_phase<EpiYs, MoeOrder<false>, true>(F.lds, DFF, S, E);
    } SEAM(7);
    if (IN(8)) { moe_table(F); final_phase(F); }
#undef IN
#undef SEAM
}

__global__ void br_route(const bf16_t* XN, const int* tke, const unsigned* ctl, float* h, int* cnt, int* list) {
    const int idx = blockIdx.x * 256 + threadIdx.x;
    const int ep = tke[idx]; list[(ep >> 16) * NTOK + (ep & 0xffff)] = idx;
    if (idx < NE) cnt[idx] = (int)ctl[CW_CNT + idx * 64];
    const int t = idx >> 2, q = idx & 3;
    for (int k = q * 256; k < q * 256 + 256; ++k) h[(size_t)t * DM + k] = bf2f(XN[(size_t)t * DM + k]);
}
extern "C" void kernel_launch(void* const* d_in, const int* in_sizes, int n_in, void* d_out, int out_size, void* d_ws, size_t ws_size, hipStream_t stream) {
    static int grid = 0;
    if (grid == 0) {
        if (n_in != 17 || ws_size < (size_t)1001 * MiB) { fprintf(stderr, "kernel_launch: bad n_in %d or ws_size %zu\n", n_in, ws_size); grid = -1; return; }
        int dev = 0, cus = 0, per_cu = 0;
        if (hipGetDevice(&dev) != hipSuccess || hipDeviceGetAttribute(&cus, hipDeviceAttributeMultiprocessorCount, dev) != hipSuccess) { grid = -1; return; }
        if (hipFuncSetAttribute((const void*)mk_fwd, hipFuncAttributeMaxDynamicSharedMemorySize, LDS_BYTES) != hipSuccess) { fprintf(stderr, "kernel_launch: hipFuncSetAttribute failed\n"); grid = -1; return; }
        if (hipOccupancyMaxActiveBlocksPerMultiprocessor(&per_cu, (const void*)mk_fwd, NWAVES * 64, LDS_BYTES) != hipSuccess || per_cu < 1) { fprintf(stderr, "kernel_launch: occupancy query says %d\n", per_cu); }
        (void)hipGetLastError();
        grid = cus;
    }
    if (grid < 0) return;
    const float* x = (const float*)d_in[0]; const float* sink = (const float*)d_in[5]; const float* rpb = (const float*)d_in[6]; const float* ga = (const float*)d_in[7];
    const float* gb = (const float*)d_in[8]; const float* w_out = (const float*)d_in[9]; const float* w_router = (const float*)d_in[10]; const float* b_router = (const float*)d_in[11];
    const float* w_gu = (const float*)d_in[12]; const float* b_gu = (const float*)d_in[13]; const float* w_down = (const float*)d_in[14]; const float* b_down = (const float*)d_in[15];
    const float* g_final = (const float*)d_in[16];
    char* ws = (char*)d_ws; float* out = (float*)d_out;
    (void)hipMemsetAsync(ws + WS_CTL, 0, CTL_ZERO_BYTES, stream);
    MkArgs a{};
    for (int i = 0; i < 17; ++i) a.in[i] = (const float*)d_in[i];
    a.out = out; a.ws = (unsigned char*)d_ws;
#if defined(MK_PER_PHASE)
    for (int ph = 0; ph < N_PHASES; ++ph) { a.ph_lo = ph; a.ph_hi = ph + 1; hipLaunchKernelGGL(mk_fwd, dim3(grid), dim3(NWAVES * 64), LDS_BYTES, stream, a); }
#else
    a.ph_lo = 0; a.ph_hi = N_PHASES; hipLaunchKernelGGL(mk_fwd, dim3(grid), dim3(NWAVES * 64), LDS_BYTES, stream, a);
#endif
#if DBG_STAGE < 9
    float* mod = (float*)(ws + WS_MOD);
    float* h = (float*)(ws + 17 * MiB);
    float* y = (float*)(ws + 337 * MiB);
    float* act = (float*)(ws + 481 * MiB);
    int* cnt = (int*)(ws + 993 * MiB); int* tke = (int*)(ws + 994 * MiB); float* tkg = (float*)(ws + 995 * MiB); int* list = (int*)(ws + 996 * MiB);
    (void)hipMemsetAsync(cnt, 0, 64 * sizeof(int), stream);
    (void)hipMemsetAsync(y, 0, (size_t)NTOK * DM * 4, stream);
#if DBG_STAGE == 5
    nv_norm_mod<<<NTOK, 256, 0, stream>>>(out, mod, 3 * DM, 4 * DM, h);
    nv_router<<<NTOK, 64, 0, stream>>>(h, w_router, b_router, cnt, tke, tkg, list);
#elif DBG_STAGE == 6
    br_route<<<NTOK * 4 / 256, 256, 0, stream>>>((const bf16_t*)(ws + WS_XN), (const int*)(ws + WS_TKE), (const unsigned*)(ws + WS_CTL), h, cnt, list);
    tkg = (float*)(ws + WS_TKG);
#endif
    nv_offsets<<<1, 64, 0, stream>>>(cnt);
    nv_sgemm<true><<<dim3(DFF / 64, NTOK / 64, NE), 256, 0, stream>>>(w_gu, 2 * DFF, DM, RmMoe1{h, list, cnt, (size_t)DM * 2 * DFF}, EpiMoe1{act, cnt, b_gu});
    nv_sgemm<false><<<dim3(DM / 64, NTOK / 64, NE), 256, 0, stream>>>(w_down, DM, DFF, RmMoe2{act, cnt, (size_t)DFF * DM}, EpiMoe2{y, list, cnt, tkg, b_down});
    nv_final<<<NTOK, 256, 0, stream>>>(out, y, mod, g_final, out);
#endif
}
```

```cpp
#define DBG_STAGE 9
#include <hip/hip_runtime.h>
#include <cstdio>
#include <cstdint>
#include <cmath>

constexpr int DM = 1024, NB = 8, SEQ = 4096, NTOK = NB * SEQ;
constexpr int HD = 64, AQH = 8, AKVH = 2, BH = 8;
constexpr int AQW = 512, AKVW = 128, BW = 512, DIN = 2304;
constexpr int OFF_QA = 0, OFF_KA = 512, OFF_VA = 640, OFF_QB = 768, OFF_KB = 1280, OFF_VB = 1792;
constexpr int WIN = 128, GW = 64, NAR = 8, NAC = 16, NE = 32, TOPK = 4, DFF = 1024;
constexpr float EPS = 1e-5f;
constexpr size_t MiB = 1u << 20;

#define GAS __attribute__((address_space(1)))
#define LAS __attribute__((address_space(3)))
typedef unsigned short bf16_t;
typedef short bf16x8 __attribute__((ext_vector_type(8)));
typedef float f32x4 __attribute__((ext_vector_type(4)));
typedef float f32x2 __attribute__((ext_vector_type(2)));
typedef float f32x16 __attribute__((ext_vector_type(16)));
typedef unsigned u32x4 __attribute__((ext_vector_type(4)));
typedef unsigned u32x2 __attribute__((ext_vector_type(2)));
typedef GAS unsigned gu32;
#define RLX_AGENT __ATOMIC_RELAXED, __HIP_MEMORY_SCOPE_AGENT
#define LDS_WAIT() asm volatile("s_waitcnt lgkmcnt(0)" ::: "memory")
#define VM_WAIT() asm volatile("s_waitcnt vmcnt(0)" ::: "memory")
__device__ __forceinline__ unsigned cvt_pk_bf16(float lo, float hi) { unsigned r; asm volatile("v_cvt_pk_bf16_f32 %0, %1, %2" : "=v"(r) : "v"(lo), "v"(hi)); return r; }
__device__ __forceinline__ unsigned f2bf(float f) { unsigned u = __builtin_bit_cast(unsigned, f); return (u + 0x7fffu + ((u >> 16) & 1u)) >> 16; }
__device__ __forceinline__ unsigned pk2(float lo, float hi) { return f2bf(lo) | (f2bf(hi) << 16); }
__device__ __forceinline__ float bf2f(unsigned h) { return __builtin_bit_cast(float, h << 16); }

constexpr int NWAVES = 8;
__device__ __forceinline__ int lane_id() { int l; asm volatile("v_mbcnt_lo_u32_b32 %0, -1, 0\n\tv_mbcnt_hi_u32_b32 %0, -1, %0" : "=v"(l)); return l; }
constexpr float C2 = 0.125f * 1.4426950408889634f;
constexpr float LOG2E = 1.4426950408889634f;
constexpr int NSLOT_MAX = 139264;

constexpr size_t WS_CTL = 0, CTL_ZERO_BYTES = 1 * MiB;
constexpr size_t WS_MOD = 1 * MiB;
constexpr size_t WS_ROPE = WS_MOD + 256 * 1024;
constexpr size_t WS_WR = WS_ROPE + 256 * 1024;
constexpr size_t WS_SSQ = 2 * MiB;
constexpr size_t WS_TKE = 3 * MiB;
constexpr size_t WS_TKG = 4 * MiB;
constexpr size_t WS_LIST = 5 * MiB;
constexpr size_t WS_WIN = 10 * MiB;
constexpr size_t WS_WOUT = 15 * MiB;
constexpr size_t WS_WGU = 17 * MiB;
constexpr size_t WS_WD = 145 * MiB;
constexpr size_t WS_XN = 209 * MiB;
constexpr size_t WS_PROJ = 273 * MiB;
constexpr size_t WS_O = 417 * MiB;
constexpr size_t WS_YS = 209 * MiB;
constexpr size_t WS_ACT = 481 * MiB;
constexpr size_t WS_MK_END = 753 * MiB;
constexpr int CW_TMO = 0, CW_CNT = 64  , CW_BAR = 4096;

constexpr int RING_BYTES = 131072;
constexpr int LDSCTL_OFF = RING_BYTES, MISC_OFF = LDSCTL_OFF + 320;
constexpr int TAB_OFF = LDSCTL_OFF + 1024;
constexpr int LDS_BYTES = 163840;

namespace pg8 {
constexpr int BM = 256, BK = 64, HALF = 128, HTB = HALF * BK * 2, NXCD = 8, WGM = 8;
__host__ __device__ __forceinline__ int lds_byte(int r, int c) { const int st = (r >> 4) * 2 + (c >> 5), rr = r & 15, cc = c & 31, ob = rr * 64 + cc * 2; return st * 1024 + (ob ^ (((ob >> 9) & 1) << 5)); }
__host__ __device__ __forceinline__ void stage_rc(int b, int& R, int& C) { const int st = b / 1024, sb = b % 1024, swz = sb ^ (((sb >> 9) & 1) << 5); R = (st >> 1) * 16 + swz / 64; C = (st & 1) * 32 + (swz % 64) / 2; }
__host__ __device__ __forceinline__ int perm32(int rho) { const int n = rho >> 4, i = rho & 15; return 8 * (i >> 2) + 4 * n + (i & 3); }

struct Unit { int pm, pn, e, aux; };

struct DenseOrder {
    const char* A; const char* Bt; int K; int nM, nN, nwg, G, c;
    __device__ void init(const void* A_, const void* Bt_, int M, int N, int K_, int G_, int c_) { A = (const char*)A_; Bt = (const char*)Bt_; K = K_; nM = M / BM; nN = N / BM; nwg = nM * nN; G = G_; c = c_; }
    __device__ bool next(int i, Unit& u) const {
        const long L = (long)i * G + c; if (L >= nwg) return false;
        int wgid = (int)L; { const int q = nwg / NXCD, r = nwg % NXCD, xcd = wgid % NXCD, off = wgid / NXCD; wgid = (xcd < r ? xcd * (q + 1) : r * (q + 1) + (xcd - r) * q) + off; }
        const int nig = WGM * nN, gid = wgid / nig, fm = gid * WGM, gsz = (nM - fm) < WGM ? (nM - fm) : WGM;
        u.pm = fm + ((wgid % nig) % gsz); u.pn = (wgid % nig) / gsz; u.e = 0; u.aux = 0; return true;
    }
    __device__ __forceinline__ const char* abase() const { return A; }
    __device__ __forceinline__ const char* bbase(const Unit& u) const { return Bt + (size_t)u.pn * BM * K * 2; }
    __device__ __forceinline__ void aoffs(const Unit& u, int, const int (&R)[2], const int (&C)[2], unsigned (&off)[4]) const {
#pragma unroll
        for (int h = 0; h < 2; ++h)
#pragma unroll
            for (int i = 0; i < 2; ++i) off[h * 2 + i] = (unsigned)((u.pm * BM + h * HALF + R[i]) * K + C[i]) * 2u;
    }
    __device__ __forceinline__ void meta_init(const Unit&, bool, const Unit&, int) const {}
    __device__ __forceinline__ void meta_top(int, bool, const Unit&, bool, const Unit&, int) const {}
};

#define PG8_LAS __attribute__((address_space(3)))
template <class Epi, class Sched, bool ALIGN_EPI>
__device__ __forceinline__ void gemm_phase(PG8_LAS unsigned char* lds, const int K, const Sched& S, const Epi& E, const int wid_  ) {
    const int lane = lane_id(), tid = wid_ * 64 + lane, wid = wid_, wr = wid >> 2, wc = wid & 3, fr = lane & 15, fq = lane >> 4;
    const int nt = K / BK;
    int sR[2], sC[2]; unsigned voffB[2];
#pragma unroll
    for (int i = 0; i < 2; ++i) { int R, C; stage_rc(tid * 16 + i * 8192, R, C); sR[i] = R; sC[i] = C; const int Rb = Epi::PERM ? ((R & ~31) + perm32(R & 31)) : R; voffB[i] = (unsigned)(Rb * K + C) * 2u; }
    const size_t kstep = (size_t)(BK * 2);
    const size_t hstepB = (size_t)HALF * K * 2;
    const unsigned ldsw = (unsigned)wid * 1024u;
    const int aoff = lds_byte(wr * 64 + fr, fq * 8), boff = lds_byte(wc * 32 + fr, fq * 8);
    const char* const gA = S.abase();
#define PG8_SA(b, h) (((b) * 2 + (h)) * HTB)
#define PG8_SB(b, h) ((4 + (b) * 2 + (h)) * HTB)
#define PG8_STAGE(bufoff, gbase, voff) do { _Pragma("unroll") for (int _i = 0; _i < 2; ++_i) \
        __builtin_amdgcn_global_load_lds((const unsigned*)((const char*)(gbase) + (voff)[_i]), (PG8_LAS unsigned*)(lds + (bufoff) + ldsw + _i * 8192), 16, 0, 0); } while (0)
#define PG8_STAGEA(bufoff, offs, h, kb) do { _Pragma("unroll") for (int _i = 0; _i < 2; ++_i) \
        __builtin_amdgcn_global_load_lds((const unsigned*)((gA + (kb)) + (offs)[(h) * 2 + _i]), (PG8_LAS unsigned*)(lds + (bufoff) + ldsw + _i * 8192), 16, 0, 0); } while (0)
#define PG8_LDA(dst, b, h) do { _Pragma("unroll") for (int m = 0; m < 4; ++m) _Pragma("unroll") for (int k = 0; k < 2; ++k) dst[m][k] = *(const PG8_LAS bf16x8*)(lds + PG8_SA(b, h) + aoff + m * 2048 + k * 1024); } while (0)
#define PG8_LDB(dst, b, h) do { _Pragma("unroll") for (int n = 0; n < 2; ++n) _Pragma("unroll") for (int k = 0; k < 2; ++k) dst[n][k] = *(const PG8_LAS bf16x8*)(lds + PG8_SB(b, h) + boff + n * 2048 + k * 1024); } while (0)
#define PG8_MMA(ai, bj, At, Bt) do { __builtin_amdgcn_s_setprio(1); _Pragma("unroll") for (int m = 0; m < 4; ++m) _Pragma("unroll") for (int n = 0; n < 2; ++n) _Pragma("unroll") for (int k = 0; k < 2; ++k) \
        acc[ai][bj][m][n] = __builtin_amdgcn_mfma_f32_16x16x32_bf16(Bt[n][k], At[m][k], acc[ai][bj][m][n], 0, 0, 0); __builtin_amdgcn_s_setprio(0); } while (0)
#define PG8_WAIT_V(n) asm volatile("s_waitcnt vmcnt(" #n ")" ::: "memory")
#define PG8_WAIT_L(n) asm volatile("s_waitcnt lgkmcnt(" #n ")" ::: "memory")
#define PG8_BAR __builtin_amdgcn_s_barrier()
#define PG8_SCHED __builtin_amdgcn_sched_barrier(0)
    Unit cur, nxt, nn; int ui = 0;
    if (!S.next(0, cur)) return;
    bool h1 = S.next(1, nxt), h2 = h1 && S.next(2, nn);
    f32x4 acc[2][2][4][2];
#pragma unroll
    for (int a = 0; a < 2; ++a)
#pragma unroll
        for (int b = 0; b < 2; ++b)
#pragma unroll
            for (int m = 0; m < 4; ++m)
#pragma unroll
                for (int n = 0; n < 2; ++n) acc[a][b][m][n] = (f32x4){0.f, 0.f, 0.f, 0.f};
    bf16x8 At[4][2], B0[2][2], B1[2][2];
    unsigned cO[4], nO[4];
    S.meta_init(cur, h1, nxt, wid);
    S.aoffs(cur, 0, sR, sC, cO);
    const char* cB = S.bbase(cur);
    PG8_STAGE(PG8_SB(0, 0), cB, voffB); PG8_STAGE(PG8_SB(0, 1), cB + hstepB, voffB); PG8_STAGEA(PG8_SA(0, 0), cO, 0, 0); PG8_STAGEA(PG8_SA(0, 1), cO, 1, 0);
    if (wr == 1) PG8_BAR;
    PG8_WAIT_V(2); PG8_BAR;
    PG8_STAGE(PG8_SB(1, 0), cB + kstep, voffB); PG8_STAGEA(PG8_SA(1, 0), cO, 0, kstep); PG8_STAGE(PG8_SB(1, 1), cB + hstepB + kstep, voffB);
    PG8_WAIT_V(6); PG8_BAR;
    for (;;) {
        const bool has_next = h1;
        const char* nB = cB;
#pragma unroll
        for (int i = 0; i < 4; ++i) nO[i] = cO[i];
        if (has_next) { nB = S.bbase(nxt); S.aoffs(nxt, ui + 1, sR, sC, nO); }
        S.meta_top(ui, h1, nxt, h2, nn, wid);
        for (int t = 0; t < nt; t += 2) {
            const bool last = (t == nt - 2);
            if constexpr (Epi::MID) { if (t == nt / 2) E.mid(acc, cur, wr, fr); }
            const size_t k1 = (size_t)(t + 1) * kstep;
            const size_t k2 = last ? 0 : (size_t)(t + 2) * kstep, k3 = k2 + kstep;
            const char* b2 = (last ? nB : cB) + k2; const char* b3 = b2 + kstep;
            unsigned o2[4];
#pragma unroll
            for (int i = 0; i < 4; ++i) o2[i] = last ? nO[i] : cO[i];
            PG8_LDB(B0, 0, 0); PG8_LDB(B1, 0, 1); PG8_SCHED; PG8_LDA(At, 0, 0); PG8_STAGEA(PG8_SA(1, 1), cO, 1, k1);
            PG8_WAIT_V(8); PG8_WAIT_L(0); PG8_BAR; PG8_MMA(0, 0, At, B0); PG8_MMA(0, 1, At, B1); PG8_BAR; PG8_SCHED;
            PG8_LDA(At, 0, 1); PG8_STAGE(PG8_SB(0, 0), b2, voffB); PG8_STAGE(PG8_SB(0, 1), b2 + hstepB, voffB); PG8_STAGEA(PG8_SA(0, 0), o2, 0, k2);
            PG8_WAIT_V(8); PG8_WAIT_L(0); PG8_BAR; PG8_MMA(1, 0, At, B0); PG8_MMA(1, 1, At, B1); PG8_BAR; PG8_SCHED;
            PG8_LDB(B0, 1, 0); PG8_LDB(B1, 1, 1); PG8_SCHED; PG8_LDA(At, 1, 0); PG8_STAGEA(PG8_SA(0, 1), o2, 1, k2);
            PG8_WAIT_V(8); PG8_WAIT_L(0); PG8_BAR; PG8_MMA(0, 0, At, B0); PG8_MMA(0, 1, At, B1); PG8_BAR; PG8_SCHED;
            PG8_LDA(At, 1, 1); PG8_STAGE(PG8_SB(1, 0), b3, voffB); PG8_STAGE(PG8_SB(1, 1), b3 + hstepB, voffB); PG8_STAGEA(PG8_SA(1, 0), o2, 0, k3);
            PG8_WAIT_V(8); PG8_WAIT_L(0); PG8_BAR; PG8_MMA(1, 0, At, B0); PG8_MMA(1, 1, At, B1); PG8_BAR; PG8_SCHED;
        }
        if constexpr (ALIGN_EPI) { if (wr == 0) PG8_BAR; }
        E(acc, cur, ui, wr, wc, fr, fq);
        if (!has_next) break;
#pragma unroll
        for (int a = 0; a < 2; ++a)
#pragma unroll
            for (int b = 0; b < 2; ++b)
#pragma unroll
                for (int m = 0; m < 4; ++m)
#pragma unroll
                    for (int n = 0; n < 2; ++n) acc[a][b][m][n] = (f32x4){0.f, 0.f, 0.f, 0.f};
        cur = nxt; cB = nB;
#pragma unroll
        for (int i = 0; i < 4; ++i) cO[i] = nO[i];
        nxt = nn; h1 = h2; h2 = h1 && S.next(ui + 3, nn);
        ++ui;
        if constexpr (ALIGN_EPI) { if (wr == 1) PG8_BAR; }
    }
    PG8_WAIT_V(0);
    if constexpr (!ALIGN_EPI) { if (wr == 0) PG8_BAR; }
    PG8_BAR;
#undef PG8_SA
#undef PG8_SB
#undef PG8_STAGE
#undef PG8_STAGEA
#undef PG8_LDA
#undef PG8_LDB
#undef PG8_MMA
#undef PG8_WAIT_V
#undef PG8_WAIT_L
#undef PG8_BAR
#undef PG8_SCHED
}
}
#define XB_TMO      128
#define XB_XCNT(j)  (256  + 64 * (j))
#define XB_XSUB(j)  (1280 + 64 * (j))
#define XB_XGEN(j)  (2304 + 64 * (j))
#define XB_TOP      3328
#define XB_TOPGEN   3392
#define XCD_BAR_WORDS 3456
#define XB_SPIN_CAP (1u << 18)
__device__ __forceinline__ unsigned xb_ld(unsigned* p)              { return __hip_atomic_load(p, __ATOMIC_RELAXED, __HIP_MEMORY_SCOPE_AGENT); }
__device__ __forceinline__ unsigned xb_add(unsigned* p, unsigned v) { return __hip_atomic_fetch_add(p, v, __ATOMIC_RELAXED, __HIP_MEMORY_SCOPE_AGENT); }
__device__ __forceinline__ unsigned xb_xcc_id() { return (unsigned)__builtin_amdgcn_s_getreg((3 << 11) | 20) & 0xFu; }
#define XB_SPIN(cond, bar) do { unsigned _sp = 0; while (cond) { __builtin_amdgcn_s_sleep(1); \
    if ((++_sp & 255u) == 0u) { if (xb_ld(&(bar)[XB_TMO])) break; if (_sp > XB_SPIN_CAP) { atomicAdd(&(bar)[XB_TMO], 1u); break; } } } } while (0)
struct XcdBarrier { unsigned* bar; unsigned x; volatile LAS unsigned* st; };
__device__ __forceinline__ XcdBarrier xcd_barrier_post(unsigned* bar, volatile LAS unsigned* st, int wave) {
    XcdBarrier b; b.bar = bar; b.x = xb_xcc_id(); b.st = st;
    if (wave == 0 && lane_id() == 0) (void)xb_add(&bar[XB_XCNT(b.x)], 1u);
    return b;
}
__device__ __forceinline__ void xcd_barrier_complete(unsigned* bar, unsigned x, unsigned& nloc, unsigned& nx) {
    const unsigned G = gridDim.x * gridDim.y * gridDim.z;
    unsigned sum, cnt, mine, sp = 0u;
    for (;;) {
        sum = 0u; cnt = 0u; mine = 0u;
#pragma unroll
        for (unsigned j = 0; j < 16; ++j) { const unsigned c = xb_ld(&bar[XB_XCNT(j)]); sum += c; cnt += (c > 0u) ? 1u : 0u; mine = (j == x) ? c : mine; }
        if (sum == G) break;
        __builtin_amdgcn_s_sleep(1);
        if ((++sp & 255u) == 0u) { if (xb_ld(&bar[XB_TMO])) break; if (sp > XB_SPIN_CAP) { atomicAdd(&bar[XB_TMO], 1u); break; } }
    }
    nloc = mine > 0u ? mine : 1u; nx = cnt > 0u ? cnt : 1u;
}
__device__ __forceinline__ void xcd_barrier(const XcdBarrier& b, int wave) {
    asm volatile("s_waitcnt vmcnt(0)" ::: "memory");
    __syncthreads();
    if (wave == 0 && lane_id() == 0) {
        unsigned* bar = b.bar;
        __builtin_amdgcn_s_waitcnt(0);
        unsigned nloc = b.st[0], nx = b.st[1];
        if (nloc == 0u) { xcd_barrier_complete(bar, b.x, nloc, nx); b.st[0] = nloc; b.st[1] = nx; }
        const unsigned old = xb_add(&bar[XB_XSUB(b.x)], 1u);
        const unsigned gen = old / nloc;
        if (old + 1u == (gen + 1u) * nloc) {
            __builtin_amdgcn_fence(__ATOMIC_RELEASE, "agent");
            asm volatile("s_waitcnt vmcnt(0)" ::: "memory");
            const unsigned og = xb_add(&bar[XB_TOP], 1u);
            const unsigned tg = og / nx;
            if (og + 1u == (tg + 1u) * nx) xb_add(&bar[XB_TOPGEN], 1u);
            else XB_SPIN(xb_ld(&bar[XB_TOPGEN]) == tg, bar);
            __builtin_amdgcn_fence(__ATOMIC_ACQUIRE, "agent");
            xb_add(&bar[XB_XGEN(b.x)], 1u);
            asm volatile("s_waitcnt vmcnt(0)" ::: "memory");
        } else {
            XB_SPIN(xb_ld(&bar[XB_XGEN(b.x)]) == gen, bar);
            __builtin_amdgcn_fence(__ATOMIC_ACQUIRE, "agent");
            asm volatile("s_waitcnt vmcnt(0)" ::: "memory");
        }
    }
    __syncthreads();
}

struct Frame {
    LAS unsigned char* lds;
    volatile LAS unsigned* MISC;
    gu32* ctl;
    int tid, lane, wave, vcu, G;
    const float *x, *c, *w_ada, *b_ada, *w_in, *sink, *rpb, *ga, *gb, *w_out, *w_router, *b_router, *w_gu, *b_gu, *w_down, *b_down, *g_final;
    float* out;
    float *mod, *rope, *ssq, *tkg;
    int *tke, *list;
    bf16_t *wr_t, *win_t, *wout_t, *wgu_t, *wd_t, *XN, *PROJ, *O, *YS, *ACT;
};
__device__ __forceinline__ float wave_sum(float v) {
#pragma unroll
    for (int o = 1; o < 64; o <<= 1) v += __shfl_xor(v, o);
    return v;
}

__device__ __forceinline__ void p0_transpose_item(const float* W, int N, int Kd, bf16_t* WT, int k0, int n0, int drow0, const float* ga, const float* gb, LAS float* scr, int lane) {
#pragma unroll
    for (int i = 0; i < 8; ++i) { const int kk = 8 * i + (lane >> 3), nn = 4 * (lane & 7); f32x4 w = *(const GAS f32x4*)(W + (size_t)(k0 + kk) * N + n0 + nn);
        if (ga) { const int k = k0 + kk; w = w * (k < 512 ? ga[k] : gb[k - 512]); }
        scr[kk * 33 + nn] = w.x; scr[kk * 33 + nn + 1] = w.y; scr[kk * 33 + nn + 2] = w.z; scr[kk * 33 + nn + 3] = w.w; }
    LDS_WAIT(); asm volatile("" ::: "memory");
    const int c = lane & 7;
#pragma unroll
    for (int j = 0; j < 4; ++j) { const int n = (lane >> 3) + 8 * j; const LAS float* s = scr + (8 * c) * 33 + n;
        u32x4 o; o.x = pk2(s[0 * 33], s[1 * 33]); o.y = pk2(s[2 * 33], s[3 * 33]); o.z = pk2(s[4 * 33], s[5 * 33]); o.w = pk2(s[6 * 33], s[7 * 33]);
        *(GAS u32x4*)(WT + (size_t)(drow0 + n) * Kd + k0 + 8 * c) = o; }
    LDS_WAIT(); asm volatile("" ::: "memory");
}
__device__ __forceinline__ void p0_prologue(Frame& F) {
    const int gt = blockIdx.x * (NWAVES * 64) + F.tid;
    if (blockIdx.x < 6 * DM / 32) {
        LAS float* sc = (LAS float*)F.lds;
        LAS float* red = (LAS float*)(F.lds + 32768);
        for (int i = F.tid; i < NB * DM; i += NWAVES * 64) { const float v = F.c[i]; sc[i] = v / (1.f + __expf(-v)); }
        __syncthreads();
        const int col = F.tid & 31, ks = F.tid >> 5, n = blockIdx.x * 32 + col;
        float a[NB];
#pragma unroll
        for (int b = 0; b < NB; ++b) a[b] = 0.f;
        for (int k = ks * 64; k < ks * 64 + 64; ++k) { const float w = F.w_ada[(size_t)k * 6 * DM + n];
#pragma unroll
            for (int b = 0; b < NB; ++b) a[b] += sc[b * DM + k] * w; }
#pragma unroll
        for (int b = 0; b < NB; ++b) red[(ks * NB + b) * 32 + col] = a[b];
        __syncthreads();
        if (F.tid < 256) { const int b = F.tid >> 5; float s = F.b_ada[n];
#pragma unroll
            for (int q = 0; q < 16; ++q) s += red[(q * NB + b) * 32 + col];
            F.mod[b * 6 * DM + n] = s; }
        __syncthreads();
    }
    if (gt < SEQ * 8) {
        const int pos = gt >> 3, i = gt & 7;
        const float invf[8] = {1.0f, 0.1939227432012558f, 0.03760603070259094f, 0.007292664609849453f, 0.0014142135623842478f, 0.00027424818836152554f, 5.3182957344688475e-05f, 1.0313385246263351e-05f};
        float inv = invf[0];
#pragma unroll
        for (int q = 1; q < 8; ++q) inv = (i == q) ? invf[q] : inv;
        const float angf = (float)pos * inv;
        const double ang = (double)angf, twopi = 6.283185307179586476925287;
        const double r = ang - __builtin_rint(ang / twopi) * twopi, r2 = r * r;
        double cs = 1.0, sn = r, tc = 1.0, ts = r;
#pragma unroll 1
        for (int q = 1; q <= 20; ++q) { tc = -tc * r2 / (double)((2 * q - 1) * (2 * q)); ts = -ts * r2 / (double)((2 * q) * (2 * q + 1)); cs += tc; sn += ts; }
        F.rope[gt] = (float)cs; F.rope[SEQ * 8 + gt] = (float)sn;
    }
    if (gt < NE * DM) { const int e = gt >> 10, k = gt & 1023; const float w = F.w_router[k * NE + e]; const unsigned hi = f2bf(w); const unsigned lo = f2bf(w - bf2f(hi));
        F.wr_t[gt] = (bf16_t)hi; F.wr_t[NE * DM + gt] = (bf16_t)lo; }
    if (gt < NTOK * 2) F.ssq[gt] = 0.f;
    LAS float* scr = (LAS float*)(F.lds + F.wave * 16384);
    const int gw = F.vcu * NWAVES + F.wave, NGW = F.G * NWAVES;
    constexpr int I_IN = 16 * (DIN / 32), I_OUT = 16 * (DM / 32), I_GU1 = 16 * (2 * DFF / 32), I_GU = NE * I_GU1, I_D1 = (DFF / 64) * (DM / 32), I_D = NE * I_D1;
    constexpr int NITEMS = I_IN + I_OUT + I_GU + I_D;
    for (int it = gw; it < NITEMS; it += NGW) {
        int r = it;
        if (r < I_IN) { const int nb = r % (DIN / 32), kb = r / (DIN / 32); p0_transpose_item(F.w_in, DIN, DM, F.win_t, kb * 64, nb * 32, nb * 32, nullptr, nullptr, scr, F.lane); continue; } r -= I_IN;
        if (r < I_OUT) { const int nb = r % (DM / 32), kb = r / (DM / 32); p0_transpose_item(F.w_out, DM, DM, F.wout_t, kb * 64, nb * 32, nb * 32, F.ga, F.gb, scr, F.lane); continue; } r -= I_OUT;
        if (r < I_GU) { const int e = r / I_GU1, q = r % I_GU1, nb = q % (2 * DFF / 32), kb = q / (2 * DFF / 32), n0 = nb * 32;
            const int f = n0 & (DFF - 1), drow0 = (f >> 7) * 256 + (n0 >= DFF ? 128 : 0) + (f & 127);
            p0_transpose_item(F.w_gu + (size_t)e * DM * 2 * DFF, 2 * DFF, DM, F.wgu_t + (size_t)e * 2 * DFF * DM, kb * 64, n0, drow0, nullptr, nullptr, scr, F.lane); continue; } r -= I_GU;
        { const int e = r / I_D1, q = r % I_D1, nb = q % (DM / 32), kb = q / (DM / 32);
            p0_transpose_item(F.w_down + (size_t)e * DFF * DM, DM, DFF, F.wd_t + (size_t)e * DM * DFF, kb * 64, nb * 32, nb * 32, nullptr, nullptr, scr, F.lane); }
    }
}
__device__ __forceinline__ void p1_xn(Frame& F) {
    const int gw = F.vcu * NWAVES + F.wave, NGW = F.G * NWAVES;
    for (int chunk = gw; chunk < NTOK / 16; chunk += NGW) {
        const int m0 = chunk * 16, b = m0 / SEQ;
        f32x4 s1[4], sh[4];
#pragma unroll
        for (int j = 0; j < 4; ++j) { s1[j] = *(const GAS f32x4*)(F.mod + b * 6 * DM + DM + 4 * F.lane + 256 * j) + 1.0f; sh[j] = *(const GAS f32x4*)(F.mod + b * 6 * DM + 4 * F.lane + 256 * j); }
        for (int r = 0; r < 16; ++r) {
            const GAS f32x4* xr = (const GAS f32x4*)(F.x + (size_t)(m0 + r) * DM) + F.lane;
            f32x4 v[4]; float s = 0.f;
#pragma unroll
            for (int j = 0; j < 4; ++j) { v[j] = xr[64 * j]; s += (v[j].x * v[j].x + v[j].y * v[j].y) + (v[j].z * v[j].z + v[j].w * v[j].w); }
            const float rstd = 1.f / sqrtf(wave_sum(s) * (1.f / DM) + EPS);
            GAS unsigned long long* o8 = (GAS unsigned long long*)(F.XN + (size_t)(m0 + r) * DM) + F.lane;
#pragma unroll
            for (int j = 0; j < 4; ++j) { const f32x4 h = v[j] * rstd * s1[j] + sh[j];
                o8[64 * j] = (unsigned long long)pk2(h.x, h.y) | ((unsigned long long)pk2(h.z, h.w) << 32); }
        }
    }
}
struct EpiProj {
    static constexpr bool PERM = true, MID = false;
    bf16_t* O; const float* rope;
    __device__ __forceinline__ void mid(f32x4 (&)[2][2][4][2], const pg8::Unit&, int, int) const {}
    __device__ __forceinline__ void operator()(const f32x4 (&acc)[2][2][4][2], const pg8::Unit& u, int, int wr, int wc, int fr, int fq) const {
        const int row0 = u.pm * 256 + wr * 64 + fr, col0 = u.pn * 256 + wc * 32 + 8 * fq;
        const float sc = (u.pn < 2 || u.pn == 3 || u.pn == 4) ? C2 : 1.f;
#pragma unroll
        for (int ai = 0; ai < 2; ++ai)
#pragma unroll
            for (int m = 0; m < 4; ++m) { const int row = row0 + ai * 128 + m * 16; bf16_t* rowp = O + (size_t)row * DIN + col0;
#pragma unroll
                for (int bj = 0; bj < 2; ++bj) { f32x4 v0 = acc[ai][bj][m][0], v1 = acc[ai][bj][m][1];
                    const bool rope_tile = (u.pn < 2) || (u.pn == 2 && bj == 0);
                    if (rope_tile && (wc & 1) == 0) {
                        f32x4 o0, o1;
#pragma unroll
                        for (int q = 0; q < 4; ++q) { o0[q] = __shfl_xor(v0[q], 16); o1[q] = __shfl_xor(v1[q], 16); }
                        if (fq < 2) { const int pos = row & (SEQ - 1);
                            const f32x4 c0 = *(const GAS f32x4*)(rope + pos * 8), c1 = *(const GAS f32x4*)(rope + pos * 8 + 4);
                            const f32x4 s0 = *(const GAS f32x4*)(rope + SEQ * 8 + pos * 8), s1 = *(const GAS f32x4*)(rope + SEQ * 8 + pos * 8 + 4);
                            const float sg = fq == 0 ? -1.f : 1.f;
                            v0 = v0 * c0 + (o0 * sg) * s0; v1 = v1 * c1 + (o1 * sg) * s1; }
                    }
                    v0 = v0 * sc; v1 = v1 * sc;
                    u32x4 w; w.x = cvt_pk_bf16(v0[0], v0[1]); w.y = cvt_pk_bf16(v0[2], v0[3]); w.z = cvt_pk_bf16(v1[0], v1[1]); w.w = cvt_pk_bf16(v1[2], v1[3]);
                    *(GAS u32x4*)(rowp + bj * 128) = w; } }
    }
};
__device__ __forceinline__ int crow(int r, int hi) { return (r & 3) + 8 * (r >> 2) + 4 * hi; }
typedef short v4i16_t __attribute__((ext_vector_type(4)));
__device__ __forceinline__ v4i16_t vtr(const LAS unsigned char* p) { return __builtin_amdgcn_ds_read_tr16_b64_v4i16((LAS v4i16_t*)p); }
__device__ __forceinline__ float max3f(float a, float b, float c) { return __builtin_fmaxf(__builtin_fmaxf(a, b), c); }
__device__ __forceinline__ void dma_k(const bf16_t* Ktile  , LAS unsigned char* slot, int p, int lane) {
    const int row = 8 * p + (lane >> 3), ch = (lane & 7) ^ ((row >> 1) & 7);
    __builtin_amdgcn_global_load_lds((const unsigned*)(Ktile + (size_t)row * DIN + ch * 8), (LAS unsigned*)(slot + p * 1024), 16, 0, 0);
}
__device__ __forceinline__ void dma_v(const bf16_t* Vtile, LAS unsigned char* slot, int p, int lane) {
    __builtin_amdgcn_global_load_lds((const unsigned*)(Vtile + (size_t)(8 * p + ((lane >> 2) & 7)) * DIN + (lane >> 5) * 32 + (lane & 3) * 8), (LAS unsigned*)(slot + p * 1024), 16, 0, 0);
}
struct AttnState { float m, l; f32x16 o[2]; };
template <class MB>
__device__ __forceinline__ void attn_tile(const LAS unsigned char* Ks, const LAS unsigned char* Vs, const bf16x8 (&qr)[4], AttnState& st, int r32, int hi, int lane, const MB& mb) {
    f32x16 p0, p1;
#pragma unroll
    for (int r = 0; r < 16; ++r) { p0[r] = 0.f; p1[r] = 0.f; }
    const LAS unsigned char* kb = Ks + r32 * 128; const int sw = (r32 >> 1) & 7;
#pragma unroll
    for (int d0 = 0; d0 < 4; ++d0) {
        const int ko = ((2 * d0 + hi) ^ sw) << 4;
        const bf16x8 a0 = *(const LAS bf16x8*)(kb + ko), a1 = *(const LAS bf16x8*)(kb + ko + 4096);
        p0 = __builtin_amdgcn_mfma_f32_32x32x16_bf16(a0, qr[d0], p0, 0, 0, 0);
        p1 = __builtin_amdgcn_mfma_f32_32x32x16_bf16(a1, qr[d0], p1, 0, 0, 0);
    }
    mb(p0, p1, r32, hi);
    float a = max3f(p0[0], p0[1], p1[0]), b = max3f(p0[2], p0[3], p1[1]); a = max3f(a, p1[2], p1[3]);
#pragma unroll
    for (int r = 4; r < 16; r += 4) { a = max3f(a, p0[r], p0[r + 1]); b = max3f(b, p0[r + 2], p0[r + 3]); a = max3f(a, p1[r], p1[r + 1]); b = max3f(b, p1[r + 2], p1[r + 3]); }
    float rm = __builtin_fmaxf(a, b);
    rm = __builtin_fmaxf(rm, __shfl_xor(rm, 32));
    if (__any(rm > st.m + 8.0f)) {
        const float mn = __builtin_fmaxf(st.m, rm), f = __builtin_amdgcn_exp2f(st.m - mn);
        st.m = mn; st.l *= f;
#pragma unroll
        for (int r = 0; r < 16; ++r) { st.o[0][r] *= f; st.o[1][r] *= f; }
    }
    const float mref = st.m;
    float ls = 0.f;
#pragma unroll
    for (int r = 0; r < 16; ++r) { p0[r] = __builtin_amdgcn_exp2f(p0[r] - mref); p1[r] = __builtin_amdgcn_exp2f(p1[r] - mref); ls += p0[r] + p1[r]; }
    st.l += ls;
    u32x4 pw[4];
#pragma unroll
    for (int q = 0; q < 4; ++q) { pw[0][q] = cvt_pk_bf16(p0[2 * q], p0[2 * q + 1]); pw[1][q] = cvt_pk_bf16(p0[8 + 2 * q], p0[8 + 2 * q + 1]);
                                  pw[2][q] = cvt_pk_bf16(p1[2 * q], p1[2 * q + 1]); pw[3][q] = cvt_pk_bf16(p1[8 + 2 * q], p1[8 + 2 * q + 1]); }
    const LAS unsigned char* vb = Vs + ((lane >> 4) & 1) * 32 + (lane & 3) * 8 + (4 * hi + ((lane & 15) >> 2)) * 64;
#pragma unroll
    for (int d0 = 0; d0 < 2; ++d0)
#pragma unroll
        for (int s = 0; s < 4; ++s) {
            const v4i16_t lo = vtr(vb + d0 * 512 + s * 2048), hh = vtr(vb + d0 * 512 + s * 2048 + 1024);
            const bf16x8 vf = (bf16x8){lo[0], lo[1], lo[2], lo[3], hh[0], hh[1], hh[2], hh[3]};
            st.o[d0] = __builtin_amdgcn_mfma_f32_32x32x16_bf16(vf, __builtin_bit_cast(bf16x8, pw[s]), st.o[d0], 0, 0, 0);
        }
}
__device__ __forceinline__ void attn_finish(AttnState& st, LAS unsigned char* stg, bf16_t* Obase  , float* ssqp  , int r32, int hi, int lane) {
    float l = st.l; l += __shfl_xor(l, 32);
    const float inv = 1.0f / l;
    float sq = 0.f;
#pragma unroll
    for (int d0 = 0; d0 < 2; ++d0)
#pragma unroll
        for (int rg = 0; rg < 4; ++rg) {
            const float v0 = st.o[d0][4 * rg] * inv, v1 = st.o[d0][4 * rg + 1] * inv, v2 = st.o[d0][4 * rg + 2] * inv, v3 = st.o[d0][4 * rg + 3] * inv;
            sq += (v0 * v0 + v1 * v1) + (v2 * v2 + v3 * v3);
            u32x2 w; w.x = cvt_pk_bf16(v0, v1); w.y = cvt_pk_bf16(v2, v3);
            const int ch = 4 * d0 + rg;
            *(LAS u32x2*)(stg + r32 * 128 + ((ch ^ (r32 & 7)) << 4) + hi * 8) = w;
        }
    sq += __shfl_xor(sq, 32);
    if (hi == 0) atomicAdd(ssqp + r32 * 2, sq);
    asm volatile("s_waitcnt lgkmcnt(0)" ::: "memory");
#pragma unroll
    for (int i = 0; i < 4; ++i) { const int row = i * 8 + (lane >> 3), ch = lane & 7;
        const u32x4 v = *(const LAS u32x4*)(stg + row * 128 + ((ch ^ (row & 7)) << 4));
        *(GAS u32x4*)(Obase + (size_t)row * DM + ch * 8) = v; }
}
struct MbNone { __device__ __forceinline__ void operator()(f32x16&, f32x16&, int, int) const {} };
struct MbBandLo { int qi;
    __device__ __forceinline__ void operator()(f32x16& p0, f32x16& p1, int, int hi) const {
#pragma unroll
        for (int r = 0; r < 16; ++r) { const int kj = crow(r, hi); p0[r] = (kj >= qi) ? p0[r] : -1e30f; p1[r] = (kj + 32 >= qi) ? p1[r] : -1e30f; } } };
struct MbBandHi { int qi;
    __device__ __forceinline__ void operator()(f32x16& p0, f32x16& p1, int, int hi) const {
#pragma unroll
        for (int r = 0; r < 16; ++r) { const int kj = crow(r, hi); p0[r] = (kj <= qi) ? p0[r] : -1e30f; p1[r] = (kj + 32 <= qi) ? p1[r] : -1e30f; } } };
struct MbNeigh { const LAS float* base; const float* ma;
    __device__ __forceinline__ void operator()(f32x16& p0, f32x16& p1, int, int) const {
#pragma unroll
        for (int r = 0; r < 16; ++r) { const int o = (r & 3) + 8 * (r >> 2); p0[r] = (p0[r] + base[o]) + ma[r]; p1[r] = (p1[r] + base[o + 32]) + ma[16 + r]; } } };

__device__ __forceinline__ void attn_a_phase(Frame& F, float* ssq) {
    const int wave = F.wave, lane = F.lane, r32 = lane & 31, hi = lane >> 5, g = wave >> 1, qh = wave & 1;
    for (int u = F.vcu; u < NB * AKVH * (SEQ / 64); u += F.G) {
        const int qblk = u % (SEQ / 64), kvh = (u / (SEQ / 64)) % AKVH, b = u / ((SEQ / 64) * AKVH);
        const int q0 = qblk * 64, h = kvh * 4 + g;
        const bf16_t* base = F.PROJ + (size_t)b * SEQ * DIN;
        asm volatile("s_waitcnt lgkmcnt(0)" ::: "memory"); __builtin_amdgcn_s_barrier();
#pragma unroll
        for (int t = 0; t < 5; ++t) { const int k0 = q0 - 128 + 64 * t;
            if (k0 >= 0 && k0 < SEQ) { dma_k(base + (size_t)k0 * DIN + OFF_KA + kvh * HD, F.lds + t * 8192, wave, lane); dma_v(base + (size_t)k0 * DIN + OFF_VA + kvh * HD, F.lds + 40960 + t * 8192, wave, lane); } }
        const bf16_t* qp = base + (size_t)(q0 + qh * 32 + r32) * DIN + OFF_QA + h * HD + hi * 8;
        bf16x8 qr[4];
#pragma unroll
        for (int d0 = 0; d0 < 4; ++d0) qr[d0] = *(const GAS bf16x8*)(qp + d0 * 16);
        AttnState st; st.m = F.sink[h] * LOG2E; st.l = (hi == 0) ? 1.f : 0.f;
#pragma unroll
        for (int r = 0; r < 16; ++r) { st.o[0][r] = 0.f; st.o[1][r] = 0.f; }
        asm volatile("s_waitcnt vmcnt(0)" ::: "memory"); __builtin_amdgcn_s_barrier();
        const int qi = qh * 32 + r32;
        if (q0 - 128 >= 0) attn_tile(F.lds, F.lds + 40960, qr, st, r32, hi, lane, MbBandLo{qi});
        if (q0 - 64 >= 0) attn_tile(F.lds + 8192, F.lds + 40960 + 8192, qr, st, r32, hi, lane, MbNone{});
        attn_tile(F.lds + 2 * 8192, F.lds + 40960 + 2 * 8192, qr, st, r32, hi, lane, MbNone{});
        if (q0 + 64 < SEQ) attn_tile(F.lds + 3 * 8192, F.lds + 40960 + 3 * 8192, qr, st, r32, hi, lane, MbNone{});
        if (q0 + 128 < SEQ) attn_tile(F.lds + 4 * 8192, F.lds + 40960 + 4 * 8192, qr, st, r32, hi, lane, MbBandHi{qi});
        const int tok0 = b * SEQ + q0 + qh * 32;
        attn_finish(st, F.lds + 81920 + wave * 4096, F.O + (size_t)tok0 * DM + h * HD, ssq + tok0 * 2, r32, hi, lane);
    }
}
constexpr int NTAB_OFF = LDSCTL_OFF + 2048;
__device__ __forceinline__ void attn_b_phase(Frame& F, float* ssq) {
    const int wave = F.wave, lane = F.lane, r32 = lane & 31, hi = lane >> 5, rw = wave >> 1, qh = wave & 1;
    LAS float* tab = (LAS float*)(F.lds + NTAB_OFF);
    int cur_head = -1;
    for (int u = F.vcu; u < NB * BH * (GW / 4); u += F.G) {
        const int rg = u % (GW / 4), head = (u / (GW / 4)) % BH, b = u / ((GW / 4) * BH);
        const int r0 = rg * 4, r = r0 + rw;
        const int R0 = min(max(r0 - NAR / 2, 0), GW - NAR), nst = min(max(r0 + 3 - NAR / 2, 0), GW - NAR) + NAR - R0;
        const int rs = min(max(r - NAR / 2, 0), GW - NAR);
        const bf16_t* base = F.PROJ + (size_t)b * SEQ * DIN;
        asm volatile("s_waitcnt lgkmcnt(0)" ::: "memory"); __builtin_amdgcn_s_barrier();
        if (head != cur_head) { cur_head = head;
            for (int i = F.tid; i < 15 * 128; i += NWAVES * 64) { const int d = (i & 127) - 63, ro = i >> 7;
                tab[i] = (d >= -15 && d <= 15) ? F.rpb[(head * 15 + ro) * 31 + d + 15] * LOG2E : 0.f; }
            asm volatile("s_waitcnt lgkmcnt(0)" ::: "memory"); }
#define NB_DMA(t) do { const int _bs = ((t) & 3) * 16384; const bf16_t* _kr = base + (size_t)((R0 + (t)) * GW) * DIN; \
        dma_k(_kr + OFF_KB + head * HD, F.lds + _bs, wave, lane); dma_v(_kr + OFF_VB + head * HD, F.lds + _bs + 8192, wave, lane); } while (0)
        NB_DMA(0); NB_DMA(1); NB_DMA(2);
        const int qc = qh * 32 + r32, cs = min(max(qc - NAC / 2, 0), GW - NAC);
        float ma[32];
#pragma unroll
        for (int q = 0; q < 16; ++q) { const int kc = crow(q, hi); ma[q] = (kc >= cs && kc < cs + 16) ? 0.f : -1e30f; ma[16 + q] = (kc + 32 >= cs && kc + 32 < cs + 16) ? 0.f : -1e30f; }
        const bf16_t* qp = base + (size_t)(r * GW + qc) * DIN + OFF_QB + head * HD + hi * 8;
        bf16x8 qr[4];
#pragma unroll
        for (int d0 = 0; d0 < 4; ++d0) qr[d0] = *(const GAS bf16x8*)(qp + d0 * 16);
        AttnState st; st.m = -1e30f; st.l = 0.f;
#pragma unroll
        for (int q = 0; q < 16; ++q) { st.o[0][q] = 0.f; st.o[1][q] = 0.f; }
        for (int t = 0; t < nst; ++t) {
            if (t + 3 < nst) { NB_DMA(t + 3); asm volatile("s_waitcnt vmcnt(6)" ::: "memory"); }
            else if (t + 2 < nst) asm volatile("s_waitcnt vmcnt(4)" ::: "memory");
            else if (t + 1 < nst) asm volatile("s_waitcnt vmcnt(2)" ::: "memory");
            else asm volatile("s_waitcnt vmcnt(0)" ::: "memory");
            __builtin_amdgcn_s_barrier();
            const int kr = R0 + t;
            if (kr >= rs && kr < rs + NAR) {
                const LAS unsigned char* ks = F.lds + (t & 3) * 16384;
                attn_tile(ks, ks + 8192, qr, st, r32, hi, lane, MbNeigh{tab + (kr - r + NAR - 1) * 128 + (63 - qc + 4 * hi), ma});
            }
            asm volatile("s_waitcnt lgkmcnt(0)" ::: "memory"); __builtin_amdgcn_s_barrier();
        }
#undef NB_DMA
        const int tok0 = b * SEQ + r * GW + qh * 32;
        attn_finish(st, F.lds + 65536 + wave * 4096, F.O + (size_t)tok0 * DM + AQW + head * HD, ssq + tok0 * 2 + 1, r32, hi, lane);
    }
}
struct EpiX1 {
    static constexpr bool PERM = false, MID = true;
    const float* x; float* x1; const float* mod; const float* ssq;
    __device__ __forceinline__ void mid(f32x4 (&acc)[2][2][4][2], const pg8::Unit& u, int wr, int fr) const {
#pragma unroll
        for (int ai = 0; ai < 2; ++ai)
#pragma unroll
            for (int m = 0; m < 4; ++m) { const int row = u.pm * 256 + ai * 128 + wr * 64 + m * 16 + fr;
                const f32x2 s = *(const GAS f32x2*)(ssq + row * 2);
                const float f = sqrtf((s.y * (1.f / 512.f) + EPS) / (s.x * (1.f / 512.f) + EPS));
#pragma unroll
                for (int bj = 0; bj < 2; ++bj)
#pragma unroll
                    for (int n = 0; n < 2; ++n) acc[ai][bj][m][n] *= f; }
    }
    __device__ __forceinline__ void operator()(const f32x4 (&acc)[2][2][4][2], const pg8::Unit& u, int, int wr, int wc, int fr, int fq) const {
        const int b = (u.pm * 256) / SEQ, col0 = u.pn * 256 + wc * 32 + 4 * fq;
        f32x4 gm[2][2];
#pragma unroll
        for (int bj = 0; bj < 2; ++bj)
#pragma unroll
            for (int n = 0; n < 2; ++n) gm[bj][n] = *(const GAS f32x4*)(mod + b * 6 * DM + 2 * DM + col0 + bj * 128 + n * 16);
#pragma unroll
        for (int ai = 0; ai < 2; ++ai)
#pragma unroll
            for (int m = 0; m < 4; ++m) { const int row = u.pm * 256 + ai * 128 + wr * 64 + m * 16 + fr;
                const float rb = 1.0f / sqrtf(ssq[row * 2 + 1] * (1.f / 512.f) + EPS);
                const size_t off = (size_t)row * DM + col0;
#pragma unroll
                for (int bj = 0; bj < 2; ++bj)
#pragma unroll
                    for (int n = 0; n < 2; ++n) { const f32x4 xr = *(const GAS f32x4*)(x + off + bj * 128 + n * 16);
                        *(GAS f32x4*)(x1 + off + bj * 128 + n * 16) = xr + gm[bj][n] * (acc[ai][bj][m][n] * rb); } }
    }
};

__device__ __forceinline__ void router_phase(Frame& F, gu32* cntw) {
    const int wave = F.wave, lane = F.lane, r32 = lane & 31, hi = lane >> 5;
    bf16x8 wh[8], wl[8];
#pragma unroll
    for (int c = 0; c < 8; ++c) { const bf16_t* p = F.wr_t + r32 * DM + 128 * wave + 16 * c + 8 * hi; wh[c] = *(const GAS bf16x8*)p; wl[c] = *(const GAS bf16x8*)(p + NE * DM); }
    LAS float* part = (LAS float*)(F.lds);
    LAS float* R = (LAS float*)(F.lds + 1024);
    LAS float* L = (LAS float*)(F.lds + 1024 + 32768);
    LAS int* lcnt = (LAS int*)(F.lds + 1024 + 32768 + 4352);
    const float* x1 = F.out;
    for (int it = F.vcu; it < NTOK / 32; it += F.G) {
        const int t0 = it * 32, b = t0 / SEQ, tok = t0 + r32;
        const float* xp = x1 + (size_t)tok * DM + 128 * wave + 8 * hi;
        f32x4 xa[8], xb[8]; float s = 0.f;
#pragma unroll
        for (int c = 0; c < 8; ++c) { xa[c] = *(const GAS f32x4*)(xp + 16 * c); xb[c] = *(const GAS f32x4*)(xp + 16 * c + 4);
            s += (xa[c].x * xa[c].x + xa[c].y * xa[c].y) + (xa[c].z * xa[c].z + xa[c].w * xa[c].w) + (xb[c].x * xb[c].x + xb[c].y * xb[c].y) + (xb[c].z * xb[c].z + xb[c].w * xb[c].w); }
        s += __shfl_xor(s, 32);
        if (hi == 0) part[wave * 32 + r32] = s;
        if (F.tid < 32) lcnt[F.tid] = 0;
        asm volatile("s_waitcnt lgkmcnt(0)" ::: "memory"); __builtin_amdgcn_s_barrier(); asm volatile("" ::: "memory");
        float tot = 0.f;
#pragma unroll
        for (int w = 0; w < 8; ++w) tot += part[w * 32 + r32];
        const float rstd = 1.0f / sqrtf(tot * (1.f / DM) + EPS);
        f32x16 acc;
#pragma unroll
        for (int r = 0; r < 16; ++r) acc[r] = 0.f;
        const float* mp = F.mod + b * 6 * DM + 128 * wave + 8 * hi;
        bf16_t* xnp = F.XN + (size_t)tok * DM + 128 * wave + 8 * hi;
#pragma unroll
        for (int c = 0; c < 8; ++c) {
            const f32x4 sc0 = *(const GAS f32x4*)(mp + 4 * DM + 16 * c), sc1 = *(const GAS f32x4*)(mp + 4 * DM + 16 * c + 4);
            const f32x4 sh0 = *(const GAS f32x4*)(mp + 3 * DM + 16 * c), sh1 = *(const GAS f32x4*)(mp + 3 * DM + 16 * c + 4);
            const f32x4 h0 = xa[c] * rstd * (sc0 + 1.0f) + sh0, h1 = xb[c] * rstd * (sc1 + 1.0f) + sh1;
            u32x4 hw; hw.x = pk2(h0.x, h0.y); hw.y = pk2(h0.z, h0.w); hw.z = pk2(h1.x, h1.y); hw.w = pk2(h1.z, h1.w);
            u32x4 lw;
            lw.x = pk2(h0.x - bf2f(hw.x & 0xffffu), h0.y - bf2f(hw.x >> 16)); lw.y = pk2(h0.z - bf2f(hw.y & 0xffffu), h0.w - bf2f(hw.y >> 16));
            lw.z = pk2(h1.x - bf2f(hw.z & 0xffffu), h1.y - bf2f(hw.z >> 16)); lw.w = pk2(h1.z - bf2f(hw.w & 0xffffu), h1.w - bf2f(hw.w >> 16));
            *(GAS u32x4*)(xnp + 16 * c) = hw;
            const bf16x8 hf = __builtin_bit_cast(bf16x8, hw), lf = __builtin_bit_cast(bf16x8, lw);
            acc = __builtin_amdgcn_mfma_f32_32x32x16_bf16(hf, wh[c], acc, 0, 0, 0);
            acc = __builtin_amdgcn_mfma_f32_32x32x16_bf16(lf, wh[c], acc, 0, 0, 0);
            acc = __builtin_amdgcn_mfma_f32_32x32x16_bf16(hf, wl[c], acc, 0, 0, 0);
        }
#pragma unroll
        for (int r = 0; r < 16; ++r) R[wave * 1024 + crow(r, hi) * 32 + r32] = acc[r];
        asm volatile("s_waitcnt lgkmcnt(0)" ::: "memory"); __builtin_amdgcn_s_barrier(); asm volatile("" ::: "memory");
#pragma unroll
        for (int q = 0; q < 2; ++q) { const int idx = F.tid * 2 + q, tk = idx >> 5, e = idx & 31; float v = F.b_router[e];
#pragma unroll
            for (int w = 0; w < 8; ++w) v += R[w * 1024 + idx];
            L[tk * 33 + e] = v; }
        asm volatile("s_waitcnt lgkmcnt(0)" ::: "memory"); __builtin_amdgcn_s_barrier(); asm volatile("" ::: "memory");
        if (wave == 0) {
            int sel[TOPK]; float gt[TOPK]; int lpos[TOPK];
            if (lane < 32) {
                float v[NE];
#pragma unroll
                for (int j = 0; j < NE; ++j) v[j] = L[lane * 33 + j];
                unsigned used = 0u; float sv[TOPK];
#pragma unroll
                for (int kk = 0; kk < TOPK; ++kk) { float best = -INFINITY; int bi = 0;
#pragma unroll
                    for (int j = 0; j < NE; ++j) { const bool ok = !((used >> j) & 1u) && (v[j] > best); best = ok ? v[j] : best; bi = ok ? j : bi; }
                    used |= 1u << bi; sel[kk] = bi; sv[kk] = best; }
                float den = 0.f;
#pragma unroll
                for (int kk = 0; kk < TOPK; ++kk) { gt[kk] = __expf(sv[kk] - sv[0]); den += gt[kk]; }
                const float rden = 1.0f / den;
#pragma unroll
                for (int kk = 0; kk < TOPK; ++kk) { gt[kk] *= rden; lpos[kk] = __hip_atomic_fetch_add(lcnt + sel[kk], 1, __ATOMIC_RELAXED, __HIP_MEMORY_SCOPE_WORKGROUP); }
            }
            asm volatile("s_waitcnt lgkmcnt(0)" ::: "memory");
            if (lane < 32) { const int n = lcnt[lane]; int base = 0;
                if (n > 0) base = (int)__hip_atomic_fetch_add((unsigned*)(cntw + lane * 64), (unsigned)n, __ATOMIC_RELAXED, __HIP_MEMORY_SCOPE_AGENT);
                lcnt[32 + lane] = base; }
            asm volatile("s_waitcnt vmcnt(0) lgkmcnt(0)" ::: "memory");
            if (lane < 32) {
                const int t = t0 + lane;
#pragma unroll
                for (int kk = 0; kk < TOPK; ++kk) { const int e = sel[kk], pos = lcnt[32 + e] + lpos[kk];
                    F.tkg[t * 4 + kk] = gt[kk]; F.list[e * NTOK + pos] = t * 4 + kk; }
            }
        }
    }
}

__device__ __forceinline__ void moe_table(Frame& F) {
    LAS int* tab = (LAS int*)(F.lds + TAB_OFF);
    if (F.tid == 0) { int s = 0;
        for (int e = 0; e < NE; ++e) { const int c = (int)__hip_atomic_load((unsigned*)(F.ctl + CW_CNT + e * 64), __ATOMIC_RELAXED, __HIP_MEMORY_SCOPE_AGENT); tab[e] = s; tab[40 + e] = c; s += (c + 255) >> 8; }
        tab[32] = s; }
    asm volatile("s_waitcnt vmcnt(0) lgkmcnt(0)" ::: "memory"); __syncthreads();
}
constexpr int META_OFF = NTAB_OFF, META_SLOT = 2048;
template <bool GATHER>
struct MoeOrder {
    const char* A; const char* Bt; const int* list; const float* bias; const LAS int* tab; LAS unsigned char* meta; int K, N, nN, G, c;
    mutable int ec;
    __device__ bool next(int i, pg8::Unit& u) const {
        const int L = i * G + c; if (L >= tab[32] * nN) return false;
        int e = ec;
#pragma unroll 1
        while (L >= tab[e + 1] * nN) ++e;
        ec = e;
        const int nm = tab[e + 1] - tab[e], ql = L - tab[e] * nN;
        u.e = e; u.pn = ql / nm; u.aux = ql % nm; u.pm = tab[e] + u.aux; return true;
    }
    __device__ __forceinline__ const char* abase() const { return A; }
    __device__ __forceinline__ const char* bbase(const pg8::Unit& u) const { return Bt + ((size_t)u.e * N + (size_t)u.pn * 256) * K * 2; }
    __device__ __forceinline__ void dma_list(const pg8::Unit& u, int slot) const {
        const int lane = lane_id();
        __builtin_amdgcn_global_load_lds((const unsigned*)(list + (size_t)u.e * NTOK + u.aux * 256 + 4 * lane), (LAS unsigned*)(meta + slot * META_SLOT), 16, 0, 0);
    }
    __device__ __forceinline__ void dma_bias(const pg8::Unit& u, int slot) const {
        const int lane = lane_id();
        const float* src = GATHER ? bias + (size_t)u.e * 2 * DFF + u.pn * 128 + (lane >> 5) * DFF + 4 * (lane & 31) : bias + (size_t)u.e * DM + u.pn * 256 + 4 * lane;
        __builtin_amdgcn_global_load_lds((const unsigned*)src, (LAS unsigned*)(meta + slot * META_SLOT + 1024), 16, 0, 0);
    }
    __device__ __forceinline__ void meta_init(const pg8::Unit& u0, bool h1, const pg8::Unit& u1, int wid) const {
        if (wid == 0) { dma_list(u0, 0); dma_bias(u0, 0); if (h1) dma_list(u1, 1); }
        asm volatile("s_waitcnt vmcnt(0)" ::: "memory"); __builtin_amdgcn_s_barrier(); asm volatile("" ::: "memory");
    }
    __device__ __forceinline__ void meta_top(int ui, bool has_next, const pg8::Unit& nxt, bool h2, const pg8::Unit& nn, int wid) const {
        if (wid == 0) { if (has_next) dma_bias(nxt, (ui + 1) % 3); if (h2) dma_list(nn, (ui + 2) % 3); }
    }
    __device__ __forceinline__ void aoffs(const pg8::Unit& u, int ui, const int (&R)[2], const int (&C)[2], unsigned (&off)[4]) const {
        if (GATHER) { const int lim = tab[40 + u.e] - 1 - u.aux * 256; const LAS int* lst = (const LAS int*)(meta + (ui % 3) * META_SLOT);
#pragma unroll
            for (int h = 0; h < 2; ++h)
#pragma unroll
                for (int i = 0; i < 2; ++i) { int mi = h * 128 + R[i]; mi = mi < lim ? mi : lim; const int tk = lst[mi] >> 2; off[h * 2 + i] = (unsigned)(tk * K + C[i]) * 2u; }
        } else {
#pragma unroll
            for (int h = 0; h < 2; ++h)
#pragma unroll
                for (int i = 0; i < 2; ++i) off[h * 2 + i] = (unsigned)((u.pm * 256 + h * 128 + R[i]) * K + C[i]) * 2u;
        }
    }
};
struct EpiSwiglu {
    static constexpr bool PERM = true, MID = false;
    bf16_t* act; const LAS unsigned char* meta;
    __device__ __forceinline__ void mid(f32x4 (&)[2][2][4][2], const pg8::Unit&, int, int) const {}
    __device__ __forceinline__ void operator()(const f32x4 (&acc)[2][2][4][2], const pg8::Unit& u, int ui, int wr, int wc, int fr, int fq) const {
        const int c0 = wc * 32 + 8 * fq, f0 = u.pn * 128 + c0, row0 = u.pm * 256 + wr * 64 + fr;
        const LAS float* bp = (const LAS float*)(meta + (ui % 3) * META_SLOT + 1024) + c0;
        const f32x4 bg0 = *(const LAS f32x4*)bp, bg1 = *(const LAS f32x4*)(bp + 4), bu0 = *(const LAS f32x4*)(bp + 128), bu1 = *(const LAS f32x4*)(bp + 132);
#pragma unroll
        for (int ai = 0; ai < 2; ++ai)
#pragma unroll
            for (int m = 0; m < 4; ++m) { const int row = row0 + ai * 128 + m * 16;
                float o[8];
#pragma unroll
                for (int q = 0; q < 8; ++q) { float g = (q < 4 ? acc[ai][0][m][0][q] + bg0[q] : acc[ai][0][m][1][q - 4] + bg1[q - 4]);
                    float up = (q < 4 ? acc[ai][1][m][0][q] + bu0[q] : acc[ai][1][m][1][q - 4] + bu1[q - 4]);
                    g = __builtin_fminf(g, 7.f); up = __builtin_fminf(__builtin_fmaxf(up, -7.f), 7.f);
                    const float glu = g * __builtin_amdgcn_rcpf(1.f + __builtin_amdgcn_exp2f(-1.702f * LOG2E * g));
                    o[q] = (up + 1.f) * glu; }
                u32x4 w; w.x = cvt_pk_bf16(o[0], o[1]); w.y = cvt_pk_bf16(o[2], o[3]); w.z = cvt_pk_bf16(o[4], o[5]); w.w = cvt_pk_bf16(o[6], o[7]);
                *(GAS u32x4*)(act + (size_t)row * DFF + f0) = w; }
    }
};
struct EpiNull {
    static constexpr bool PERM = true, MID = false;
    __device__ __forceinline__ void mid(f32x4 (&)[2][2][4][2], const pg8::Unit&, int, int) const {}
    __device__ __forceinline__ void operator()(const f32x4 (&acc)[2][2][4][2], const pg8::Unit&, int, int, int, int, int) const {
#pragma unroll
        for (int a = 0; a < 2; ++a)
#pragma unroll
            for (int b = 0; b < 2; ++b)
#pragma unroll
                for (int m = 0; m < 4; ++m)
#pragma unroll
                    for (int n = 0; n < 2; ++n) asm volatile("" :: "v"(acc[a][b][m][n]));
    }
};
struct EpiYs {
    static constexpr bool PERM = true, MID = false;
    bf16_t* ys; const LAS int* tab; const LAS unsigned char* meta;
    __device__ __forceinline__ void mid(f32x4 (&)[2][2][4][2], const pg8::Unit&, int, int) const {}
    __device__ __forceinline__ void operator()(const f32x4 (&acc)[2][2][4][2], const pg8::Unit& u, int ui, int wr, int wc, int fr, int fq) const {
        const int c0 = wc * 32 + 8 * fq, col0 = u.pn * 256 + c0, rl0 = wr * 64 + fr, lim = tab[40 + u.e] - u.aux * 256;
        const LAS int* lst = (const LAS int*)(meta + (ui % 3) * META_SLOT); const LAS float* bp = (const LAS float*)(meta + (ui % 3) * META_SLOT + 1024) + c0;
        int ent[2][4];
#pragma unroll
        for (int ai = 0; ai < 2; ++ai)
#pragma unroll
            for (int m = 0; m < 4; ++m) { const int rl = rl0 + ai * 128 + m * 16; const int e_ = lst[rl]; ent[ai][m] = (rl < lim) ? e_ : -1; }
        f32x4 bv[2][2];
#pragma unroll
        for (int bj = 0; bj < 2; ++bj)
#pragma unroll
            for (int n = 0; n < 2; ++n) bv[bj][n] = *(const LAS f32x4*)(bp + bj * 128 + 4 * n);
#pragma unroll
        for (int ai = 0; ai < 2; ++ai)
#pragma unroll
            for (int m = 0; m < 4; ++m) { if (ent[ai][m] >= 0) { bf16_t* rowp = ys + (size_t)ent[ai][m] * DM + col0;
#pragma unroll
                for (int bj = 0; bj < 2; ++bj) { const f32x4 v0 = acc[ai][bj][m][0] + bv[bj][0], v1 = acc[ai][bj][m][1] + bv[bj][1];
                    u32x4 w; w.x = cvt_pk_bf16(v0[0], v0[1]); w.y = cvt_pk_bf16(v0[2], v0[3]); w.z = cvt_pk_bf16(v1[0], v1[1]); w.w = cvt_pk_bf16(v1[2], v1[3]);
                    *(GAS u32x4*)(rowp + bj * 128) = w; } } }
    }
};
struct FinRow { f32x4 x[4]; u32x2 y[TOPK][4]; };
__device__ __forceinline__ void fin_load(FinRow& R, const float* xrow, const bf16_t* yrow, int lane) {
    const GAS f32x4* xr = (const GAS f32x4*)xrow + lane;
#pragma unroll
    for (int kk = 0; kk < TOPK; ++kk) { const GAS u32x2* yr = (const GAS u32x2*)(yrow + (size_t)kk * DM) + lane;
#pragma unroll
        for (int j = 0; j < 4; ++j) R.y[kk][j] = __builtin_nontemporal_load(yr + 64 * j); }
#pragma unroll
    for (int j = 0; j < 4; ++j) R.x[j] = xr[64 * j];
}
__device__ __forceinline__ void fin_compute(const FinRow& R, float* drow, float gv, int r, int lane, const f32x4 (&gfm)[4], const f32x4 (&gf)[4]) {
    f32x4 y[4];
#pragma unroll
    for (int j = 0; j < 4; ++j) y[j] = (f32x4){0.f, 0.f, 0.f, 0.f};
#pragma unroll
    for (int kk = 0; kk < TOPK; ++kk) { const float g = __builtin_bit_cast(float, __builtin_amdgcn_readlane(__builtin_bit_cast(int, gv), r * 4 + kk));
#pragma unroll
        for (int j = 0; j < 4; ++j) { const u32x2 w = R.y[kk][j]; y[j] += (f32x4){bf2f(w.x & 0xffffu), bf2f(w.x >> 16), bf2f(w.y & 0xffffu), bf2f(w.y >> 16)} * g; } }
    f32x4 v[4]; float s = 0.f;
#pragma unroll
    for (int j = 0; j < 4; ++j) { v[j] = R.x[j] + gfm[j] * y[j]; s += (v[j].x * v[j].x + v[j].y * v[j].y) + (v[j].z * v[j].z + v[j].w * v[j].w); }
    const float rstd = 1.f / sqrtf(wave_sum(s) * (1.f / DM) + EPS);
    GAS f32x4* orow = (GAS f32x4*)drow + lane;
#pragma unroll
    for (int j = 0; j < 4; ++j) orow[64 * j] = v[j] * rstd * gf[j];
}
__device__ __forceinline__ void final_phase(Frame& F, float* dst) {
    const int gw = F.vcu * NWAVES + F.wave, NGW = F.G * NWAVES, lane = F.lane;
    f32x4 gf[4];
#pragma unroll
    for (int j = 0; j < 4; ++j) gf[j] = *(const GAS f32x4*)(F.g_final + 4 * lane + 256 * j);
    for (int chunk = gw; chunk < NTOK / 16; chunk += NGW) {
        const int m0 = chunk * 16, b = m0 / SEQ;
        f32x4 gfm[4];
#pragma unroll
        for (int j = 0; j < 4; ++j) gfm[j] = *(const GAS f32x4*)(F.mod + b * 6 * DM + 5 * DM + 4 * lane + 256 * j);
        const float gv = F.tkg[m0 * 4 + lane];
        FinRow A, B;
        fin_load(A, F.out + (size_t)m0 * DM, F.YS + (size_t)m0 * 4 * DM, lane);
#pragma unroll 1
        for (int r = 0; r < 16; r += 2) {
            fin_load(B, F.out + (size_t)(m0 + r + 1) * DM, F.YS + (size_t)(m0 + r + 1) * 4 * DM, lane);
            fin_compute(A, dst + (size_t)(m0 + r) * DM, gv, r, lane, gfm, gf);
            if (r + 2 < 16) fin_load(A, F.out + (size_t)(m0 + r + 2) * DM, F.YS + (size_t)(m0 + r + 2) * 4 * DM, lane);
            fin_compute(B, dst + (size_t)(m0 + r + 1) * DM, gv, r + 1, lane, gfm, gf);
        }
    }
}
struct MkArgs { const float* in[17]; float* out; unsigned char* ws; int ph_lo, ph_hi; };
#ifndef DBG_STAGE
#define DBG_STAGE 9
#endif
constexpr int N_PHASES = DBG_STAGE;
__global__ void __launch_bounds__(NWAVES * 64, 2) mk_fwd(MkArgs args) {
    extern __shared__ __attribute__((aligned(16))) unsigned char lds[];
    Frame F;
    F.lds = (LAS unsigned char*)lds;
    F.MISC = (volatile LAS unsigned*)(F.lds + MISC_OFF);
    F.tid = threadIdx.x; F.lane = F.tid & 63; F.wave = __builtin_amdgcn_readfirstlane(F.tid >> 6);
    F.G = gridDim.x; { const int bx = blockIdx.x; F.vcu = (F.G % 8 == 0) ? (bx % 8) * (F.G / 8) + bx / 8 : bx; }
    unsigned char* ws = args.ws;
    F.ctl = (gu32*)(ws + WS_CTL);
    F.x = args.in[0]; F.c = args.in[1]; F.w_ada = args.in[2]; F.b_ada = args.in[3]; F.w_in = args.in[4]; F.sink = args.in[5]; F.rpb = args.in[6]; F.ga = args.in[7]; F.gb = args.in[8];
    F.w_out = args.in[9]; F.w_router = args.in[10]; F.b_router = args.in[11]; F.w_gu = args.in[12]; F.b_gu = args.in[13]; F.w_down = args.in[14]; F.b_down = args.in[15]; F.g_final = args.in[16];
    F.out = args.out;
    F.mod = (float*)(ws + WS_MOD); F.rope = (float*)(ws + WS_ROPE); F.ssq = (float*)(ws + WS_SSQ); F.tkg = (float*)(ws + WS_TKG); F.tke = (int*)(ws + WS_TKE); F.list = (int*)(ws + WS_LIST);
    F.wr_t = (bf16_t*)(ws + WS_WR); F.win_t = (bf16_t*)(ws + WS_WIN); F.wout_t = (bf16_t*)(ws + WS_WOUT); F.wgu_t = (bf16_t*)(ws + WS_WGU); F.wd_t = (bf16_t*)(ws + WS_WD);
    F.XN = (bf16_t*)(ws + WS_XN); F.PROJ = (bf16_t*)(ws + WS_PROJ); F.O = (bf16_t*)(ws + WS_O); F.YS = (bf16_t*)(ws + WS_YS); F.ACT = (bf16_t*)(ws + WS_ACT);
    for (int u = F.tid; u < (LDS_BYTES - LDSCTL_OFF) / 4; u += NWAVES * 64) ((LAS unsigned*)(F.lds + LDSCTL_OFF))[u] = 0u;
    __syncthreads();
    const int lo = args.ph_lo, hi = args.ph_hi;
    XcdBarrier bar; bar.bar = (unsigned*)(F.ctl + CW_BAR); bar.x = 0; bar.st = nullptr;
    if (hi - lo > 1) bar = xcd_barrier_post((unsigned*)(F.ctl + CW_BAR), F.MISC + 8, F.wave);
#define IN(k) (lo <= (k) && (k) < hi)
#define FRESH() do { F.lane = lane_id(); F.tid = F.wave * 64 + F.lane; } while (0)
#define SEAM(k) do { if (IN(k) && IN((k) + 1)) xcd_barrier(bar, F.wave); } while (0)
#ifndef PROBE_PH
#define PROBE_PH -1
#endif
#ifndef PROBE_FIN
#define PROBE_FIN 0
#endif
#define REP(k) for (int _rep = (PROBE_PH == (k)) ? 0 : 1; _rep < 2; ++_rep)
    float* const dummy = (float*)(ws + 760 * MiB);
    FRESH();
    if (IN(0)) { REP(0) { __syncthreads(); p0_prologue(F); } } SEAM(0);
    FRESH();
    if (IN(1)) { REP(1) p1_xn(F); } SEAM(1);
    FRESH();
    if (IN(2)) REP(2) {
        pg8::DenseOrder S; S.init(F.XN, F.win_t, NTOK, DIN, DM, F.G, (int)blockIdx.x);
        EpiProj E{F.PROJ, F.rope};
        pg8::gemm_phase<EpiProj, pg8::DenseOrder, true>(F.lds, DM, S, E, F.wave);
    } SEAM(2);
    FRESH();
    if (IN(3)) { if (PROBE_PH == 3) { if (PROBE_FIN != 2) attn_a_phase(F, dummy); if (PROBE_FIN != 1) attn_b_phase(F, dummy); }
                 attn_a_phase(F, F.ssq); attn_b_phase(F, F.ssq); } SEAM(3);
    FRESH();
    if (IN(4)) REP(4) {
        pg8::DenseOrder S; S.init(F.O, F.wout_t, NTOK, DM, DM, F.G, (int)blockIdx.x);
        EpiX1 E{F.x, F.out, F.mod, F.ssq};
        pg8::gemm_phase<EpiX1, pg8::DenseOrder, true>(F.lds, DM, S, E, F.wave);
    } SEAM(4);
    FRESH();
    if (IN(5)) REP(5) { router_phase(F, _rep ? F.ctl + CW_CNT : F.ctl + 16384); } SEAM(5);
    FRESH();
    if (IN(6)) {
        moe_table(F);
        MoeOrder<true> S{(const char*)F.XN, (const char*)F.wgu_t, F.list, F.b_gu, (const LAS int*)(F.lds + TAB_OFF), F.lds + META_OFF, DM, 2 * DFF, 2 * DFF / 256, F.G, F.vcu, 0};
        if (PROBE_PH == 6) { EpiNull E0; pg8::gemm_phase<EpiNull, MoeOrder<true>, true>(F.lds, DM, S, E0, F.wave); S.ec = 0; }
        EpiSwiglu E{F.ACT, F.lds + META_OFF};
        pg8::gemm_phase<EpiSwiglu, MoeOrder<true>, true>(F.lds, DM, S, E, F.wave);
    } SEAM(6);
    FRESH();
    if (IN(7)) REP(7) {
        moe_table(F);
        MoeOrder<false> S{(const char*)F.ACT, (const char*)F.wd_t, F.list, F.b_down, (const LAS int*)(F.lds + TAB_OFF), F.lds + META_OFF, DFF, DM, DM / 256, F.G, F.vcu, 0};
        EpiYs E{F.YS, (const LAS int*)(F.lds + TAB_OFF), F.lds + META_OFF};
        pg8::gemm_phase<EpiYs, MoeOrder<false>, true>(F.lds, DFF, S, E, F.wave);
    } SEAM(7);
    FRESH();
    if (IN(8)) REP(8) { final_phase(F, _rep ? F.out : dummy); }
#undef IN
#undef SEAM
}

__global__ void br_route(const bf16_t* XN, const int* tke, const unsigned* ctl, float* h, int* cnt, int* list) {
    const int idx = blockIdx.x * 256 + threadIdx.x;
    const int ep = tke[idx]; list[(ep >> 16) * NTOK + (ep & 0xffff)] = idx;
    if (idx < NE) cnt[idx] = (int)ctl[CW_CNT + idx * 64];
    const int t = idx >> 2, q = idx & 3;
    for (int k = q * 256; k < q * 256 + 256; ++k) h[(size_t)t * DM + k] = bf2f(XN[(size_t)t * DM + k]);
}
extern "C" void kernel_launch(void* const* d_in, const int* in_sizes, int n_in, void* d_out, int out_size, void* d_ws, size_t ws_size, hipStream_t stream) {
    static int grid = 0;
    if (grid == 0) {
        if (n_in != 17 || ws_size < (size_t)1001 * MiB) { fprintf(stderr, "kernel_launch: bad n_in %d or ws_size %zu\n", n_in, ws_size); grid = -1; return; }
        int dev = 0, cus = 0, per_cu = 0;
        if (hipGetDevice(&dev) != hipSuccess || hipDeviceGetAttribute(&cus, hipDeviceAttributeMultiprocessorCount, dev) != hipSuccess) { grid = -1; return; }
        if (hipFuncSetAttribute((const void*)mk_fwd, hipFuncAttributeMaxDynamicSharedMemorySize, LDS_BYTES) != hipSuccess) { fprintf(stderr, "kernel_launch: hipFuncSetAttribute failed\n"); grid = -1; return; }
        if (hipOccupancyMaxActiveBlocksPerMultiprocessor(&per_cu, (const void*)mk_fwd, NWAVES * 64, LDS_BYTES) != hipSuccess || per_cu < 1) { fprintf(stderr, "kernel_launch: occupancy query says %d\n", per_cu); }
        (void)hipGetLastError();
        grid = cus;
    }
    if (grid < 0) return;
    const float* x = (const float*)d_in[0]; const float* sink = (const float*)d_in[5]; const float* rpb = (const float*)d_in[6]; const float* ga = (const float*)d_in[7];
    const float* gb = (const float*)d_in[8]; const float* w_out = (const float*)d_in[9]; const float* w_router = (const float*)d_in[10]; const float* b_router = (const float*)d_in[11];
    const float* w_gu = (const float*)d_in[12]; const float* b_gu = (const float*)d_in[13]; const float* w_down = (const float*)d_in[14]; const float* b_down = (const float*)d_in[15];
    const float* g_final = (const float*)d_in[16];
    char* ws = (char*)d_ws; float* out = (float*)d_out;
    (void)hipMemsetAsync(ws + WS_CTL, 0, CTL_ZERO_BYTES, stream);
    MkArgs a{};
    for (int i = 0; i < 17; ++i) a.in[i] = (const float*)d_in[i];
    a.out = out; a.ws = (unsigned char*)d_ws;
#if defined(MK_PER_PHASE)
    for (int ph = 0; ph < N_PHASES; ++ph) { a.ph_lo = ph; a.ph_hi = ph + 1; hipLaunchKernelGGL(mk_fwd, dim3(grid), dim3(NWAVES * 64), LDS_BYTES, stream, a); }
#else
    a.ph_lo = 0; a.ph_hi = N_PHASES; hipLaunchKernelGGL(mk_fwd, dim3(grid), dim3(NWAVES * 64), LDS_BYTES, stream, a);
#endif
#if DBG_STAGE < 9
    float* mod = (float*)(ws + WS_MOD);
    float* h = (float*)(ws + 17 * MiB);
    float* y = (float*)(ws + 337 * MiB);
    float* act = (float*)(ws + 481 * MiB);
    int* cnt = (int*)(ws + 993 * MiB); int* tke = (int*)(ws + 994 * MiB); float* tkg = (float*)(ws + 995 * MiB); int* list = (int*)(ws + 996 * MiB);
    (void)hipMemsetAsync(cnt, 0, 64 * sizeof(int), stream);
    (void)hipMemsetAsync(y, 0, (size_t)NTOK * DM * 4, stream);
#if DBG_STAGE == 5
    nv_norm_mod<<<NTOK, 256, 0, stream>>>(out, mod, 3 * DM, 4 * DM, h);
    nv_router<<<NTOK, 64, 0, stream>>>(h, w_router, b_router, cnt, tke, tkg, list);
#elif DBG_STAGE == 6
    br_route<<<NTOK * 4 / 256, 256, 0, stream>>>((const bf16_t*)(ws + WS_XN), (const int*)(ws + WS_TKE), (const unsigned*)(ws + WS_CTL), h, cnt, list);
    tkg = (float*)(ws + WS_TKG);
#endif
    nv_offsets<<<1, 64, 0, stream>>>(cnt);
    nv_sgemm<true><<<dim3(DFF / 64, NTOK / 64, NE), 256, 0, stream>>>(w_gu, 2 * DFF, DM, RmMoe1{h, list, cnt, (size_t)DM * 2 * DFF}, EpiMoe1{act, cnt, b_gu});
    nv_sgemm<false><<<dim3(DM / 64, NTOK / 64, NE), 256, 0, stream>>>(w_down, DM, DFF, RmMoe2{act, cnt, (size_t)DFF * DM}, EpiMoe2{y, list, cnt, tkg, b_down});
    nv_final<<<NTOK, 256, 0, stream>>>(out, y, mod, g_final, out);
#endif
}
```

```cpp
#define DBG_STAGE 9
#include <hip/hip_runtime.h>
#include <cstdio>
#include <cstdint>
#include <cmath>

constexpr int DM = 1024, NB = 8, SEQ = 4096, NTOK = NB * SEQ;
constexpr int HD = 64, AQH = 8, AKVH = 2, BH = 8;
constexpr int AQW = 512, AKVW = 128, BW = 512, DIN = 2304;
constexpr int OFF_QA = 0, OFF_KA = 512, OFF_VA = 640, OFF_QB = 768, OFF_KB = 1280, OFF_VB = 1792;
constexpr int WIN = 128, GW = 64, NAR = 8, NAC = 16, NE = 32, TOPK = 4, DFF = 1024;
constexpr float EPS = 1e-5f;
constexpr size_t MiB = 1u << 20;

#define GAS __attribute__((address_space(1)))
#define LAS __attribute__((address_space(3)))
typedef unsigned short bf16_t;
typedef short bf16x8 __attribute__((ext_vector_type(8)));
typedef float f32x4 __attribute__((ext_vector_type(4)));
typedef float f32x2 __attribute__((ext_vector_type(2)));
typedef float f32x16 __attribute__((ext_vector_type(16)));
typedef unsigned u32x4 __attribute__((ext_vector_type(4)));
typedef unsigned u32x2 __attribute__((ext_vector_type(2)));
typedef unsigned u32x8 __attribute__((ext_vector_type(8)));
typedef GAS unsigned gu32;
#define RLX_AGENT __ATOMIC_RELAXED, __HIP_MEMORY_SCOPE_AGENT
#define LDS_WAIT() asm volatile("s_waitcnt lgkmcnt(0)" ::: "memory")
#define VM_WAIT() asm volatile("s_waitcnt vmcnt(0)" ::: "memory")
__device__ __forceinline__ unsigned cvt_pk_bf16(float lo, float hi) { unsigned r; asm volatile("v_cvt_pk_bf16_f32 %0, %1, %2" : "=v"(r) : "v"(lo), "v"(hi)); return r; }
__device__ __forceinline__ unsigned f2bf(float f) { unsigned u = __builtin_bit_cast(unsigned, f); return (u + 0x7fffu + ((u >> 16) & 1u)) >> 16; }
__device__ __forceinline__ unsigned pk2(float lo, float hi) { return f2bf(lo) | (f2bf(hi) << 16); }
__device__ __forceinline__ float bf2f(unsigned h) { return __builtin_bit_cast(float, h << 16); }
__device__ __forceinline__ unsigned pk_fp8x4(float a, float b, float c, float d) { int p = __builtin_amdgcn_cvt_pk_fp8_f32(a, b, 0, false); return (unsigned)__builtin_amdgcn_cvt_pk_fp8_f32(c, d, p, true); }
typedef int v8i32 __attribute__((ext_vector_type(8)));
constexpr float W8_SCALE = 32.0f;

constexpr int NWAVES = 8;
__device__ __forceinline__ int lane_id() { int l; asm volatile("v_mbcnt_lo_u32_b32 %0, -1, 0\n\tv_mbcnt_hi_u32_b32 %0, -1, %0" : "=v"(l)); return l; }
constexpr float C2 = 0.125f * 1.4426950408889634f;
constexpr float LOG2E = 1.4426950408889634f;
constexpr int NSLOT_MAX = 139264;

constexpr size_t WS_CTL = 0, CTL_ZERO_BYTES = 1 * MiB;
constexpr size_t WS_MOD = 1 * MiB;
constexpr size_t WS_ROPE = WS_MOD + 256 * 1024;
constexpr size_t WS_WR = WS_ROPE + 256 * 1024;
constexpr size_t WS_SSQ = 2 * MiB;
constexpr size_t WS_TKE = 3 * MiB;
constexpr size_t WS_TKG = 4 * MiB;
constexpr size_t WS_LIST = 5 * MiB;
constexpr size_t WS_WIN = 10 * MiB;
constexpr size_t WS_WOUT = 15 * MiB;
constexpr size_t WS_WGU = 17 * MiB;
constexpr size_t WS_WD = 145 * MiB;
constexpr size_t WS_XN = 209 * MiB;
constexpr size_t WS_PROJ = 273 * MiB;
constexpr size_t WS_O = 417 * MiB;
constexpr size_t WS_YS = 209 * MiB;
constexpr size_t WS_ACT = 481 * MiB;
constexpr size_t WS_MK_END = 753 * MiB;
constexpr int CW_TMO = 0, CW_CNT = 64  , CW_BAR = 4096;

constexpr int RING_BYTES = 131072;
constexpr int LDSCTL_OFF = RING_BYTES, MISC_OFF = LDSCTL_OFF + 320;
constexpr int TAB_OFF = LDSCTL_OFF + 1024;
constexpr int LDS_BYTES = 163840;

namespace pg8 {
constexpr int BM = 256, BK = 64, HALF = 128, HTB = HALF * BK * 2, NXCD = 8, WGM = 8;
__host__ __device__ __forceinline__ int lds_byte(int r, int c) { const int st = (r >> 4) * 2 + (c >> 5), rr = r & 15, cc = c & 31, ob = rr * 64 + cc * 2; return st * 1024 + (ob ^ (((ob >> 9) & 1) << 5)); }
__host__ __device__ __forceinline__ void stage_rc(int b, int& R, int& C) { const int st = b / 1024, sb = b % 1024, swz = sb ^ (((sb >> 9) & 1) << 5); R = (st >> 1) * 16 + swz / 64; C = (st & 1) * 32 + (swz % 64) / 2; }
__host__ __device__ __forceinline__ int perm32(int rho) { const int n = rho >> 4, i = rho & 15; return 8 * (i >> 2) + 4 * n + (i & 3); }

struct Unit { int pm, pn, e, aux; };

struct DenseOrder {
    const char* A; const char* Bt; int K; int nM, nN, nwg, G, c;
    __device__ void init(const void* A_, const void* Bt_, int M, int N, int K_, int G_, int c_) { A = (const char*)A_; Bt = (const char*)Bt_; K = K_; nM = M / BM; nN = N / BM; nwg = nM * nN; G = G_; c = c_; }
    __device__ bool next(int i, Unit& u) const {
        const long L = (long)i * G + c; if (L >= nwg) return false;
        int wgid = (int)L; { const int q = nwg / NXCD, r = nwg % NXCD, xcd = wgid % NXCD, off = wgid / NXCD; wgid = (xcd < r ? xcd * (q + 1) : r * (q + 1) + (xcd - r) * q) + off; }
        const int nig = WGM * nN, gid = wgid / nig, fm = gid * WGM, gsz = (nM - fm) < WGM ? (nM - fm) : WGM;
        u.pm = fm + ((wgid % nig) % gsz); u.pn = (wgid % nig) / gsz; u.e = 0; u.aux = 0; return true;
    }
    __device__ __forceinline__ const char* abase() const { return A; }
    __device__ __forceinline__ const char* bbase(const Unit& u) const { return Bt + (size_t)u.pn * BM * K * 2; }
    __device__ __forceinline__ void aoffs(const Unit& u, int, const int (&R)[2], const int (&C)[2], unsigned (&off)[4]) const {
#pragma unroll
        for (int h = 0; h < 2; ++h)
#pragma unroll
            for (int i = 0; i < 2; ++i) off[h * 2 + i] = (unsigned)((u.pm * BM + h * HALF + R[i]) * K + C[i]) * 2u;
    }
    __device__ __forceinline__ void meta_init(const Unit&, bool, const Unit&, int) const {}
    __device__ __forceinline__ void meta_top(int, bool, const Unit&, bool, const Unit&, int) const {}
};

#define PG8_LAS __attribute__((address_space(3)))
template <class Epi, class Sched, bool ALIGN_EPI>
__device__ __forceinline__ void gemm_phase(PG8_LAS unsigned char* lds, const int K, const Sched& S, const Epi& E, const int wid_  ) {
    const int lane = lane_id(), tid = wid_ * 64 + lane, wid = wid_, wr = wid >> 2, wc = wid & 3, fr = lane & 15, fq = lane >> 4;
    constexpr int ESZ = Epi::FP8 ? 1 : 2;
    const int nt = K * ESZ / (BK * 2);
    unsigned voffB[2];
#pragma unroll
    for (int i = 0; i < 2; ++i) { int R, C; stage_rc(tid * 16 + i * 8192, R, C); const int Rb = Epi::PERM ? ((R & ~31) + perm32(R & 31)) : R; voffB[i] = (unsigned)(Rb * K * ESZ + C * 2); }
#define PG8_RC() int sR[2], sC[2]; { int t2_ = tid; asm volatile("" : "+v"(t2_)); _Pragma("unroll") for (int i = 0; i < 2; ++i) stage_rc(t2_ * 16 + i * 8192, sR[i], sC[i]); }
    const size_t kstep = (size_t)(BK * 2);
    const size_t hstepB = (size_t)HALF * K * ESZ;
    const unsigned ldsw = (unsigned)wid * 1024u;
    const int aoff = lds_byte(wr * 64 + fr, fq * 8), boff = lds_byte(wc * 32 + fr, fq * 8);
    const char* const gA = S.abase();
#define PG8_SA(b, h) (((b) * 2 + (h)) * HTB)
#define PG8_SB(b, h) ((4 + (b) * 2 + (h)) * HTB)
#define PG8_STAGE(bufoff, gbase, voff) do { _Pragma("unroll") for (int _i = 0; _i < 2; ++_i) \
        __builtin_amdgcn_global_load_lds((const unsigned*)((const char*)(gbase) + (voff)[_i]), (PG8_LAS unsigned*)(lds + (bufoff) + ldsw + _i * 8192), 16, 0, 0); } while (0)
#define PG8_STAGEA(bufoff, offs, h, kb) do { _Pragma("unroll") for (int _i = 0; _i < 2; ++_i) \
        __builtin_amdgcn_global_load_lds((const unsigned*)((gA + (kb)) + (offs)[(h) * 2 + _i]), (PG8_LAS unsigned*)(lds + (bufoff) + ldsw + _i * 8192), 16, 0, 0); } while (0)
#define PG8_LD16(off) (*(const PG8_LAS u32x4*)(lds + (off)))
#define PG8_LDA(dst, b, h) do { _Pragma("unroll") for (int m = 0; m < 4; ++m) dst[m] = __builtin_shufflevector(PG8_LD16(PG8_SA(b, h) + aoff + m * 2048), PG8_LD16(PG8_SA(b, h) + aoff + m * 2048 + 1024), 0, 1, 2, 3, 4, 5, 6, 7); } while (0)
#define PG8_LDB(dst, b, h) do { _Pragma("unroll") for (int n = 0; n < 2; ++n) dst[n] = __builtin_shufflevector(PG8_LD16(PG8_SB(b, h) + boff + n * 2048), PG8_LD16(PG8_SB(b, h) + boff + n * 2048 + 1024), 0, 1, 2, 3, 4, 5, 6, 7); } while (0)
#define PG8_HALF(x, k) __builtin_bit_cast(bf16x8, __builtin_shufflevector(x, x, 4 * (k), 4 * (k) + 1, 4 * (k) + 2, 4 * (k) + 3))
#define PG8_MMA(ai, bj, At, Bt) do { __builtin_amdgcn_s_setprio(1); _Pragma("unroll") for (int m = 0; m < 4; ++m) _Pragma("unroll") for (int n = 0; n < 2; ++n) { \
        if constexpr (Epi::FP8) asm volatile("v_mfma_scale_f32_16x16x128_f8f6f4 %0, %1, %2, %0, %3, %4 op_sel_hi:[0,0,0]" : "+v"(acc[ai][bj][m][n]) : "v"(Bt[n]), "v"(At[m]), "v"(scw), "v"(sca)); \
        else { acc[ai][bj][m][n] = __builtin_amdgcn_mfma_f32_16x16x32_bf16(PG8_HALF(Bt[n], 0), PG8_HALF(At[m], 0), acc[ai][bj][m][n], 0, 0, 0); \
               acc[ai][bj][m][n] = __builtin_amdgcn_mfma_f32_16x16x32_bf16(PG8_HALF(Bt[n], 1), PG8_HALF(At[m], 1), acc[ai][bj][m][n], 0, 0, 0); } } \
        __builtin_amdgcn_s_setprio(0); } while (0)
#define PG8_WAIT_V(n) asm volatile("s_waitcnt vmcnt(" #n ")" ::: "memory")
#define PG8_WAIT_L(n) asm volatile("s_waitcnt lgkmcnt(" #n ")" ::: "memory")
#define PG8_BAR __builtin_amdgcn_s_barrier()
#define PG8_SCHED __builtin_amdgcn_sched_barrier(0)
    Unit cur, nxt, nn; int ui = 0;
    if (!S.next(0, cur)) return;
    bool h1 = S.next(1, nxt), h2 = h1 && S.next(2, nn);
    f32x4 acc[2][2][4][2];
#pragma unroll
    for (int a = 0; a < 2; ++a)
#pragma unroll
        for (int b = 0; b < 2; ++b)
#pragma unroll
            for (int m = 0; m < 4; ++m)
#pragma unroll
                for (int n = 0; n < 2; ++n) { acc[a][b][m][n] = (f32x4){0.f, 0.f, 0.f, 0.f}; asm volatile("" : "+v"(acc[a][b][m][n])); }
    unsigned scw = 0x7A7A7A7Au, sca = 0x7F7F7F7Fu; asm volatile("" : "+v"(scw), "+v"(sca));
    u32x8 At[4], B0[2], B1[2];
    unsigned lO[4], hO[2];
    S.meta_init(cur, h1, nxt, wid);
    { PG8_RC(); S.aoffs(cur, 0, sR, sC, lO); } hO[0] = lO[2]; hO[1] = lO[3];
    const char* cB = S.bbase(cur);
    PG8_STAGE(PG8_SB(0, 0), cB, voffB); PG8_STAGE(PG8_SB(0, 1), cB + hstepB, voffB); PG8_STAGEA(PG8_SA(0, 0), lO, 0, 0); PG8_STAGEA(PG8_SA(0, 1), lO, 1, 0);
    if (wr == 1) PG8_BAR;
    PG8_WAIT_V(2); PG8_BAR;
    PG8_STAGE(PG8_SB(1, 0), cB + kstep, voffB); PG8_STAGEA(PG8_SA(1, 0), lO, 0, kstep); PG8_STAGE(PG8_SB(1, 1), cB + hstepB + kstep, voffB);
    PG8_WAIT_V(6); PG8_BAR;
    for (;;) {
        const bool has_next = h1;
        const char* nB = has_next ? S.bbase(nxt) : cB;
        S.meta_top(ui, h1, nxt, h2, nn, wid);
#pragma unroll 1
        for (int t = 0; t < nt; t += 2) {
            const bool last = (t == nt - 2);
            if constexpr (Epi::MID) { if (t == nt / 2) { int l2_ = lane; asm volatile("" : "+v"(l2_)); E.mid(acc, cur, wr, l2_ & 15); } }
            if (last && has_next) { PG8_RC(); S.aoffs(nxt, ui + 1, sR, sC, lO); }
            const size_t k1 = (size_t)(t + 1) * kstep;
            const size_t k2 = last ? 0 : (size_t)(t + 2) * kstep, k3 = k2 + kstep;
            const char* b2 = (last ? nB : cB) + k2; const char* b3 = b2 + kstep;
            PG8_LDB(B0, 0, 0); PG8_LDB(B1, 0, 1); PG8_SCHED; PG8_LDA(At, 0, 0); PG8_STAGEA(PG8_SA(1, 1), hO, 0, k1);
            PG8_WAIT_V(8); PG8_WAIT_L(0); PG8_BAR; PG8_MMA(0, 0, At, B0); PG8_MMA(0, 1, At, B1); PG8_BAR; PG8_SCHED;
            PG8_LDA(At, 0, 1); PG8_STAGE(PG8_SB(0, 0), b2, voffB); PG8_STAGE(PG8_SB(0, 1), b2 + hstepB, voffB); PG8_STAGEA(PG8_SA(0, 0), lO, 0, k2);
            PG8_WAIT_V(8); PG8_WAIT_L(0); PG8_BAR; PG8_MMA(1, 0, At, B0); PG8_MMA(1, 1, At, B1); PG8_BAR; PG8_SCHED;
            PG8_LDB(B0, 1, 0); PG8_LDB(B1, 1, 1); PG8_SCHED; PG8_LDA(At, 1, 0); PG8_STAGEA(PG8_SA(0, 1), lO, 1, k2);
            PG8_WAIT_V(8); PG8_WAIT_L(0); PG8_BAR; PG8_MMA(0, 0, At, B0); PG8_MMA(0, 1, At, B1); PG8_BAR; PG8_SCHED;
            PG8_LDA(At, 1, 1); PG8_STAGE(PG8_SB(1, 0), b3, voffB); PG8_STAGE(PG8_SB(1, 1), b3 + hstepB, voffB); PG8_STAGEA(PG8_SA(1, 0), lO, 0, k3);
            PG8_WAIT_V(8); PG8_WAIT_L(0); PG8_BAR; PG8_MMA(1, 0, At, B0); PG8_MMA(1, 1, At, B1); PG8_BAR; PG8_SCHED;
        }
        if constexpr (ALIGN_EPI) { if (wr == 0) PG8_BAR; }
        if constexpr (Epi::FP8) asm volatile("s_nop 15\n\ts_nop 7" ::: "memory");
        { int l2_ = lane; asm volatile("" : "+v"(l2_)); E(acc, cur, ui, wr, wc, l2_ & 15, l2_ >> 4); }
        if (!has_next) break;
#pragma unroll
        for (int a = 0; a < 2; ++a)
#pragma unroll
            for (int b = 0; b < 2; ++b)
#pragma unroll
                for (int m = 0; m < 4; ++m)
#pragma unroll
                    for (int n = 0; n < 2; ++n) { acc[a][b][m][n] = (f32x4){0.f, 0.f, 0.f, 0.f}; asm volatile("" : "+v"(acc[a][b][m][n])); }
        cur = nxt; cB = nB; hO[0] = lO[2]; hO[1] = lO[3];
        nxt = nn; h1 = h2; h2 = h1 && S.next(ui + 3, nn);
        ++ui;
        if constexpr (ALIGN_EPI) { if (wr == 1) PG8_BAR; }
    }
    PG8_WAIT_V(0);
    if constexpr (!ALIGN_EPI) { if (wr == 0) PG8_BAR; }
    PG8_BAR;
#undef PG8_SA
#undef PG8_SB
#undef PG8_STAGE
#undef PG8_STAGEA
#undef PG8_LDA
#undef PG8_LDB
#undef PG8_MMA
#undef PG8_RC
#undef PG8_HALF
#undef PG8_LD16
#undef PG8_WAIT_V
#undef PG8_WAIT_L
#undef PG8_BAR
#undef PG8_SCHED
}
}
#define XB_TMO      128
#define XB_XCNT(j)  (256  + 64 * (j))
#define XB_XSUB(j)  (1280 + 64 * (j))
#define XB_XGEN(j)  (2304 + 64 * (j))
#define XB_TOP      3328
#define XB_TOPGEN   3392
#define XCD_BAR_WORDS 3456
#define XB_SPIN_CAP (1u << 18)
__device__ __forceinline__ unsigned xb_ld(unsigned* p)              { return __hip_atomic_load(p, __ATOMIC_RELAXED, __HIP_MEMORY_SCOPE_AGENT); }
__device__ __forceinline__ unsigned xb_add(unsigned* p, unsigned v) { return __hip_atomic_fetch_add(p, v, __ATOMIC_RELAXED, __HIP_MEMORY_SCOPE_AGENT); }
__device__ __forceinline__ unsigned xb_xcc_id() { return (unsigned)__builtin_amdgcn_s_getreg((3 << 11) | 20) & 0xFu; }
#define XB_SPIN(cond, bar) do { unsigned _sp = 0; while (cond) { __builtin_amdgcn_s_sleep(1); \
    if ((++_sp & 255u) == 0u) { if (xb_ld(&(bar)[XB_TMO])) break; if (_sp > XB_SPIN_CAP) { atomicAdd(&(bar)[XB_TMO], 1u); break; } } } } while (0)
struct XcdBarrier { unsigned* bar; unsigned x; volatile LAS unsigned* st; };
__device__ __forceinline__ XcdBarrier xcd_barrier_post(unsigned* bar, volatile LAS unsigned* st, int wave) {
    XcdBarrier b; b.bar = bar; b.x = xb_xcc_id(); b.st = st;
    if (wave == 0 && lane_id() == 0) (void)xb_add(&bar[XB_XCNT(b.x)], 1u);
    return b;
}
__device__ __forceinline__ void xcd_barrier_complete(unsigned* bar, unsigned x, unsigned& nloc, unsigned& nx) {
    const unsigned G = gridDim.x * gridDim.y * gridDim.z;
    unsigned sum, cnt, mine, sp = 0u;
    for (;;) {
        sum = 0u; cnt = 0u; mine = 0u;
#pragma unroll
        for (unsigned j = 0; j < 16; ++j) { const unsigned c = xb_ld(&bar[XB_XCNT(j)]); sum += c; cnt += (c > 0u) ? 1u : 0u; mine = (j == x) ? c : mine; }
        if (sum == G) break;
        __builtin_amdgcn_s_sleep(1);
        if ((++sp & 255u) == 0u) { if (xb_ld(&bar[XB_TMO])) break; if (sp > XB_SPIN_CAP) { atomicAdd(&bar[XB_TMO], 1u); break; } }
    }
    nloc = mine > 0u ? mine : 1u; nx = cnt > 0u ? cnt : 1u;
}
__device__ __forceinline__ void xcd_barrier(const XcdBarrier& b, int wave) {
    asm volatile("s_waitcnt vmcnt(0)" ::: "memory");
    __syncthreads();
    if (wave == 0 && lane_id() == 0) {
        unsigned* bar = b.bar;
        __builtin_amdgcn_s_waitcnt(0);
        unsigned nloc = b.st[0], nx = b.st[1];
        if (nloc == 0u) { xcd_barrier_complete(bar, b.x, nloc, nx); b.st[0] = nloc; b.st[1] = nx; }
        const unsigned old = xb_add(&bar[XB_XSUB(b.x)], 1u);
        const unsigned gen = old / nloc;
        if (old + 1u == (gen + 1u) * nloc) {
            __builtin_amdgcn_fence(__ATOMIC_RELEASE, "agent");
            asm volatile("s_waitcnt vmcnt(0)" ::: "memory");
            const unsigned og = xb_add(&bar[XB_TOP], 1u);
            const unsigned tg = og / nx;
            if (og + 1u == (tg + 1u) * nx) xb_add(&bar[XB_TOPGEN], 1u);
            else XB_SPIN(xb_ld(&bar[XB_TOPGEN]) == tg, bar);
            __builtin_amdgcn_fence(__ATOMIC_ACQUIRE, "agent");
            xb_add(&bar[XB_XGEN(b.x)], 1u);
            asm volatile("s_waitcnt vmcnt(0)" ::: "memory");
        } else {
            XB_SPIN(xb_ld(&bar[XB_XGEN(b.x)]) == gen, bar);
            __builtin_amdgcn_fence(__ATOMIC_ACQUIRE, "agent");
            asm volatile("s_waitcnt vmcnt(0)" ::: "memory");
        }
    }
    __syncthreads();
}

struct Frame {
    LAS unsigned char* lds;
    volatile LAS unsigned* MISC;
    gu32* ctl;
    int tid, lane, wave, vcu, G;
    const float *x, *c, *w_ada, *b_ada, *w_in, *sink, *rpb, *ga, *gb, *w_out, *w_router, *b_router, *w_gu, *b_gu, *w_down, *b_down, *g_final;
    float* out;
    float *mod, *rope, *ssq, *tkg;
    int *tke, *list;
    bf16_t *wr_t, *win_t, *wout_t, *wgu_t, *wd_t, *XN, *PROJ, *O, *YS, *ACT;
};
__device__ __forceinline__ float wave_sum(float v) {
#pragma unroll
    for (int o = 1; o < 64; o <<= 1) v += __shfl_xor(v, o);
    return v;
}

struct P0Item { const float* W; bf16_t* WT; int N, Kd, k0, n0, drow0, gains, fp8; };
__device__ __forceinline__ bool p0_item(const Frame& F, int it, P0Item& I) {
    constexpr int I_IN = 16 * (DIN / 32), I_OUT = 16 * (DM / 32), I_GU1 = 16 * (2 * DFF / 32), I_GU = NE * I_GU1, I_D1 = (DFF / 64) * (DM / 32), I_D = NE * I_D1;
    if (it >= I_IN + I_OUT + I_GU + I_D) return false;
    int r = it; I.gains = 0; I.fp8 = 0;
    if (r < I_IN) { const int nb = r % (DIN / 32), kb = r / (DIN / 32); I.W = F.w_in; I.WT = F.win_t; I.N = DIN; I.Kd = DM; I.k0 = kb * 64; I.n0 = nb * 32; I.drow0 = nb * 32; return true; } r -= I_IN;
    if (r < I_OUT) { const int nb = r % (DM / 32), kb = r / (DM / 32); I.W = F.w_out; I.WT = F.wout_t; I.N = DM; I.Kd = DM; I.k0 = kb * 64; I.n0 = nb * 32; I.drow0 = nb * 32; I.gains = 1; return true; } r -= I_OUT;
    if (r < I_GU) { const int e = r / I_GU1, q = r % I_GU1, nb = q % (2 * DFF / 32), kb = q / (2 * DFF / 32), n0 = nb * 32, f = n0 & (DFF - 1);
        I.W = F.w_gu + (size_t)e * DM * 2 * DFF; I.WT = (bf16_t*)((unsigned char*)F.wgu_t + (size_t)e * 2 * DFF * DM); I.N = 2 * DFF; I.Kd = DM; I.k0 = kb * 64; I.n0 = n0; I.drow0 = (f >> 7) * 256 + (n0 >= DFF ? 128 : 0) + (f & 127); I.fp8 = 1; return true; } r -= I_GU;
    { const int e = r / I_D1, q = r % I_D1, nb = q % (DM / 32), kb = q / (DM / 32);
        I.W = F.w_down + (size_t)e * DFF * DM; I.WT = (bf16_t*)((unsigned char*)F.wd_t + (size_t)e * DM * DFF); I.N = DM; I.Kd = DFF; I.k0 = kb * 64; I.n0 = nb * 32; I.drow0 = nb * 32; I.fp8 = 1; return true; }
}
__device__ __forceinline__ void p0_load(const P0Item& I, f32x4 (&w)[8], int lane) {
#pragma unroll
    for (int i = 0; i < 8; ++i) w[i] = __builtin_nontemporal_load((const GAS f32x4*)(I.W + (size_t)(I.k0 + 8 * i + (lane >> 3)) * I.N + I.n0 + 4 * (lane & 7)));
}
__device__ __forceinline__ void p0_finish(const Frame& F, const P0Item& I, const f32x4 (&w)[8], LAS float* scr, int lane) {
#pragma unroll
    for (int i = 0; i < 8; ++i) { const int kk = 8 * i + (lane >> 3), nn = 4 * (lane & 7); f32x4 v = w[i];
        if (I.gains) { const int k = I.k0 + kk; v = v * (k < 512 ? F.ga[k] : F.gb[k - 512]); }
        scr[kk * 33 + nn] = v.x; scr[kk * 33 + nn + 1] = v.y; scr[kk * 33 + nn + 2] = v.z; scr[kk * 33 + nn + 3] = v.w; }
    LDS_WAIT(); asm volatile("" ::: "memory");
    const int c = lane & 7;
#pragma unroll
    for (int j = 0; j < 4; ++j) { const int n = (lane >> 3) + 8 * j; const LAS float* s = scr + (8 * c) * 33 + n;
        if (I.fp8) { u32x2 o; o.x = pk_fp8x4(s[0 * 33] * W8_SCALE, s[1 * 33] * W8_SCALE, s[2 * 33] * W8_SCALE, s[3 * 33] * W8_SCALE); o.y = pk_fp8x4(s[4 * 33] * W8_SCALE, s[5 * 33] * W8_SCALE, s[6 * 33] * W8_SCALE, s[7 * 33] * W8_SCALE);
            *(GAS u32x2*)((unsigned char*)I.WT + (size_t)(I.drow0 + n) * I.Kd + I.k0 + 8 * c) = o; }
        else { u32x4 o; o.x = pk2(s[0 * 33], s[1 * 33]); o.y = pk2(s[2 * 33], s[3 * 33]); o.z = pk2(s[4 * 33], s[5 * 33]); o.w = pk2(s[6 * 33], s[7 * 33]);
            *(GAS u32x4*)(I.WT + (size_t)(I.drow0 + n) * I.Kd + I.k0 + 8 * c) = o; } }
    LDS_WAIT(); asm volatile("" ::: "memory");
}
__device__ __forceinline__ void p0_prologue(Frame& F) {
    const int gt = blockIdx.x * (NWAVES * 64) + F.tid;
    if (blockIdx.x < 6 * DM / 32) {
        LAS float* sc = (LAS float*)F.lds;
        LAS float* red = (LAS float*)(F.lds + 32768);
        for (int i = F.tid; i < NB * DM; i += NWAVES * 64) { const float v = F.c[i]; sc[i] = v / (1.f + __expf(-v)); }
        __syncthreads();
        const int col = F.tid & 31, ks = F.tid >> 5, n = blockIdx.x * 32 + col;
        float a[NB];
#pragma unroll
        for (int b = 0; b < NB; ++b) a[b] = 0.f;
        for (int k = ks * 64; k < ks * 64 + 64; ++k) { const float w = F.w_ada[(size_t)k * 6 * DM + n];
#pragma unroll
            for (int b = 0; b < NB; ++b) a[b] += sc[b * DM + k] * w; }
#pragma unroll
        for (int b = 0; b < NB; ++b) red[(ks * NB + b) * 32 + col] = a[b];
        __syncthreads();
        if (F.tid < 256) { const int b = F.tid >> 5; float s = F.b_ada[n];
#pragma unroll
            for (int q = 0; q < 16; ++q) s += red[(q * NB + b) * 32 + col];
            F.mod[b * 6 * DM + n] = s; }
        __syncthreads();
    }
    if (gt < SEQ * 8) {
        const int pos = gt >> 3, i = gt & 7;
        const float invf[8] = {1.0f, 0.1939227432012558f, 0.03760603070259094f, 0.007292664609849453f, 0.0014142135623842478f, 0.00027424818836152554f, 5.3182957344688475e-05f, 1.0313385246263351e-05f};
        float inv = invf[0];
#pragma unroll
        for (int q = 1; q < 8; ++q) inv = (i == q) ? invf[q] : inv;
        const float angf = (float)pos * inv;
        const double ang = (double)angf, twopi = 6.283185307179586476925287;
        const double r = ang - __builtin_rint(ang / twopi) * twopi, r2 = r * r;
        double cs = 1.0, sn = r, tc = 1.0, ts = r;
#pragma unroll 1
        for (int q = 1; q <= 20; ++q) { tc = -tc * r2 / (double)((2 * q - 1) * (2 * q)); ts = -ts * r2 / (double)((2 * q) * (2 * q + 1)); cs += tc; sn += ts; }
        F.rope[gt] = (float)cs; F.rope[SEQ * 8 + gt] = (float)sn;
    }
    if (gt < NE * DM) { const int e = gt >> 10, k = gt & 1023; const float w = F.w_router[k * NE + e]; const unsigned hi = f2bf(w); const unsigned lo = f2bf(w - bf2f(hi));
        F.wr_t[gt] = (bf16_t)hi; F.wr_t[NE * DM + gt] = (bf16_t)lo; }
    if (gt < NTOK * 2) F.ssq[gt] = 0.f;
    LAS float* scr = (LAS float*)(F.lds + F.wave * 16384);
    const int gw = F.vcu * NWAVES + F.wave, NGW = F.G * NWAVES;
    P0Item Ia, Ib; f32x4 wa[8], wb[8];
    bool ha = p0_item(F, gw, Ia), hb;
    if (ha) p0_load(Ia, wa, F.lane);
#pragma unroll 1
    for (int it = gw; ha; it += 2 * NGW) {
        hb = p0_item(F, it + NGW, Ib); if (hb) p0_load(Ib, wb, F.lane);
        p0_finish(F, Ia, wa, scr, F.lane);
        ha = p0_item(F, it + 2 * NGW, Ia); if (ha) p0_load(Ia, wa, F.lane);
        if (hb) p0_finish(F, Ib, wb, scr, F.lane);
    }
}
__device__ __forceinline__ void p1_xn(Frame& F) {
    const int gw = F.vcu * NWAVES + F.wave, NGW = F.G * NWAVES;
    for (int chunk = gw; chunk < NTOK / 16; chunk += NGW) {
        const int m0 = chunk * 16, b = m0 / SEQ;
        f32x4 s1[4], sh[4];
#pragma unroll
        for (int j = 0; j < 4; ++j) { s1[j] = *(const GAS f32x4*)(F.mod + b * 6 * DM + DM + 4 * F.lane + 256 * j) + 1.0f; sh[j] = *(const GAS f32x4*)(F.mod + b * 6 * DM + 4 * F.lane + 256 * j); }
        for (int r = 0; r < 16; ++r) {
            const GAS f32x4* xr = (const GAS f32x4*)(F.x + (size_t)(m0 + r) * DM) + F.lane;
            f32x4 v[4]; float s = 0.f;
#pragma unroll
            for (int j = 0; j < 4; ++j) { v[j] = xr[64 * j]; s += (v[j].x * v[j].x + v[j].y * v[j].y) + (v[j].z * v[j].z + v[j].w * v[j].w); }
            const float rstd = 1.f / sqrtf(wave_sum(s) * (1.f / DM) + EPS);
            GAS unsigned long long* o8 = (GAS unsigned long long*)(F.XN + (size_t)(m0 + r) * DM) + F.lane;
#pragma unroll
            for (int j = 0; j < 4; ++j) { const f32x4 h = v[j] * rstd * s1[j] + sh[j];
                o8[64 * j] = (unsigned long long)pk2(h.x, h.y) | ((unsigned long long)pk2(h.z, h.w) << 32); }
        }
    }
}
struct EpiProj {
    static constexpr bool PERM = true, MID = false, FP8 = false;
    bf16_t* O; const float* rope;
    __device__ __forceinline__ void mid(f32x4 (&)[2][2][4][2], const pg8::Unit&, int, int) const {}
    __device__ __forceinline__ void operator()(const f32x4 (&acc)[2][2][4][2], const pg8::Unit& u, int, int wr, int wc, int fr, int fq) const {
        const int row0 = u.pm * 256 + wr * 64 + fr, col0 = u.pn * 256 + wc * 32 + 8 * fq;
        const float sc = (u.pn < 2 || u.pn == 3 || u.pn == 4) ? C2 : 1.f;
#pragma unroll
        for (int ai = 0; ai < 2; ++ai)
#pragma unroll
            for (int m = 0; m < 4; ++m) { const int row = row0 + ai * 128 + m * 16; bf16_t* rowp = O + (size_t)row * DIN + col0;
#pragma unroll
                for (int bj = 0; bj < 2; ++bj) { f32x4 v0 = acc[ai][bj][m][0], v1 = acc[ai][bj][m][1];
                    const bool rope_tile = (u.pn < 2) || (u.pn == 2 && bj == 0);
                    if (rope_tile && (wc & 1) == 0) {
                        f32x4 o0, o1;
#pragma unroll
                        for (int q = 0; q < 4; ++q) { o0[q] = __shfl_xor(v0[q], 16); o1[q] = __shfl_xor(v1[q], 16); }
                        if (fq < 2) { const int pos = row & (SEQ - 1);
                            const f32x4 c0 = *(const GAS f32x4*)(rope + pos * 8), c1 = *(const GAS f32x4*)(rope + pos * 8 + 4);
                            const f32x4 s0 = *(const GAS f32x4*)(rope + SEQ * 8 + pos * 8), s1 = *(const GAS f32x4*)(rope + SEQ * 8 + pos * 8 + 4);
                            const float sg = fq == 0 ? -1.f : 1.f;
                            v0 = v0 * c0 + (o0 * sg) * s0; v1 = v1 * c1 + (o1 * sg) * s1; }
                    }
                    v0 = v0 * sc; v1 = v1 * sc;
                    u32x4 w; w.x = cvt_pk_bf16(v0[0], v0[1]); w.y = cvt_pk_bf16(v0[2], v0[3]); w.z = cvt_pk_bf16(v1[0], v1[1]); w.w = cvt_pk_bf16(v1[2], v1[3]);
                    *(GAS u32x4*)(rowp + bj * 128) = w; } }
    }
};
__device__ __forceinline__ int crow(int r, int hi) { return (r & 3) + 8 * (r >> 2) + 4 * hi; }
typedef short v4i16_t __attribute__((ext_vector_type(4)));
__device__ __forceinline__ v4i16_t vtr(const LAS unsigned char* p) { return __builtin_amdgcn_ds_read_tr16_b64_v4i16((LAS v4i16_t*)p); }
__device__ __forceinline__ float max3f(float a, float b, float c) { return __builtin_fmaxf(__builtin_fmaxf(a, b), c); }
__device__ __forceinline__ void dma_k(const bf16_t* Ktile  , LAS unsigned char* slot, int p, int lane) {
    const int row = 8 * p + (lane >> 3), ch = (lane & 7) ^ ((row >> 1) & 7);
    __builtin_amdgcn_global_load_lds((const unsigned*)(Ktile + (size_t)row * DIN + ch * 8), (LAS unsigned*)(slot + p * 1024), 16, 0, 0);
}
__device__ __forceinline__ void dma_v(const bf16_t* Vtile, LAS unsigned char* slot, int p, int lane) {
    __builtin_amdgcn_global_load_lds((const unsigned*)(Vtile + (size_t)(8 * p + ((lane >> 2) & 7)) * DIN + (lane >> 5) * 32 + (lane & 3) * 8), (LAS unsigned*)(slot + p * 1024), 16, 0, 0);
}
struct AttnState { float m, l; f32x16 o[2]; };
template <class MB>
__device__ __forceinline__ void attn_tile(const LAS unsigned char* Ks, const LAS unsigned char* Vs, const bf16x8 (&qr)[4], AttnState& st, int r32, int hi, int lane, const MB& mb) {
    f32x16 p0, p1;
#pragma unroll
    for (int r = 0; r < 16; ++r) { p0[r] = 0.f; p1[r] = 0.f; }
    const LAS unsigned char* kb = Ks + r32 * 128; const int sw = (r32 >> 1) & 7;
#pragma unroll
    for (int d0 = 0; d0 < 4; ++d0) {
        const int ko = ((2 * d0 + hi) ^ sw) << 4;
        const bf16x8 a0 = *(const LAS bf16x8*)(kb + ko), a1 = *(const LAS bf16x8*)(kb + ko + 4096);
        p0 = __builtin_amdgcn_mfma_f32_32x32x16_bf16(a0, qr[d0], p0, 0, 0, 0);
        p1 = __builtin_amdgcn_mfma_f32_32x32x16_bf16(a1, qr[d0], p1, 0, 0, 0);
    }
    mb(p0, p1, r32, hi);
    float a = max3f(p0[0], p0[1], p1[0]), b = max3f(p0[2], p0[3], p1[1]); a = max3f(a, p1[2], p1[3]);
#pragma unroll
    for (int r = 4; r < 16; r += 4) { a = max3f(a, p0[r], p0[r + 1]); b = max3f(b, p0[r + 2], p0[r + 3]); a = max3f(a, p1[r], p1[r + 1]); b = max3f(b, p1[r + 2], p1[r + 3]); }
    float rm = __builtin_fmaxf(a, b);
    rm = __builtin_fmaxf(rm, __shfl_xor(rm, 32));
    if (__any(rm > st.m + 8.0f)) {
        const float mn = __builtin_fmaxf(st.m, rm), f = __builtin_amdgcn_exp2f(st.m - mn);
        st.m = mn; st.l *= f;
#pragma unroll
        for (int r = 0; r < 16; ++r) { st.o[0][r] *= f; st.o[1][r] *= f; }
    }
    const float mref = st.m;
    float ls = 0.f;
#pragma unroll
    for (int r = 0; r < 16; ++r) { p0[r] = __builtin_amdgcn_exp2f(p0[r] - mref); p1[r] = __builtin_amdgcn_exp2f(p1[r] - mref); ls += p0[r] + p1[r]; }
    st.l += ls;
    u32x4 pw[4];
#pragma unroll
    for (int q = 0; q < 4; ++q) { pw[0][q] = cvt_pk_bf16(p0[2 * q], p0[2 * q + 1]); pw[1][q] = cvt_pk_bf16(p0[8 + 2 * q], p0[8 + 2 * q + 1]);
                                  pw[2][q] = cvt_pk_bf16(p1[2 * q], p1[2 * q + 1]); pw[3][q] = cvt_pk_bf16(p1[8 + 2 * q], p1[8 + 2 * q + 1]); }
    const LAS unsigned char* vb = Vs + ((lane >> 4) & 1) * 32 + (lane & 3) * 8 + (4 * hi + ((lane & 15) >> 2)) * 64;
#pragma unroll
    for (int d0 = 0; d0 < 2; ++d0)
#pragma unroll
        for (int s = 0; s < 4; ++s) {
            const v4i16_t lo = vtr(vb + d0 * 512 + s * 2048), hh = vtr(vb + d0 * 512 + s * 2048 + 1024);
            const bf16x8 vf = (bf16x8){lo[0], lo[1], lo[2], lo[3], hh[0], hh[1], hh[2], hh[3]};
            st.o[d0] = __builtin_amdgcn_mfma_f32_32x32x16_bf16(vf, __builtin_bit_cast(bf16x8, pw[s]), st.o[d0], 0, 0, 0);
        }
}
__device__ __forceinline__ void attn_finish(AttnState& st, LAS unsigned char* stg, bf16_t* Obase  , float* ssqp  , int r32, int hi, int lane) {
    float l = st.l; l += __shfl_xor(l, 32);
    const float inv = 1.0f / l;
    float sq = 0.f;
#pragma unroll
    for (int d0 = 0; d0 < 2; ++d0)
#pragma unroll
        for (int rg = 0; rg < 4; ++rg) {
            const float v0 = st.o[d0][4 * rg] * inv, v1 = st.o[d0][4 * rg + 1] * inv, v2 = st.o[d0][4 * rg + 2] * inv, v3 = st.o[d0][4 * rg + 3] * inv;
            sq += (v0 * v0 + v1 * v1) + (v2 * v2 + v3 * v3);
            u32x2 w; w.x = cvt_pk_bf16(v0, v1); w.y = cvt_pk_bf16(v2, v3);
            const int ch = 4 * d0 + rg;
            *(LAS u32x2*)(stg + r32 * 128 + ((ch ^ (r32 & 7)) << 4) + hi * 8) = w;
        }
    sq += __shfl_xor(sq, 32);
    if (hi == 0) atomicAdd(ssqp + r32 * 2, sq);
    asm volatile("s_waitcnt lgkmcnt(0)" ::: "memory");
#pragma unroll
    for (int i = 0; i < 4; ++i) { const int row = i * 8 + (lane >> 3), ch = lane & 7;
        const u32x4 v = *(const LAS u32x4*)(stg + row * 128 + ((ch ^ (row & 7)) << 4));
        *(GAS u32x4*)(Obase + (size_t)row * DM + ch * 8) = v; }
}
struct MbNone { __device__ __forceinline__ void operator()(f32x16&, f32x16&, int, int) const {} };
struct MbBandLo { int qi;
    __device__ __forceinline__ void operator()(f32x16& p0, f32x16& p1, int, int hi) const {
#pragma unroll
        for (int r = 0; r < 16; ++r) { const int kj = crow(r, hi); p0[r] = (kj >= qi) ? p0[r] : -1e30f; p1[r] = (kj + 32 >= qi) ? p1[r] : -1e30f; } } };
struct MbBandHi { int qi;
    __device__ __forceinline__ void operator()(f32x16& p0, f32x16& p1, int, int hi) const {
#pragma unroll
        for (int r = 0; r < 16; ++r) { const int kj = crow(r, hi); p0[r] = (kj <= qi) ? p0[r] : -1e30f; p1[r] = (kj + 32 <= qi) ? p1[r] : -1e30f; } } };
struct MbNeigh { const LAS float* base; const float* ma;
    __device__ __forceinline__ void operator()(f32x16& p0, f32x16& p1, int, int) const {
#pragma unroll
        for (int r = 0; r < 16; ++r) { const int o = (r & 3) + 8 * (r >> 2); p0[r] = (p0[r] + base[o]) + ma[r]; p1[r] = (p1[r] + base[o + 32]) + ma[16 + r]; } } };

__device__ __forceinline__ void attn_a_phase(Frame& F, float* ssq) {
    const int wave = F.wave, lane = F.lane, r32 = lane & 31, hi = lane >> 5, g = wave >> 1, qh = wave & 1;
    for (int u = F.vcu; u < NB * AKVH * (SEQ / 64); u += F.G) {
        const int qblk = u % (SEQ / 64), kvh = (u / (SEQ / 64)) % AKVH, b = u / ((SEQ / 64) * AKVH);
        const int q0 = qblk * 64, h = kvh * 4 + g;
        const bf16_t* base = F.PROJ + (size_t)b * SEQ * DIN;
        asm volatile("s_waitcnt lgkmcnt(0)" ::: "memory"); __builtin_amdgcn_s_barrier();
#pragma unroll
        for (int t = 0; t < 5; ++t) { const int k0 = q0 - 128 + 64 * t;
            if (k0 >= 0 && k0 < SEQ) { dma_k(base + (size_t)k0 * DIN + OFF_KA + kvh * HD, F.lds + t * 8192, wave, lane); dma_v(base + (size_t)k0 * DIN + OFF_VA + kvh * HD, F.lds + 40960 + t * 8192, wave, lane); } }
        const bf16_t* qp = base + (size_t)(q0 + qh * 32 + r32) * DIN + OFF_QA + h * HD + hi * 8;
        bf16x8 qr[4];
#pragma unroll
        for (int d0 = 0; d0 < 4; ++d0) qr[d0] = *(const GAS bf16x8*)(qp + d0 * 16);
        AttnState st; st.m = F.sink[h] * LOG2E; st.l = (hi == 0) ? 1.f : 0.f;
#pragma unroll
        for (int r = 0; r < 16; ++r) { st.o[0][r] = 0.f; st.o[1][r] = 0.f; }
        asm volatile("s_waitcnt vmcnt(0)" ::: "memory"); __builtin_amdgcn_s_barrier();
        const int qi = qh * 32 + r32;
        if (q0 - 128 >= 0) attn_tile(F.lds, F.lds + 40960, qr, st, r32, hi, lane, MbBandLo{qi});
        if (q0 - 64 >= 0) attn_tile(F.lds + 8192, F.lds + 40960 + 8192, qr, st, r32, hi, lane, MbNone{});
        attn_tile(F.lds + 2 * 8192, F.lds + 40960 + 2 * 8192, qr, st, r32, hi, lane, MbNone{});
        if (q0 + 64 < SEQ) attn_tile(F.lds + 3 * 8192, F.lds + 40960 + 3 * 8192, qr, st, r32, hi, lane, MbNone{});
        if (q0 + 128 < SEQ) attn_tile(F.lds + 4 * 8192, F.lds + 40960 + 4 * 8192, qr, st, r32, hi, lane, MbBandHi{qi});
        const int tok0 = b * SEQ + q0 + qh * 32;
        attn_finish(st, F.lds + 81920 + wave * 4096, F.O + (size_t)tok0 * DM + h * HD, ssq + tok0 * 2, r32, hi, lane);
    }
}
constexpr int NTAB_OFF = LDSCTL_OFF + 2048;
__device__ __forceinline__ void attn_b_phase(Frame& F, float* ssq) {
    const int wave = F.wave, lane = F.lane, r32 = lane & 31, hi = lane >> 5, rw = wave >> 1, qh = wave & 1;
    LAS float* tab = (LAS float*)(F.lds + NTAB_OFF);
    int cur_head = -1;
    for (int u = F.vcu; u < NB * BH * (GW / 4); u += F.G) {
        const int rg = u % (GW / 4), head = (u / (GW / 4)) % BH, b = u / ((GW / 4) * BH);
        const int r0 = rg * 4, r = r0 + rw;
        const int R0 = min(max(r0 - NAR / 2, 0), GW - NAR), nst = min(max(r0 + 3 - NAR / 2, 0), GW - NAR) + NAR - R0;
        const int rs = min(max(r - NAR / 2, 0), GW - NAR);
        const bf16_t* base = F.PROJ + (size_t)b * SEQ * DIN;
        asm volatile("s_waitcnt lgkmcnt(0)" ::: "memory"); __builtin_amdgcn_s_barrier();
        if (head != cur_head) { cur_head = head;
            for (int i = F.tid; i < 15 * 128; i += NWAVES * 64) { const int d = (i & 127) - 63, ro = i >> 7;
                tab[i] = (d >= -15 && d <= 15) ? F.rpb[(head * 15 + ro) * 31 + d + 15] * LOG2E : 0.f; }
            asm volatile("s_waitcnt lgkmcnt(0)" ::: "memory"); }
#define NB_DMA(t) do { const int _bs = ((t) & 3) * 16384; const bf16_t* _kr = base + (size_t)((R0 + (t)) * GW) * DIN; \
        dma_k(_kr + OFF_KB + head * HD, F.lds + _bs, wave, lane); dma_v(_kr + OFF_VB + head * HD, F.lds + _bs + 8192, wave, lane); } while (0)
        NB_DMA(0); NB_DMA(1); NB_DMA(2);
        const int qc = qh * 32 + r32, cs = min(max(qc - NAC / 2, 0), GW - NAC);
        float ma[32];
#pragma unroll
        for (int q = 0; q < 16; ++q) { const int kc = crow(q, hi); ma[q] = (kc >= cs && kc < cs + 16) ? 0.f : -1e30f; ma[16 + q] = (kc + 32 >= cs && kc + 32 < cs + 16) ? 0.f : -1e30f; }
        const bf16_t* qp = base + (size_t)(r * GW + qc) * DIN + OFF_QB + head * HD + hi * 8;
        bf16x8 qr[4];
#pragma unroll
        for (int d0 = 0; d0 < 4; ++d0) qr[d0] = *(const GAS bf16x8*)(qp + d0 * 16);
        AttnState st; st.m = -1e30f; st.l = 0.f;
#pragma unroll
        for (int q = 0; q < 16; ++q) { st.o[0][q] = 0.f; st.o[1][q] = 0.f; }
        for (int t = 0; t < nst; ++t) {
            if (t + 3 < nst) { NB_DMA(t + 3); asm volatile("s_waitcnt vmcnt(6)" ::: "memory"); }
            else if (t + 2 < nst) asm volatile("s_waitcnt vmcnt(4)" ::: "memory");
            else if (t + 1 < nst) asm volatile("s_waitcnt vmcnt(2)" ::: "memory");
            else asm volatile("s_waitcnt vmcnt(0)" ::: "memory");
            __builtin_amdgcn_s_barrier();
            const int kr = R0 + t;
            if (kr >= rs && kr < rs + NAR) {
                const LAS unsigned char* ks = F.lds + (t & 3) * 16384;
                attn_tile(ks, ks + 8192, qr, st, r32, hi, lane, MbNeigh{tab + (kr - r + NAR - 1) * 128 + (63 - qc + 4 * hi), ma});
            }
            asm volatile("s_waitcnt lgkmcnt(0)" ::: "memory"); __builtin_amdgcn_s_barrier();
        }
#undef NB_DMA
        const int tok0 = b * SEQ + r * GW + qh * 32;
        attn_finish(st, F.lds + 65536 + wave * 4096, F.O + (size_t)tok0 * DM + AQW + head * HD, ssq + tok0 * 2 + 1, r32, hi, lane);
    }
}
struct EpiX1 {
    static constexpr bool PERM = false, MID = true, FP8 = false;
    const float* x; float* x1; const float* mod; const float* ssq;
    __device__ __forceinline__ void mid(f32x4 (&acc)[2][2][4][2], const pg8::Unit& u, int wr, int fr) const {
#pragma unroll
        for (int ai = 0; ai < 2; ++ai)
#pragma unroll
            for (int m = 0; m < 4; ++m) { const int row = u.pm * 256 + ai * 128 + wr * 64 + m * 16 + fr;
                const f32x2 s = *(const GAS f32x2*)(ssq + row * 2);
                const float f = sqrtf((s.y * (1.f / 512.f) + EPS) / (s.x * (1.f / 512.f) + EPS));
#pragma unroll
                for (int bj = 0; bj < 2; ++bj)
#pragma unroll
                    for (int n = 0; n < 2; ++n) acc[ai][bj][m][n] *= f; }
    }
    __device__ __forceinline__ void operator()(const f32x4 (&acc)[2][2][4][2], const pg8::Unit& u, int, int wr, int wc, int fr, int fq) const {
        const int b = (u.pm * 256) / SEQ, col0 = u.pn * 256 + wc * 32 + 4 * fq;
        f32x4 gm[2][2];
#pragma unroll
        for (int bj = 0; bj < 2; ++bj)
#pragma unroll
            for (int n = 0; n < 2; ++n) gm[bj][n] = *(const GAS f32x4*)(mod + b * 6 * DM + 2 * DM + col0 + bj * 128 + n * 16);
#pragma unroll
        for (int ai = 0; ai < 2; ++ai)
#pragma unroll
            for (int m = 0; m < 4; ++m) { const int row = u.pm * 256 + ai * 128 + wr * 64 + m * 16 + fr;
                const float rb = 1.0f / sqrtf(ssq[row * 2 + 1] * (1.f / 512.f) + EPS);
                const size_t off = (size_t)row * DM + col0;
#pragma unroll
                for (int bj = 0; bj < 2; ++bj)
#pragma unroll
                    for (int n = 0; n < 2; ++n) { const f32x4 xr = *(const GAS f32x4*)(x + off + bj * 128 + n * 16);
                        *(GAS f32x4*)(x1 + off + bj * 128 + n * 16) = xr + gm[bj][n] * (acc[ai][bj][m][n] * rb); } }
    }
};

__device__ __forceinline__ void router_phase(Frame& F, gu32* cntw) {
    const int wave = F.wave, lane = F.lane, r32 = lane & 31, hi = lane >> 5;
    bf16x8 wh[8], wl[8];
#pragma unroll
    for (int c = 0; c < 8; ++c) { const bf16_t* p = F.wr_t + r32 * DM + 128 * wave + 16 * c + 8 * hi; wh[c] = *(const GAS bf16x8*)p; wl[c] = *(const GAS bf16x8*)(p + NE * DM); }
    LAS float* part = (LAS float*)(F.lds);
    LAS float* R = (LAS float*)(F.lds + 1024);
    LAS float* L = (LAS float*)(F.lds + 1024 + 32768);
    LAS int* lcnt = (LAS int*)(F.lds + 1024 + 32768 + 4352);
    const float* x1 = F.out;
    for (int it = F.vcu; it < NTOK / 32; it += F.G) {
        const int t0 = it * 32, b = t0 / SEQ, tok = t0 + r32;
        const float* xp = x1 + (size_t)tok * DM + 128 * wave + 8 * hi;
        f32x4 xa[8], xb[8]; float s = 0.f;
#pragma unroll
        for (int c = 0; c < 8; ++c) { xa[c] = *(const GAS f32x4*)(xp + 16 * c); xb[c] = *(const GAS f32x4*)(xp + 16 * c + 4);
            s += (xa[c].x * xa[c].x + xa[c].y * xa[c].y) + (xa[c].z * xa[c].z + xa[c].w * xa[c].w) + (xb[c].x * xb[c].x + xb[c].y * xb[c].y) + (xb[c].z * xb[c].z + xb[c].w * xb[c].w); }
        s += __shfl_xor(s, 32);
        if (hi == 0) part[wave * 32 + r32] = s;
        if (F.tid < 32) lcnt[F.tid] = 0;
        asm volatile("s_waitcnt lgkmcnt(0)" ::: "memory"); __builtin_amdgcn_s_barrier(); asm volatile("" ::: "memory");
        float tot = 0.f;
#pragma unroll
        for (int w = 0; w < 8; ++w) tot += part[w * 32 + r32];
        const float rstd = 1.0f / sqrtf(tot * (1.f / DM) + EPS);
        f32x16 acc;
#pragma unroll
        for (int r = 0; r < 16; ++r) acc[r] = 0.f;
        const float* mp = F.mod + b * 6 * DM + 128 * wave + 8 * hi;
        unsigned char* xnp = (unsigned char*)F.XN + (size_t)tok * DM + 128 * wave + 8 * hi;
#pragma unroll
        for (int c = 0; c < 8; ++c) {
            const f32x4 sc0 = *(const GAS f32x4*)(mp + 4 * DM + 16 * c), sc1 = *(const GAS f32x4*)(mp + 4 * DM + 16 * c + 4);
            const f32x4 sh0 = *(const GAS f32x4*)(mp + 3 * DM + 16 * c), sh1 = *(const GAS f32x4*)(mp + 3 * DM + 16 * c + 4);
            const f32x4 h0 = xa[c] * rstd * (sc0 + 1.0f) + sh0, h1 = xb[c] * rstd * (sc1 + 1.0f) + sh1;
            u32x4 hw; hw.x = pk2(h0.x, h0.y); hw.y = pk2(h0.z, h0.w); hw.z = pk2(h1.x, h1.y); hw.w = pk2(h1.z, h1.w);
            u32x4 lw;
            lw.x = pk2(h0.x - bf2f(hw.x & 0xffffu), h0.y - bf2f(hw.x >> 16)); lw.y = pk2(h0.z - bf2f(hw.y & 0xffffu), h0.w - bf2f(hw.y >> 16));
            lw.z = pk2(h1.x - bf2f(hw.z & 0xffffu), h1.y - bf2f(hw.z >> 16)); lw.w = pk2(h1.z - bf2f(hw.w & 0xffffu), h1.w - bf2f(hw.w >> 16));
            { u32x2 q8; q8.x = pk_fp8x4(h0.x, h0.y, h0.z, h0.w); q8.y = pk_fp8x4(h1.x, h1.y, h1.z, h1.w); *(GAS u32x2*)(xnp + 16 * c) = q8; }
            const bf16x8 hf = __builtin_bit_cast(bf16x8, hw), lf = __builtin_bit_cast(bf16x8, lw);
            acc = __builtin_amdgcn_mfma_f32_32x32x16_bf16(hf, wh[c], acc, 0, 0, 0);
            acc = __builtin_amdgcn_mfma_f32_32x32x16_bf16(lf, wh[c], acc, 0, 0, 0);
            acc = __builtin_amdgcn_mfma_f32_32x32x16_bf16(hf, wl[c], acc, 0, 0, 0);
        }
#pragma unroll
        for (int r = 0; r < 16; ++r) R[wave * 1024 + crow(r, hi) * 32 + r32] = acc[r];
        asm volatile("s_waitcnt lgkmcnt(0)" ::: "memory"); __builtin_amdgcn_s_barrier(); asm volatile("" ::: "memory");
#pragma unroll
        for (int q = 0; q < 2; ++q) { const int idx = F.tid * 2 + q, tk = idx >> 5, e = idx & 31; float v = F.b_router[e];
#pragma unroll
            for (int w = 0; w < 8; ++w) v += R[w * 1024 + idx];
            L[tk * 33 + e] = v; }
        asm volatile("s_waitcnt lgkmcnt(0)" ::: "memory"); __builtin_amdgcn_s_barrier(); asm volatile("" ::: "memory");
        if (wave == 0) {
            int sel[TOPK]; float gt[TOPK]; int lpos[TOPK];
            if (lane < 32) {
                float v[NE];
#pragma unroll
                for (int j = 0; j < NE; ++j) v[j] = L[lane * 33 + j];
                unsigned used = 0u; float sv[TOPK];
#pragma unroll
                for (int kk = 0; kk < TOPK; ++kk) { float best = -INFINITY; int bi = 0;
#pragma unroll
                    for (int j = 0; j < NE; ++j) { const bool ok = !((used >> j) & 1u) && (v[j] > best); best = ok ? v[j] : best; bi = ok ? j : bi; }
                    used |= 1u << bi; sel[kk] = bi; sv[kk] = best; }
                float den = 0.f;
#pragma unroll
                for (int kk = 0; kk < TOPK; ++kk) { gt[kk] = __expf(sv[kk] - sv[0]); den += gt[kk]; }
                const float rden = 1.0f / den;
#pragma unroll
                for (int kk = 0; kk < TOPK; ++kk) { gt[kk] *= rden; lpos[kk] = __hip_atomic_fetch_add(lcnt + sel[kk], 1, __ATOMIC_RELAXED, __HIP_MEMORY_SCOPE_WORKGROUP); }
            }
            asm volatile("s_waitcnt lgkmcnt(0)" ::: "memory");
            if (lane < 32) { const int n = lcnt[lane]; int base = 0;
                if (n > 0) base = (int)__hip_atomic_fetch_add((unsigned*)(cntw + lane * 64), (unsigned)n, __ATOMIC_RELAXED, __HIP_MEMORY_SCOPE_AGENT);
                lcnt[32 + lane] = base; }
            asm volatile("s_waitcnt vmcnt(0) lgkmcnt(0)" ::: "memory");
            if (lane < 32) {
                const int t = t0 + lane;
#pragma unroll
                for (int kk = 0; kk < TOPK; ++kk) { const int e = sel[kk], pos = lcnt[32 + e] + lpos[kk];
                    F.tkg[t * 4 + kk] = gt[kk]; F.list[e * NTOK + pos] = t * 4 + kk; }
            }
        }
    }
}

__device__ __forceinline__ void moe_table(Frame& F) {
    LAS int* tab = (LAS int*)(F.lds + TAB_OFF);
    if (F.tid == 0) { int s = 0;
        for (int e = 0; e < NE; ++e) { const int c = (int)__hip_atomic_load((unsigned*)(F.ctl + CW_CNT + e * 64), __ATOMIC_RELAXED, __HIP_MEMORY_SCOPE_AGENT); tab[e] = s; tab[40 + e] = c; s += (c + 255) >> 8; }
        tab[32] = s; }
    asm volatile("s_waitcnt vmcnt(0) lgkmcnt(0)" ::: "memory"); __syncthreads();
}
constexpr int META_OFF = NTAB_OFF, META_SLOT = 2048;
template <bool GATHER>
struct MoeOrder {
    const char* A; const char* Bt; const int* list; const float* bias; const LAS int* tab; LAS unsigned char* meta; int K, N, nN, G, c;
    mutable int ec;
    __device__ bool next(int i, pg8::Unit& u) const {
        const int L = i * G + c; if (L >= tab[32] * nN) return false;
        int e = ec;
#pragma unroll 1
        while (L >= tab[e + 1] * nN) ++e;
        ec = e;
        const int nm = tab[e + 1] - tab[e], ql = L - tab[e] * nN;
        u.e = e; u.pn = ql / nm; u.aux = ql % nm; u.pm = tab[e] + u.aux; return true;
    }
    __device__ __forceinline__ const char* abase() const { return A; }
    __device__ __forceinline__ const char* bbase(const pg8::Unit& u) const { return Bt + ((size_t)u.e * N + (size_t)u.pn * 256) * K; }
    __device__ __forceinline__ void dma_list(const pg8::Unit& u, int slot) const {
        const int lane = lane_id();
        __builtin_amdgcn_global_load_lds((const unsigned*)(list + (size_t)u.e * NTOK + u.aux * 256 + 4 * lane), (LAS unsigned*)(meta + slot * META_SLOT), 16, 0, 0);
    }
    __device__ __forceinline__ void dma_bias(const pg8::Unit& u, int slot) const {
        const int lane = lane_id();
        const float* src = GATHER ? bias + (size_t)u.e * 2 * DFF + u.pn * 128 + (lane >> 5) * DFF + 4 * (lane & 31) : bias + (size_t)u.e * DM + u.pn * 256 + 4 * lane;
        __builtin_amdgcn_global_load_lds((const unsigned*)src, (LAS unsigned*)(meta + slot * META_SLOT + 1024), 16, 0, 0);
    }
    __device__ __forceinline__ void meta_init(const pg8::Unit& u0, bool h1, const pg8::Unit& u1, int wid) const {
        if (wid == 0) { dma_list(u0, 0); dma_bias(u0, 0); if (h1) dma_list(u1, 1); }
        asm volatile("s_waitcnt vmcnt(0)" ::: "memory"); __builtin_amdgcn_s_barrier(); asm volatile("" ::: "memory");
    }
    __device__ __forceinline__ void meta_top(int ui, bool has_next, const pg8::Unit& nxt, bool h2, const pg8::Unit& nn, int wid) const {
        if (wid == 0) { if (has_next) dma_bias(nxt, (ui + 1) % 3); if (h2) dma_list(nn, (ui + 2) % 3); }
    }
    __device__ __forceinline__ void aoffs(const pg8::Unit& u, int ui, const int (&R)[2], const int (&C)[2], unsigned (&off)[4]) const {
        if (GATHER) { const int lim = tab[40 + u.e] - 1 - u.aux * 256; const LAS int* lst = (const LAS int*)(meta + (ui % 3) * META_SLOT);
#pragma unroll
            for (int h = 0; h < 2; ++h)
#pragma unroll
                for (int i = 0; i < 2; ++i) { int mi = h * 128 + R[i]; mi = mi < lim ? mi : lim; const int tk = lst[mi] >> 2; off[h * 2 + i] = (unsigned)(tk * K + C[i] * 2); }
        } else {
#pragma unroll
            for (int h = 0; h < 2; ++h)
#pragma unroll
                for (int i = 0; i < 2; ++i) off[h * 2 + i] = (unsigned)((u.pm * 256 + h * 128 + R[i]) * K + C[i] * 2);
        }
    }
};
struct EpiSwiglu {
    static constexpr bool PERM = true, MID = false, FP8 = true;
    bf16_t* act; const LAS unsigned char* meta;
    __device__ __forceinline__ void mid(f32x4 (&)[2][2][4][2], const pg8::Unit&, int, int) const {}
    __device__ __forceinline__ void operator()(const f32x4 (&acc)[2][2][4][2], const pg8::Unit& u, int ui, int wr, int wc, int fr, int fq) const {
        const int c0 = wc * 32 + 8 * fq, f0 = u.pn * 128 + c0, row0 = u.pm * 256 + wr * 64 + fr;
        const LAS float* bp = (const LAS float*)(meta + (ui % 3) * META_SLOT + 1024) + c0;
        const f32x4 bg0 = *(const LAS f32x4*)bp, bg1 = *(const LAS f32x4*)(bp + 4), bu0 = *(const LAS f32x4*)(bp + 128), bu1 = *(const LAS f32x4*)(bp + 132);
#pragma unroll
        for (int ai = 0; ai < 2; ++ai)
#pragma unroll
            for (int m = 0; m < 4; ++m) { const int row = row0 + ai * 128 + m * 16;
                float o[8];
#pragma unroll
                for (int q = 0; q < 8; ++q) { float g = (q < 4 ? acc[ai][0][m][0][q] + bg0[q] : acc[ai][0][m][1][q - 4] + bg1[q - 4]);
                    float up = (q < 4 ? acc[ai][1][m][0][q] + bu0[q] : acc[ai][1][m][1][q - 4] + bu1[q - 4]);
                    g = __builtin_fminf(g, 7.f); up = __builtin_fminf(__builtin_fmaxf(up, -7.f), 7.f);
                    const float glu = g * __builtin_amdgcn_rcpf(1.f + __builtin_amdgcn_exp2f(-1.702f * LOG2E * g));
                    o[q] = (up + 1.f) * glu; }
                u32x2 w; w.x = pk_fp8x4(o[0], o[1], o[2], o[3]); w.y = pk_fp8x4(o[4], o[5], o[6], o[7]);
                *(GAS u32x2*)((unsigned char*)act + (size_t)row * DFF + f0) = w; }
    }
};
struct EpiNull {
    static constexpr bool PERM = true, MID = false, FP8 = true;
    __device__ __forceinline__ void mid(f32x4 (&)[2][2][4][2], const pg8::Unit&, int, int) const {}
    __device__ __forceinline__ void operator()(const f32x4 (&acc)[2][2][4][2], const pg8::Unit&, int, int, int, int, int) const {
#pragma unroll
        for (int a = 0; a < 2; ++a)
#pragma unroll
            for (int b = 0; b < 2; ++b)
#pragma unroll
                for (int m = 0; m < 4; ++m)
#pragma unroll
                    for (int n = 0; n < 2; ++n) asm volatile("" :: "v"(acc[a][b][m][n]));
    }
};
struct EpiYs {
    static constexpr bool PERM = true, MID = false, FP8 = true;
    bf16_t* ys; const LAS int* tab; const LAS unsigned char* meta;
    __device__ __forceinline__ void mid(f32x4 (&)[2][2][4][2], const pg8::Unit&, int, int) const {}
    __device__ __forceinline__ void operator()(const f32x4 (&acc)[2][2][4][2], const pg8::Unit& u, int ui, int wr, int wc, int fr, int fq) const {
        const int c0 = wc * 32 + 8 * fq, col0 = u.pn * 256 + c0, rl0 = wr * 64 + fr, lim = tab[40 + u.e] - u.aux * 256;
        const LAS int* lst = (const LAS int*)(meta + (ui % 3) * META_SLOT); const LAS float* bp = (const LAS float*)(meta + (ui % 3) * META_SLOT + 1024) + c0;
        int ent[2][4];
#pragma unroll
        for (int ai = 0; ai < 2; ++ai)
#pragma unroll
            for (int m = 0; m < 4; ++m) { const int rl = rl0 + ai * 128 + m * 16; const int e_ = lst[rl]; ent[ai][m] = (rl < lim) ? e_ : -1; }
        f32x4 bv[2][2];
#pragma unroll
        for (int bj = 0; bj < 2; ++bj)
#pragma unroll
            for (int n = 0; n < 2; ++n) bv[bj][n] = *(const LAS f32x4*)(bp + bj * 128 + 4 * n);
#pragma unroll
        for (int ai = 0; ai < 2; ++ai)
#pragma unroll
            for (int m = 0; m < 4; ++m) { if (ent[ai][m] >= 0) { bf16_t* rowp = ys + (size_t)ent[ai][m] * DM + col0;
#pragma unroll
                for (int bj = 0; bj < 2; ++bj) { const f32x4 v0 = acc[ai][bj][m][0] + bv[bj][0], v1 = acc[ai][bj][m][1] + bv[bj][1];
                    u32x4 w; w.x = cvt_pk_bf16(v0[0], v0[1]); w.y = cvt_pk_bf16(v0[2], v0[3]); w.z = cvt_pk_bf16(v1[0], v1[1]); w.w = cvt_pk_bf16(v1[2], v1[3]);
                    *(GAS u32x4*)(rowp + bj * 128) = w; } } }
    }
};
struct FinRow { f32x4 x[4]; u32x2 y[TOPK][4]; };
__device__ __forceinline__ void fin_load(FinRow& R, const float* xrow, const bf16_t* yrow, int lane) {
    const GAS f32x4* xr = (const GAS f32x4*)xrow + lane;
#pragma unroll
    for (int kk = 0; kk < TOPK; ++kk) { const GAS u32x2* yr = (const GAS u32x2*)(yrow + (size_t)kk * DM) + lane;
#pragma unroll
        for (int j = 0; j < 4; ++j) R.y[kk][j] = __builtin_nontemporal_load(yr + 64 * j); }
#pragma unroll
    for (int j = 0; j < 4; ++j) R.x[j] = xr[64 * j];
}
__device__ __forceinline__ void fin_compute(const FinRow& R, float* drow, float gv, int r, int lane, const f32x4 (&gfm)[4], const f32x4 (&gf)[4]) {
    f32x4 y[4];
#pragma unroll
    for (int j = 0; j < 4; ++j) y[j] = (f32x4){0.f, 0.f, 0.f, 0.f};
#pragma unroll
    for (int kk = 0; kk < TOPK; ++kk) { const float g = __builtin_bit_cast(float, __builtin_amdgcn_readlane(__builtin_bit_cast(int, gv), r * 4 + kk));
#pragma unroll
        for (int j = 0; j < 4; ++j) { const u32x2 w = R.y[kk][j]; y[j] += (f32x4){bf2f(w.x & 0xffffu), bf2f(w.x >> 16), bf2f(w.y & 0xffffu), bf2f(w.y >> 16)} * g; } }
    f32x4 v[4]; float s = 0.f;
#pragma unroll
    for (int j = 0; j < 4; ++j) { v[j] = R.x[j] + gfm[j] * y[j]; s += (v[j].x * v[j].x + v[j].y * v[j].y) + (v[j].z * v[j].z + v[j].w * v[j].w); }
    const float rstd = 1.f / sqrtf(wave_sum(s) * (1.f / DM) + EPS);
    GAS f32x4* orow = (GAS f32x4*)drow + lane;
#pragma unroll
    for (int j = 0; j < 4; ++j) orow[64 * j] = v[j] * rstd * gf[j];
}
__device__ __forceinline__ void final_phase(Frame& F, float* dst) {
    const int gw = F.vcu * NWAVES + F.wave, NGW = F.G * NWAVES, lane = F.lane;
    f32x4 gf[4];
#pragma unroll
    for (int j = 0; j < 4; ++j) gf[j] = *(const GAS f32x4*)(F.g_final + 4 * lane + 256 * j);
    for (int chunk = gw; chunk < NTOK / 16; chunk += NGW) {
        const int m0 = chunk * 16, b = m0 / SEQ;
        f32x4 gfm[4];
#pragma unroll
        for (int j = 0; j < 4; ++j) gfm[j] = *(const GAS f32x4*)(F.mod + b * 6 * DM + 5 * DM + 4 * lane + 256 * j);
        const float gv = F.tkg[m0 * 4 + lane];
        FinRow A, B;
        fin_load(A, F.out + (size_t)m0 * DM, F.YS + (size_t)m0 * 4 * DM, lane);
#pragma unroll 1
        for (int r = 0; r < 16; r += 2) {
            fin_load(B, F.out + (size_t)(m0 + r + 1) * DM, F.YS + (size_t)(m0 + r + 1) * 4 * DM, lane);
            fin_compute(A, dst + (size_t)(m0 + r) * DM, gv, r, lane, gfm, gf);
            if (r + 2 < 16) fin_load(A, F.out + (size_t)(m0 + r + 2) * DM, F.YS + (size_t)(m0 + r + 2) * 4 * DM, lane);
            fin_compute(B, dst + (size_t)(m0 + r + 1) * DM, gv, r + 1, lane, gfm, gf);
        }
    }
}
struct MkArgs { const float* in[17]; float* out; unsigned char* ws; int ph_lo, ph_hi; };
#ifndef DBG_STAGE
#define DBG_STAGE 9
#endif
constexpr int N_PHASES = DBG_STAGE;
__global__ void __launch_bounds__(NWAVES * 64, 2) mk_fwd(MkArgs args) {
    extern __shared__ __attribute__((aligned(16))) unsigned char lds[];
    Frame F;
    F.lds = (LAS unsigned char*)lds;
    F.MISC = (volatile LAS unsigned*)(F.lds + MISC_OFF);
    F.tid = threadIdx.x; F.lane = F.tid & 63; F.wave = __builtin_amdgcn_readfirstlane(F.tid >> 6);
    F.G = gridDim.x; { const int bx = blockIdx.x; F.vcu = (F.G % 8 == 0) ? (bx % 8) * (F.G / 8) + bx / 8 : bx; }
    unsigned char* ws = args.ws;
    F.ctl = (gu32*)(ws + WS_CTL);
    F.x = args.in[0]; F.c = args.in[1]; F.w_ada = args.in[2]; F.b_ada = args.in[3]; F.w_in = args.in[4]; F.sink = args.in[5]; F.rpb = args.in[6]; F.ga = args.in[7]; F.gb = args.in[8];
    F.w_out = args.in[9]; F.w_router = args.in[10]; F.b_router = args.in[11]; F.w_gu = args.in[12]; F.b_gu = args.in[13]; F.w_down = args.in[14]; F.b_down = args.in[15]; F.g_final = args.in[16];
    F.out = args.out;
    F.mod = (float*)(ws + WS_MOD); F.rope = (float*)(ws + WS_ROPE); F.ssq = (float*)(ws + WS_SSQ); F.tkg = (float*)(ws + WS_TKG); F.tke = (int*)(ws + WS_TKE); F.list = (int*)(ws + WS_LIST);
    F.wr_t = (bf16_t*)(ws + WS_WR); F.win_t = (bf16_t*)(ws + WS_WIN); F.wout_t = (bf16_t*)(ws + WS_WOUT); F.wgu_t = (bf16_t*)(ws + WS_WGU); F.wd_t = (bf16_t*)(ws + WS_WD);
    F.XN = (bf16_t*)(ws + WS_XN); F.PROJ = (bf16_t*)(ws + WS_PROJ); F.O = (bf16_t*)(ws + WS_O); F.YS = (bf16_t*)(ws + WS_YS); F.ACT = (bf16_t*)(ws + WS_ACT);
    for (int u = F.tid; u < (LDS_BYTES - LDSCTL_OFF) / 4; u += NWAVES * 64) ((LAS unsigned*)(F.lds + LDSCTL_OFF))[u] = 0u;
    __syncthreads();
    const int lo = args.ph_lo, hi = args.ph_hi;
    XcdBarrier bar; bar.bar = (unsigned*)(F.ctl + CW_BAR); bar.x = 0; bar.st = nullptr;
    if (hi - lo > 1) bar = xcd_barrier_post((unsigned*)(F.ctl + CW_BAR), F.MISC + 8, F.wave);
#define IN(k) (lo <= (k) && (k) < hi)
#define FRESH() do { F.lane = lane_id(); F.tid = F.wave * 64 + F.lane; } while (0)
#if defined(DIAG_A)
    unsigned long long* const ts = (unsigned long long*)(ws + WS_CTL + 512 * 1024);
#define STAMP(k) do { if (blockIdx.x == 0 && F.wave == 0 && lane_id() == 0) ts[k] = __builtin_amdgcn_s_memrealtime(); } while (0)
#else
#define STAMP(k) do {} while (0)
#endif
#define SEAM(k) do { if (IN(k) && IN((k) + 1)) xcd_barrier(bar, F.wave); STAMP((k) + 1); } while (0)
#ifndef PROBE_PH
#define PROBE_PH -1
#endif
#ifndef PROBE_FIN
#define PROBE_FIN 0
#endif
#define REP(k) for (int _rep = (PROBE_PH == (k)) ? 0 : 1; _rep < 2; ++_rep)
    float* const dummy = (float*)(ws + 760 * MiB);
    STAMP(0);
    FRESH();
    if (IN(0)) { REP(0) { __syncthreads(); p0_prologue(F); } } SEAM(0);
    FRESH();
    if (IN(1)) { REP(1) p1_xn(F); } SEAM(1);
    FRESH();
    if (IN(2)) REP(2) {
        pg8::DenseOrder S; S.init(F.XN, F.win_t, NTOK, DIN, DM, F.G, (int)blockIdx.x);
        EpiProj E{F.PROJ, F.rope};
        pg8::gemm_phase<EpiProj, pg8::DenseOrder, true>(F.lds, DM, S, E, F.wave);
    } SEAM(2);
    FRESH();
    if (IN(3)) { if (PROBE_PH == 3) { if (PROBE_FIN != 2) attn_a_phase(F, dummy); if (PROBE_FIN != 1) attn_b_phase(F, dummy); }
                 attn_a_phase(F, F.ssq); attn_b_phase(F, F.ssq); } SEAM(3);
    FRESH();
    if (IN(4)) REP(4) {
        pg8::DenseOrder S; S.init(F.O, F.wout_t, NTOK, DM, DM, F.G, (int)blockIdx.x);
        EpiX1 E{F.x, F.out, F.mod, F.ssq};
        pg8::gemm_phase<EpiX1, pg8::DenseOrder, true>(F.lds, DM, S, E, F.wave);
    } SEAM(4);
    FRESH();
    if (IN(5)) REP(5) { router_phase(F, _rep ? F.ctl + CW_CNT : F.ctl + 16384); } SEAM(5);
    FRESH();
    if (IN(6)) {
        moe_table(F);
        MoeOrder<true> S{(const char*)F.XN, (const char*)F.wgu_t, F.list, F.b_gu, (const LAS int*)(F.lds + TAB_OFF), F.lds + META_OFF, DM, 2 * DFF, 2 * DFF / 256, F.G, F.vcu, 0};
        if (PROBE_PH == 6) { EpiNull E0; pg8::gemm_phase<EpiNull, MoeOrder<true>, true>(F.lds, DM, S, E0, F.wave); S.ec = 0; }
        EpiSwiglu E{F.ACT, F.lds + META_OFF};
        pg8::gemm_phase<EpiSwiglu, MoeOrder<true>, true>(F.lds, DM, S, E, F.wave);
    } SEAM(6);
    FRESH();
    if (IN(7)) REP(7) {
        moe_table(F);
        MoeOrder<false> S{(const char*)F.ACT, (const char*)F.wd_t, F.list, F.b_down, (const LAS int*)(F.lds + TAB_OFF), F.lds + META_OFF, DFF, DM, DM / 256, F.G, F.vcu, 0};
        EpiYs E{F.YS, (const LAS int*)(F.lds + TAB_OFF), F.lds + META_OFF};
        pg8::gemm_phase<EpiYs, MoeOrder<false>, true>(F.lds, DFF, S, E, F.wave);
    } SEAM(7);
    FRESH();
    if (IN(8)) REP(8) { final_phase(F, _rep ? F.out : dummy); }
#if defined(DIAG_A)
    xcd_barrier(bar, F.wave); STAMP(9);
    if (blockIdx.x == 0 && F.wave == 0) { asm volatile("s_waitcnt vmcnt(0)" ::: "memory");
        const unsigned long long t9 = __builtin_amdgcn_s_memrealtime(), span = (DIAG_A == 9) ? 0ull : (ts[DIAG_A + 1] - ts[DIAG_A]);
        while (__builtin_amdgcn_s_memrealtime() - t9 < 4ull * span) __builtin_amdgcn_s_sleep(16); }
#endif
#undef IN
#undef SEAM
}

__global__ void br_route(const bf16_t* XN, const int* tke, const unsigned* ctl, float* h, int* cnt, int* list) {
    const int idx = blockIdx.x * 256 + threadIdx.x;
    const int ep = tke[idx]; list[(ep >> 16) * NTOK + (ep & 0xffff)] = idx;
    if (idx < NE) cnt[idx] = (int)ctl[CW_CNT + idx * 64];
    const int t = idx >> 2, q = idx & 3;
    for (int k = q * 256; k < q * 256 + 256; ++k) h[(size_t)t * DM + k] = bf2f(XN[(size_t)t * DM + k]);
}
extern "C" void kernel_launch(void* const* d_in, const int* in_sizes, int n_in, void* d_out, int out_size, void* d_ws, size_t ws_size, hipStream_t stream) {
    static int grid = 0;
    if (grid == 0) {
        if (n_in != 17 || ws_size < (size_t)1001 * MiB) { fprintf(stderr, "kernel_launch: bad n_in %d or ws_size %zu\n", n_in, ws_size); grid = -1; return; }
        int dev = 0, cus = 0, per_cu = 0;
        if (hipGetDevice(&dev) != hipSuccess || hipDeviceGetAttribute(&cus, hipDeviceAttributeMultiprocessorCount, dev) != hipSuccess) { grid = -1; return; }
        if (hipFuncSetAttribute((const void*)mk_fwd, hipFuncAttributeMaxDynamicSharedMemorySize, LDS_BYTES) != hipSuccess) { fprintf(stderr, "kernel_launch: hipFuncSetAttribute failed\n"); grid = -1; return; }
        if (hipOccupancyMaxActiveBlocksPerMultiprocessor(&per_cu, (const void*)mk_fwd, NWAVES * 64, LDS_BYTES) != hipSuccess || per_cu < 1) { fprintf(stderr, "kernel_launch: occupancy query says %d\n", per_cu); }
        (void)hipGetLastError();
        grid = cus;
    }
    if (grid < 0) return;
    const float* x = (const float*)d_in[0]; const float* sink = (const float*)d_in[5]; const float* rpb = (const float*)d_in[6]; const float* ga = (const float*)d_in[7];
    const float* gb = (const float*)d_in[8]; const float* w_out = (const float*)d_in[9]; const float* w_router = (const float*)d_in[10]; const float* b_router = (const float*)d_in[11];
    const float* w_gu = (const float*)d_in[12]; const float* b_gu = (const float*)d_in[13]; const float* w_down = (const float*)d_in[14]; const float* b_down = (const float*)d_in[15];
    const float* g_final = (const float*)d_in[16];
    char* ws = (char*)d_ws; float* out = (float*)d_out;
    (void)hipMemsetAsync(ws + WS_CTL, 0, CTL_ZERO_BYTES, stream);
    MkArgs a{};
    for (int i = 0; i < 17; ++i) a.in[i] = (const float*)d_in[i];
    a.out = out; a.ws = (unsigned char*)d_ws;
#if defined(MK_PER_PHASE)
    for (int ph = 0; ph < N_PHASES; ++ph) { a.ph_lo = ph; a.ph_hi = ph + 1; hipLaunchKernelGGL(mk_fwd, dim3(grid), dim3(NWAVES * 64), LDS_BYTES, stream, a); }
#else
    a.ph_lo = 0; a.ph_hi = N_PHASES; hipLaunchKernelGGL(mk_fwd, dim3(grid), dim3(NWAVES * 64), LDS_BYTES, stream, a);
#endif
#if DBG_STAGE < 9
    float* mod = (float*)(ws + WS_MOD);
    float* h = (float*)(ws + 17 * MiB);
    float* y = (float*)(ws + 337 * MiB);
    float* act = (float*)(ws + 481 * MiB);
    int* cnt = (int*)(ws + 993 * MiB); int* tke = (int*)(ws + 994 * MiB); float* tkg = (float*)(ws + 995 * MiB); int* list = (int*)(ws + 996 * MiB);
    (void)hipMemsetAsync(cnt, 0, 64 * sizeof(int), stream);
    (void)hipMemsetAsync(y, 0, (size_t)NTOK * DM * 4, stream);
#if DBG_STAGE == 5
    nv_norm_mod<<<NTOK, 256, 0, stream>>>(out, mod, 3 * DM, 4 * DM, h);
    nv_router<<<NTOK, 64, 0, stream>>>(h, w_router, b_router, cnt, tke, tkg, list);
#elif DBG_STAGE == 6
    br_route<<<NTOK * 4 / 256, 256, 0, stream>>>((const bf16_t*)(ws + WS_XN), (const int*)(ws + WS_TKE), (const unsigned*)(ws + WS_CTL), h, cnt, list);
    tkg = (float*)(ws + WS_TKG);
#endif
    nv_offsets<<<1, 64, 0, stream>>>(cnt);
    nv_sgemm<true><<<dim3(DFF / 64, NTOK / 64, NE), 256, 0, stream>>>(w_gu, 2 * DFF, DM, RmMoe1{h, list, cnt, (size_t)DM * 2 * DFF}, EpiMoe1{act, cnt, b_gu});
    nv_sgemm<false><<<dim3(DM / 64, NTOK / 64, NE), 256, 0, stream>>>(w_down, DM, DFF, RmMoe2{act, cnt, (size_t)DFF * DM}, EpiMoe2{y, list, cnt, tkg, b_down});
    nv_final<<<NTOK, 256, 0, stream>>>(out, y, mod, g_final, out);
#endif
}
```

```cpp
#define DBG_STAGE 9
#include <hip/hip_runtime.h>
#include <cstdio>
#include <cstdint>
#include <cmath>

constexpr int DM = 1024, NB = 8, SEQ = 4096, NTOK = NB * SEQ;
constexpr int HD = 64, AQH = 8, AKVH = 2, BH = 8;
constexpr int AQW = 512, AKVW = 128, BW = 512, DIN = 2304;
constexpr int OFF_QA = 0, OFF_KA = 512, OFF_VA = 640, OFF_QB = 768, OFF_KB = 1280, OFF_VB = 1792;
constexpr int WIN = 128, GW = 64, NAR = 8, NAC = 16, NE = 32, TOPK = 4, DFF = 1024;
constexpr float EPS = 1e-5f;
constexpr size_t MiB = 1u << 20;

#define GAS __attribute__((address_space(1)))
#define LAS __attribute__((address_space(3)))
typedef unsigned short bf16_t;
typedef short bf16x8 __attribute__((ext_vector_type(8)));
typedef float f32x4 __attribute__((ext_vector_type(4)));
typedef float f32x2 __attribute__((ext_vector_type(2)));
typedef float f32x16 __attribute__((ext_vector_type(16)));
typedef unsigned u32x4 __attribute__((ext_vector_type(4)));
typedef unsigned u32x2 __attribute__((ext_vector_type(2)));
typedef unsigned u32x8 __attribute__((ext_vector_type(8)));
typedef GAS unsigned gu32;
#define RLX_AGENT __ATOMIC_RELAXED, __HIP_MEMORY_SCOPE_AGENT
#define LDS_WAIT() asm volatile("s_waitcnt lgkmcnt(0)" ::: "memory")
#define VM_WAIT() asm volatile("s_waitcnt vmcnt(0)" ::: "memory")
__device__ __forceinline__ unsigned cvt_pk_bf16(float lo, float hi) { unsigned r; asm volatile("v_cvt_pk_bf16_f32 %0, %1, %2" : "=v"(r) : "v"(lo), "v"(hi)); return r; }
__device__ __forceinline__ unsigned f2bf(float f) { unsigned u = __builtin_bit_cast(unsigned, f); return (u + 0x7fffu + ((u >> 16) & 1u)) >> 16; }
__device__ __forceinline__ unsigned pk2(float lo, float hi) { return f2bf(lo) | (f2bf(hi) << 16); }
__device__ __forceinline__ float bf2f(unsigned h) { return __builtin_bit_cast(float, h << 16); }
__device__ __forceinline__ unsigned pk_fp8x4(float a, float b, float c, float d) { int p = __builtin_amdgcn_cvt_pk_fp8_f32(a, b, 0, false); return (unsigned)__builtin_amdgcn_cvt_pk_fp8_f32(c, d, p, true); }
typedef int v8i32 __attribute__((ext_vector_type(8)));
constexpr float W8_SCALE = 32.0f;

constexpr int NWAVES = 8;
__device__ __forceinline__ int lane_id() { int l; asm volatile("v_mbcnt_lo_u32_b32 %0, -1, 0\n\tv_mbcnt_hi_u32_b32 %0, -1, %0" : "=v"(l)); return l; }
constexpr float C2 = 0.125f * 1.4426950408889634f;
constexpr float LOG2E = 1.4426950408889634f;
constexpr int NSLOT_MAX = 139264;

constexpr size_t WS_CTL = 0, CTL_ZERO_BYTES = 128 * 1024;
constexpr size_t WS_MOD = 1 * MiB;
constexpr size_t WS_ROPE = WS_MOD + 256 * 1024;
constexpr size_t WS_WR = WS_ROPE + 256 * 1024;
constexpr size_t WS_SSQ = 2 * MiB;
constexpr size_t WS_TKE = 3 * MiB;
constexpr size_t WS_TKG = 4 * MiB;
constexpr size_t WS_LIST = 5 * MiB;
constexpr size_t WS_WIN = 10 * MiB;
constexpr size_t WS_WOUT = 15 * MiB;
constexpr size_t WS_WGU = 17 * MiB;
constexpr size_t WS_WD = 145 * MiB;
constexpr size_t WS_XN = 209 * MiB;
constexpr size_t WS_PROJ = 273 * MiB;
constexpr size_t WS_O = 417 * MiB;
constexpr size_t WS_YS = 209 * MiB;
constexpr size_t WS_ACT = 481 * MiB;
constexpr size_t WS_DELTA = 760 * MiB;
constexpr size_t WS_MK_END = 824 * MiB;
constexpr int CW_TMO = 0, CW_CNT = 64  , CW_BAR = 4096;

constexpr int RING_BYTES = 131072;
constexpr int LDSCTL_OFF = RING_BYTES, MISC_OFF = LDSCTL_OFF + 320;
constexpr int TAB_OFF = LDSCTL_OFF + 1024;
constexpr int LDS_BYTES = 163840;

namespace pg8 {
constexpr int BM = 256, BK = 64, HALF = 128, HTB = HALF * BK * 2, NXCD = 8, WGM = 8;
__host__ __device__ __forceinline__ int lds_byte(int r, int c) { const int st = (r >> 4) * 2 + (c >> 5), rr = r & 15, cc = c & 31, ob = rr * 64 + cc * 2; return st * 1024 + (ob ^ (((ob >> 9) & 1) << 5)); }
__host__ __device__ __forceinline__ void stage_rc(int b, int& R, int& C) { const int st = b / 1024, sb = b % 1024, swz = sb ^ (((sb >> 9) & 1) << 5); R = (st >> 1) * 16 + swz / 64; C = (st & 1) * 32 + (swz % 64) / 2; }
__host__ __device__ __forceinline__ int perm32(int rho) { const int n = rho >> 4, i = rho & 15; return 8 * (i >> 2) + 4 * n + (i & 3); }

struct Unit { int pm, pn, e, aux; };

struct DenseOrder {
    const char* A; const char* Bt; int K; int nM, nN, nwg, G, c;
    __device__ void init(const void* A_, const void* Bt_, int M, int N, int K_, int G_, int c_) { A = (const char*)A_; Bt = (const char*)Bt_; K = K_; nM = M / BM; nN = N / BM; nwg = nM * nN; G = G_; c = c_; }
    __device__ bool next(int i, Unit& u) const {
        const long L = (long)i * G + c; if (L >= nwg) return false;
        int wgid = (int)L; { const int q = nwg / NXCD, r = nwg % NXCD, xcd = wgid % NXCD, off = wgid / NXCD; wgid = (xcd < r ? xcd * (q + 1) : r * (q + 1) + (xcd - r) * q) + off; }
        const int nig = WGM * nN, gid = wgid / nig, fm = gid * WGM, gsz = (nM - fm) < WGM ? (nM - fm) : WGM;
        u.pm = fm + ((wgid % nig) % gsz); u.pn = (wgid % nig) / gsz; u.e = 0; u.aux = 0; return true;
    }
    __device__ __forceinline__ const char* abase() const { return A; }
    __device__ __forceinline__ const char* bbase(const Unit& u) const { return Bt + (size_t)u.pn * BM * K * 2; }
    __device__ __forceinline__ void aoffs(const Unit& u, int, const int (&R)[2], const int (&C)[2], unsigned (&off)[4]) const {
#pragma unroll
        for (int h = 0; h < 2; ++h)
#pragma unroll
            for (int i = 0; i < 2; ++i) off[h * 2 + i] = (unsigned)((u.pm * BM + h * HALF + R[i]) * K + C[i]) * 2u;
    }
    __device__ __forceinline__ void meta_init(const Unit&, bool, const Unit&, int) const {}
    __device__ __forceinline__ void meta_top(int, bool, const Unit&, bool, const Unit&, int) const {}
};

#define PG8_LAS __attribute__((address_space(3)))
template <class Epi, class Sched, bool ALIGN_EPI>
__device__ __forceinline__ void gemm_phase(PG8_LAS unsigned char* lds, const int K, const Sched& S, const Epi& E, const int wid_  ) {
    const int lane = lane_id(), tid = wid_ * 64 + lane, wid = wid_, wr = wid >> 2, wc = wid & 3, fr = lane & 15, fq = lane >> 4;
    constexpr int ESZ = Epi::FP8 ? 1 : 2;
    const int nt = K * ESZ / (BK * 2);
    unsigned voffB[2];
#pragma unroll
    for (int i = 0; i < 2; ++i) { int R, C; stage_rc(tid * 16 + i * 8192, R, C); const int Rp = Epi::PERM ? ((R & ~31) + perm32(R & 31)) : R; const int Rb = Epi::WIDE ? ((Rp >> 5) * 64 + (Rp & 31)) : Rp; voffB[i] = (unsigned)(Rb * K * ESZ + C * 2); }
#define PG8_RC() int sR[2], sC[2]; { int t2_ = tid; asm volatile("" : "+v"(t2_)); _Pragma("unroll") for (int i = 0; i < 2; ++i) stage_rc(t2_ * 16 + i * 8192, sR[i], sC[i]); }
    const size_t kstep = (size_t)(BK * 2);
    const size_t hstepB = (size_t)(Epi::WIDE ? 32 : HALF) * K * ESZ;
    const unsigned ldsw = (unsigned)wid * 1024u;
    const int aoff = lds_byte(wr * 64 + fr, fq * 8), boff = lds_byte(wc * 32 + fr, fq * 8);
    const char* const gA = S.abase();
#define PG8_SA(b, h) (((b) * 2 + (h)) * HTB)
#define PG8_SB(b, h) ((4 + (b) * 2 + (h)) * HTB)
#define PG8_STAGE(bufoff, gbase, voff) do { _Pragma("unroll") for (int _i = 0; _i < 2; ++_i) \
        __builtin_amdgcn_global_load_lds((const unsigned*)((const char*)(gbase) + (voff)[_i]), (PG8_LAS unsigned*)(lds + (bufoff) + ldsw + _i * 8192), 16, 0, 0); } while (0)
#define PG8_STAGEA(bufoff, offs, h, kb) do { _Pragma("unroll") for (int _i = 0; _i < 2; ++_i) \
        __builtin_amdgcn_global_load_lds((const unsigned*)((gA + (kb)) + (offs)[(h) * 2 + _i]), (PG8_LAS unsigned*)(lds + (bufoff) + ldsw + _i * 8192), 16, 0, 0); } while (0)
#define PG8_LD16(off) (*(const PG8_LAS u32x4*)(lds + (off)))
#define PG8_LDA(dst, b, h) do { _Pragma("unroll") for (int m = 0; m < 4; ++m) dst[m] = __builtin_shufflevector(PG8_LD16(PG8_SA(b, h) + aoff + m * 2048), PG8_LD16(PG8_SA(b, h) + aoff + m * 2048 + 1024), 0, 1, 2, 3, 4, 5, 6, 7); } while (0)
#define PG8_LDB(dst, b, h) do { _Pragma("unroll") for (int n = 0; n < 2; ++n) dst[n] = __builtin_shufflevector(PG8_LD16(PG8_SB(b, h) + boff + n * 2048), PG8_LD16(PG8_SB(b, h) + boff + n * 2048 + 1024), 0, 1, 2, 3, 4, 5, 6, 7); } while (0)
#define PG8_HALF(x, k) __builtin_bit_cast(bf16x8, __builtin_shufflevector(x, x, 4 * (k), 4 * (k) + 1, 4 * (k) + 2, 4 * (k) + 3))
#define PG8_MMA(ai, bj, At, Bt) do { __builtin_amdgcn_s_setprio(1); _Pragma("unroll") for (int m = 0; m < 4; ++m) _Pragma("unroll") for (int n = 0; n < 2; ++n) { \
        if constexpr (Epi::FP8) asm volatile("v_mfma_scale_f32_16x16x128_f8f6f4 %0, %1, %2, %0, %3, %4 op_sel_hi:[0,0,0]" : "+v"(acc[ai][bj][m][n]) : "v"(Bt[n]), "v"(At[m]), "v"(scw), "v"(sca)); \
        else { acc[ai][bj][m][n] = __builtin_amdgcn_mfma_f32_16x16x32_bf16(PG8_HALF(Bt[n], 0), PG8_HALF(At[m], 0), acc[ai][bj][m][n], 0, 0, 0); \
               acc[ai][bj][m][n] = __builtin_amdgcn_mfma_f32_16x16x32_bf16(PG8_HALF(Bt[n], 1), PG8_HALF(At[m], 1), acc[ai][bj][m][n], 0, 0, 0); } } \
        __builtin_amdgcn_s_setprio(0); } while (0)
#define PG8_ACC_INIT(uix) do { f32x4 i_[2][2]; { int l2_ = lane; asm volatile("" : "+v"(l2_)); E.init(i_, (uix), wc, l2_ >> 4); } \
        _Pragma("unroll") for (int a = 0; a < 2; ++a) _Pragma("unroll") for (int b = 0; b < 2; ++b) _Pragma("unroll") for (int m = 0; m < 4; ++m) _Pragma("unroll") for (int n = 0; n < 2; ++n) { \
            acc[a][b][m][n] = i_[b][n]; asm volatile("" : "+v"(acc[a][b][m][n])); } } while (0)
#define PG8_WAIT_V(n) asm volatile("s_waitcnt vmcnt(" #n ")" ::: "memory")
#define PG8_WAIT_L(n) asm volatile("s_waitcnt lgkmcnt(" #n ")" ::: "memory")
#define PG8_BAR __builtin_amdgcn_s_barrier()
#define PG8_SCHED __builtin_amdgcn_sched_barrier(0)
    Unit cur, nxt, nn; int ui = 0;
    if (!S.next(0, cur)) return;
    bool h1 = S.next(1, nxt), h2 = h1 && S.next(2, nn);
    f32x4 acc[2][2][4][2];
    unsigned scw = 0x7A7A7A7Au, sca = 0x7F7F7F7Fu; asm volatile("" : "+v"(scw), "+v"(sca));
    u32x8 At[4], B0[2], B1[2];
    unsigned lO[4], hO[2];
    S.meta_init(cur, h1, nxt, wid);
    { PG8_RC(); S.aoffs(cur, 0, sR, sC, lO); } hO[0] = lO[2]; hO[1] = lO[3];
    PG8_ACC_INIT(0);
    const char* cB = S.bbase(cur);
    PG8_STAGE(PG8_SB(0, 0), cB, voffB); PG8_STAGE(PG8_SB(0, 1), cB + hstepB, voffB); PG8_STAGEA(PG8_SA(0, 0), lO, 0, 0); PG8_STAGEA(PG8_SA(0, 1), lO, 1, 0);
    if (wr == 1) PG8_BAR;
    PG8_WAIT_V(2); PG8_BAR;
    PG8_STAGE(PG8_SB(1, 0), cB + kstep, voffB); PG8_STAGEA(PG8_SA(1, 0), lO, 0, kstep); PG8_STAGE(PG8_SB(1, 1), cB + hstepB + kstep, voffB);
    PG8_WAIT_V(6); PG8_BAR;
    for (;;) {
        const bool has_next = h1;
        const char* nB = has_next ? S.bbase(nxt) : cB;
        S.meta_top(ui, h1, nxt, h2, nn, wid);
#pragma unroll 1
        for (int t = 0; t < nt; t += 2) {
            const bool last = (t == nt - 2);
            if constexpr (Epi::MID) { if (t == nt / 2) { int l2_ = lane; asm volatile("" : "+v"(l2_)); E.mid(acc, cur, wr, l2_ & 15); } }
            if (last && has_next) { PG8_RC(); S.aoffs(nxt, ui + 1, sR, sC, lO); }
            const size_t k1 = (size_t)(t + 1) * kstep;
            const size_t k2 = last ? 0 : (size_t)(t + 2) * kstep, k3 = k2 + kstep;
            const char* b2 = (last ? nB : cB) + k2; const char* b3 = b2 + kstep;
            PG8_LDB(B0, 0, 0); PG8_LDB(B1, 0, 1); PG8_SCHED; PG8_LDA(At, 0, 0); PG8_STAGEA(PG8_SA(1, 1), hO, 0, k1);
            PG8_WAIT_V(8); PG8_WAIT_L(0); PG8_BAR; PG8_MMA(0, 0, At, B0); PG8_MMA(0, 1, At, B1); PG8_BAR; PG8_SCHED;
            PG8_LDA(At, 0, 1); PG8_STAGE(PG8_SB(0, 0), b2, voffB); PG8_STAGE(PG8_SB(0, 1), b2 + hstepB, voffB); PG8_STAGEA(PG8_SA(0, 0), lO, 0, k2);
            PG8_WAIT_V(8); PG8_WAIT_L(0); PG8_BAR; PG8_MMA(1, 0, At, B0); PG8_MMA(1, 1, At, B1); PG8_BAR; PG8_SCHED;
            PG8_LDB(B0, 1, 0); PG8_LDB(B1, 1, 1); PG8_SCHED; PG8_LDA(At, 1, 0); PG8_STAGEA(PG8_SA(0, 1), lO, 1, k2);
            PG8_WAIT_V(8); PG8_WAIT_L(0); PG8_BAR; PG8_MMA(0, 0, At, B0); PG8_MMA(0, 1, At, B1); PG8_BAR; PG8_SCHED;
            PG8_LDA(At, 1, 1); PG8_STAGE(PG8_SB(1, 0), b3, voffB); PG8_STAGE(PG8_SB(1, 1), b3 + hstepB, voffB); PG8_STAGEA(PG8_SA(1, 0), lO, 0, k3);
            PG8_WAIT_V(8); PG8_WAIT_L(0); PG8_BAR; PG8_MMA(1, 0, At, B0); PG8_MMA(1, 1, At, B1); PG8_BAR; PG8_SCHED;
        }
        if constexpr (ALIGN_EPI) { if (wr == 0) PG8_BAR; }
        if constexpr (Epi::FP8) asm volatile("s_nop 15\n\ts_nop 7" ::: "memory");
        { int l2_ = lane; asm volatile("" : "+v"(l2_)); E(acc, cur, ui, wr, wc, l2_ & 15, l2_ >> 4); }
        if (!has_next) break;
        PG8_ACC_INIT(ui + 1);
        cur = nxt; cB = nB; hO[0] = lO[2]; hO[1] = lO[3];
        nxt = nn; h1 = h2; h2 = h1 && S.next(ui + 3, nn);
        ++ui;
        if constexpr (ALIGN_EPI) { if (wr == 1) PG8_BAR; }
    }
    PG8_WAIT_V(0);
    if constexpr (!ALIGN_EPI) { if (wr == 0) PG8_BAR; }
    PG8_BAR;
#undef PG8_SA
#undef PG8_SB
#undef PG8_STAGE
#undef PG8_STAGEA
#undef PG8_LDA
#undef PG8_LDB
#undef PG8_MMA
#undef PG8_ACC_INIT
#undef PG8_RC
#undef PG8_HALF
#undef PG8_LD16
#undef PG8_WAIT_V
#undef PG8_WAIT_L
#undef PG8_BAR
#undef PG8_SCHED
}
}
#define XB_TMO      128
#define XB_XCNT(j)  (256  + 64 * (j))
#define XB_XSUB(j)  (1280 + 64 * (j))
#define XB_XGEN(j)  (2304 + 64 * (j))
#define XB_TOP      3328
#define XB_TOPGEN   3392
#define XCD_BAR_WORDS 3456
#define XB_SPIN_CAP (1u << 18)
__device__ __forceinline__ unsigned xb_ld(unsigned* p)              { return __hip_atomic_load(p, __ATOMIC_RELAXED, __HIP_MEMORY_SCOPE_AGENT); }
__device__ __forceinline__ unsigned xb_add(unsigned* p, unsigned v) { return __hip_atomic_fetch_add(p, v, __ATOMIC_RELAXED, __HIP_MEMORY_SCOPE_AGENT); }
__device__ __forceinline__ unsigned xb_xcc_id() { return (unsigned)__builtin_amdgcn_s_getreg((3 << 11) | 20) & 0xFu; }
#define XB_SPIN(cond, bar) do { unsigned _sp = 0; while (cond) { __builtin_amdgcn_s_sleep(1); \
    if ((++_sp & 255u) == 0u) { if (xb_ld(&(bar)[XB_TMO])) break; if (_sp > XB_SPIN_CAP) { atomicAdd(&(bar)[XB_TMO], 1u); break; } } } } while (0)
struct XcdBarrier { unsigned* bar; unsigned x; volatile LAS unsigned* st; };
__device__ __forceinline__ XcdBarrier xcd_barrier_post(unsigned* bar, volatile LAS unsigned* st, int wave) {
    XcdBarrier b; b.bar = bar; b.x = xb_xcc_id(); b.st = st;
    if (wave == 0 && lane_id() == 0) (void)xb_add(&bar[XB_XCNT(b.x)], 1u);
    return b;
}
__device__ __forceinline__ void xcd_barrier_complete(unsigned* bar, unsigned x, unsigned& nloc, unsigned& nx) {
    const unsigned G = gridDim.x * gridDim.y * gridDim.z;
    unsigned sum, cnt, mine, sp = 0u;
    for (;;) {
        sum = 0u; cnt = 0u; mine = 0u;
#pragma unroll
        for (unsigned j = 0; j < 16; ++j) { const unsigned c = xb_ld(&bar[XB_XCNT(j)]); sum += c; cnt += (c > 0u) ? 1u : 0u; mine = (j == x) ? c : mine; }
        if (sum == G) break;
        __builtin_amdgcn_s_sleep(1);
        if ((++sp & 255u) == 0u) { if (xb_ld(&bar[XB_TMO])) break; if (sp > XB_SPIN_CAP) { atomicAdd(&bar[XB_TMO], 1u); break; } }
    }
    nloc = mine > 0u ? mine : 1u; nx = cnt > 0u ? cnt : 1u;
}
__device__ __forceinline__ void xcd_barrier(const XcdBarrier& b, int wave) {
    asm volatile("s_waitcnt vmcnt(0)" ::: "memory");
    __syncthreads();
    if (wave == 0 && lane_id() == 0) {
        unsigned* bar = b.bar;
        __builtin_amdgcn_s_waitcnt(0);
        unsigned nloc = b.st[0], nx = b.st[1];
        if (nloc == 0u) { xcd_barrier_complete(bar, b.x, nloc, nx); b.st[0] = nloc; b.st[1] = nx; }
        const unsigned old = xb_add(&bar[XB_XSUB(b.x)], 1u);
        const unsigned gen = old / nloc;
        if (old + 1u == (gen + 1u) * nloc) {
            __builtin_amdgcn_fence(__ATOMIC_RELEASE, "agent");
            asm volatile("s_waitcnt vmcnt(0)" ::: "memory");
            const unsigned og = xb_add(&bar[XB_TOP], 1u);
            const unsigned tg = og / nx;
            if (og + 1u == (tg + 1u) * nx) xb_add(&bar[XB_TOPGEN], 1u);
            else XB_SPIN(xb_ld(&bar[XB_TOPGEN]) == tg, bar);
            __builtin_amdgcn_fence(__ATOMIC_ACQUIRE, "agent");
            xb_add(&bar[XB_XGEN(b.x)], 1u);
            asm volatile("s_waitcnt vmcnt(0)" ::: "memory");
        } else {
            XB_SPIN(xb_ld(&bar[XB_XGEN(b.x)]) == gen, bar);
            __builtin_amdgcn_fence(__ATOMIC_ACQUIRE, "agent");
            asm volatile("s_waitcnt vmcnt(0)" ::: "memory");
        }
    }
    __syncthreads();
}

struct Frame {
    LAS unsigned char* lds;
    volatile LAS unsigned* MISC;
    gu32* ctl;
    int tid, lane, wave, vcu, G;
    const float *x, *c, *w_ada, *b_ada, *w_in, *sink, *rpb, *ga, *gb, *w_out, *w_router, *b_router, *w_gu, *b_gu, *w_down, *b_down, *g_final;
    float* out;
    float *mod, *rope, *ssq, *tkg;
    int *tke, *list;
    bf16_t *wr_t, *win_t, *wout_t, *wgu_t, *wd_t, *XN, *PROJ, *O, *YS, *ACT, *DELTA;
};
__device__ __forceinline__ float wave_sum(float v) {
#pragma unroll
    for (int o = 1; o < 64; o <<= 1) v += __shfl_xor(v, o);
    return v;
}

struct P0Item { const float* W; bf16_t* WT; int N, Kd, k0, n0, drow0, gains, fp8; };
__device__ __forceinline__ bool p0_item(const Frame& F, int it, P0Item& I) {
    constexpr int I_IN = 16 * (DIN / 32), I_OUT = 16 * (DM / 32), I_GU1 = 16 * (2 * DFF / 32), I_GU = NE * I_GU1, I_D1 = (DFF / 64) * (DM / 32), I_D = NE * I_D1;
    if (it >= I_IN + I_OUT + I_GU + I_D) return false;
    int r = it; I.gains = 0; I.fp8 = 0;
    if (r < I_IN) { const int nb = r % (DIN / 32), kb = r / (DIN / 32); I.W = F.w_in; I.WT = F.win_t; I.N = DIN; I.Kd = DM; I.k0 = kb * 64; I.n0 = nb * 32; I.drow0 = nb * 32; return true; } r -= I_IN;
    if (r < I_OUT) { const int nb = r % (DM / 32), kb = r / (DM / 32); I.W = F.w_out; I.WT = F.wout_t; I.N = DM; I.Kd = DM; I.k0 = kb * 64; I.n0 = nb * 32; I.drow0 = nb * 32; I.gains = 1; return true; } r -= I_OUT;
    if (r < I_GU) { const int e = r / I_GU1, q = r % I_GU1, nb = q % (2 * DFF / 32), kb = q / (2 * DFF / 32), n0 = nb * 32, f = n0 & (DFF - 1);
        I.W = F.w_gu + (size_t)e * DM * 2 * DFF; I.WT = (bf16_t*)((unsigned char*)F.wgu_t + (size_t)e * 2 * DFF * DM); I.N = 2 * DFF; I.Kd = DM; I.k0 = kb * 64; I.n0 = n0; I.drow0 = (f >> 7) * 256 + (n0 >= DFF ? 128 : 0) + (f & 127); I.fp8 = 1; return true; } r -= I_GU;
    { const int e = r / I_D1, q = r % I_D1, nb = q % (DM / 32), kb = q / (DM / 32);
        I.W = F.w_down + (size_t)e * DFF * DM; I.WT = (bf16_t*)((unsigned char*)F.wd_t + (size_t)e * DM * DFF); I.N = DM; I.Kd = DFF; I.k0 = kb * 64; I.n0 = nb * 32; I.drow0 = nb * 32; I.fp8 = 1; return true; }
}
__device__ __forceinline__ void p0_load(const P0Item& I, f32x4 (&w)[8], int lane) {
#pragma unroll
    for (int i = 0; i < 8; ++i) w[i] = __builtin_nontemporal_load((const GAS f32x4*)(I.W + (size_t)(I.k0 + 8 * i + (lane >> 3)) * I.N + I.n0 + 4 * (lane & 7)));
}
__device__ __forceinline__ void p0_finish(const Frame& F, const P0Item& I, const f32x4 (&w)[8], LAS float* scr, int lane) {
#pragma unroll
    for (int i = 0; i < 8; ++i) { const int kk = 8 * i + (lane >> 3), nn = 4 * (lane & 7); f32x4 v = w[i];
        if (I.gains) { const int k = I.k0 + kk; v = v * (k < 512 ? F.ga[k] : F.gb[k - 512]); }
        scr[kk * 33 + nn] = v.x; scr[kk * 33 + nn + 1] = v.y; scr[kk * 33 + nn + 2] = v.z; scr[kk * 33 + nn + 3] = v.w; }
    LDS_WAIT(); asm volatile("" ::: "memory");
    const int c = lane & 7;
#pragma unroll
    for (int j = 0; j < 4; ++j) { const int n = (lane >> 3) + 8 * j; const LAS float* s = scr + (8 * c) * 33 + n;
        if (I.fp8) { u32x2 o; o.x = pk_fp8x4(s[0 * 33] * W8_SCALE, s[1 * 33] * W8_SCALE, s[2 * 33] * W8_SCALE, s[3 * 33] * W8_SCALE); o.y = pk_fp8x4(s[4 * 33] * W8_SCALE, s[5 * 33] * W8_SCALE, s[6 * 33] * W8_SCALE, s[7 * 33] * W8_SCALE);
            *(GAS u32x2*)((unsigned char*)I.WT + (size_t)(I.drow0 + n) * I.Kd + I.k0 + 8 * c) = o; }
        else { u32x4 o; o.x = pk2(s[0 * 33], s[1 * 33]); o.y = pk2(s[2 * 33], s[3 * 33]); o.z = pk2(s[4 * 33], s[5 * 33]); o.w = pk2(s[6 * 33], s[7 * 33]);
            *(GAS u32x4*)(I.WT + (size_t)(I.drow0 + n) * I.Kd + I.k0 + 8 * c) = o; } }
    LDS_WAIT(); asm volatile("" ::: "memory");
}
__device__ __forceinline__ void p0_prologue(Frame& F) {
    const int gt = blockIdx.x * (NWAVES * 64) + F.tid;
    if (blockIdx.x < 6 * DM / 32) {
        LAS float* sc = (LAS float*)F.lds;
        LAS float* red = (LAS float*)(F.lds + 32768);
        for (int i = F.tid; i < NB * DM; i += NWAVES * 64) { const float v = F.c[i]; sc[i] = v / (1.f + __expf(-v)); }
        const int c4 = F.tid & 7, ks = F.tid >> 3, n0 = blockIdx.x * 32;
        f32x4 w[16];
#pragma unroll
        for (int q = 0; q < 16; ++q) w[q] = __builtin_nontemporal_load((const GAS f32x4*)(F.w_ada + (size_t)(ks * 16 + q) * 6 * DM + n0 + 4 * c4));
        __syncthreads();
        f32x4 a[NB];
#pragma unroll
        for (int b = 0; b < NB; ++b) a[b] = (f32x4){0.f, 0.f, 0.f, 0.f};
#pragma unroll
        for (int q = 0; q < 16; ++q)
#pragma unroll
            for (int b = 0; b < NB; ++b) a[b] += w[q] * sc[b * DM + ks * 16 + q];
#pragma unroll
        for (int b = 0; b < NB; ++b) *(LAS f32x4*)(red + (ks * NB + b) * 32 + 4 * c4) = a[b];
        __syncthreads();
        if (F.tid < 256) { const int b = F.tid >> 5, col = F.tid & 31; float s = F.b_ada[n0 + col];
#pragma unroll 8
            for (int q = 0; q < 64; ++q) s += red[(q * NB + b) * 32 + col];
            F.mod[b * 6 * DM + n0 + col] = s; }
        __syncthreads();
    }
    if (gt < SEQ * 8) {
        const int pos = gt >> 3, i = gt & 7;
        const float invf[8] = {1.0f, 0.1939227432012558f, 0.03760603070259094f, 0.007292664609849453f, 0.0014142135623842478f, 0.00027424818836152554f, 5.3182957344688475e-05f, 1.0313385246263351e-05f};
        float inv = invf[0];
#pragma unroll
        for (int q = 1; q < 8; ++q) inv = (i == q) ? invf[q] : inv;
        const float angf = (float)pos * inv;
        const double ang = (double)angf, twopi = 6.283185307179586476925287;
        const double r = ang - __builtin_rint(ang / twopi) * twopi, r2 = r * r;
        double cs = 1.0, sn = r, tc = 1.0, ts = r;
#pragma unroll 1
        for (int q = 1; q <= 20; ++q) { tc = -tc * r2 / (double)((2 * q - 1) * (2 * q)); ts = -ts * r2 / (double)((2 * q) * (2 * q + 1)); cs += tc; sn += ts; }
        F.rope[gt] = (float)cs; F.rope[SEQ * 8 + gt] = (float)sn;
    }
    if (gt < NE * DM) { const int e = gt >> 10, k = gt & 1023; const float w = F.w_router[k * NE + e]; const unsigned hi = f2bf(w); const unsigned lo = f2bf(w - bf2f(hi));
        F.wr_t[gt] = (bf16_t)hi; F.wr_t[NE * DM + gt] = (bf16_t)lo; }
    if (gt < NTOK * 2) F.ssq[gt] = 0.f;
    LAS float* scr = (LAS float*)(F.lds + F.wave * 16384);
    const int gw = F.vcu * NWAVES + F.wave, NGW = F.G * NWAVES;
    P0Item Ia, Ib; f32x4 wa[8], wb[8];
    bool ha = p0_item(F, gw, Ia), hb;
    if (ha) p0_load(Ia, wa, F.lane);
#pragma unroll 1
    for (int it = gw; ha; it += 2 * NGW) {
        hb = p0_item(F, it + NGW, Ib); if (hb) p0_load(Ib, wb, F.lane);
        p0_finish(F, Ia, wa, scr, F.lane);
        ha = p0_item(F, it + 2 * NGW, Ia); if (ha) p0_load(Ia, wa, F.lane);
        if (hb) p0_finish(F, Ib, wb, scr, F.lane);
    }
}
__device__ __forceinline__ void p1_xn(Frame& F) {
    const int gw = F.vcu * NWAVES + F.wave, NGW = F.G * NWAVES;
    for (int chunk = gw; chunk < NTOK / 16; chunk += NGW) {
        const int m0 = chunk * 16, b = m0 / SEQ;
        f32x4 s1[4], sh[4];
#pragma unroll
        for (int j = 0; j < 4; ++j) { s1[j] = *(const GAS f32x4*)(F.mod + b * 6 * DM + DM + 4 * F.lane + 256 * j) + 1.0f; sh[j] = *(const GAS f32x4*)(F.mod + b * 6 * DM + 4 * F.lane + 256 * j); }
        for (int r = 0; r < 16; ++r) {
            const GAS f32x4* xr = (const GAS f32x4*)(F.x + (size_t)(m0 + r) * DM) + F.lane;
            f32x4 v[4]; float s = 0.f;
#pragma unroll
            for (int j = 0; j < 4; ++j) { v[j] = xr[64 * j]; s += (v[j].x * v[j].x + v[j].y * v[j].y) + (v[j].z * v[j].z + v[j].w * v[j].w); }
            const float rstd = 1.f / sqrtf(wave_sum(s) * (1.f / DM) + EPS);
            GAS unsigned long long* o8 = (GAS unsigned long long*)(F.XN + (size_t)(m0 + r) * DM) + F.lane;
#pragma unroll
            for (int j = 0; j < 4; ++j) { const f32x4 h = v[j] * rstd * s1[j] + sh[j];
                o8[64 * j] = (unsigned long long)pk2(h.x, h.y) | ((unsigned long long)pk2(h.z, h.w) << 32); }
        }
    }
}
struct EpiProj {
    static constexpr bool PERM = true, MID = false, FP8 = false, WIDE = true;
    bf16_t* O; const float* rope;
    __device__ __forceinline__ void mid(f32x4 (&)[2][2][4][2], const pg8::Unit&, int, int) const {}
    __device__ __forceinline__ void init(f32x4 (&i)[2][2], int, int, int) const { i[0][0] = i[0][1] = i[1][0] = i[1][1] = (f32x4){0.f, 0.f, 0.f, 0.f}; }
    __device__ __forceinline__ void operator()(const f32x4 (&acc)[2][2][4][2], const pg8::Unit& u, int, int wr, int wc, int fr, int fq) const {
        const int row0 = u.pm * 256 + wr * 64 + fr, col0 = u.pn * 256 + wc * 64 + 8 * fq;
        const float sc = (u.pn < 2 || u.pn == 3 || u.pn == 4) ? C2 : 1.f;
#pragma unroll
        for (int ai = 0; ai < 2; ++ai)
#pragma unroll
            for (int m = 0; m < 4; ++m) { const int row = row0 + ai * 128 + m * 16; bf16_t* rowp = O + (size_t)row * DIN + col0;
#pragma unroll
                for (int bj = 0; bj < 2; ++bj) { f32x4 v0 = acc[ai][bj][m][0], v1 = acc[ai][bj][m][1];
                    const bool rope_tile = (u.pn < 2) || (u.pn == 2 && wc < 2);
                    if (rope_tile && bj == 0) {
                        f32x4 o0, o1;
#pragma unroll
                        for (int q = 0; q < 4; ++q) { o0[q] = __shfl_xor(v0[q], 16); o1[q] = __shfl_xor(v1[q], 16); }
                        if (fq < 2) { const int pos = row & (SEQ - 1);
                            const f32x4 c0 = *(const GAS f32x4*)(rope + pos * 8), c1 = *(const GAS f32x4*)(rope + pos * 8 + 4);
                            const f32x4 s0 = *(const GAS f32x4*)(rope + SEQ * 8 + pos * 8), s1 = *(const GAS f32x4*)(rope + SEQ * 8 + pos * 8 + 4);
                            const float sg = fq == 0 ? -1.f : 1.f;
                            v0 = v0 * c0 + (o0 * sg) * s0; v1 = v1 * c1 + (o1 * sg) * s1; }
                    }
                    v0 = v0 * sc; v1 = v1 * sc;
                    u32x4 w; w.x = cvt_pk_bf16(v0[0], v0[1]); w.y = cvt_pk_bf16(v0[2], v0[3]); w.z = cvt_pk_bf16(v1[0], v1[1]); w.w = cvt_pk_bf16(v1[2], v1[3]);
                    *(GAS u32x4*)(rowp + bj * 32) = w; } }
    }
};
__device__ __forceinline__ int crow(int r, int hi) { return (r & 3) + 8 * (r >> 2) + 4 * hi; }
typedef short v4i16_t __attribute__((ext_vector_type(4)));
__device__ __forceinline__ v4i16_t vtr(const LAS unsigned char* p) { return __builtin_amdgcn_ds_read_tr16_b64_v4i16((LAS v4i16_t*)p); }
__device__ __forceinline__ float max3f(float a, float b, float c) { return __builtin_fmaxf(__builtin_fmaxf(a, b), c); }
__device__ __forceinline__ void dma_k(const bf16_t* Ktile  , LAS unsigned char* slot, int p, int lane) {
    const int row = 8 * p + (lane >> 3), ch = (lane & 7) ^ ((row >> 1) & 7);
    __builtin_amdgcn_global_load_lds((const unsigned*)(Ktile + (size_t)row * DIN + ch * 8), (LAS unsigned*)(slot + p * 1024), 16, 0, 0);
}
__device__ __forceinline__ void dma_v(const bf16_t* Vtile, LAS unsigned char* slot, int p, int lane) {
    __builtin_amdgcn_global_load_lds((const unsigned*)(Vtile + (size_t)(8 * p + ((lane >> 2) & 7)) * DIN + (lane >> 5) * 32 + (lane & 3) * 8), (LAS unsigned*)(slot + p * 1024), 16, 0, 0);
}
struct AttnState { float m, l; f32x16 o[2]; };
template <class MB>
__device__ __forceinline__ void attn_tile(const LAS unsigned char* Ks, const LAS unsigned char* Vs, const bf16x8 (&qr)[4], AttnState& st, int r32, int hi, int lane, const MB& mb) {
    f32x16 p0, p1;
#pragma unroll
    for (int r = 0; r < 16; ++r) { p0[r] = 0.f; p1[r] = 0.f; }
    const LAS unsigned char* kb = Ks + r32 * 128; const int sw = (r32 >> 1) & 7;
#pragma unroll
    for (int d0 = 0; d0 < 4; ++d0) {
        const int ko = ((2 * d0 + hi) ^ sw) << 4;
        const bf16x8 a0 = *(const LAS bf16x8*)(kb + ko), a1 = *(const LAS bf16x8*)(kb + ko + 4096);
        p0 = __builtin_amdgcn_mfma_f32_32x32x16_bf16(a0, qr[d0], p0, 0, 0, 0);
        p1 = __builtin_amdgcn_mfma_f32_32x32x16_bf16(a1, qr[d0], p1, 0, 0, 0);
    }
    mb(p0, p1, r32, hi);
    float a = max3f(p0[0], p0[1], p1[0]), b = max3f(p0[2], p0[3], p1[1]); a = max3f(a, p1[2], p1[3]);
#pragma unroll
    for (int r = 4; r < 16; r += 4) { a = max3f(a, p0[r], p0[r + 1]); b = max3f(b, p0[r + 2], p0[r + 3]); a = max3f(a, p1[r], p1[r + 1]); b = max3f(b, p1[r + 2], p1[r + 3]); }
    float rm = __builtin_fmaxf(a, b);
    rm = __builtin_fmaxf(rm, __shfl_xor(rm, 32));
    if (__any(rm > st.m + 8.0f)) {
        const float mn = __builtin_fmaxf(st.m, rm), f = __builtin_amdgcn_exp2f(st.m - mn);
        st.m = mn; st.l *= f;
#pragma unroll
        for (int r = 0; r < 16; ++r) { st.o[0][r] *= f; st.o[1][r] *= f; }
    }
    const float mref = st.m;
    float ls = 0.f;
#pragma unroll
    for (int r = 0; r < 16; ++r) { p0[r] = __builtin_amdgcn_exp2f(p0[r] - mref); p1[r] = __builtin_amdgcn_exp2f(p1[r] - mref); ls += p0[r] + p1[r]; }
    st.l += ls;
    u32x4 pw[4];
#pragma unroll
    for (int q = 0; q < 4; ++q) { pw[0][q] = cvt_pk_bf16(p0[2 * q], p0[2 * q + 1]); pw[1][q] = cvt_pk_bf16(p0[8 + 2 * q], p0[8 + 2 * q + 1]);
                                  pw[2][q] = cvt_pk_bf16(p1[2 * q], p1[2 * q + 1]); pw[3][q] = cvt_pk_bf16(p1[8 + 2 * q], p1[8 + 2 * q + 1]); }
    const LAS unsigned char* vb = Vs + ((lane >> 4) & 1) * 32 + (lane & 3) * 8 + (4 * hi + ((lane & 15) >> 2)) * 64;
#pragma unroll
    for (int d0 = 0; d0 < 2; ++d0)
#pragma unroll
        for (int s = 0; s < 4; ++s) {
            const v4i16_t lo = vtr(vb + d0 * 512 + s * 2048), hh = vtr(vb + d0 * 512 + s * 2048 + 1024);
            const bf16x8 vf = (bf16x8){lo[0], lo[1], lo[2], lo[3], hh[0], hh[1], hh[2], hh[3]};
            st.o[d0] = __builtin_amdgcn_mfma_f32_32x32x16_bf16(vf, __builtin_bit_cast(bf16x8, pw[s]), st.o[d0], 0, 0, 0);
        }
}
__device__ __forceinline__ void attn_finish(AttnState& st, LAS unsigned char* stg, bf16_t* Obase  , float* ssqp  , int r32, int hi, int lane) {
    float l = st.l; l += __shfl_xor(l, 32);
    const float inv = 1.0f / l;
    float sq = 0.f;
#pragma unroll
    for (int d0 = 0; d0 < 2; ++d0)
#pragma unroll
        for (int rg = 0; rg < 4; ++rg) {
            const float v0 = st.o[d0][4 * rg] * inv, v1 = st.o[d0][4 * rg + 1] * inv, v2 = st.o[d0][4 * rg + 2] * inv, v3 = st.o[d0][4 * rg + 3] * inv;
            sq += (v0 * v0 + v1 * v1) + (v2 * v2 + v3 * v3);
            u32x2 w; w.x = cvt_pk_bf16(v0, v1); w.y = cvt_pk_bf16(v2, v3);
            const int ch = 4 * d0 + rg;
            *(LAS u32x2*)(stg + r32 * 128 + ((ch ^ (r32 & 7)) << 4) + hi * 8) = w;
        }
    sq += __shfl_xor(sq, 32);
    if (hi == 0) atomicAdd(ssqp + r32 * 2, sq);
    asm volatile("s_waitcnt lgkmcnt(0)" ::: "memory");
#pragma unroll
    for (int i = 0; i < 4; ++i) { const int row = i * 8 + (lane >> 3), ch = lane & 7;
        const u32x4 v = *(const LAS u32x4*)(stg + row * 128 + ((ch ^ (row & 7)) << 4));
        *(GAS u32x4*)(Obase + (size_t)row * DM + ch * 8) = v; }
}
struct MbNone { __device__ __forceinline__ void operator()(f32x16&, f32x16&, int, int) const {} };
struct MbBandLo { int qi;
    __device__ __forceinline__ void operator()(f32x16& p0, f32x16& p1, int, int hi) const {
#pragma unroll
        for (int r = 0; r < 16; ++r) { const int kj = crow(r, hi); p0[r] = (kj >= qi) ? p0[r] : -1e30f; p1[r] = (kj + 32 >= qi) ? p1[r] : -1e30f; } } };
struct MbBandHi { int qi;
    __device__ __forceinline__ void operator()(f32x16& p0, f32x16& p1, int, int hi) const {
#pragma unroll
        for (int r = 0; r < 16; ++r) { const int kj = crow(r, hi); p0[r] = (kj <= qi) ? p0[r] : -1e30f; p1[r] = (kj + 32 <= qi) ? p1[r] : -1e30f; } } };
struct MbNeigh { const LAS float* base; const float* ma;
    __device__ __forceinline__ void operator()(f32x16& p0, f32x16& p1, int, int) const {
#pragma unroll
        for (int r = 0; r < 16; ++r) { const int o = (r & 3) + 8 * (r >> 2); p0[r] = (p0[r] + base[o]) + ma[r]; p1[r] = (p1[r] + base[o + 32]) + ma[16 + r]; } } };

__device__ __forceinline__ void attn_a_phase(Frame& F, float* ssq) {
    const int wave = F.wave, lane = F.lane, r32 = lane & 31, hi = lane >> 5, g = wave >> 1, qh = wave & 1;
    for (int u = F.vcu; u < NB * AKVH * (SEQ / 64); u += F.G) {
        const int qblk = u % (SEQ / 64), kvh = (u / (SEQ / 64)) % AKVH, b = u / ((SEQ / 64) * AKVH);
        const int q0 = qblk * 64, h = kvh * 4 + g;
        const bf16_t* base = F.PROJ + (size_t)b * SEQ * DIN;
        asm volatile("s_waitcnt lgkmcnt(0)" ::: "memory"); __builtin_amdgcn_s_barrier();
#pragma unroll
        for (int t = 0; t < 5; ++t) { const int k0 = q0 - 128 + 64 * t;
            if (k0 >= 0 && k0 < SEQ) { dma_k(base + (size_t)k0 * DIN + OFF_KA + kvh * HD, F.lds + t * 8192, wave, lane); dma_v(base + (size_t)k0 * DIN + OFF_VA + kvh * HD, F.lds + 40960 + t * 8192, wave, lane); } }
        const bf16_t* qp = base + (size_t)(q0 + qh * 32 + r32) * DIN + OFF_QA + h * HD + hi * 8;
        bf16x8 qr[4];
#pragma unroll
        for (int d0 = 0; d0 < 4; ++d0) qr[d0] = *(const GAS bf16x8*)(qp + d0 * 16);
        AttnState st; st.m = F.sink[h] * LOG2E; st.l = (hi == 0) ? 1.f : 0.f;
#pragma unroll
        for (int r = 0; r < 16; ++r) { st.o[0][r] = 0.f; st.o[1][r] = 0.f; }
        asm volatile("s_waitcnt vmcnt(0)" ::: "memory"); __builtin_amdgcn_s_barrier();
        const int qi = qh * 32 + r32;
        if (q0 - 128 >= 0) attn_tile(F.lds, F.lds + 40960, qr, st, r32, hi, lane, MbBandLo{qi});
        if (q0 - 64 >= 0) attn_tile(F.lds + 8192, F.lds + 40960 + 8192, qr, st, r32, hi, lane, MbNone{});
        attn_tile(F.lds + 2 * 8192, F.lds + 40960 + 2 * 8192, qr, st, r32, hi, lane, MbNone{});
        if (q0 + 64 < SEQ) attn_tile(F.lds + 3 * 8192, F.lds + 40960 + 3 * 8192, qr, st, r32, hi, lane, MbNone{});
        if (q0 + 128 < SEQ) attn_tile(F.lds + 4 * 8192, F.lds + 40960 + 4 * 8192, qr, st, r32, hi, lane, MbBandHi{qi});
        const int tok0 = b * SEQ + q0 + qh * 32;
        attn_finish(st, F.lds + 81920 + wave * 4096, F.O + (size_t)tok0 * DM + h * HD, ssq + tok0 * 2, r32, hi, lane);
    }
}
constexpr int NTAB_OFF = LDSCTL_OFF + 2048;
__device__ __forceinline__ void attn_b_phase(Frame& F, float* ssq) {
    const int wave = F.wave, lane = F.lane, r32 = lane & 31, hi = lane >> 5, rw = wave >> 1, qh = wave & 1;
    LAS float* tab = (LAS float*)(F.lds + NTAB_OFF);
    int cur_head = -1;
    for (int u = F.vcu; u < NB * BH * (GW / 4); u += F.G) {
        const int rg = u % (GW / 4), head = (u / (GW / 4)) % BH, b = u / ((GW / 4) * BH);
        const int r0 = rg * 4, r = r0 + rw;
        const int R0 = min(max(r0 - NAR / 2, 0), GW - NAR), nst = min(max(r0 + 3 - NAR / 2, 0), GW - NAR) + NAR - R0;
        const int rs = min(max(r - NAR / 2, 0), GW - NAR);
        const bf16_t* base = F.PROJ + (size_t)b * SEQ * DIN;
        asm volatile("s_waitcnt lgkmcnt(0)" ::: "memory"); __builtin_amdgcn_s_barrier();
        if (head != cur_head) { cur_head = head;
            for (int i = F.tid; i < 15 * 128; i += NWAVES * 64) { const int d = (i & 127) - 63, ro = i >> 7;
                tab[i] = (d >= -15 && d <= 15) ? F.rpb[(head * 15 + ro) * 31 + d + 15] * LOG2E : 0.f; }
            asm volatile("s_waitcnt lgkmcnt(0)" ::: "memory"); }
#define NB_DMA(t) do { const int _bs = ((t) & 3) * 16384; const bf16_t* _kr = base + (size_t)((R0 + (t)) * GW) * DIN; \
        dma_k(_kr + OFF_KB + head * HD, F.lds + _bs, wave, lane); dma_v(_kr + OFF_VB + head * HD, F.lds + _bs + 8192, wave, lane); } while (0)
        NB_DMA(0); NB_DMA(1); NB_DMA(2);
        const int qc = qh * 32 + r32, cs = min(max(qc - NAC / 2, 0), GW - NAC);
        float ma[32];
#pragma unroll
        for (int q = 0; q < 16; ++q) { const int kc = crow(q, hi); ma[q] = (kc >= cs && kc < cs + 16) ? 0.f : -1e30f; ma[16 + q] = (kc + 32 >= cs && kc + 32 < cs + 16) ? 0.f : -1e30f; }
        const bf16_t* qp = base + (size_t)(r * GW + qc) * DIN + OFF_QB + head * HD + hi * 8;
        bf16x8 qr[4];
#pragma unroll
        for (int d0 = 0; d0 < 4; ++d0) qr[d0] = *(const GAS bf16x8*)(qp + d0 * 16);
        AttnState st; st.m = -1e30f; st.l = 0.f;
#pragma unroll
        for (int q = 0; q < 16; ++q) { st.o[0][q] = 0.f; st.o[1][q] = 0.f; }
        for (int t = 0; t < nst; ++t) {
            if (t + 3 < nst) { NB_DMA(t + 3); asm volatile("s_waitcnt vmcnt(6)" ::: "memory"); }
            else if (t + 2 < nst) asm volatile("s_waitcnt vmcnt(4)" ::: "memory");
            else if (t + 1 < nst) asm volatile("s_waitcnt vmcnt(2)" ::: "memory");
            else asm volatile("s_waitcnt vmcnt(0)" ::: "memory");
            __builtin_amdgcn_s_barrier();
            const int kr = R0 + t;
            if (kr >= rs && kr < rs + NAR) {
                const LAS unsigned char* ks = F.lds + (t & 3) * 16384;
                attn_tile(ks, ks + 8192, qr, st, r32, hi, lane, MbNeigh{tab + (kr - r + NAR - 1) * 128 + (63 - qc + 4 * hi), ma});
            }
            asm volatile("s_waitcnt lgkmcnt(0)" ::: "memory"); __builtin_amdgcn_s_barrier();
        }
#undef NB_DMA
        const int tok0 = b * SEQ + r * GW + qh * 32;
        attn_finish(st, F.lds + 65536 + wave * 4096, F.O + (size_t)tok0 * DM + AQW + head * HD, ssq + tok0 * 2 + 1, r32, hi, lane);
    }
}
struct EpiX1 {
    static constexpr bool PERM = true, MID = true, FP8 = false, WIDE = true;
    bf16_t* delta; const float* mod; const float* ssq;
    __device__ __forceinline__ void init(f32x4 (&i)[2][2], int, int, int) const { i[0][0] = i[0][1] = i[1][0] = i[1][1] = (f32x4){0.f, 0.f, 0.f, 0.f}; }
    __device__ __forceinline__ void mid(f32x4 (&acc)[2][2][4][2], const pg8::Unit& u, int wr, int fr) const {
#pragma unroll
        for (int ai = 0; ai < 2; ++ai)
#pragma unroll
            for (int m = 0; m < 4; ++m) { const int row = u.pm * 256 + ai * 128 + wr * 64 + m * 16 + fr;
                const f32x2 s = *(const GAS f32x2*)(ssq + row * 2);
                const float f = sqrtf((s.y * (1.f / 512.f) + EPS) / (s.x * (1.f / 512.f) + EPS));
#pragma unroll
                for (int bj = 0; bj < 2; ++bj)
#pragma unroll
                    for (int n = 0; n < 2; ++n) acc[ai][bj][m][n] *= f; }
    }
    __device__ __forceinline__ void operator()(const f32x4 (&acc)[2][2][4][2], const pg8::Unit& u, int, int wr, int wc, int fr, int fq) const {
        const int b = (u.pm * 256) / SEQ, col0 = u.pn * 256 + wc * 64 + 8 * fq;
        f32x4 gm[2][2];
#pragma unroll
        for (int bj = 0; bj < 2; ++bj)
#pragma unroll
            for (int n = 0; n < 2; ++n) gm[bj][n] = *(const GAS f32x4*)(mod + b * 6 * DM + 2 * DM + col0 + bj * 32 + 4 * n);
#pragma unroll
        for (int ai = 0; ai < 2; ++ai)
#pragma unroll
            for (int m = 0; m < 4; ++m) { const int row = u.pm * 256 + ai * 128 + wr * 64 + m * 16 + fr;
                const float rb = 1.0f / sqrtf(ssq[row * 2 + 1] * (1.f / 512.f) + EPS);
                bf16_t* rowp = delta + (size_t)row * DM + col0;
#pragma unroll
                for (int bj = 0; bj < 2; ++bj) { const f32x4 v0 = gm[bj][0] * (acc[ai][bj][m][0] * rb), v1 = gm[bj][1] * (acc[ai][bj][m][1] * rb);
                    u32x4 w; w.x = cvt_pk_bf16(v0[0], v0[1]); w.y = cvt_pk_bf16(v0[2], v0[3]); w.z = cvt_pk_bf16(v1[0], v1[1]); w.w = cvt_pk_bf16(v1[2], v1[3]);
                    *(GAS u32x4*)(rowp + bj * 32) = w; } }
    }
};

__device__ __forceinline__ void router_phase(Frame& F, gu32* cntw) {
    const int wave = F.wave, lane = F.lane, r32 = lane & 31, hi = lane >> 5;
    bf16x8 wh[8], wl[8];
#pragma unroll
    for (int c = 0; c < 8; ++c) { const bf16_t* p = F.wr_t + r32 * DM + 128 * wave + 16 * c + 8 * hi; wh[c] = *(const GAS bf16x8*)p; wl[c] = *(const GAS bf16x8*)(p + NE * DM); }
    LAS float* part = (LAS float*)(F.lds);
    LAS float* R = (LAS float*)(F.lds + 1024);
    LAS float* L = (LAS float*)(F.lds + 1024 + 32768);
    LAS int* lcnt = (LAS int*)(F.lds + 1024 + 32768 + 4352);
    for (int it = F.vcu; it < NTOK / 32; it += F.G) {
        const int t0 = it * 32, b = t0 / SEQ, tok = t0 + r32;
        const float* xp = F.x + (size_t)tok * DM + 128 * wave + 8 * hi; const bf16_t* dp = F.DELTA + (size_t)tok * DM + 128 * wave + 8 * hi;
        f32x4 xa[8], xb[8]; float s = 0.f;
#pragma unroll
        for (int c = 0; c < 8; ++c) { const u32x4 d = *(const GAS u32x4*)(dp + 16 * c);
            xa[c] = *(const GAS f32x4*)(xp + 16 * c) + (f32x4){bf2f(d.x & 0xffffu), bf2f(d.x >> 16), bf2f(d.y & 0xffffu), bf2f(d.y >> 16)};
            xb[c] = *(const GAS f32x4*)(xp + 16 * c + 4) + (f32x4){bf2f(d.z & 0xffffu), bf2f(d.z >> 16), bf2f(d.w & 0xffffu), bf2f(d.w >> 16)};
            s += (xa[c].x * xa[c].x + xa[c].y * xa[c].y) + (xa[c].z * xa[c].z + xa[c].w * xa[c].w) + (xb[c].x * xb[c].x + xb[c].y * xb[c].y) + (xb[c].z * xb[c].z + xb[c].w * xb[c].w); }
        s += __shfl_xor(s, 32);
        if (hi == 0) part[wave * 32 + r32] = s;
        if (F.tid < 32) lcnt[F.tid] = 0;
        asm volatile("s_waitcnt lgkmcnt(0)" ::: "memory"); __builtin_amdgcn_s_barrier(); asm volatile("" ::: "memory");
        float tot = 0.f;
#pragma unroll
        for (int w = 0; w < 8; ++w) tot += part[w * 32 + r32];
        const float rstd = 1.0f / sqrtf(tot * (1.f / DM) + EPS);
        f32x16 acc;
#pragma unroll
        for (int r = 0; r < 16; ++r) acc[r] = 0.f;
        const float* mp = F.mod + b * 6 * DM + 128 * wave + 8 * hi;
        unsigned char* xnp = (unsigned char*)F.XN + (size_t)tok * DM + 128 * wave + 8 * hi;
#pragma unroll
        for (int c = 0; c < 8; ++c) {
            const f32x4 sc0 = *(const GAS f32x4*)(mp + 4 * DM + 16 * c), sc1 = *(const GAS f32x4*)(mp + 4 * DM + 16 * c + 4);
            const f32x4 sh0 = *(const GAS f32x4*)(mp + 3 * DM + 16 * c), sh1 = *(const GAS f32x4*)(mp + 3 * DM + 16 * c + 4);
            const f32x4 h0 = xa[c] * rstd * (sc0 + 1.0f) + sh0, h1 = xb[c] * rstd * (sc1 + 1.0f) + sh1;
            u32x4 hw; hw.x = pk2(h0.x, h0.y); hw.y = pk2(h0.z, h0.w); hw.z = pk2(h1.x, h1.y); hw.w = pk2(h1.z, h1.w);
            u32x4 lw;
            lw.x = pk2(h0.x - bf2f(hw.x & 0xffffu), h0.y - bf2f(hw.x >> 16)); lw.y = pk2(h0.z - bf2f(hw.y & 0xffffu), h0.w - bf2f(hw.y >> 16));
            lw.z = pk2(h1.x - bf2f(hw.z & 0xffffu), h1.y - bf2f(hw.z >> 16)); lw.w = pk2(h1.z - bf2f(hw.w & 0xffffu), h1.w - bf2f(hw.w >> 16));
            { u32x2 q8; q8.x = pk_fp8x4(h0.x, h0.y, h0.z, h0.w); q8.y = pk_fp8x4(h1.x, h1.y, h1.z, h1.w); *(GAS u32x2*)(xnp + 16 * c) = q8; }
            const bf16x8 hf = __builtin_bit_cast(bf16x8, hw), lf = __builtin_bit_cast(bf16x8, lw);
            acc = __builtin_amdgcn_mfma_f32_32x32x16_bf16(hf, wh[c], acc, 0, 0, 0);
            acc = __builtin_amdgcn_mfma_f32_32x32x16_bf16(lf, wh[c], acc, 0, 0, 0);
            acc = __builtin_amdgcn_mfma_f32_32x32x16_bf16(hf, wl[c], acc, 0, 0, 0);
        }
#pragma unroll
        for (int r = 0; r < 16; ++r) R[wave * 1024 + crow(r, hi) * 32 + r32] = acc[r];
        asm volatile("s_waitcnt lgkmcnt(0)" ::: "memory"); __builtin_amdgcn_s_barrier(); asm volatile("" ::: "memory");
#pragma unroll
        for (int q = 0; q < 2; ++q) { const int idx = F.tid * 2 + q, tk = idx >> 5, e = idx & 31; float v = F.b_router[e];
#pragma unroll
            for (int w = 0; w < 8; ++w) v += R[w * 1024 + idx];
            L[tk * 33 + e] = v; }
        asm volatile("s_waitcnt lgkmcnt(0)" ::: "memory"); __builtin_amdgcn_s_barrier(); asm volatile("" ::: "memory");
        if (wave == 0) {
            int sel[TOPK]; float gt[TOPK]; int lpos[TOPK];
            if (lane < 32) {
                float v[NE];
#pragma unroll
                for (int j = 0; j < NE; ++j) v[j] = L[lane * 33 + j];
                unsigned used = 0u; float sv[TOPK];
#pragma unroll
                for (int kk = 0; kk < TOPK; ++kk) { float best = -INFINITY; int bi = 0;
#pragma unroll
                    for (int j = 0; j < NE; ++j) { const bool ok = !((used >> j) & 1u) && (v[j] > best); best = ok ? v[j] : best; bi = ok ? j : bi; }
                    used |= 1u << bi; sel[kk] = bi; sv[kk] = best; }
                float den = 0.f;
#pragma unroll
                for (int kk = 0; kk < TOPK; ++kk) { gt[kk] = __expf(sv[kk] - sv[0]); den += gt[kk]; }
                const float rden = 1.0f / den;
#pragma unroll
                for (int kk = 0; kk < TOPK; ++kk) { gt[kk] *= rden; lpos[kk] = __hip_atomic_fetch_add(lcnt + sel[kk], 1, __ATOMIC_RELAXED, __HIP_MEMORY_SCOPE_WORKGROUP); }
            }
            asm volatile("s_waitcnt lgkmcnt(0)" ::: "memory");
            if (lane < 32) { const int n = lcnt[lane]; int base = 0;
                if (n > 0) base = (int)__hip_atomic_fetch_add((unsigned*)(cntw + lane * 64), (unsigned)n, __ATOMIC_RELAXED, __HIP_MEMORY_SCOPE_AGENT);
                lcnt[32 + lane] = base; }
            asm volatile("s_waitcnt vmcnt(0) lgkmcnt(0)" ::: "memory");
            if (lane < 32) {
                const int t = t0 + lane;
#pragma unroll
                for (int kk = 0; kk < TOPK; ++kk) { const int e = sel[kk], pos = lcnt[32 + e] + lpos[kk];
                    F.tkg[t * 4 + kk] = gt[kk]; F.list[e * NTOK + pos] = t * 4 + kk; }
            }
        }
    }
}

__device__ __forceinline__ void moe_table(Frame& F) {
    LAS int* tab = (LAS int*)(F.lds + TAB_OFF);
    if (F.tid == 0) { int s = 0;
        for (int e = 0; e < NE; ++e) { const int c = (int)__hip_atomic_load((unsigned*)(F.ctl + CW_CNT + e * 64), __ATOMIC_RELAXED, __HIP_MEMORY_SCOPE_AGENT); tab[e] = s; tab[40 + e] = c; s += (c + 255) >> 8; }
        tab[32] = s; }
    asm volatile("s_waitcnt vmcnt(0) lgkmcnt(0)" ::: "memory"); __syncthreads();
}
constexpr int META_OFF = NTAB_OFF, META_SLOT = 2048;
template <bool GATHER>
struct MoeOrder {
    const char* A; const char* Bt; const int* list; const float* bias; const LAS int* tab; LAS unsigned char* meta; int K, N, nN, G, c;
    mutable int ec;
    __device__ bool next(int i, pg8::Unit& u) const {
        const int L = i * G + c; if (L >= tab[32] * nN) return false;
        int e = ec;
#pragma unroll 1
        while (L >= tab[e + 1] * nN) ++e;
        ec = e;
        const int nm = tab[e + 1] - tab[e], ql = L - tab[e] * nN;
        u.e = e; u.pn = ql / nm; u.aux = ql % nm; u.pm = tab[e] + u.aux; return true;
    }
    __device__ __forceinline__ const char* abase() const { return A; }
    __device__ __forceinline__ const char* bbase(const pg8::Unit& u) const { return Bt + ((size_t)u.e * N + (size_t)u.pn * 256) * K; }
    __device__ __forceinline__ void dma_list(const pg8::Unit& u, int slot) const {
        const int lane = lane_id();
        __builtin_amdgcn_global_load_lds((const unsigned*)(list + (size_t)u.e * NTOK + u.aux * 256 + 4 * lane), (LAS unsigned*)(meta + slot * META_SLOT), 16, 0, 0);
    }
    __device__ __forceinline__ void dma_bias(const pg8::Unit& u, int slot) const {
        const int lane = lane_id();
        const float* src = GATHER ? bias + (size_t)u.e * 2 * DFF + u.pn * 128 + (lane >> 5) * DFF + 4 * (lane & 31) : bias + (size_t)u.e * DM + u.pn * 256 + 4 * lane;
        __builtin_amdgcn_global_load_lds((const unsigned*)src, (LAS unsigned*)(meta + slot * META_SLOT + 1024), 16, 0, 0);
    }
    __device__ __forceinline__ void meta_init(const pg8::Unit& u0, bool h1, const pg8::Unit& u1, int wid) const {
        if (wid == 0) { dma_list(u0, 0); dma_bias(u0, 0); if (h1) dma_list(u1, 1); }
        asm volatile("s_waitcnt vmcnt(0)" ::: "memory"); __builtin_amdgcn_s_barrier(); asm volatile("" ::: "memory");
    }
    __device__ __forceinline__ void meta_top(int ui, bool has_next, const pg8::Unit& nxt, bool h2, const pg8::Unit& nn, int wid) const {
        if (wid == 0) { if (has_next) dma_bias(nxt, (ui + 1) % 3); if (h2) dma_list(nn, (ui + 2) % 3); }
    }
    __device__ __forceinline__ void aoffs(const pg8::Unit& u, int ui, const int (&R)[2], const int (&C)[2], unsigned (&off)[4]) const {
        if (GATHER) { const int lim = tab[40 + u.e] - 1 - u.aux * 256; const LAS int* lst = (const LAS int*)(meta + (ui % 3) * META_SLOT);
#pragma unroll
            for (int h = 0; h < 2; ++h)
#pragma unroll
                for (int i = 0; i < 2; ++i) { int mi = h * 128 + R[i]; mi = mi < lim ? mi : lim; const int tk = lst[mi] >> 2; off[h * 2 + i] = (unsigned)(tk * K + C[i] * 2); }
        } else {
#pragma unroll
            for (int h = 0; h < 2; ++h)
#pragma unroll
                for (int i = 0; i < 2; ++i) off[h * 2 + i] = (unsigned)((u.pm * 256 + h * 128 + R[i]) * K + C[i] * 2);
        }
    }
};
struct EpiSwiglu {
    static constexpr bool PERM = true, MID = false, FP8 = true, WIDE = false;
    bf16_t* act; const LAS unsigned char* meta;
    __device__ __forceinline__ void mid(f32x4 (&)[2][2][4][2], const pg8::Unit&, int, int) const {}
    __device__ __forceinline__ void init(f32x4 (&i)[2][2], int ui, int wc, int fq) const {
        const LAS float* bp = (const LAS float*)(meta + (ui % 3) * META_SLOT + 1024) + wc * 32 + 8 * fq;
        i[0][0] = *(const LAS f32x4*)bp; i[0][1] = *(const LAS f32x4*)(bp + 4); i[1][0] = *(const LAS f32x4*)(bp + 128); i[1][1] = *(const LAS f32x4*)(bp + 132);
    }
    __device__ __forceinline__ void operator()(const f32x4 (&acc)[2][2][4][2], const pg8::Unit& u, int, int wr, int wc, int fr, int fq) const {
        const int f0 = u.pn * 128 + wc * 32 + 8 * fq, row0 = u.pm * 256 + wr * 64 + fr;
#pragma unroll
        for (int ai = 0; ai < 2; ++ai)
#pragma unroll
            for (int m = 0; m < 4; ++m) { const int row = row0 + ai * 128 + m * 16;
                float o[8];
#pragma unroll
                for (int q = 0; q < 8; ++q) { float g = (q < 4 ? acc[ai][0][m][0][q] : acc[ai][0][m][1][q - 4]);
                    float up = (q < 4 ? acc[ai][1][m][0][q] : acc[ai][1][m][1][q - 4]);
                    g = __builtin_fminf(g, 7.f); up = __builtin_amdgcn_fmed3f(up, -7.f, 7.f);
                    const float glu = g * __builtin_amdgcn_rcpf(1.f + __builtin_amdgcn_exp2f(-1.702f * LOG2E * g));
                    o[q] = __builtin_fmaf(up, glu, glu); }
                u32x2 w; w.x = pk_fp8x4(o[0], o[1], o[2], o[3]); w.y = pk_fp8x4(o[4], o[5], o[6], o[7]);
                *(GAS u32x2*)((unsigned char*)act + (size_t)row * DFF + f0) = w; }
    }
};
struct EpiNull {
    static constexpr bool PERM = true, MID = false, FP8 = true, WIDE = false;
    __device__ __forceinline__ void mid(f32x4 (&)[2][2][4][2], const pg8::Unit&, int, int) const {}
    __device__ __forceinline__ void init(f32x4 (&i)[2][2], int, int, int) const { i[0][0] = i[0][1] = i[1][0] = i[1][1] = (f32x4){0.f, 0.f, 0.f, 0.f}; }
    __device__ __forceinline__ void operator()(const f32x4 (&acc)[2][2][4][2], const pg8::Unit&, int, int, int, int, int) const {
#pragma unroll
        for (int a = 0; a < 2; ++a)
#pragma unroll
            for (int b = 0; b < 2; ++b)
#pragma unroll
                for (int m = 0; m < 4; ++m)
#pragma unroll
                    for (int n = 0; n < 2; ++n) asm volatile("" :: "v"(acc[a][b][m][n]));
    }
};
struct EpiDense {
    static constexpr bool PERM = true, MID = false, FP8 = true, WIDE = false;
    bf16_t* dst;
    __device__ __forceinline__ void mid(f32x4 (&)[2][2][4][2], const pg8::Unit&, int, int) const {}
    __device__ __forceinline__ void init(f32x4 (&i)[2][2], int, int, int) const { i[0][0] = i[0][1] = i[1][0] = i[1][1] = (f32x4){0.f, 0.f, 0.f, 0.f}; }
    __device__ __forceinline__ void operator()(const f32x4 (&acc)[2][2][4][2], const pg8::Unit& u, int, int wr, int wc, int fr, int fq) const {
        const int tid = (wr * 4 + wc) * 64 + fq * 16 + fr;
        unsigned char* base = (unsigned char*)dst + ((size_t)(u.pm * 4 + u.pn) % 512) * 131072 + tid * 16;
#pragma unroll
        for (int ai = 0; ai < 2; ++ai)
#pragma unroll
            for (int m = 0; m < 4; ++m)
#pragma unroll
                for (int bj = 0; bj < 2; ++bj) { const f32x4 v0 = acc[ai][bj][m][0], v1 = acc[ai][bj][m][1];
                    u32x4 w; w.x = cvt_pk_bf16(v0[0], v0[1]); w.y = cvt_pk_bf16(v0[2], v0[3]); w.z = cvt_pk_bf16(v1[0], v1[1]); w.w = cvt_pk_bf16(v1[2], v1[3]);
                    *(GAS u32x4*)(base + ((ai * 4 + m) * 2 + bj) * 8192) = w; }
    }
};
struct EpiYs {
    static constexpr bool PERM = true, MID = false, FP8 = true, WIDE = true;
    bf16_t* ys; const LAS int* tab; const LAS unsigned char* meta;
    __device__ __forceinline__ void mid(f32x4 (&)[2][2][4][2], const pg8::Unit&, int, int) const {}
    __device__ __forceinline__ void init(f32x4 (&i)[2][2], int ui, int wc, int fq) const {
        const LAS float* bp = (const LAS float*)(meta + (ui % 3) * META_SLOT + 1024) + wc * 64 + 8 * fq;
#pragma unroll
        for (int bj = 0; bj < 2; ++bj)
#pragma unroll
            for (int n = 0; n < 2; ++n) i[bj][n] = *(const LAS f32x4*)(bp + bj * 32 + 4 * n);
    }
    __device__ __forceinline__ void operator()(const f32x4 (&acc)[2][2][4][2], const pg8::Unit& u, int ui, int wr, int wc, int fr, int fq) const {
        const int c0 = wc * 64 + 8 * fq, col0 = u.pn * 256 + c0, rl0 = wr * 64 + fr, lim = tab[40 + u.e] - u.aux * 256;
        const LAS int* lst = (const LAS int*)(meta + (ui % 3) * META_SLOT);
        int ent[2][4];
#pragma unroll
        for (int ai = 0; ai < 2; ++ai)
#pragma unroll
            for (int m = 0; m < 4; ++m) { const int rl = rl0 + ai * 128 + m * 16; const int e_ = lst[rl]; ent[ai][m] = (rl < lim) ? e_ : -1; }
#pragma unroll
        for (int ai = 0; ai < 2; ++ai)
#pragma unroll
            for (int m = 0; m < 4; ++m) { if (ent[ai][m] >= 0) { unsigned char* rowp = (unsigned char*)ys + (size_t)ent[ai][m] * DM + col0;
#pragma unroll
                for (int bj = 0; bj < 2; ++bj) { const f32x4 v0 = acc[ai][bj][m][0], v1 = acc[ai][bj][m][1];
                    u32x2 w; w.x = pk_fp8x4(v0[0], v0[1], v0[2], v0[3]); w.y = pk_fp8x4(v1[0], v1[1], v1[2], v1[3]);
                    *(GAS u32x2*)(rowp + bj * 32) = w; } } }
    }
};
struct FinRow { f32x4 x[4]; u32x2 d[4]; unsigned y[TOPK][4]; };
__device__ __forceinline__ void fin_load(FinRow& R, const float* xrow, const bf16_t* drow, const bf16_t* yrow, int lane) {
    const GAS f32x4* xr = (const GAS f32x4*)xrow + lane;
#pragma unroll
    for (int kk = 0; kk < TOPK; ++kk) { const GAS unsigned* yr = (const GAS unsigned*)((const unsigned char*)yrow + (size_t)kk * DM) + lane;
#pragma unroll
        for (int j = 0; j < 4; ++j) R.y[kk][j] = __builtin_nontemporal_load(yr + 64 * j); }
    const GAS u32x2* dr = (const GAS u32x2*)drow + lane;
#pragma unroll
    for (int j = 0; j < 4; ++j) { R.x[j] = xr[64 * j]; R.d[j] = dr[64 * j]; }
}
__device__ __forceinline__ void fin_compute(const FinRow& R, float* drow, float gv, int r, int lane, const f32x4 (&gfm)[4], const f32x4 (&gf)[4]) {
    f32x4 y[4];
#pragma unroll
    for (int j = 0; j < 4; ++j) y[j] = (f32x4){0.f, 0.f, 0.f, 0.f};
#pragma unroll
    for (int kk = 0; kk < TOPK; ++kk) { const float g = __builtin_bit_cast(float, __builtin_amdgcn_readlane(__builtin_bit_cast(int, gv), r * 4 + kk));
#pragma unroll
        for (int j = 0; j < 4; ++j) { const int w = (int)R.y[kk][j]; const f32x2 lo = __builtin_amdgcn_cvt_pk_f32_fp8(w, false), hi = __builtin_amdgcn_cvt_pk_f32_fp8(w, true);
            y[j] += (f32x4){lo.x, lo.y, hi.x, hi.y} * g; } }
    f32x4 v[4]; float s = 0.f;
#pragma unroll
    for (int j = 0; j < 4; ++j) { const u32x2 w = R.d[j]; v[j] = (R.x[j] + (f32x4){bf2f(w.x & 0xffffu), bf2f(w.x >> 16), bf2f(w.y & 0xffffu), bf2f(w.y >> 16)}) + gfm[j] * y[j]; s += (v[j].x * v[j].x + v[j].y * v[j].y) + (v[j].z * v[j].z + v[j].w * v[j].w); }
    const float rstd = 1.f / sqrtf(wave_sum(s) * (1.f / DM) + EPS);
    GAS f32x4* orow = (GAS f32x4*)drow + lane;
#pragma unroll
    for (int j = 0; j < 4; ++j) orow[64 * j] = v[j] * rstd * gf[j];
}
__device__ __forceinline__ void final_phase(Frame& F, float* dst) {
    const int gw = F.vcu * NWAVES + F.wave, NGW = F.G * NWAVES, lane = F.lane;
    f32x4 gf[4];
#pragma unroll
    for (int j = 0; j < 4; ++j) gf[j] = *(const GAS f32x4*)(F.g_final + 4 * lane + 256 * j);
    for (int chunk = gw; chunk < NTOK / 16; chunk += NGW) {
        const int m0 = chunk * 16, b = m0 / SEQ;
        f32x4 gfm[4];
#pragma unroll
        for (int j = 0; j < 4; ++j) gfm[j] = *(const GAS f32x4*)(F.mod + b * 6 * DM + 5 * DM + 4 * lane + 256 * j);
        const float gv = F.tkg[m0 * 4 + lane];
        FinRow A, B;
        fin_load(A, F.x + (size_t)m0 * DM, F.DELTA + (size_t)m0 * DM, (const bf16_t*)((const unsigned char*)F.YS + (size_t)m0 * 4 * DM), lane);
#pragma unroll 1
        for (int r = 0; r < 16; r += 2) {
            fin_load(B, F.x + (size_t)(m0 + r + 1) * DM, F.DELTA + (size_t)(m0 + r + 1) * DM, (const bf16_t*)((const unsigned char*)F.YS + (size_t)(m0 + r + 1) * 4 * DM), lane);
            fin_compute(A, dst + (size_t)(m0 + r) * DM, gv, r, lane, gfm, gf);
            if (r + 2 < 16) fin_load(A, F.x + (size_t)(m0 + r + 2) * DM, F.DELTA + (size_t)(m0 + r + 2) * DM, (const bf16_t*)((const unsigned char*)F.YS + (size_t)(m0 + r + 2) * 4 * DM), lane);
            fin_compute(B, dst + (size_t)(m0 + r + 1) * DM, gv, r + 1, lane, gfm, gf);
        }
    }
}
struct MkArgs { const float* in[17]; float* out; unsigned char* ws; int ph_lo, ph_hi; };
#ifndef DBG_STAGE
#define DBG_STAGE 9
#endif
constexpr int N_PHASES = DBG_STAGE;
__global__ void __launch_bounds__(NWAVES * 64, 2) mk_fwd(MkArgs args) {
    extern __shared__ __attribute__((aligned(16))) unsigned char lds[];
    Frame F;
    F.lds = (LAS unsigned char*)lds;
    F.MISC = (volatile LAS unsigned*)(F.lds + MISC_OFF);
    F.tid = threadIdx.x; F.lane = F.tid & 63; F.wave = __builtin_amdgcn_readfirstlane(F.tid >> 6);
    F.G = gridDim.x; { const int bx = blockIdx.x; F.vcu = (F.G % 8 == 0) ? (bx % 8) * (F.G / 8) + bx / 8 : bx; }
    unsigned char* ws = args.ws;
    F.ctl = (gu32*)(ws + WS_CTL);
    F.x = args.in[0]; F.c = args.in[1]; F.w_ada = args.in[2]; F.b_ada = args.in[3]; F.w_in = args.in[4]; F.sink = args.in[5]; F.rpb = args.in[6]; F.ga = args.in[7]; F.gb = args.in[8];
    F.w_out = args.in[9]; F.w_router = args.in[10]; F.b_router = args.in[11]; F.w_gu = args.in[12]; F.b_gu = args.in[13]; F.w_down = args.in[14]; F.b_down = args.in[15]; F.g_final = args.in[16];
    F.out = args.out;
    F.mod = (float*)(ws + WS_MOD); F.rope = (float*)(ws + WS_ROPE); F.ssq = (float*)(ws + WS_SSQ); F.tkg = (float*)(ws + WS_TKG); F.tke = (int*)(ws + WS_TKE); F.list = (int*)(ws + WS_LIST);
    F.wr_t = (bf16_t*)(ws + WS_WR); F.win_t = (bf16_t*)(ws + WS_WIN); F.wout_t = (bf16_t*)(ws + WS_WOUT); F.wgu_t = (bf16_t*)(ws + WS_WGU); F.wd_t = (bf16_t*)(ws + WS_WD);
    F.XN = (bf16_t*)(ws + WS_XN); F.PROJ = (bf16_t*)(ws + WS_PROJ); F.O = (bf16_t*)(ws + WS_O); F.YS = (bf16_t*)(ws + WS_YS); F.ACT = (bf16_t*)(ws + WS_ACT); F.DELTA = (bf16_t*)(ws + WS_DELTA);
    for (int u = F.tid; u < (LDS_BYTES - LDSCTL_OFF) / 4; u += NWAVES * 64) ((LAS unsigned*)(F.lds + LDSCTL_OFF))[u] = 0u;
    __syncthreads();
    const int lo = args.ph_lo, hi = args.ph_hi;
    XcdBarrier bar; bar.bar = (unsigned*)(F.ctl + CW_BAR); bar.x = 0; bar.st = nullptr;
    if (hi - lo > 1) bar = xcd_barrier_post((unsigned*)(F.ctl + CW_BAR), F.MISC + 8, F.wave);
#define IN(k) (lo <= (k) && (k) < hi)
#define MOE_STAGGER(nN_, ticks_) do { const int tot_ = ((const LAS int*)(F.lds + TAB_OFF))[32] * (nN_); const int maxu_ = (tot_ + F.G - 1) / F.G, mine_ = (tot_ - F.vcu + F.G - 1) / F.G; \
        if (mine_ < maxu_) { const unsigned long long t0_ = __builtin_amdgcn_s_memrealtime(); while (__builtin_amdgcn_s_memrealtime() - t0_ < (ticks_)) __builtin_amdgcn_s_sleep(8); } } while (0)
#define FRESH() do { F.lane = lane_id(); F.tid = F.wave * 64 + F.lane; } while (0)
#if defined(DIAG_A)
    unsigned long long* const ts = (unsigned long long*)(ws + WS_CTL + 512 * 1024);
#define STAMP(k) do { if (blockIdx.x == 0 && F.wave == 0 && lane_id() == 0) ts[k] = __builtin_amdgcn_s_memrealtime(); } while (0)
#else
#define STAMP(k) do {} while (0)
#endif
#define SEAM(k) do { if (IN(k) && IN((k) + 1)) xcd_barrier(bar, F.wave); STAMP((k) + 1); } while (0)
#ifndef PROBE_PH
#define PROBE_PH -1
#endif
#ifndef PROBE_FIN
#define PROBE_FIN 0
#endif
#define REP(k) for (int _rep = (PROBE_PH == (k)) ? 0 : 1; _rep < 2; ++_rep)
    float* const dummy = (float*)(ws + 830 * MiB);
    STAMP(0);
    FRESH();
    if (IN(0)) { REP(0) { __syncthreads(); p0_prologue(F); } } SEAM(0);
    FRESH();
    if (IN(1)) { REP(1) p1_xn(F); } SEAM(1);
    FRESH();
    if (IN(2)) REP(2) {
        pg8::DenseOrder S; S.init(F.XN, F.win_t, NTOK, DIN, DM, F.G, (int)blockIdx.x);
        EpiProj E{F.PROJ, F.rope};
        pg8::gemm_phase<EpiProj, pg8::DenseOrder, true>(F.lds, DM, S, E, F.wave);
    } SEAM(2);
    FRESH();
    if (IN(3)) { if (PROBE_PH == 3) { if (PROBE_FIN != 2) attn_a_phase(F, dummy); if (PROBE_FIN != 1) attn_b_phase(F, dummy); }
                 attn_a_phase(F, F.ssq); attn_b_phase(F, F.ssq); } SEAM(3);
    FRESH();
    if (IN(4)) REP(4) {
        pg8::DenseOrder S; S.init(F.O, F.wout_t, NTOK, DM, DM, F.G, (int)blockIdx.x);
        EpiX1 E{F.DELTA, F.mod, F.ssq};
        pg8::gemm_phase<EpiX1, pg8::DenseOrder, true>(F.lds, DM, S, E, F.wave);
    } SEAM(4);
    FRESH();
    if (IN(5)) REP(5) { router_phase(F, _rep ? F.ctl + CW_CNT : F.ctl + 16384); } SEAM(5);
    FRESH();
    if (IN(6)) {
        moe_table(F);
        MoeOrder<true> S{(const char*)F.XN, (const char*)F.wgu_t, F.list, F.b_gu, (const LAS int*)(F.lds + TAB_OFF), F.lds + META_OFF, DM, 2 * DFF, 2 * DFF / 256, F.G, F.vcu, 0};
        if (PROBE_PH == 6) { EpiNull E0; pg8::gemm_phase<EpiNull, MoeOrder<true>, true>(F.lds, DM, S, E0, F.wave); S.ec = 0; }
        EpiSwiglu E{F.ACT, F.lds + META_OFF};
        pg8::gemm_phase<EpiSwiglu, MoeOrder<true>, true>(F.lds, DM, S, E, F.wave);
    } SEAM(6);
    FRESH();
    if (IN(7)) {
        moe_table(F);
        MoeOrder<false> S{(const char*)F.ACT, (const char*)F.wd_t, F.list, F.b_down, (const LAS int*)(F.lds + TAB_OFF), F.lds + META_OFF, DFF, DM, DM / 256, F.G, F.vcu, 0};
        if (PROBE_PH == 7) { EpiDense E0{(bf16_t*)(ws + 830 * MiB)}; pg8::gemm_phase<EpiDense, MoeOrder<false>, true>(F.lds, DFF, S, E0, F.wave); S.ec = 0; }
        EpiYs E{F.YS, (const LAS int*)(F.lds + TAB_OFF), F.lds + META_OFF};
        pg8::gemm_phase<EpiYs, MoeOrder<false>, true>(F.lds, DFF, S, E, F.wave);
    } SEAM(7);
    FRESH();
    if (IN(8)) REP(8) { final_phase(F, _rep ? F.out : dummy); }
#if defined(DIAG_A)
    xcd_barrier(bar, F.wave); STAMP(9);
    if (blockIdx.x == 0 && F.wave == 0) { asm volatile("s_waitcnt vmcnt(0)" ::: "memory");
        const unsigned long long t9 = __builtin_amdgcn_s_memrealtime(), span = (DIAG_A == 9) ? 0ull : (ts[DIAG_A + 1] - ts[DIAG_A]);
        while (__builtin_amdgcn_s_memrealtime() - t9 < 4ull * span) __builtin_amdgcn_s_sleep(16); }
#endif
#undef IN
#undef SEAM
}

__global__ void br_route(const bf16_t* XN, const int* tke, const unsigned* ctl, float* h, int* cnt, int* list) {
    const int idx = blockIdx.x * 256 + threadIdx.x;
    const int ep = tke[idx]; list[(ep >> 16) * NTOK + (ep & 0xffff)] = idx;
    if (idx < NE) cnt[idx] = (int)ctl[CW_CNT + idx * 64];
    const int t = idx >> 2, q = idx & 3;
    for (int k = q * 256; k < q * 256 + 256; ++k) h[(size_t)t * DM + k] = bf2f(XN[(size_t)t * DM + k]);
}
extern "C" void kernel_launch(void* const* d_in, const int* in_sizes, int n_in, void* d_out, int out_size, void* d_ws, size_t ws_size, hipStream_t stream) {
    static int grid = 0;
    if (grid == 0) {
        if (n_in != 17 || ws_size < (size_t)1001 * MiB) { fprintf(stderr, "kernel_launch: bad n_in %d or ws_size %zu\n", n_in, ws_size); grid = -1; return; }
        int dev = 0, cus = 0, per_cu = 0;
        if (hipGetDevice(&dev) != hipSuccess || hipDeviceGetAttribute(&cus, hipDeviceAttributeMultiprocessorCount, dev) != hipSuccess) { grid = -1; return; }
        if (hipFuncSetAttribute((const void*)mk_fwd, hipFuncAttributeMaxDynamicSharedMemorySize, LDS_BYTES) != hipSuccess) { fprintf(stderr, "kernel_launch: hipFuncSetAttribute failed\n"); grid = -1; return; }
        if (hipOccupancyMaxActiveBlocksPerMultiprocessor(&per_cu, (const void*)mk_fwd, NWAVES * 64, LDS_BYTES) != hipSuccess || per_cu < 1) { fprintf(stderr, "kernel_launch: occupancy query says %d\n", per_cu); }
        (void)hipGetLastError();
        grid = cus;
    }
    if (grid < 0) return;
    const float* x = (const float*)d_in[0]; const float* sink = (const float*)d_in[5]; const float* rpb = (const float*)d_in[6]; const float* ga = (const float*)d_in[7];
    const float* gb = (const float*)d_in[8]; const float* w_out = (const float*)d_in[9]; const float* w_router = (const float*)d_in[10]; const float* b_router = (const float*)d_in[11];
    const float* w_gu = (const float*)d_in[12]; const float* b_gu = (const float*)d_in[13]; const float* w_down = (const float*)d_in[14]; const float* b_down = (const float*)d_in[15];
    const float* g_final = (const float*)d_in[16];
    char* ws = (char*)d_ws; float* out = (float*)d_out;
    (void)hipMemsetAsync(ws + WS_CTL, 0, CTL_ZERO_BYTES, stream);
    MkArgs a{};
    for (int i = 0; i < 17; ++i) a.in[i] = (const float*)d_in[i];
    a.out = out; a.ws = (unsigned char*)d_ws;
#if defined(MK_PER_PHASE)
    for (int ph = 0; ph < N_PHASES; ++ph) { a.ph_lo = ph; a.ph_hi = ph + 1; hipLaunchKernelGGL(mk_fwd, dim3(grid), dim3(NWAVES * 64), LDS_BYTES, stream, a); }
#else
    a.ph_lo = 0; a.ph_hi = N_PHASES; hipLaunchKernelGGL(mk_fwd, dim3(grid), dim3(NWAVES * 64), LDS_BYTES, stream, a);
#endif
#if DBG_STAGE < 9
    float* mod = (float*)(ws + WS_MOD);
    float* h = (float*)(ws + 17 * MiB);
    float* y = (float*)(ws + 337 * MiB);
    float* act = (float*)(ws + 481 * MiB);
    int* cnt = (int*)(ws + 993 * MiB); int* tke = (int*)(ws + 994 * MiB); float* tkg = (float*)(ws + 995 * MiB); int* list = (int*)(ws + 996 * MiB);
    (void)hipMemsetAsync(cnt, 0, 64 * sizeof(int), stream);
    (void)hipMemsetAsync(y, 0, (size_t)NTOK * DM * 4, stream);
#if DBG_STAGE == 5
    nv_norm_mod<<<NTOK, 256, 0, stream>>>(out, mod, 3 * DM, 4 * DM, h);
    nv_router<<<NTOK, 64, 0, stream>>>(h, w_router, b_router, cnt, tke, tkg, list);
#elif DBG_STAGE == 6
    br_route<<<NTOK * 4 / 256, 256, 0, stream>>>((const bf16_t*)(ws + WS_XN), (const int*)(ws + WS_TKE), (const unsigned*)(ws + WS_CTL), h, cnt, list);
    tkg = (float*)(ws + WS_TKG);
#endif
    nv_offsets<<<1, 64, 0, stream>>>(cnt);
    nv_sgemm<true><<<dim3(DFF / 64, NTOK / 64, NE), 256, 0, stream>>>(w_gu, 2 * DFF, DM, RmMoe1{h, list, cnt, (size_t)DM * 2 * DFF}, EpiMoe1{act, cnt, b_gu});
    nv_sgemm<false><<<dim3(DM / 64, NTOK / 64, NE), 256, 0, stream>>>(w_down, DM, DFF, RmMoe2{act, cnt, (size_t)DFF * DM}, EpiMoe2{y, list, cnt, tkg, b_down});
    nv_final<<<NTOK, 256, 0, stream>>>(out, y, mod, g_final, out);
#endif
}
```

```cpp
#define DBG_STAGE 9
#include <hip/hip_runtime.h>
#include <cstdio>
#include <cstdint>
#include <cmath>

constexpr int DM = 1024, NB = 8, SEQ = 4096, NTOK = NB * SEQ;
constexpr int HD = 64, AQH = 8, AKVH = 2, BH = 8;
constexpr int AQW = 512, AKVW = 128, BW = 512, DIN = 2304;
constexpr int OFF_QA = 0, OFF_KA = 512, OFF_VA = 640, OFF_QB = 768, OFF_KB = 1280, OFF_VB = 1792;
constexpr int WIN = 128, GW = 64, NAR = 8, NAC = 16, NE = 32, TOPK = 4, DFF = 1024;
constexpr float EPS = 1e-5f;
constexpr size_t MiB = 1u << 20;

#define GAS __attribute__((address_space(1)))
#define LAS __attribute__((address_space(3)))
typedef unsigned short bf16_t;
typedef short bf16x8 __attribute__((ext_vector_type(8)));
typedef float f32x4 __attribute__((ext_vector_type(4)));
typedef float f32x2 __attribute__((ext_vector_type(2)));
typedef float f32x16 __attribute__((ext_vector_type(16)));
typedef unsigned u32x4 __attribute__((ext_vector_type(4)));
typedef unsigned u32x2 __attribute__((ext_vector_type(2)));
typedef unsigned u32x8 __attribute__((ext_vector_type(8)));
typedef GAS unsigned gu32;
#define RLX_AGENT __ATOMIC_RELAXED, __HIP_MEMORY_SCOPE_AGENT
#define LDS_WAIT() asm volatile("s_waitcnt lgkmcnt(0)" ::: "memory")
#define VM_WAIT() asm volatile("s_waitcnt vmcnt(0)" ::: "memory")
__device__ __forceinline__ unsigned cvt_pk_bf16(float lo, float hi) { unsigned r; asm volatile("v_cvt_pk_bf16_f32 %0, %1, %2" : "=v"(r) : "v"(lo), "v"(hi)); return r; }
__device__ __forceinline__ unsigned f2bf(float f) { unsigned u = __builtin_bit_cast(unsigned, f); return (u + 0x7fffu + ((u >> 16) & 1u)) >> 16; }
__device__ __forceinline__ unsigned pk2(float lo, float hi) { return f2bf(lo) | (f2bf(hi) << 16); }
__device__ __forceinline__ float bf2f(unsigned h) { return __builtin_bit_cast(float, h << 16); }
__device__ __forceinline__ unsigned pk_fp8x4(float a, float b, float c, float d) { int p = __builtin_amdgcn_cvt_pk_fp8_f32(a, b, 0, false); return (unsigned)__builtin_amdgcn_cvt_pk_fp8_f32(c, d, p, true); }
typedef int v8i32 __attribute__((ext_vector_type(8)));
constexpr float W8_SCALE = 32.0f;

constexpr int NWAVES = 8;
__device__ __forceinline__ int lane_id() { int l; asm volatile("v_mbcnt_lo_u32_b32 %0, -1, 0\n\tv_mbcnt_hi_u32_b32 %0, -1, %0" : "=v"(l)); return l; }
constexpr float C2 = 0.125f * 1.4426950408889634f;
constexpr float LOG2E = 1.4426950408889634f;
constexpr int NSLOT_MAX = 139264;

constexpr size_t WS_CTL = 0, CTL_ZERO_BYTES = 128 * 1024;
constexpr size_t WS_MOD = 1 * MiB;
constexpr size_t WS_ROPE = WS_MOD + 256 * 1024;
constexpr size_t WS_WR = WS_ROPE + 256 * 1024;
constexpr size_t WS_SSQ = 2 * MiB;
constexpr size_t WS_TKE = 3 * MiB;
constexpr size_t WS_TKG = 4 * MiB;
constexpr size_t WS_LIST = 5 * MiB;
constexpr size_t WS_WIN = 10 * MiB;
constexpr size_t WS_WOUT = 15 * MiB;
constexpr size_t WS_WGU = 17 * MiB;
constexpr size_t WS_WD = 145 * MiB;
constexpr size_t WS_XN = 209 * MiB;
constexpr size_t WS_PROJ = 273 * MiB;
constexpr size_t WS_O = 417 * MiB;
constexpr size_t WS_YS = 209 * MiB;
constexpr size_t WS_ACT = 481 * MiB;
constexpr size_t WS_DELTA = 760 * MiB;
constexpr size_t WS_MK_END = 824 * MiB;
constexpr int CW_TMO = 0, CW_CNT = 64  , CW_BAR = 4096;

constexpr int RING_BYTES = 131072;
constexpr int LDSCTL_OFF = RING_BYTES, MISC_OFF = LDSCTL_OFF + 320;
constexpr int TAB_OFF = LDSCTL_OFF + 1024;
constexpr int LDS_BYTES = 163840;

namespace pg8 {
constexpr int BM = 256, BK = 64, HALF = 128, HTB = HALF * BK * 2, NXCD = 8, WGM = 8;
__host__ __device__ __forceinline__ int lds_byte(int r, int c) { const int st = (r >> 4) * 2 + (c >> 5), rr = r & 15, cc = c & 31, ob = rr * 64 + cc * 2; return st * 1024 + (ob ^ (((ob >> 9) & 1) << 5)); }
__host__ __device__ __forceinline__ void stage_rc(int b, int& R, int& C) { const int st = b / 1024, sb = b % 1024, swz = sb ^ (((sb >> 9) & 1) << 5); R = (st >> 1) * 16 + swz / 64; C = (st & 1) * 32 + (swz % 64) / 2; }
__host__ __device__ __forceinline__ int perm32(int rho) { const int n = rho >> 4, i = rho & 15; return 8 * (i >> 2) + 4 * n + (i & 3); }

struct Unit { int pm, pn, e, aux; };

struct DenseOrder {
    const char* A; const char* Bt; int K; int nM, nN, nwg, G, c;
    __device__ void init(const void* A_, const void* Bt_, int M, int N, int K_, int G_, int c_) { A = (const char*)A_; Bt = (const char*)Bt_; K = K_; nM = M / BM; nN = N / BM; nwg = nM * nN; G = G_; c = c_; }
    __device__ bool next(int i, Unit& u) const {
        const long L = (long)i * G + c; if (L >= nwg) return false;
        int wgid = (int)L; { const int q = nwg / NXCD, r = nwg % NXCD, xcd = wgid % NXCD, off = wgid / NXCD; wgid = (xcd < r ? xcd * (q + 1) : r * (q + 1) + (xcd - r) * q) + off; }
        const int nig = WGM * nN, gid = wgid / nig, fm = gid * WGM, gsz = (nM - fm) < WGM ? (nM - fm) : WGM;
        u.pm = fm + ((wgid % nig) % gsz); u.pn = (wgid % nig) / gsz; u.e = 0; u.aux = 0; return true;
    }
    __device__ __forceinline__ const char* abase() const { return A; }
    __device__ __forceinline__ const char* bbase(const Unit& u) const { return Bt + (size_t)u.pn * BM * K * 2; }
    __device__ __forceinline__ void aoffs(const Unit& u, int, const int (&R)[2], const int (&C)[2], unsigned (&off)[4]) const {
#pragma unroll
        for (int h = 0; h < 2; ++h)
#pragma unroll
            for (int i = 0; i < 2; ++i) off[h * 2 + i] = (unsigned)((u.pm * BM + h * HALF + R[i]) * K + C[i]) * 2u;
    }
    __device__ __forceinline__ void meta_init(const Unit&, bool, const Unit&, int) const {}
    __device__ __forceinline__ void meta_top(int, bool, const Unit&, bool, const Unit&, int) const {}
};

#define PG8_LAS __attribute__((address_space(3)))
template <class Epi, class Sched, bool ALIGN_EPI>
__device__ __forceinline__ void gemm_phase(PG8_LAS unsigned char* lds, const int K, const Sched& S, const Epi& E, const int wid_  ) {
    const int lane = lane_id(), tid = wid_ * 64 + lane, wid = wid_, wr = wid >> 2, wc = wid & 3, fr = lane & 15, fq = lane >> 4;
    constexpr int ESZ = Epi::FP8 ? 1 : 2;
    const int nt = K * ESZ / (BK * 2);
    unsigned voffB[2];
#pragma unroll
    for (int i = 0; i < 2; ++i) { int R, C; stage_rc(tid * 16 + i * 8192, R, C); const int Rp = Epi::PERM ? ((R & ~31) + perm32(R & 31)) : R; const int Rb = Epi::WIDE ? ((Rp >> 5) * 64 + (Rp & 31)) : Rp; voffB[i] = (unsigned)(Rb * K * ESZ + C * 2); }
#define PG8_RC() int sR[2], sC[2]; { int t2_ = tid; asm volatile("" : "+v"(t2_)); _Pragma("unroll") for (int i = 0; i < 2; ++i) stage_rc(t2_ * 16 + i * 8192, sR[i], sC[i]); }
    const size_t kstep = (size_t)(BK * 2);
    const size_t hstepB = (size_t)(Epi::WIDE ? 32 : HALF) * K * ESZ;
    const unsigned ldsw = (unsigned)wid * 1024u;
    const int aoff = lds_byte(wr * 64 + fr, fq * 8), boff = lds_byte(wc * 32 + fr, fq * 8);
    const char* const gA = S.abase();
#define PG8_SA(b, h) (((b) * 2 + (h)) * HTB)
#define PG8_SB(b, h) ((4 + (b) * 2 + (h)) * HTB)
#define PG8_STAGE(bufoff, gbase, voff) do { _Pragma("unroll") for (int _i = 0; _i < 2; ++_i) \
        __builtin_amdgcn_global_load_lds((const unsigned*)((const char*)(gbase) + (voff)[_i]), (PG8_LAS unsigned*)(lds + (bufoff) + ldsw + _i * 8192), 16, 0, 0); } while (0)
#define PG8_STAGEA(bufoff, offs, h, kb) do { _Pragma("unroll") for (int _i = 0; _i < 2; ++_i) \
        __builtin_amdgcn_global_load_lds((const unsigned*)((gA + (kb)) + (offs)[(h) * 2 + _i]), (PG8_LAS unsigned*)(lds + (bufoff) + ldsw + _i * 8192), 16, 0, 0); } while (0)
#define PG8_LD16(off) (*(const PG8_LAS u32x4*)(lds + (off)))
#define PG8_LDA(dst, b, h) do { _Pragma("unroll") for (int m = 0; m < 4; ++m) dst[m] = __builtin_shufflevector(PG8_LD16(PG8_SA(b, h) + aoff + m * 2048), PG8_LD16(PG8_SA(b, h) + aoff + m * 2048 + 1024), 0, 1, 2, 3, 4, 5, 6, 7); } while (0)
#define PG8_LDB(dst, b, h) do { _Pragma("unroll") for (int n = 0; n < 2; ++n) dst[n] = __builtin_shufflevector(PG8_LD16(PG8_SB(b, h) + boff + n * 2048), PG8_LD16(PG8_SB(b, h) + boff + n * 2048 + 1024), 0, 1, 2, 3, 4, 5, 6, 7); } while (0)
#define PG8_HALF(x, k) __builtin_bit_cast(bf16x8, __builtin_shufflevector(x, x, 4 * (k), 4 * (k) + 1, 4 * (k) + 2, 4 * (k) + 3))
#define PG8_MMA(ai, bj, At, Bt) do { __builtin_amdgcn_s_setprio(1); _Pragma("unroll") for (int m = 0; m < 4; ++m) _Pragma("unroll") for (int n = 0; n < 2; ++n) { \
        if constexpr (Epi::FP8) asm volatile("v_mfma_scale_f32_16x16x128_f8f6f4 %0, %1, %2, %0, %3, %4 op_sel_hi:[0,0,0]" : "+v"(acc[ai][bj][m][n]) : "v"(Bt[n]), "v"(At[m]), "v"(scw), "v"(sca)); \
        else { acc[ai][bj][m][n] = __builtin_amdgcn_mfma_f32_16x16x32_bf16(PG8_HALF(Bt[n], 0), PG8_HALF(At[m], 0), acc[ai][bj][m][n], 0, 0, 0); \
               acc[ai][bj][m][n] = __builtin_amdgcn_mfma_f32_16x16x32_bf16(PG8_HALF(Bt[n], 1), PG8_HALF(At[m], 1), acc[ai][bj][m][n], 0, 0, 0); } } \
        __builtin_amdgcn_s_setprio(0); } while (0)
#define PG8_ACC_INIT(uix) do { f32x4 i_[2][2]; { int l2_ = lane; asm volatile("" : "+v"(l2_)); E.init(i_, (uix), wc, l2_ >> 4); } \
        _Pragma("unroll") for (int a = 0; a < 2; ++a) _Pragma("unroll") for (int b = 0; b < 2; ++b) _Pragma("unroll") for (int m = 0; m < 4; ++m) _Pragma("unroll") for (int n = 0; n < 2; ++n) { \
            acc[a][b][m][n] = i_[b][n]; asm volatile("" : "+v"(acc[a][b][m][n])); } } while (0)
#define PG8_WAIT_V(n) asm volatile("s_waitcnt vmcnt(" #n ")" ::: "memory")
#define PG8_WAIT_L(n) asm volatile("s_waitcnt lgkmcnt(" #n ")" ::: "memory")
#define PG8_BAR __builtin_amdgcn_s_barrier()
#define PG8_SCHED __builtin_amdgcn_sched_barrier(0)
    Unit cur, nxt, nn; int ui = 0;
    if (!S.next(0, cur)) return;
    bool h1 = S.next(1, nxt), h2 = h1 && S.next(2, nn);
    f32x4 acc[2][2][4][2];
    unsigned scw = 0x7A7A7A7Au, sca = 0x7F7F7F7Fu; asm volatile("" : "+v"(scw), "+v"(sca));
    u32x8 At[4], B0[2], B1[2];
    unsigned lO[4], hO[2];
    S.meta_init(cur, h1, nxt, wid);
    { PG8_RC(); S.aoffs(cur, 0, sR, sC, lO); } hO[0] = lO[2]; hO[1] = lO[3];
    PG8_ACC_INIT(0);
    const char* cB = S.bbase(cur);
    PG8_STAGE(PG8_SB(0, 0), cB, voffB); PG8_STAGE(PG8_SB(0, 1), cB + hstepB, voffB); PG8_STAGEA(PG8_SA(0, 0), lO, 0, 0); PG8_STAGEA(PG8_SA(0, 1), lO, 1, 0);
    if (wr == 1) PG8_BAR;
    PG8_WAIT_V(2); PG8_BAR;
    PG8_STAGE(PG8_SB(1, 0), cB + kstep, voffB); PG8_STAGEA(PG8_SA(1, 0), lO, 0, kstep); PG8_STAGE(PG8_SB(1, 1), cB + hstepB + kstep, voffB);
    PG8_WAIT_V(6); PG8_BAR;
    for (;;) {
        const bool has_next = h1;
        const char* nB = has_next ? S.bbase(nxt) : cB;
        S.meta_top(ui, h1, nxt, h2, nn, wid);
#pragma unroll 1
        for (int t = 0; t < nt; t += 2) {
            const bool last = (t == nt - 2);
            if constexpr (Epi::MID) { if (t == nt / 2) { int l2_ = lane; asm volatile("" : "+v"(l2_)); E.mid(acc, cur, wr, l2_ & 15); } }
            if (last && has_next) { PG8_RC(); S.aoffs(nxt, ui + 1, sR, sC, lO); }
            const size_t k1 = (size_t)(t + 1) * kstep;
            const size_t k2 = last ? 0 : (size_t)(t + 2) * kstep, k3 = k2 + kstep;
            const char* b2 = (last ? nB : cB) + k2; const char* b3 = b2 + kstep;
            PG8_LDB(B0, 0, 0); PG8_LDB(B1, 0, 1); PG8_SCHED; PG8_LDA(At, 0, 0); PG8_STAGEA(PG8_SA(1, 1), hO, 0, k1);
            PG8_WAIT_V(8); PG8_WAIT_L(0); PG8_BAR; PG8_MMA(0, 0, At, B0); PG8_MMA(0, 1, At, B1); PG8_BAR; PG8_SCHED;
            PG8_LDA(At, 0, 1); PG8_STAGE(PG8_SB(0, 0), b2, voffB); PG8_STAGE(PG8_SB(0, 1), b2 + hstepB, voffB); PG8_STAGEA(PG8_SA(0, 0), lO, 0, k2);
            PG8_WAIT_V(8); PG8_WAIT_L(0); PG8_BAR; PG8_MMA(1, 0, At, B0); PG8_MMA(1, 1, At, B1); PG8_BAR; PG8_SCHED;
            PG8_LDB(B0, 1, 0); PG8_LDB(B1, 1, 1); PG8_SCHED; PG8_LDA(At, 1, 0); PG8_STAGEA(PG8_SA(0, 1), lO, 1, k2);
            PG8_WAIT_V(8); PG8_WAIT_L(0); PG8_BAR; PG8_MMA(0, 0, At, B0); PG8_MMA(0, 1, At, B1); PG8_BAR; PG8_SCHED;
            PG8_LDA(At, 1, 1); PG8_STAGE(PG8_SB(1, 0), b3, voffB); PG8_STAGE(PG8_SB(1, 1), b3 + hstepB, voffB); PG8_STAGEA(PG8_SA(1, 0), lO, 0, k3);
            PG8_WAIT_V(8); PG8_WAIT_L(0); PG8_BAR; PG8_MMA(1, 0, At, B0); PG8_MMA(1, 1, At, B1); PG8_BAR; PG8_SCHED;
        }
        if constexpr (ALIGN_EPI) { if (wr == 0) PG8_BAR; }
        if constexpr (Epi::FP8) asm volatile("s_nop 15\n\ts_nop 7" ::: "memory");
        { int l2_ = lane; asm volatile("" : "+v"(l2_)); E(acc, cur, ui, wr, wc, l2_ & 15, l2_ >> 4); }
        if (!has_next) break;
        PG8_ACC_INIT(ui + 1);
        cur = nxt; cB = nB; hO[0] = lO[2]; hO[1] = lO[3];
        nxt = nn; h1 = h2; h2 = h1 && S.next(ui + 3, nn);
        ++ui;
        if constexpr (ALIGN_EPI) { if (wr == 1) PG8_BAR; }
    }
    PG8_WAIT_V(0);
    if constexpr (!ALIGN_EPI) { if (wr == 0) PG8_BAR; }
    PG8_BAR;
#undef PG8_SA
#undef PG8_SB
#undef PG8_STAGE
#undef PG8_STAGEA
#undef PG8_LDA
#undef PG8_LDB
#undef PG8_MMA
#undef PG8_ACC_INIT
#undef PG8_RC
#undef PG8_HALF
#undef PG8_LD16
#undef PG8_WAIT_V
#undef PG8_WAIT_L
#undef PG8_BAR
#undef PG8_SCHED
}
}
#define XB_TMO      128
#define XB_XCNT(j)  (256  + 64 * (j))
#define XB_XSUB(j)  (1280 + 64 * (j))
#define XB_XGEN(j)  (2304 + 64 * (j))
#define XB_TOP      3328
#define XB_TOPGEN   3392
#define XCD_BAR_WORDS 3456
#define XB_SPIN_CAP (1u << 18)
__device__ __forceinline__ unsigned xb_ld(unsigned* p)              { return __hip_atomic_load(p, __ATOMIC_RELAXED, __HIP_MEMORY_SCOPE_AGENT); }
__device__ __forceinline__ unsigned xb_add(unsigned* p, unsigned v) { return __hip_atomic_fetch_add(p, v, __ATOMIC_RELAXED, __HIP_MEMORY_SCOPE_AGENT); }
__device__ __forceinline__ unsigned xb_xcc_id() { return (unsigned)__builtin_amdgcn_s_getreg((3 << 11) | 20) & 0xFu; }
#define XB_SPIN(cond, bar) do { unsigned _sp = 0; while (cond) { __builtin_amdgcn_s_sleep(1); \
    if ((++_sp & 255u) == 0u) { if (xb_ld(&(bar)[XB_TMO])) break; if (_sp > XB_SPIN_CAP) { atomicAdd(&(bar)[XB_TMO], 1u); break; } } } } while (0)
struct XcdBarrier { unsigned* bar; unsigned x; volatile LAS unsigned* st; };
__device__ __forceinline__ XcdBarrier xcd_barrier_post(unsigned* bar, volatile LAS unsigned* st, int wave) {
    XcdBarrier b; b.bar = bar; b.x = xb_xcc_id(); b.st = st;
    if (wave == 0 && lane_id() == 0) (void)xb_add(&bar[XB_XCNT(b.x)], 1u);
    return b;
}
__device__ __forceinline__ void xcd_barrier_complete(unsigned* bar, unsigned x, unsigned& nloc, unsigned& nx) {
    const unsigned G = gridDim.x * gridDim.y * gridDim.z;
    unsigned sum, cnt, mine, sp = 0u;
    for (;;) {
        sum = 0u; cnt = 0u; mine = 0u;
#pragma unroll
        for (unsigned j = 0; j < 16; ++j) { const unsigned c = xb_ld(&bar[XB_XCNT(j)]); sum += c; cnt += (c > 0u) ? 1u : 0u; mine = (j == x) ? c : mine; }
        if (sum == G) break;
        __builtin_amdgcn_s_sleep(1);
        if ((++sp & 255u) == 0u) { if (xb_ld(&bar[XB_TMO])) break; if (sp > XB_SPIN_CAP) { atomicAdd(&bar[XB_TMO], 1u); break; } }
    }
    nloc = mine > 0u ? mine : 1u; nx = cnt > 0u ? cnt : 1u;
}
__device__ __forceinline__ void xcd_barrier(const XcdBarrier& b, int wave) {
    asm volatile("s_waitcnt vmcnt(0)" ::: "memory");
    __syncthreads();
    if (wave == 0 && lane_id() == 0) {
        unsigned* bar = b.bar;
        __builtin_amdgcn_s_waitcnt(0);
        unsigned nloc = b.st[0], nx = b.st[1];
        if (nloc == 0u) { xcd_barrier_complete(bar, b.x, nloc, nx); b.st[0] = nloc; b.st[1] = nx; }
        const unsigned old = xb_add(&bar[XB_XSUB(b.x)], 1u);
        const unsigned gen = old / nloc;
        if (old + 1u == (gen + 1u) * nloc) {
            __builtin_amdgcn_fence(__ATOMIC_RELEASE, "agent");
            asm volatile("s_waitcnt vmcnt(0)" ::: "memory");
            const unsigned og = xb_add(&bar[XB_TOP], 1u);
            const unsigned tg = og / nx;
            if (og + 1u == (tg + 1u) * nx) xb_add(&bar[XB_TOPGEN], 1u);
            else XB_SPIN(xb_ld(&bar[XB_TOPGEN]) == tg, bar);
            __builtin_amdgcn_fence(__ATOMIC_ACQUIRE, "agent");
            xb_add(&bar[XB_XGEN(b.x)], 1u);
            asm volatile("s_waitcnt vmcnt(0)" ::: "memory");
        } else {
            XB_SPIN(xb_ld(&bar[XB_XGEN(b.x)]) == gen, bar);
            __builtin_amdgcn_fence(__ATOMIC_ACQUIRE, "agent");
            asm volatile("s_waitcnt vmcnt(0)" ::: "memory");
        }
    }
    __syncthreads();
}

struct Frame {
    LAS unsigned char* lds;
    volatile LAS unsigned* MISC;
    gu32* ctl;
    int tid, lane, wave, vcu, G;
    const float *x, *c, *w_ada, *b_ada, *w_in, *sink, *rpb, *ga, *gb, *w_out, *w_router, *b_router, *w_gu, *b_gu, *w_down, *b_down, *g_final;
    float* out;
    float *mod, *rope, *ssq, *tkg;
    int *tke, *list;
    bf16_t *wr_t, *win_t, *wout_t, *wgu_t, *wd_t, *XN, *PROJ, *O, *YS, *ACT, *DELTA;
};
__device__ __forceinline__ float wave_sum(float v) {
#pragma unroll
    for (int o = 1; o < 64; o <<= 1) v += __shfl_xor(v, o);
    return v;
}

struct P0Item { const float* W; bf16_t* WT; int N, Kd, k0, n0, drow0, gains, fp8; };
__device__ __forceinline__ bool p0_item(const Frame& F, int it, P0Item& I) {
    constexpr int I_IN = 16 * (DIN / 32), I_OUT = 16 * (DM / 32), I_GU1 = 16 * (2 * DFF / 32), I_GU = NE * I_GU1, I_D1 = (DFF / 64) * (DM / 32), I_D = NE * I_D1;
    if (it >= I_IN + I_OUT + I_GU + I_D) return false;
    int r = it; I.gains = 0; I.fp8 = 0;
    if (r < I_IN) { const int nb = r % (DIN / 32), kb = r / (DIN / 32); I.W = F.w_in; I.WT = F.win_t; I.N = DIN; I.Kd = DM; I.k0 = kb * 64; I.n0 = nb * 32; I.drow0 = nb * 32; return true; } r -= I_IN;
    if (r < I_OUT) { const int nb = r % (DM / 32), kb = r / (DM / 32); I.W = F.w_out; I.WT = F.wout_t; I.N = DM; I.Kd = DM; I.k0 = kb * 64; I.n0 = nb * 32; I.drow0 = nb * 32; I.gains = 1; return true; } r -= I_OUT;
    if (r < I_GU) { const int e = r / I_GU1, q = r % I_GU1, nb = q % (2 * DFF / 32), kb = q / (2 * DFF / 32), n0 = nb * 32, f = n0 & (DFF - 1);
        I.W = F.w_gu + (size_t)e * DM * 2 * DFF; I.WT = (bf16_t*)((unsigned char*)F.wgu_t + (size_t)e * 2 * DFF * DM); I.N = 2 * DFF; I.Kd = DM; I.k0 = kb * 64; I.n0 = n0; I.drow0 = (f >> 7) * 256 + (n0 >= DFF ? 128 : 0) + (f & 127); I.fp8 = 1; return true; } r -= I_GU;
    { const int e = r / I_D1, q = r % I_D1, nb = q % (DM / 32), kb = q / (DM / 32);
        I.W = F.w_down + (size_t)e * DFF * DM; I.WT = (bf16_t*)((unsigned char*)F.wd_t + (size_t)e * DM * DFF); I.N = DM; I.Kd = DFF; I.k0 = kb * 64; I.n0 = nb * 32; I.drow0 = nb * 32; I.fp8 = 1; return true; }
}
__device__ __forceinline__ void p0_load(const P0Item& I, f32x4 (&w)[8], int lane) {
#pragma unroll
    for (int i = 0; i < 8; ++i) w[i] = __builtin_nontemporal_load((const GAS f32x4*)(I.W + (size_t)(I.k0 + 8 * i + (lane >> 3)) * I.N + I.n0 + 4 * (lane & 7)));
}
__device__ __forceinline__ void p0_finish(const Frame& F, const P0Item& I, const f32x4 (&w)[8], LAS float* scr, int lane) {
#pragma unroll
    for (int i = 0; i < 8; ++i) { const int kk = 8 * i + (lane >> 3), nn = 4 * (lane & 7); f32x4 v = w[i];
        if (I.gains) { const int k = I.k0 + kk; v = v * (k < 512 ? F.ga[k] : F.gb[k - 512]); }
        scr[kk * 33 + nn] = v.x; scr[kk * 33 + nn + 1] = v.y; scr[kk * 33 + nn + 2] = v.z; scr[kk * 33 + nn + 3] = v.w; }
    LDS_WAIT(); asm volatile("" ::: "memory");
    const int c = lane & 7;
#pragma unroll
    for (int j = 0; j < 4; ++j) { const int n = (lane >> 3) + 8 * j; const LAS float* s = scr + (8 * c) * 33 + n;
        if (I.fp8) { u32x2 o; o.x = pk_fp8x4(s[0 * 33] * W8_SCALE, s[1 * 33] * W8_SCALE, s[2 * 33] * W8_SCALE, s[3 * 33] * W8_SCALE); o.y = pk_fp8x4(s[4 * 33] * W8_SCALE, s[5 * 33] * W8_SCALE, s[6 * 33] * W8_SCALE, s[7 * 33] * W8_SCALE);
            *(GAS u32x2*)((unsigned char*)I.WT + (size_t)(I.drow0 + n) * I.Kd + I.k0 + 8 * c) = o; }
        else { u32x4 o; o.x = pk2(s[0 * 33], s[1 * 33]); o.y = pk2(s[2 * 33], s[3 * 33]); o.z = pk2(s[4 * 33], s[5 * 33]); o.w = pk2(s[6 * 33], s[7 * 33]);
            *(GAS u32x4*)(I.WT + (size_t)(I.drow0 + n) * I.Kd + I.k0 + 8 * c) = o; } }
    LDS_WAIT(); asm volatile("" ::: "memory");
}
__device__ __forceinline__ void p0_prologue(Frame& F) {
    const int gt = blockIdx.x * (NWAVES * 64) + F.tid;
    if (blockIdx.x < 6 * DM / 32) {
        LAS float* sc = (LAS float*)F.lds;
        LAS float* red = (LAS float*)(F.lds + 32768);
        for (int i = F.tid; i < NB * DM; i += NWAVES * 64) { const float v = F.c[i]; sc[i] = v / (1.f + __expf(-v)); }
        const int c4 = F.tid & 7, ks = F.tid >> 3, n0 = blockIdx.x * 32;
        f32x4 w[16];
#pragma unroll
        for (int q = 0; q < 16; ++q) w[q] = __builtin_nontemporal_load((const GAS f32x4*)(F.w_ada + (size_t)(ks * 16 + q) * 6 * DM + n0 + 4 * c4));
        __syncthreads();
        f32x4 a[NB];
#pragma unroll
        for (int b = 0; b < NB; ++b) a[b] = (f32x4){0.f, 0.f, 0.f, 0.f};
#pragma unroll
        for (int q = 0; q < 16; ++q)
#pragma unroll
            for (int b = 0; b < NB; ++b) a[b] += w[q] * sc[b * DM + ks * 16 + q];
#pragma unroll
        for (int b = 0; b < NB; ++b) *(LAS f32x4*)(red + (ks * NB + b) * 32 + 4 * c4) = a[b];
        __syncthreads();
        if (F.tid < 256) { const int b = F.tid >> 5, col = F.tid & 31; float s = F.b_ada[n0 + col];
#pragma unroll 8
            for (int q = 0; q < 64; ++q) s += red[(q * NB + b) * 32 + col];
            F.mod[b * 6 * DM + n0 + col] = s; }
        __syncthreads();
    }
    if (gt < SEQ * 8) {
        const int pos = gt >> 3, i = gt & 7;
        const float invf[8] = {1.0f, 0.1939227432012558f, 0.03760603070259094f, 0.007292664609849453f, 0.0014142135623842478f, 0.00027424818836152554f, 5.3182957344688475e-05f, 1.0313385246263351e-05f};
        float inv = invf[0];
#pragma unroll
        for (int q = 1; q < 8; ++q) inv = (i == q) ? invf[q] : inv;
        const float angf = (float)pos * inv;
        const double ang = (double)angf, twopi = 6.283185307179586476925287;
        const double r = ang - __builtin_rint(ang / twopi) * twopi, r2 = r * r;
        double cs = 1.0, sn = r, tc = 1.0, ts = r;
#pragma unroll 1
        for (int q = 1; q <= 20; ++q) { tc = -tc * r2 / (double)((2 * q - 1) * (2 * q)); ts = -ts * r2 / (double)((2 * q) * (2 * q + 1)); cs += tc; sn += ts; }
        F.rope[gt] = (float)cs; F.rope[SEQ * 8 + gt] = (float)sn;
    }
    if (gt < NE * DM) { const int e = gt >> 10, k = gt & 1023; const float w = F.w_router[k * NE + e]; const unsigned hi = f2bf(w); const unsigned lo = f2bf(w - bf2f(hi));
        F.wr_t[gt] = (bf16_t)hi; F.wr_t[NE * DM + gt] = (bf16_t)lo; }
    if (gt < NTOK * 2) F.ssq[gt] = 0.f;
    LAS float* scr = (LAS float*)(F.lds + F.wave * 16384);
    const int gw = F.vcu * NWAVES + F.wave, NGW = F.G * NWAVES;
    P0Item Ia, Ib; f32x4 wa[8], wb[8];
    bool ha = p0_item(F, gw, Ia), hb;
    if (ha) p0_load(Ia, wa, F.lane);
#pragma unroll 1
    for (int it = gw; ha; it += 2 * NGW) {
        hb = p0_item(F, it + NGW, Ib); if (hb) p0_load(Ib, wb, F.lane);
        p0_finish(F, Ia, wa, scr, F.lane);
        ha = p0_item(F, it + 2 * NGW, Ia); if (ha) p0_load(Ia, wa, F.lane);
        if (hb) p0_finish(F, Ib, wb, scr, F.lane);
    }
}
__device__ __forceinline__ void p1_xn(Frame& F) {
    const int gw = F.vcu * NWAVES + F.wave, NGW = F.G * NWAVES;
    for (int chunk = gw; chunk < NTOK / 16; chunk += NGW) {
        const int m0 = chunk * 16, b = m0 / SEQ;
        f32x4 s1[4], sh[4];
#pragma unroll
        for (int j = 0; j < 4; ++j) { s1[j] = *(const GAS f32x4*)(F.mod + b * 6 * DM + DM + 4 * F.lane + 256 * j) + 1.0f; sh[j] = *(const GAS f32x4*)(F.mod + b * 6 * DM + 4 * F.lane + 256 * j); }
        for (int r = 0; r < 16; ++r) {
            const GAS f32x4* xr = (const GAS f32x4*)(F.x + (size_t)(m0 + r) * DM) + F.lane;
            f32x4 v[4]; float s = 0.f;
#pragma unroll
            for (int j = 0; j < 4; ++j) { v[j] = xr[64 * j]; s += (v[j].x * v[j].x + v[j].y * v[j].y) + (v[j].z * v[j].z + v[j].w * v[j].w); }
            const float rstd = 1.f / sqrtf(wave_sum(s) * (1.f / DM) + EPS);
            GAS unsigned long long* o8 = (GAS unsigned long long*)(F.XN + (size_t)(m0 + r) * DM) + F.lane;
#pragma unroll
            for (int j = 0; j < 4; ++j) { const f32x4 h = v[j] * rstd * s1[j] + sh[j];
                o8[64 * j] = (unsigned long long)pk2(h.x, h.y) | ((unsigned long long)pk2(h.z, h.w) << 32); }
        }
    }
}
struct EpiProj {
    static constexpr bool PERM = true, MID = false, FP8 = false, WIDE = true;
    bf16_t* O; const float* rope;
    __device__ __forceinline__ void mid(f32x4 (&)[2][2][4][2], const pg8::Unit&, int, int) const {}
    __device__ __forceinline__ void init(f32x4 (&i)[2][2], int, int, int) const { i[0][0] = i[0][1] = i[1][0] = i[1][1] = (f32x4){0.f, 0.f, 0.f, 0.f}; }
    __device__ __forceinline__ void operator()(const f32x4 (&acc)[2][2][4][2], const pg8::Unit& u, int, int wr, int wc, int fr, int fq) const {
        const int row0 = u.pm * 256 + wr * 64 + fr, col0 = u.pn * 256 + wc * 64 + 8 * fq;
        const float sc = (u.pn < 2 || u.pn == 3 || u.pn == 4) ? C2 : 1.f;
#pragma unroll
        for (int ai = 0; ai < 2; ++ai)
#pragma unroll
            for (int m = 0; m < 4; ++m) { const int row = row0 + ai * 128 + m * 16; bf16_t* rowp = O + (size_t)row * DIN + col0;
#pragma unroll
                for (int bj = 0; bj < 2; ++bj) { f32x4 v0 = acc[ai][bj][m][0], v1 = acc[ai][bj][m][1];
                    const bool rope_tile = (u.pn < 2) || (u.pn == 2 && wc < 2);
                    if (rope_tile && bj == 0) {
                        f32x4 o0, o1;
#pragma unroll
                        for (int q = 0; q < 4; ++q) { o0[q] = __shfl_xor(v0[q], 16); o1[q] = __shfl_xor(v1[q], 16); }
                        if (fq < 2) { const int pos = row & (SEQ - 1);
                            const f32x4 c0 = *(const GAS f32x4*)(rope + pos * 8), c1 = *(const GAS f32x4*)(rope + pos * 8 + 4);
                            const f32x4 s0 = *(const GAS f32x4*)(rope + SEQ * 8 + pos * 8), s1 = *(const GAS f32x4*)(rope + SEQ * 8 + pos * 8 + 4);
                            const float sg = fq == 0 ? -1.f : 1.f;
                            v0 = v0 * c0 + (o0 * sg) * s0; v1 = v1 * c1 + (o1 * sg) * s1; }
                    }
                    v0 = v0 * sc; v1 = v1 * sc;
                    u32x4 w; w.x = cvt_pk_bf16(v0[0], v0[1]); w.y = cvt_pk_bf16(v0[2], v0[3]); w.z = cvt_pk_bf16(v1[0], v1[1]); w.w = cvt_pk_bf16(v1[2], v1[3]);
                    *(GAS u32x4*)(rowp + bj * 32) = w; } }
    }
};
__device__ __forceinline__ int crow(int r, int hi) { return (r & 3) + 8 * (r >> 2) + 4 * hi; }
typedef short v4i16_t __attribute__((ext_vector_type(4)));
__device__ __forceinline__ v4i16_t vtr(const LAS unsigned char* p) { return __builtin_amdgcn_ds_read_tr16_b64_v4i16((LAS v4i16_t*)p); }
__device__ __forceinline__ float max3f(float a, float b, float c) { return __builtin_fmaxf(__builtin_fmaxf(a, b), c); }
__device__ __forceinline__ void dma_k(const bf16_t* Ktile  , LAS unsigned char* slot, int p, int lane) {
    const int row = 8 * p + (lane >> 3), ch = (lane & 7) ^ ((row >> 1) & 7);
    __builtin_amdgcn_global_load_lds((const unsigned*)(Ktile + (size_t)row * DIN + ch * 8), (LAS unsigned*)(slot + p * 1024), 16, 0, 0);
}
__device__ __forceinline__ void dma_v(const bf16_t* Vtile, LAS unsigned char* slot, int p, int lane) {
    __builtin_amdgcn_global_load_lds((const unsigned*)(Vtile + (size_t)(8 * p + ((lane >> 2) & 7)) * DIN + (lane >> 5) * 32 + (lane & 3) * 8), (LAS unsigned*)(slot + p * 1024), 16, 0, 0);
}
struct AttnState { float m, l; f32x16 o[2]; };
template <class MB>
__device__ __forceinline__ void attn_tile(const LAS unsigned char* Ks, const LAS unsigned char* Vs, const bf16x8 (&qr)[4], AttnState& st, int r32, int hi, int lane, const MB& mb) {
    f32x16 p0, p1;
#pragma unroll
    for (int r = 0; r < 16; ++r) { p0[r] = 0.f; p1[r] = 0.f; }
    const LAS unsigned char* kb = Ks + r32 * 128; const int sw = (r32 >> 1) & 7;
#pragma unroll
    for (int d0 = 0; d0 < 4; ++d0) {
        const int ko = ((2 * d0 + hi) ^ sw) << 4;
        const bf16x8 a0 = *(const LAS bf16x8*)(kb + ko), a1 = *(const LAS bf16x8*)(kb + ko + 4096);
        p0 = __builtin_amdgcn_mfma_f32_32x32x16_bf16(a0, qr[d0], p0, 0, 0, 0);
        p1 = __builtin_amdgcn_mfma_f32_32x32x16_bf16(a1, qr[d0], p1, 0, 0, 0);
    }
    mb(p0, p1, r32, hi);
    float a = max3f(p0[0], p0[1], p1[0]), b = max3f(p0[2], p0[3], p1[1]); a = max3f(a, p1[2], p1[3]);
#pragma unroll
    for (int r = 4; r < 16; r += 4) { a = max3f(a, p0[r], p0[r + 1]); b = max3f(b, p0[r + 2], p0[r + 3]); a = max3f(a, p1[r], p1[r + 1]); b = max3f(b, p1[r + 2], p1[r + 3]); }
    float rm = __builtin_fmaxf(a, b);
    rm = __builtin_fmaxf(rm, __shfl_xor(rm, 32));
    if (__any(rm > st.m + 8.0f)) {
        const float mn = __builtin_fmaxf(st.m, rm), f = __builtin_amdgcn_exp2f(st.m - mn);
        st.m = mn; st.l *= f;
#pragma unroll
        for (int r = 0; r < 16; ++r) { st.o[0][r] *= f; st.o[1][r] *= f; }
    }
    const float mref = st.m;
    float ls = 0.f;
#pragma unroll
    for (int r = 0; r < 16; ++r) { p0[r] = __builtin_amdgcn_exp2f(p0[r] - mref); p1[r] = __builtin_amdgcn_exp2f(p1[r] - mref); ls += p0[r] + p1[r]; }
    st.l += ls;
    u32x4 pw[4];
#pragma unroll
    for (int q = 0; q < 4; ++q) { pw[0][q] = cvt_pk_bf16(p0[2 * q], p0[2 * q + 1]); pw[1][q] = cvt_pk_bf16(p0[8 + 2 * q], p0[8 + 2 * q + 1]);
                                  pw[2][q] = cvt_pk_bf16(p1[2 * q], p1[2 * q + 1]); pw[3][q] = cvt_pk_bf16(p1[8 + 2 * q], p1[8 + 2 * q + 1]); }
    const LAS unsigned char* vb = Vs + ((lane >> 4) & 1) * 32 + (lane & 3) * 8 + (4 * hi + ((lane & 15) >> 2)) * 64;
#pragma unroll
    for (int d0 = 0; d0 < 2; ++d0)
#pragma unroll
        for (int s = 0; s < 4; ++s) {
            const v4i16_t lo = vtr(vb + d0 * 512 + s * 2048), hh = vtr(vb + d0 * 512 + s * 2048 + 1024);
            const bf16x8 vf = (bf16x8){lo[0], lo[1], lo[2], lo[3], hh[0], hh[1], hh[2], hh[3]};
            st.o[d0] = __builtin_amdgcn_mfma_f32_32x32x16_bf16(vf, __builtin_bit_cast(bf16x8, pw[s]), st.o[d0], 0, 0, 0);
        }
}
__device__ __forceinline__ void attn_finish(AttnState& st, LAS unsigned char* stg, bf16_t* Obase  , float* ssqp  , int r32, int hi, int lane) {
    float l = st.l; l += __shfl_xor(l, 32);
    const float inv = 1.0f / l;
    float sq = 0.f;
#pragma unroll
    for (int d0 = 0; d0 < 2; ++d0)
#pragma unroll
        for (int rg = 0; rg < 4; ++rg) {
            const float v0 = st.o[d0][4 * rg] * inv, v1 = st.o[d0][4 * rg + 1] * inv, v2 = st.o[d0][4 * rg + 2] * inv, v3 = st.o[d0][4 * rg + 3] * inv;
            sq += (v0 * v0 + v1 * v1) + (v2 * v2 + v3 * v3);
            u32x2 w; w.x = cvt_pk_bf16(v0, v1); w.y = cvt_pk_bf16(v2, v3);
            const int ch = 4 * d0 + rg;
            *(LAS u32x2*)(stg + r32 * 128 + ((ch ^ (r32 & 7)) << 4) + hi * 8) = w;
        }
    sq += __shfl_xor(sq, 32);
    if (hi == 0) atomicAdd(ssqp + r32 * 2, sq);
    asm volatile("s_waitcnt lgkmcnt(0)" ::: "memory");
#pragma unroll
    for (int i = 0; i < 4; ++i) { const int row = i * 8 + (lane >> 3), ch = lane & 7;
        const u32x4 v = *(const LAS u32x4*)(stg + row * 128 + ((ch ^ (row & 7)) << 4));
        *(GAS u32x4*)(Obase + (size_t)row * DM + ch * 8) = v; }
}
struct MbNone { __device__ __forceinline__ void operator()(f32x16&, f32x16&, int, int) const {} };
struct MbBandLo { int qi;
    __device__ __forceinline__ void operator()(f32x16& p0, f32x16& p1, int, int hi) const {
#pragma unroll
        for (int r = 0; r < 16; ++r) { const int kj = crow(r, hi); p0[r] = (kj >= qi) ? p0[r] : -1e30f; p1[r] = (kj + 32 >= qi) ? p1[r] : -1e30f; } } };
struct MbBandHi { int qi;
    __device__ __forceinline__ void operator()(f32x16& p0, f32x16& p1, int, int hi) const {
#pragma unroll
        for (int r = 0; r < 16; ++r) { const int kj = crow(r, hi); p0[r] = (kj <= qi) ? p0[r] : -1e30f; p1[r] = (kj + 32 <= qi) ? p1[r] : -1e30f; } } };
struct MbNeigh { const LAS float* base; const float* ma;
    __device__ __forceinline__ void operator()(f32x16& p0, f32x16& p1, int, int) const {
#pragma unroll
        for (int r = 0; r < 16; ++r) { const int o = (r & 3) + 8 * (r >> 2); p0[r] = (p0[r] + base[o]) + ma[r]; p1[r] = (p1[r] + base[o + 32]) + ma[16 + r]; } } };

__device__ __forceinline__ void attn_a_phase(Frame& F, float* ssq) {
    const int wave = F.wave, lane = F.lane, r32 = lane & 31, hi = lane >> 5, g = wave >> 1, qh = wave & 1;
    constexpr int NQB = SEQ / 64, VOFF = 49152;
    for (int run = F.vcu; run < NB * AKVH * (NQB / 4); run += F.G) {
        const int quad = run % (NQB / 4), kvh = (run / (NQB / 4)) % AKVH, b = run / ((NQB / 4) * AKVH);
        const int j0 = quad * 4, h = kvh * 4 + g;
        const bf16_t* base = F.PROJ + (size_t)b * SEQ * DIN;
        const float sink2 = F.sink[h] * LOG2E;
#define AT_DMA(k) do { const int _s = (((k) + 6) % 6) * 8192; const bf16_t* _r = base + (size_t)((k) * 64) * DIN; \
        dma_k(_r + OFF_KA + kvh * HD, F.lds + _s, wave, lane); dma_v(_r + OFF_VA + kvh * HD, F.lds + VOFF + _s, wave, lane); } while (0)
        asm volatile("s_waitcnt lgkmcnt(0)" ::: "memory"); __builtin_amdgcn_s_barrier();
#pragma unroll
        for (int k = -2; k <= 2; ++k) { if (j0 + k >= 0 && j0 + k < NQB) AT_DMA(j0 + k); }
        bf16x8 qr[4];
        { const bf16_t* qp = base + (size_t)(j0 * 64 + qh * 32 + r32) * DIN + OFF_QA + h * HD + hi * 8;
#pragma unroll
          for (int d0 = 0; d0 < 4; ++d0) qr[d0] = *(const GAS bf16x8*)(qp + d0 * 16); }
#pragma unroll 1
        for (int i = 0; i < 4; ++i) {
            const int j = j0 + i, q0 = j * 64;
            if (i > 0) { asm volatile("s_waitcnt lgkmcnt(0)" ::: "memory"); __builtin_amdgcn_s_barrier(); }
            const bool pf = (i < 3) && (j + 3 < NQB);
            if (pf) AT_DMA(j + 3);
            bf16x8 qn[4];
            if (i < 3) { const bf16_t* qp = base + (size_t)((j + 1) * 64 + qh * 32 + r32) * DIN + OFF_QA + h * HD + hi * 8;
#pragma unroll
                for (int d0 = 0; d0 < 4; ++d0) qn[d0] = *(const GAS bf16x8*)(qp + d0 * 16); }
            if (i == 0) { if (pf) asm volatile("s_waitcnt vmcnt(6)" ::: "memory"); else asm volatile("s_waitcnt vmcnt(4)" ::: "memory"); }
            else if (i < 3) { if (pf) asm volatile("s_waitcnt vmcnt(6)" ::: "memory"); else asm volatile("s_waitcnt vmcnt(4)" ::: "memory"); }
            else asm volatile("s_waitcnt vmcnt(0)" ::: "memory");
            __builtin_amdgcn_s_barrier();
            AttnState st; st.m = sink2; st.l = (hi == 0) ? 1.f : 0.f;
#pragma unroll
            for (int r = 0; r < 16; ++r) { st.o[0][r] = 0.f; st.o[1][r] = 0.f; }
            const int qi = qh * 32 + r32;
#define AT_SLOT(k) (F.lds + (((k) + 6) % 6) * 8192)
            if (j - 2 >= 0) attn_tile(AT_SLOT(j - 2), AT_SLOT(j - 2) + VOFF, qr, st, r32, hi, lane, MbBandLo{qi});
            if (j - 1 >= 0) attn_tile(AT_SLOT(j - 1), AT_SLOT(j - 1) + VOFF, qr, st, r32, hi, lane, MbNone{});
            attn_tile(AT_SLOT(j), AT_SLOT(j) + VOFF, qr, st, r32, hi, lane, MbNone{});
            if (j + 1 < NQB) attn_tile(AT_SLOT(j + 1), AT_SLOT(j + 1) + VOFF, qr, st, r32, hi, lane, MbNone{});
            if (j + 2 < NQB) attn_tile(AT_SLOT(j + 2), AT_SLOT(j + 2) + VOFF, qr, st, r32, hi, lane, MbBandHi{qi});
            const int tok0 = b * SEQ + q0 + qh * 32;
            attn_finish(st, F.lds + 98304 + wave * 4096, F.O + (size_t)tok0 * DM + h * HD, ssq + tok0 * 2, r32, hi, lane);
            if (i < 3) {
#pragma unroll
                for (int d0 = 0; d0 < 4; ++d0) qr[d0] = qn[d0]; }
        }
#undef AT_DMA
#undef AT_SLOT
    }
}
constexpr int NTAB_OFF = LDSCTL_OFF + 2048;
__device__ __forceinline__ void attn_b_phase(Frame& F, float* ssq) {
    const int wave = F.wave, lane = F.lane, r32 = lane & 31, hi = lane >> 5, rw = wave >> 1, qh = wave & 1;
    LAS float* tab = (LAS float*)(F.lds + NTAB_OFF);
    int cur_head = -1;
    for (int u = F.vcu; u < NB * BH * (GW / 4); u += F.G) {
        const int rg = u % (GW / 4), head = (u / (GW / 4)) % BH, b = u / ((GW / 4) * BH);
        const int r0 = rg * 4, r = r0 + rw;
        const int R0 = min(max(r0 - NAR / 2, 0), GW - NAR), nst = min(max(r0 + 3 - NAR / 2, 0), GW - NAR) + NAR - R0;
        const int rs = min(max(r - NAR / 2, 0), GW - NAR);
        const bf16_t* base = F.PROJ + (size_t)b * SEQ * DIN;
        asm volatile("s_waitcnt lgkmcnt(0)" ::: "memory"); __builtin_amdgcn_s_barrier();
        if (head != cur_head) { cur_head = head;
            for (int i = F.tid; i < 15 * 128; i += NWAVES * 64) { const int d = (i & 127) - 63, ro = i >> 7;
                tab[i] = (d >= -15 && d <= 15) ? F.rpb[(head * 15 + ro) * 31 + d + 15] * LOG2E : 0.f; }
            asm volatile("s_waitcnt lgkmcnt(0)" ::: "memory"); }
#define NB_DMA(t) do { const int _bs = ((t) & 3) * 16384; const bf16_t* _kr = base + (size_t)((R0 + (t)) * GW) * DIN; \
        dma_k(_kr + OFF_KB + head * HD, F.lds + _bs, wave, lane); dma_v(_kr + OFF_VB + head * HD, F.lds + _bs + 8192, wave, lane); } while (0)
        NB_DMA(0); NB_DMA(1); NB_DMA(2);
        const int qc = qh * 32 + r32, cs = min(max(qc - NAC / 2, 0), GW - NAC);
        float ma[32];
#pragma unroll
        for (int q = 0; q < 16; ++q) { const int kc = crow(q, hi); ma[q] = (kc >= cs && kc < cs + 16) ? 0.f : -1e30f; ma[16 + q] = (kc + 32 >= cs && kc + 32 < cs + 16) ? 0.f : -1e30f; }
        const bf16_t* qp = base + (size_t)(r * GW + qc) * DIN + OFF_QB + head * HD + hi * 8;
        bf16x8 qr[4];
#pragma unroll
        for (int d0 = 0; d0 < 4; ++d0) qr[d0] = *(const GAS bf16x8*)(qp + d0 * 16);
        AttnState st; st.m = -1e30f; st.l = 0.f;
#pragma unroll
        for (int q = 0; q < 16; ++q) { st.o[0][q] = 0.f; st.o[1][q] = 0.f; }
        for (int t = 0; t < nst; ++t) {
            if (t + 3 < nst) { NB_DMA(t + 3); asm volatile("s_waitcnt vmcnt(6)" ::: "memory"); }
            else if (t + 2 < nst) asm volatile("s_waitcnt vmcnt(4)" ::: "memory");
            else if (t + 1 < nst) asm volatile("s_waitcnt vmcnt(2)" ::: "memory");
            else asm volatile("s_waitcnt vmcnt(0)" ::: "memory");
            __builtin_amdgcn_s_barrier();
            const int kr = R0 + t;
            if (kr >= rs && kr < rs + NAR) {
                const LAS unsigned char* ks = F.lds + (t & 3) * 16384;
                attn_tile(ks, ks + 8192, qr, st, r32, hi, lane, MbNeigh{tab + (kr - r + NAR - 1) * 128 + (63 - qc + 4 * hi), ma});
            }
            asm volatile("s_waitcnt lgkmcnt(0)" ::: "memory"); __builtin_amdgcn_s_barrier();
        }
#undef NB_DMA
        const int tok0 = b * SEQ + r * GW + qh * 32;
        attn_finish(st, F.lds + 65536 + wave * 4096, F.O + (size_t)tok0 * DM + AQW + head * HD, ssq + tok0 * 2 + 1, r32, hi, lane);
    }
}
struct EpiX1 {
    static constexpr bool PERM = true, MID = true, FP8 = false, WIDE = true;
    bf16_t* delta; const float* mod; const float* ssq;
    __device__ __forceinline__ void init(f32x4 (&i)[2][2], int, int, int) const { i[0][0] = i[0][1] = i[1][0] = i[1][1] = (f32x4){0.f, 0.f, 0.f, 0.f}; }
    __device__ __forceinline__ void mid(f32x4 (&acc)[2][2][4][2], const pg8::Unit& u, int wr, int fr) const {
#pragma unroll
        for (int ai = 0; ai < 2; ++ai)
#pragma unroll
            for (int m = 0; m < 4; ++m) { const int row = u.pm * 256 + ai * 128 + wr * 64 + m * 16 + fr;
                const f32x2 s = *(const GAS f32x2*)(ssq + row * 2);
                const float f = sqrtf((s.y * (1.f / 512.f) + EPS) / (s.x * (1.f / 512.f) + EPS));
#pragma unroll
                for (int bj = 0; bj < 2; ++bj)
#pragma unroll
                    for (int n = 0; n < 2; ++n) acc[ai][bj][m][n] *= f; }
    }
    __device__ __forceinline__ void operator()(const f32x4 (&acc)[2][2][4][2], const pg8::Unit& u, int, int wr, int wc, int fr, int fq) const {
        const int b = (u.pm * 256) / SEQ, col0 = u.pn * 256 + wc * 64 + 8 * fq;
        f32x4 gm[2][2];
#pragma unroll
        for (int bj = 0; bj < 2; ++bj)
#pragma unroll
            for (int n = 0; n < 2; ++n) gm[bj][n] = *(const GAS f32x4*)(mod + b * 6 * DM + 2 * DM + col0 + bj * 32 + 4 * n);
#pragma unroll
        for (int ai = 0; ai < 2; ++ai)
#pragma unroll
            for (int m = 0; m < 4; ++m) { const int row = u.pm * 256 + ai * 128 + wr * 64 + m * 16 + fr;
                const float rb = 1.0f / sqrtf(ssq[row * 2 + 1] * (1.f / 512.f) + EPS);
                bf16_t* rowp = delta + (size_t)row * DM + col0;
#pragma unroll
                for (int bj = 0; bj < 2; ++bj) { const f32x4 v0 = gm[bj][0] * (acc[ai][bj][m][0] * rb), v1 = gm[bj][1] * (acc[ai][bj][m][1] * rb);
                    u32x4 w; w.x = cvt_pk_bf16(v0[0], v0[1]); w.y = cvt_pk_bf16(v0[2], v0[3]); w.z = cvt_pk_bf16(v1[0], v1[1]); w.w = cvt_pk_bf16(v1[2], v1[3]);
                    *(GAS u32x4*)(rowp + bj * 32) = w; } }
    }
};

__device__ __forceinline__ void router_phase(Frame& F, gu32* cntw) {
    const int wave = F.wave, lane = F.lane, r32 = lane & 31, hi = lane >> 5;
    bf16x8 wh[8], wl[8];
#pragma unroll
    for (int c = 0; c < 8; ++c) { const bf16_t* p = F.wr_t + r32 * DM + 128 * wave + 16 * c + 8 * hi; wh[c] = *(const GAS bf16x8*)p; wl[c] = *(const GAS bf16x8*)(p + NE * DM); }
    LAS unsigned char* imgH = F.lds;
    LAS unsigned char* imgL = F.lds + 65536;
    LAS float* R = (LAS float*)(F.lds);
    LAS float* L = (LAS float*)(F.lds + NTAB_OFF);
    LAS int* lcnt = (LAS int*)(F.lds + NTAB_OFF + 4352);
    for (int it = F.vcu; it < NTOK / 32; it += F.G) {
        const int t0 = it * 32, b = t0 / SEQ;
        { f32x4 s1[4], sh[4];
#pragma unroll
          for (int j = 0; j < 4; ++j) { s1[j] = *(const GAS f32x4*)(F.mod + b * 6 * DM + 4 * DM + 4 * lane + 256 * j) + 1.0f; sh[j] = *(const GAS f32x4*)(F.mod + b * 6 * DM + 3 * DM + 4 * lane + 256 * j); }
#pragma unroll
          for (int pr = 0; pr < 2; ++pr) {
              f32x4 xv[2][4]; u32x2 dv[2][4];
#pragma unroll
              for (int tt = 0; tt < 2; ++tt) { const int tok = t0 + 4 * wave + 2 * pr + tt;
                  const GAS f32x4* xr = (const GAS f32x4*)(F.x + (size_t)tok * DM) + lane; const GAS u32x2* dr = (const GAS u32x2*)(F.DELTA + (size_t)tok * DM) + lane;
#pragma unroll
                  for (int j = 0; j < 4; ++j) { xv[tt][j] = xr[64 * j]; dv[tt][j] = dr[64 * j]; } }
#pragma unroll
              for (int tt = 0; tt < 2; ++tt) { const int tl = 4 * wave + 2 * pr + tt, tok = t0 + tl; float s = 0.f;
#pragma unroll
                  for (int j = 0; j < 4; ++j) { const u32x2 w = dv[tt][j]; xv[tt][j] += (f32x4){bf2f(w.x & 0xffffu), bf2f(w.x >> 16), bf2f(w.y & 0xffffu), bf2f(w.y >> 16)};
                      s += (xv[tt][j].x * xv[tt][j].x + xv[tt][j].y * xv[tt][j].y) + (xv[tt][j].z * xv[tt][j].z + xv[tt][j].w * xv[tt][j].w); }
                  const float rstd = 1.0f / sqrtf(wave_sum(s) * (1.f / DM) + EPS);
                  GAS unsigned* xn = (GAS unsigned*)((unsigned char*)F.XN + (size_t)tok * DM) + lane;
#pragma unroll
                  for (int j = 0; j < 4; ++j) { const f32x4 h = xv[tt][j] * rstd * s1[j] + sh[j];
                      u32x2 hw; hw.x = pk2(h.x, h.y); hw.y = pk2(h.z, h.w);
                      u32x2 lw; lw.x = pk2(h.x - bf2f(hw.x & 0xffffu), h.y - bf2f(hw.x >> 16)); lw.y = pk2(h.z - bf2f(hw.y & 0xffffu), h.w - bf2f(hw.y >> 16));
                      xn[64 * j] = pk_fp8x4(h.x, h.y, h.z, h.w);
                      const int off = tl * 2048 + ((((lane >> 1) + 32 * j) ^ (tl & 15)) << 4) + (lane & 1) * 8;
                      *(LAS u32x2*)(imgH + off) = hw; *(LAS u32x2*)(imgL + off) = lw; } } } }
        asm volatile("s_waitcnt lgkmcnt(0)" ::: "memory"); __builtin_amdgcn_s_barrier(); asm volatile("" ::: "memory");
        f32x16 acc;
#pragma unroll
        for (int r = 0; r < 16; ++r) acc[r] = 0.f;
#pragma unroll
        for (int c = 0; c < 8; ++c) { const int off = r32 * 2048 + (((16 * wave + 2 * c + hi) ^ (r32 & 15)) << 4);
            const bf16x8 hf = *(const LAS bf16x8*)(imgH + off), lf = *(const LAS bf16x8*)(imgL + off);
            acc = __builtin_amdgcn_mfma_f32_32x32x16_bf16(hf, wh[c], acc, 0, 0, 0);
            acc = __builtin_amdgcn_mfma_f32_32x32x16_bf16(lf, wh[c], acc, 0, 0, 0);
            acc = __builtin_amdgcn_mfma_f32_32x32x16_bf16(hf, wl[c], acc, 0, 0, 0);
        }
        asm volatile("s_waitcnt lgkmcnt(0)" ::: "memory"); __builtin_amdgcn_s_barrier(); asm volatile("" ::: "memory");
#pragma unroll
        for (int r = 0; r < 16; ++r) R[wave * 1024 + crow(r, hi) * 32 + r32] = acc[r];
        asm volatile("s_waitcnt lgkmcnt(0)" ::: "memory"); __builtin_amdgcn_s_barrier(); asm volatile("" ::: "memory");
#pragma unroll
        for (int q = 0; q < 2; ++q) { const int idx = F.tid * 2 + q, tk = idx >> 5, e = idx & 31; float v = F.b_router[e];
#pragma unroll
            for (int w = 0; w < 8; ++w) v += R[w * 1024 + idx];
            L[tk * 33 + e] = v; }
        asm volatile("s_waitcnt lgkmcnt(0)" ::: "memory"); __builtin_amdgcn_s_barrier(); asm volatile("" ::: "memory");
        if (wave == 0) {
            if (lane < 32) lcnt[lane] = 0;
            asm volatile("s_waitcnt lgkmcnt(0)" ::: "memory");
            int sel[TOPK]; float gt[TOPK]; int lpos[TOPK];
            if (lane < 32) {
                float v[NE];
#pragma unroll
                for (int j = 0; j < NE; ++j) v[j] = L[lane * 33 + j];
                unsigned used = 0u; float sv[TOPK];
#pragma unroll
                for (int kk = 0; kk < TOPK; ++kk) { float best = -INFINITY; int bi = 0;
#pragma unroll
                    for (int j = 0; j < NE; ++j) { const bool ok = !((used >> j) & 1u) && (v[j] > best); best = ok ? v[j] : best; bi = ok ? j : bi; }
                    used |= 1u << bi; sel[kk] = bi; sv[kk] = best; }
                float den = 0.f;
#pragma unroll
                for (int kk = 0; kk < TOPK; ++kk) { gt[kk] = __expf(sv[kk] - sv[0]); den += gt[kk]; }
                const float rden = 1.0f / den;
#pragma unroll
                for (int kk = 0; kk < TOPK; ++kk) { gt[kk] *= rden; lpos[kk] = __hip_atomic_fetch_add(lcnt + sel[kk], 1, __ATOMIC_RELAXED, __HIP_MEMORY_SCOPE_WORKGROUP); }
            }
            asm volatile("s_waitcnt lgkmcnt(0)" ::: "memory");
            if (lane < 32) { const int n = lcnt[lane]; int base = 0;
                if (n > 0) base = (int)__hip_atomic_fetch_add((unsigned*)(cntw + lane * 64), (unsigned)n, __ATOMIC_RELAXED, __HIP_MEMORY_SCOPE_AGENT);
                lcnt[32 + lane] = base; }
            asm volatile("s_waitcnt vmcnt(0) lgkmcnt(0)" ::: "memory");
            if (lane < 32) {
                const int t = t0 + lane;
#pragma unroll
                for (int kk = 0; kk < TOPK; ++kk) { const int e = sel[kk], pos = lcnt[32 + e] + lpos[kk];
                    F.tkg[t * 4 + kk] = gt[kk]; F.list[e * NTOK + pos] = t * 4 + kk; }
            }
        }
    }
}

__device__ __forceinline__ void moe_table(Frame& F) {
    LAS int* tab = (LAS int*)(F.lds + TAB_OFF);
    if (F.tid == 0) { int s = 0;
        for (int e = 0; e < NE; ++e) { const int c = (int)__hip_atomic_load((unsigned*)(F.ctl + CW_CNT + e * 64), __ATOMIC_RELAXED, __HIP_MEMORY_SCOPE_AGENT); tab[e] = s; tab[40 + e] = c; s += (c + 255) >> 8; }
        tab[32] = s; }
    asm volatile("s_waitcnt vmcnt(0) lgkmcnt(0)" ::: "memory"); __syncthreads();
}
constexpr int META_OFF = NTAB_OFF, META_SLOT = 2048;
template <bool GATHER>
struct MoeOrder {
    const char* A; const char* Bt; const int* list; const float* bias; const LAS int* tab; LAS unsigned char* meta; int K, N, nN, G, c;
    mutable int ec;
    __device__ bool next(int i, pg8::Unit& u) const {
        const int L = i * G + c; if (L >= tab[32] * nN) return false;
        int e = ec;
#pragma unroll 1
        while (L >= tab[e + 1] * nN) ++e;
        ec = e;
        const int nm = tab[e + 1] - tab[e], ql = L - tab[e] * nN;
        u.e = e; u.pn = ql / nm; u.aux = ql % nm; u.pm = tab[e] + u.aux; return true;
    }
    __device__ __forceinline__ const char* abase() const { return A; }
    __device__ __forceinline__ const char* bbase(const pg8::Unit& u) const { return Bt + ((size_t)u.e * N + (size_t)u.pn * 256) * K; }
    __device__ __forceinline__ void dma_list(const pg8::Unit& u, int slot) const {
        const int lane = lane_id();
        __builtin_amdgcn_global_load_lds((const unsigned*)(list + (size_t)u.e * NTOK + u.aux * 256 + 4 * lane), (LAS unsigned*)(meta + slot * META_SLOT), 16, 0, 0);
    }
    __device__ __forceinline__ void dma_bias(const pg8::Unit& u, int slot) const {
        const int lane = lane_id();
        const float* src = GATHER ? bias + (size_t)u.e * 2 * DFF + u.pn * 128 + (lane >> 5) * DFF + 4 * (lane & 31) : bias + (size_t)u.e * DM + u.pn * 256 + 4 * lane;
        __builtin_amdgcn_global_load_lds((const unsigned*)src, (LAS unsigned*)(meta + slot * META_SLOT + 1024), 16, 0, 0);
    }
    __device__ __forceinline__ void meta_init(const pg8::Unit& u0, bool h1, const pg8::Unit& u1, int wid) const {
        if (wid == 0) { dma_list(u0, 0); dma_bias(u0, 0); if (h1) dma_list(u1, 1); }
        asm volatile("s_waitcnt vmcnt(0)" ::: "memory"); __builtin_amdgcn_s_barrier(); asm volatile("" ::: "memory");
    }
    __device__ __forceinline__ void meta_top(int ui, bool has_next, const pg8::Unit& nxt, bool h2, const pg8::Unit& nn, int wid) const {
        if (wid == 0) { if (has_next) dma_bias(nxt, (ui + 1) % 3); if (h2) dma_list(nn, (ui + 2) % 3); }
    }
    __device__ __forceinline__ void aoffs(const pg8::Unit& u, int ui, const int (&R)[2], const int (&C)[2], unsigned (&off)[4]) const {
        if (GATHER) { const int lim = tab[40 + u.e] - 1 - u.aux * 256; const LAS int* lst = (const LAS int*)(meta + (ui % 3) * META_SLOT);
#pragma unroll
            for (int h = 0; h < 2; ++h)
#pragma unroll
                for (int i = 0; i < 2; ++i) { int mi = h * 128 + R[i]; mi = mi < lim ? mi : lim; const int tk = lst[mi] >> 2; off[h * 2 + i] = (unsigned)(tk * K + C[i] * 2); }
        } else {
#pragma unroll
            for (int h = 0; h < 2; ++h)
#pragma unroll
                for (int i = 0; i < 2; ++i) off[h * 2 + i] = (unsigned)((u.pm * 256 + h * 128 + R[i]) * K + C[i] * 2);
        }
    }
};
struct EpiSwiglu {
    static constexpr bool PERM = true, MID = false, FP8 = true, WIDE = false;
    bf16_t* act; const LAS unsigned char* meta;
    __device__ __forceinline__ void mid(f32x4 (&)[2][2][4][2], const pg8::Unit&, int, int) const {}
    __device__ __forceinline__ void init(f32x4 (&i)[2][2], int ui, int wc, int fq) const {
        const LAS float* bp = (const LAS float*)(meta + (ui % 3) * META_SLOT + 1024) + wc * 32 + 8 * fq;
        i[0][0] = *(const LAS f32x4*)bp; i[0][1] = *(const LAS f32x4*)(bp + 4); i[1][0] = *(const LAS f32x4*)(bp + 128); i[1][1] = *(const LAS f32x4*)(bp + 132);
    }
    __device__ __forceinline__ void operator()(const f32x4 (&acc)[2][2][4][2], const pg8::Unit& u, int, int wr, int wc, int fr, int fq) const {
        const int f0 = u.pn * 128 + wc * 32 + 8 * fq, row0 = u.pm * 256 + wr * 64 + fr;
#pragma unroll
        for (int ai = 0; ai < 2; ++ai)
#pragma unroll
            for (int m = 0; m < 4; ++m) { const int row = row0 + ai * 128 + m * 16;
                float o[8];
#pragma unroll
                for (int q = 0; q < 8; ++q) { float g = (q < 4 ? acc[ai][0][m][0][q] : acc[ai][0][m][1][q - 4]);
                    float up = (q < 4 ? acc[ai][1][m][0][q] : acc[ai][1][m][1][q - 4]);
                    g = __builtin_fminf(g, 7.f); up = __builtin_amdgcn_fmed3f(up, -7.f, 7.f);
                    const float glu = g * __builtin_amdgcn_rcpf(1.f + __builtin_amdgcn_exp2f(-1.702f * LOG2E * g));
                    o[q] = __builtin_fmaf(up, glu, glu); }
                u32x2 w; w.x = pk_fp8x4(o[0], o[1], o[2], o[3]); w.y = pk_fp8x4(o[4], o[5], o[6], o[7]);
                *(GAS u32x2*)((unsigned char*)act + (size_t)row * DFF + f0) = w; }
    }
};
struct EpiNull {
    static constexpr bool PERM = true, MID = false, FP8 = true, WIDE = false;
    __device__ __forceinline__ void mid(f32x4 (&)[2][2][4][2], const pg8::Unit&, int, int) const {}
    __device__ __forceinline__ void init(f32x4 (&i)[2][2], int, int, int) const { i[0][0] = i[0][1] = i[1][0] = i[1][1] = (f32x4){0.f, 0.f, 0.f, 0.f}; }
    __device__ __forceinline__ void operator()(const f32x4 (&acc)[2][2][4][2], const pg8::Unit&, int, int, int, int, int) const {
#pragma unroll
        for (int a = 0; a < 2; ++a)
#pragma unroll
            for (int b = 0; b < 2; ++b)
#pragma unroll
                for (int m = 0; m < 4; ++m)
#pragma unroll
                    for (int n = 0; n < 2; ++n) asm volatile("" :: "v"(acc[a][b][m][n]));
    }
};
struct EpiDense {
    static constexpr bool PERM = true, MID = false, FP8 = true, WIDE = false;
    bf16_t* dst;
    __device__ __forceinline__ void mid(f32x4 (&)[2][2][4][2], const pg8::Unit&, int, int) const {}
    __device__ __forceinline__ void init(f32x4 (&i)[2][2], int, int, int) const { i[0][0] = i[0][1] = i[1][0] = i[1][1] = (f32x4){0.f, 0.f, 0.f, 0.f}; }
    __device__ __forceinline__ void operator()(const f32x4 (&acc)[2][2][4][2], const pg8::Unit& u, int, int wr, int wc, int fr, int fq) const {
        const int tid = (wr * 4 + wc) * 64 + fq * 16 + fr;
        unsigned char* base = (unsigned char*)dst + ((size_t)(u.pm * 4 + u.pn) % 512) * 131072 + tid * 16;
#pragma unroll
        for (int ai = 0; ai < 2; ++ai)
#pragma unroll
            for (int m = 0; m < 4; ++m)
#pragma unroll
                for (int bj = 0; bj < 2; ++bj) { const f32x4 v0 = acc[ai][bj][m][0], v1 = acc[ai][bj][m][1];
                    u32x4 w; w.x = cvt_pk_bf16(v0[0], v0[1]); w.y = cvt_pk_bf16(v0[2], v0[3]); w.z = cvt_pk_bf16(v1[0], v1[1]); w.w = cvt_pk_bf16(v1[2], v1[3]);
                    *(GAS u32x4*)(base + ((ai * 4 + m) * 2 + bj) * 8192) = w; }
    }
};
struct EpiYs {
    static constexpr bool PERM = true, MID = false, FP8 = true, WIDE = true;
    bf16_t* ys; const LAS int* tab; const LAS unsigned char* meta;
    __device__ __forceinline__ void mid(f32x4 (&)[2][2][4][2], const pg8::Unit&, int, int) const {}
    __device__ __forceinline__ void init(f32x4 (&i)[2][2], int ui, int wc, int fq) const {
        const LAS float* bp = (const LAS float*)(meta + (ui % 3) * META_SLOT + 1024) + wc * 64 + 8 * fq;
#pragma unroll
        for (int bj = 0; bj < 2; ++bj)
#pragma unroll
            for (int n = 0; n < 2; ++n) i[bj][n] = *(const LAS f32x4*)(bp + bj * 32 + 4 * n);
    }
    __device__ __forceinline__ void operator()(const f32x4 (&acc)[2][2][4][2], const pg8::Unit& u, int ui, int wr, int wc, int fr, int fq) const {
        const int c0 = wc * 64 + 8 * fq, col0 = u.pn * 256 + c0, rl0 = wr * 64 + fr, lim = tab[40 + u.e] - u.aux * 256;
        const LAS int* lst = (const LAS int*)(meta + (ui % 3) * META_SLOT);
        int ent[2][4];
#pragma unroll
        for (int ai = 0; ai < 2; ++ai)
#pragma unroll
            for (int m = 0; m < 4; ++m) { const int rl = rl0 + ai * 128 + m * 16; const int e_ = lst[rl]; ent[ai][m] = (rl < lim) ? e_ : -1; }
#pragma unroll
        for (int ai = 0; ai < 2; ++ai)
#pragma unroll
            for (int m = 0; m < 4; ++m) { if (ent[ai][m] >= 0) { unsigned char* rowp = (unsigned char*)ys + (size_t)ent[ai][m] * DM + col0;
#pragma unroll
                for (int bj = 0; bj < 2; ++bj) { const f32x4 v0 = acc[ai][bj][m][0], v1 = acc[ai][bj][m][1];
                    u32x2 w; w.x = pk_fp8x4(v0[0], v0[1], v0[2], v0[3]); w.y = pk_fp8x4(v1[0], v1[1], v1[2], v1[3]);
                    *(GAS u32x2*)(rowp + bj * 32) = w; } } }
    }
};
struct FinRow { f32x4 x[4]; u32x2 d[4]; unsigned y[TOPK][4]; };
__device__ __forceinline__ void fin_load(FinRow& R, const float* xrow, const bf16_t* drow, const bf16_t* yrow, int lane) {
    const GAS f32x4* xr = (const GAS f32x4*)xrow + lane;
#pragma unroll
    for (int kk = 0; kk < TOPK; ++kk) { const GAS unsigned* yr = (const GAS unsigned*)((const unsigned char*)yrow + (size_t)kk * DM) + lane;
#pragma unroll
        for (int j = 0; j < 4; ++j) R.y[kk][j] = __builtin_nontemporal_load(yr + 64 * j); }
    const GAS u32x2* dr = (const GAS u32x2*)drow + lane;
#pragma unroll
    for (int j = 0; j < 4; ++j) { R.x[j] = xr[64 * j]; R.d[j] = dr[64 * j]; }
}
__device__ __forceinline__ void fin_compute(const FinRow& R, float* drow, float gv, int r, int lane, const f32x4 (&gfm)[4], const f32x4 (&gf)[4]) {
    f32x4 y[4];
#pragma unroll
    for (int j = 0; j < 4; ++j) y[j] = (f32x4){0.f, 0.f, 0.f, 0.f};
#pragma unroll
    for (int kk = 0; kk < TOPK; ++kk) { const float g = __builtin_bit_cast(float, __builtin_amdgcn_readlane(__builtin_bit_cast(int, gv), r * 4 + kk));
#pragma unroll
        for (int j = 0; j < 4; ++j) { const int w = (int)R.y[kk][j]; const f32x2 lo = __builtin_amdgcn_cvt_pk_f32_fp8(w, false), hi = __builtin_amdgcn_cvt_pk_f32_fp8(w, true);
            y[j] += (f32x4){lo.x, lo.y, hi.x, hi.y} * g; } }
    f32x4 v[4]; float s = 0.f;
#pragma unroll
    for (int j = 0; j < 4; ++j) { const u32x2 w = R.d[j]; v[j] = (R.x[j] + (f32x4){bf2f(w.x & 0xffffu), bf2f(w.x >> 16), bf2f(w.y & 0xffffu), bf2f(w.y >> 16)}) + gfm[j] * y[j]; s += (v[j].x * v[j].x + v[j].y * v[j].y) + (v[j].z * v[j].z + v[j].w * v[j].w); }
    const float rstd = 1.f / sqrtf(wave_sum(s) * (1.f / DM) + EPS);
    GAS f32x4* orow = (GAS f32x4*)drow + lane;
#pragma unroll
    for (int j = 0; j < 4; ++j) orow[64 * j] = v[j] * rstd * gf[j];
}
__device__ __forceinline__ void final_phase(Frame& F, float* dst) {
    const int gw = F.vcu * NWAVES + F.wave, NGW = F.G * NWAVES, lane = F.lane;
    f32x4 gf[4];
#pragma unroll
    for (int j = 0; j < 4; ++j) gf[j] = *(const GAS f32x4*)(F.g_final + 4 * lane + 256 * j);
    for (int chunk = gw; chunk < NTOK / 16; chunk += NGW) {
        const int m0 = chunk * 16, b = m0 / SEQ;
        f32x4 gfm[4];
#pragma unroll
        for (int j = 0; j < 4; ++j) gfm[j] = *(const GAS f32x4*)(F.mod + b * 6 * DM + 5 * DM + 4 * lane + 256 * j);
        const float gv = F.tkg[m0 * 4 + lane];
        FinRow A, B;
        fin_load(A, F.x + (size_t)m0 * DM, F.DELTA + (size_t)m0 * DM, (const bf16_t*)((const unsigned char*)F.YS + (size_t)m0 * 4 * DM), lane);
#pragma unroll 1
        for (int r = 0; r < 16; r += 2) {
            fin_load(B, F.x + (size_t)(m0 + r + 1) * DM, F.DELTA + (size_t)(m0 + r + 1) * DM, (const bf16_t*)((const unsigned char*)F.YS + (size_t)(m0 + r + 1) * 4 * DM), lane);
            fin_compute(A, dst + (size_t)(m0 + r) * DM, gv, r, lane, gfm, gf);
            if (r + 2 < 16) fin_load(A, F.x + (size_t)(m0 + r + 2) * DM, F.DELTA + (size_t)(m0 + r + 2) * DM, (const bf16_t*)((const unsigned char*)F.YS + (size_t)(m0 + r + 2) * 4 * DM), lane);
            fin_compute(B, dst + (size_t)(m0 + r + 1) * DM, gv, r + 1, lane, gfm, gf);
        }
    }
}
struct MkArgs { const float* in[17]; float* out; unsigned char* ws; int ph_lo, ph_hi; };
#ifndef DBG_STAGE
#define DBG_STAGE 9
#endif
constexpr int N_PHASES = DBG_STAGE;
__global__ void __launch_bounds__(NWAVES * 64, 2) mk_fwd(MkArgs args) {
    extern __shared__ __attribute__((aligned(16))) unsigned char lds[];
    Frame F;
    F.lds = (LAS unsigned char*)lds;
    F.MISC = (volatile LAS unsigned*)(F.lds + MISC_OFF);
    F.tid = threadIdx.x; F.lane = F.tid & 63; F.wave = __builtin_amdgcn_readfirstlane(F.tid >> 6);
    F.G = gridDim.x; { const int bx = blockIdx.x; F.vcu = (F.G % 8 == 0) ? (bx % 8) * (F.G / 8) + bx / 8 : bx; }
    unsigned char* ws = args.ws;
    F.ctl = (gu32*)(ws + WS_CTL);
    F.x = args.in[0]; F.c = args.in[1]; F.w_ada = args.in[2]; F.b_ada = args.in[3]; F.w_in = args.in[4]; F.sink = args.in[5]; F.rpb = args.in[6]; F.ga = args.in[7]; F.gb = args.in[8];
    F.w_out = args.in[9]; F.w_router = args.in[10]; F.b_router = args.in[11]; F.w_gu = args.in[12]; F.b_gu = args.in[13]; F.w_down = args.in[14]; F.b_down = args.in[15]; F.g_final = args.in[16];
    F.out = args.out;
    F.mod = (float*)(ws + WS_MOD); F.rope = (float*)(ws + WS_ROPE); F.ssq = (float*)(ws + WS_SSQ); F.tkg = (float*)(ws + WS_TKG); F.tke = (int*)(ws + WS_TKE); F.list = (int*)(ws + WS_LIST);
    F.wr_t = (bf16_t*)(ws + WS_WR); F.win_t = (bf16_t*)(ws + WS_WIN); F.wout_t = (bf16_t*)(ws + WS_WOUT); F.wgu_t = (bf16_t*)(ws + WS_WGU); F.wd_t = (bf16_t*)(ws + WS_WD);
    F.XN = (bf16_t*)(ws + WS_XN); F.PROJ = (bf16_t*)(ws + WS_PROJ); F.O = (bf16_t*)(ws + WS_O); F.YS = (bf16_t*)(ws + WS_YS); F.ACT = (bf16_t*)(ws + WS_ACT); F.DELTA = (bf16_t*)(ws + WS_DELTA);
    for (int u = F.tid; u < (LDS_BYTES - LDSCTL_OFF) / 4; u += NWAVES * 64) ((LAS unsigned*)(F.lds + LDSCTL_OFF))[u] = 0u;
    __syncthreads();
    const int lo = args.ph_lo, hi = args.ph_hi;
    XcdBarrier bar; bar.bar = (unsigned*)(F.ctl + CW_BAR); bar.x = 0; bar.st = nullptr;
    if (hi - lo > 1) bar = xcd_barrier_post((unsigned*)(F.ctl + CW_BAR), F.MISC + 8, F.wave);
#define IN(k) (lo <= (k) && (k) < hi)
#define MOE_STAGGER(nN_, ticks_) do { const int tot_ = ((const LAS int*)(F.lds + TAB_OFF))[32] * (nN_); const int maxu_ = (tot_ + F.G - 1) / F.G, mine_ = (tot_ - F.vcu + F.G - 1) / F.G; \
        if (mine_ < maxu_) { const unsigned long long t0_ = __builtin_amdgcn_s_memrealtime(); while (__builtin_amdgcn_s_memrealtime() - t0_ < (ticks_)) __builtin_amdgcn_s_sleep(8); } } while (0)
#define FRESH() do { F.lane = lane_id(); F.tid = F.wave * 64 + F.lane; } while (0)
#if defined(DIAG_A)
    unsigned long long* const ts = (unsigned long long*)(ws + WS_CTL + 512 * 1024);
#define STAMP(k) do { if (blockIdx.x == 0 && F.wave == 0 && lane_id() == 0) ts[k] = __builtin_amdgcn_s_memrealtime(); } while (0)
#else
#define STAMP(k) do {} while (0)
#endif
#define SEAM(k) do { if (IN(k) && IN((k) + 1)) xcd_barrier(bar, F.wave); STAMP((k) + 1); } while (0)
#ifndef PROBE_PH
#define PROBE_PH -1
#endif
#ifndef PROBE_FIN
#define PROBE_FIN 0
#endif
#define REP(k) for (int _rep = (PROBE_PH == (k)) ? 0 : 1; _rep < 2; ++_rep)
    float* const dummy = (float*)(ws + 830 * MiB);
    STAMP(0);
    FRESH();
    if (IN(0)) { REP(0) { __syncthreads(); p0_prologue(F); } } SEAM(0);
    FRESH();
    if (IN(1)) { REP(1) p1_xn(F); } SEAM(1);
    FRESH();
    if (IN(2)) REP(2) {
        pg8::DenseOrder S; S.init(F.XN, F.win_t, NTOK, DIN, DM, F.G, (int)blockIdx.x);
        EpiProj E{F.PROJ, F.rope};
        pg8::gemm_phase<EpiProj, pg8::DenseOrder, true>(F.lds, DM, S, E, F.wave);
    } SEAM(2);
    FRESH();
    if (IN(3)) { if (PROBE_PH == 3) { if (PROBE_FIN != 2) attn_a_phase(F, dummy); if (PROBE_FIN != 1) attn_b_phase(F, dummy); }
                 attn_a_phase(F, F.ssq); attn_b_phase(F, F.ssq); } SEAM(3);
    FRESH();
    if (IN(4)) REP(4) {
        pg8::DenseOrder S; S.init(F.O, F.wout_t, NTOK, DM, DM, F.G, (int)blockIdx.x);
        EpiX1 E{F.DELTA, F.mod, F.ssq};
        pg8::gemm_phase<EpiX1, pg8::DenseOrder, true>(F.lds, DM, S, E, F.wave);
    } SEAM(4);
    FRESH();
    if (IN(5)) REP(5) { router_phase(F, _rep ? F.ctl + CW_CNT : F.ctl + 16384); } SEAM(5);
    FRESH();
    if (IN(6)) {
        moe_table(F);
        MoeOrder<true> S{(const char*)F.XN, (const char*)F.wgu_t, F.list, F.b_gu, (const LAS int*)(F.lds + TAB_OFF), F.lds + META_OFF, DM, 2 * DFF, 2 * DFF / 256, F.G, F.vcu, 0};
        if (PROBE_PH == 6) { EpiNull E0; pg8::gemm_phase<EpiNull, MoeOrder<true>, true>(F.lds, DM, S, E0, F.wave); S.ec = 0; }
        EpiSwiglu E{F.ACT, F.lds + META_OFF};
        pg8::gemm_phase<EpiSwiglu, MoeOrder<true>, true>(F.lds, DM, S, E, F.wave);
    } SEAM(6);
    FRESH();
    if (IN(7)) {
        moe_table(F);
        MoeOrder<false> S{(const char*)F.ACT, (const char*)F.wd_t, F.list, F.b_down, (const LAS int*)(F.lds + TAB_OFF), F.lds + META_OFF, DFF, DM, DM / 256, F.G, F.vcu, 0};
        if (PROBE_PH == 7) { EpiDense E0{(bf16_t*)(ws + 830 * MiB)}; pg8::gemm_phase<EpiDense, MoeOrder<false>, true>(F.lds, DFF, S, E0, F.wave); S.ec = 0; }
        EpiYs E{F.YS, (const LAS int*)(F.lds + TAB_OFF), F.lds + META_OFF};
        pg8::gemm_phase<EpiYs, MoeOrder<false>, true>(F.lds, DFF, S, E, F.wave);
    } SEAM(7);
    FRESH();
    if (IN(8)) REP(8) { final_phase(F, _rep ? F.out : dummy); }
#if defined(DIAG_A)
    xcd_barrier(bar, F.wave); STAMP(9);
    if (blockIdx.x == 0 && F.wave == 0) { asm volatile("s_waitcnt vmcnt(0)" ::: "memory");
        const unsigned long long t9 = __builtin_amdgcn_s_memrealtime(), span = (DIAG_A == 9) ? 0ull : (ts[DIAG_A + 1] - ts[DIAG_A]);
        while (__builtin_amdgcn_s_memrealtime() - t9 < 4ull * span) __builtin_amdgcn_s_sleep(16); }
#endif
#undef IN
#undef SEAM
}

__global__ void br_route(const bf16_t* XN, const int* tke, const unsigned* ctl, float* h, int* cnt, int* list) {
    const int idx = blockIdx.x * 256 + threadIdx.x;
    const int ep = tke[idx]; list[(ep >> 16) * NTOK + (ep & 0xffff)] = idx;
    if (idx < NE) cnt[idx] = (int)ctl[CW_CNT + idx * 64];
    const int t = idx >> 2, q = idx & 3;
    for (int k = q * 256; k < q * 256 + 256; ++k) h[(size_t)t * DM + k] = bf2f(XN[(size_t)t * DM + k]);
}
extern "C" void kernel_launch(void* const* d_in, const int* in_sizes, int n_in, void* d_out, int out_size, void* d_ws, size_t ws_size, hipStream_t stream) {
    static int grid = 0;
    if (grid == 0) {
        if (n_in != 17 || ws_size < (size_t)1001 * MiB) { fprintf(stderr, "kernel_launch: bad n_in %d or ws_size %zu\n", n_in, ws_size); grid = -1; return; }
        int dev = 0, cus = 0, per_cu = 0;
        if (hipGetDevice(&dev) != hipSuccess || hipDeviceGetAttribute(&cus, hipDeviceAttributeMultiprocessorCount, dev) != hipSuccess) { grid = -1; return; }
        if (hipFuncSetAttribute((const void*)mk_fwd, hipFuncAttributeMaxDynamicSharedMemorySize, LDS_BYTES) != hipSuccess) { fprintf(stderr, "kernel_launch: hipFuncSetAttribute failed\n"); grid = -1; return; }
        if (hipOccupancyMaxActiveBlocksPerMultiprocessor(&per_cu, (const void*)mk_fwd, NWAVES * 64, LDS_BYTES) != hipSuccess || per_cu < 1) { fprintf(stderr, "kernel_launch: occupancy query says %d\n", per_cu); }
        (void)hipGetLastError();
        grid = cus;
    }
    if (grid < 0) return;
    const float* x = (const float*)d_in[0]; const float* sink = (const float*)d_in[5]; const float* rpb = (const float*)d_in[6]; const float* ga = (const float*)d_in[7];
    const float* gb = (const float*)d_in[8]; const float* w_out = (const float*)d_in[9]; const float* w_router = (const float*)d_in[10]; const float* b_router = (const float*)d_in[11];
    const float* w_gu = (const float*)d_in[12]; const float* b_gu = (const float*)d_in[13]; const float* w_down = (const float*)d_in[14]; const float* b_down = (const float*)d_in[15];
    const float* g_final = (const float*)d_in[16];
    char* ws = (char*)d_ws; float* out = (float*)d_out;
    (void)hipMemsetAsync(ws + WS_CTL, 0, CTL_ZERO_BYTES, stream);
    MkArgs a{};
    for (int i = 0; i < 17; ++i) a.in[i] = (const float*)d_in[i];
    a.out = out; a.ws = (unsigned char*)d_ws;
#if defined(MK_PER_PHASE)
    for (int ph = 0; ph < N_PHASES; ++ph) { a.ph_lo = ph; a.ph_hi = ph + 1; hipLaunchKernelGGL(mk_fwd, dim3(grid), dim3(NWAVES * 64), LDS_BYTES, stream, a); }
#else
    a.ph_lo = 0; a.ph_hi = N_PHASES; hipLaunchKernelGGL(mk_fwd, dim3(grid), dim3(NWAVES * 64), LDS_BYTES, stream, a);
#endif
#if DBG_STAGE < 9
    float* mod = (float*)(ws + WS_MOD);
    float* h = (float*)(ws + 17 * MiB);
    float* y = (float*)(ws + 337 * MiB);
    float* act = (float*)(ws + 481 * MiB);
    int* cnt = (int*)(ws + 993 * MiB); int* tke = (int*)(ws + 994 * MiB); float* tkg = (float*)(ws + 995 * MiB); int* list = (int*)(ws + 996 * MiB);
    (void)hipMemsetAsync(cnt, 0, 64 * sizeof(int), stream);
    (void)hipMemsetAsync(y, 0, (size_t)NTOK * DM * 4, stream);
#if DBG_STAGE == 5
    nv_norm_mod<<<NTOK, 256, 0, stream>>>(out, mod, 3 * DM, 4 * DM, h);
    nv_router<<<NTOK, 64, 0, stream>>>(h, w_router, b_router, cnt, tke, tkg, list);
#elif DBG_STAGE == 6
    br_route<<<NTOK * 4 / 256, 256, 0, stream>>>((const bf16_t*)(ws + WS_XN), (const int*)(ws + WS_TKE), (const unsigned*)(ws + WS_CTL), h, cnt, list);
    tkg = (float*)(ws + WS_TKG);
#endif
    nv_offsets<<<1, 64, 0, stream>>>(cnt);
    nv_sgemm<true><<<dim3(DFF / 64, NTOK / 64, NE), 256, 0, stream>>>(w_gu, 2 * DFF, DM, RmMoe1{h, list, cnt, (size_t)DM * 2 * DFF}, EpiMoe1{act, cnt, b_gu});
    nv_sgemm<false><<<dim3(DM / 64, NTOK / 64, NE), 256, 0, stream>>>(w_down, DM, DFF, RmMoe2{act, cnt, (size_t)DFF * DM}, EpiMoe2{y, list, cnt, tkg, b_down});
    nv_final<<<NTOK, 256, 0, stream>>>(out, y, mod, g_final, out);
#endif
}
```

```cpp
#define DBG_STAGE 9
#include <hip/hip_runtime.h>
#include <cstdio>
#include <cstdint>
#include <cmath>

constexpr int DM = 1024, NB = 8, SEQ = 4096, NTOK = NB * SEQ;
constexpr int HD = 64, AQH = 8, AKVH = 2, BH = 8;
constexpr int AQW = 512, AKVW = 128, BW = 512, DIN = 2304;
constexpr int OFF_QA = 0, OFF_KA = 512, OFF_VA = 640, OFF_QB = 768, OFF_KB = 1280, OFF_VB = 1792;
constexpr int WIN = 128, GW = 64, NAR = 8, NAC = 16, NE = 32, TOPK = 4, DFF = 1024;
constexpr float EPS = 1e-5f;
constexpr size_t MiB = 1u << 20;

#define GAS __attribute__((address_space(1)))
#define LAS __attribute__((address_space(3)))
typedef unsigned short bf16_t;
typedef short bf16x8 __attribute__((ext_vector_type(8)));
typedef float f32x4 __attribute__((ext_vector_type(4)));
typedef float f32x2 __attribute__((ext_vector_type(2)));
typedef float f32x16 __attribute__((ext_vector_type(16)));
typedef unsigned u32x4 __attribute__((ext_vector_type(4)));
typedef unsigned u32x2 __attribute__((ext_vector_type(2)));
typedef unsigned u32x8 __attribute__((ext_vector_type(8)));
typedef GAS unsigned gu32;
#define RLX_AGENT __ATOMIC_RELAXED, __HIP_MEMORY_SCOPE_AGENT
#define LDS_WAIT() asm volatile("s_waitcnt lgkmcnt(0)" ::: "memory")
#define VM_WAIT() asm volatile("s_waitcnt vmcnt(0)" ::: "memory")
__device__ __forceinline__ unsigned cvt_pk_bf16(float lo, float hi) { unsigned r; asm volatile("v_cvt_pk_bf16_f32 %0, %1, %2" : "=v"(r) : "v"(lo), "v"(hi)); return r; }
__device__ __forceinline__ unsigned f2bf(float f) { unsigned u = __builtin_bit_cast(unsigned, f); return (u + 0x7fffu + ((u >> 16) & 1u)) >> 16; }
__device__ __forceinline__ unsigned pk2(float lo, float hi) { return f2bf(lo) | (f2bf(hi) << 16); }
__device__ __forceinline__ float bf2f(unsigned h) { return __builtin_bit_cast(float, h << 16); }
__device__ __forceinline__ unsigned pk_fp8x4(float a, float b, float c, float d) { int p = __builtin_amdgcn_cvt_pk_fp8_f32(a, b, 0, false); return (unsigned)__builtin_amdgcn_cvt_pk_fp8_f32(c, d, p, true); }
typedef int v8i32 __attribute__((ext_vector_type(8)));
constexpr float W8_SCALE = 32.0f;

constexpr int NWAVES = 8;
__device__ __forceinline__ int lane_id() { int l; asm volatile("v_mbcnt_lo_u32_b32 %0, -1, 0\n\tv_mbcnt_hi_u32_b32 %0, -1, %0" : "=v"(l)); return l; }
constexpr float C2 = 0.125f * 1.4426950408889634f;
constexpr float LOG2E = 1.4426950408889634f;
constexpr int NSLOT_MAX = 139264;

constexpr size_t WS_CTL = 0, CTL_ZERO_BYTES = 128 * 1024;
constexpr size_t WS_MOD = 1 * MiB;
constexpr size_t WS_ROPE = WS_MOD + 256 * 1024;
constexpr size_t WS_WR = WS_ROPE + 256 * 1024;
constexpr size_t WS_SSQ = 2 * MiB;
constexpr size_t WS_TKE = 3 * MiB;
constexpr size_t WS_TKG = 4 * MiB;
constexpr size_t WS_LIST = 5 * MiB;
constexpr size_t WS_WIN = 10 * MiB;
constexpr size_t WS_WOUT = 15 * MiB;
constexpr size_t WS_WGU = 17 * MiB;
constexpr size_t WS_WD = 145 * MiB;
constexpr size_t WS_XN = 209 * MiB;
constexpr size_t WS_PROJ = 273 * MiB;
constexpr size_t WS_O = 417 * MiB;
constexpr size_t WS_YS = 209 * MiB;
constexpr size_t WS_ACT = 481 * MiB;
constexpr size_t WS_DELTA = 760 * MiB;
constexpr size_t WS_MK_END = 824 * MiB;
constexpr int CW_TMO = 0, CW_CNT = 64  , CW_BAR = 4096;

constexpr int RING_BYTES = 131072;
constexpr int LDSCTL_OFF = RING_BYTES, MISC_OFF = LDSCTL_OFF + 320;
constexpr int TAB_OFF = LDSCTL_OFF + 1024;
constexpr int LDS_BYTES = 163840;

namespace pg8 {
constexpr int BM = 256, BK = 64, HALF = 128, HTB = HALF * BK * 2, NXCD = 8, WGM = 8;
__host__ __device__ __forceinline__ int lds_byte(int r, int c) { const int st = (r >> 4) * 2 + (c >> 5), rr = r & 15, cc = c & 31, ob = rr * 64 + cc * 2; return st * 1024 + (ob ^ (((ob >> 9) & 1) << 5)); }
__host__ __device__ __forceinline__ void stage_rc(int b, int& R, int& C) { const int st = b / 1024, sb = b % 1024, swz = sb ^ (((sb >> 9) & 1) << 5); R = (st >> 1) * 16 + swz / 64; C = (st & 1) * 32 + (swz % 64) / 2; }
__host__ __device__ __forceinline__ int perm32(int rho) { const int n = rho >> 4, i = rho & 15; return 8 * (i >> 2) + 4 * n + (i & 3); }

struct Unit { int pm, pn, e, aux; };

struct DenseOrder {
    const char* A; const char* Bt; int K; int nM, nN, nwg, G, c;
    __device__ void init(const void* A_, const void* Bt_, int M, int N, int K_, int G_, int c_) { A = (const char*)A_; Bt = (const char*)Bt_; K = K_; nM = M / BM; nN = N / BM; nwg = nM * nN; G = G_; c = c_; }
    __device__ bool next(int i, Unit& u) const {
        const long L = (long)i * G + c; if (L >= nwg) return false;
        int wgid = (int)L; { const int q = nwg / NXCD, r = nwg % NXCD, xcd = wgid % NXCD, off = wgid / NXCD; wgid = (xcd < r ? xcd * (q + 1) : r * (q + 1) + (xcd - r) * q) + off; }
        const int nig = WGM * nN, gid = wgid / nig, fm = gid * WGM, gsz = (nM - fm) < WGM ? (nM - fm) : WGM;
        u.pm = fm + ((wgid % nig) % gsz); u.pn = (wgid % nig) / gsz; u.e = 0; u.aux = 0; return true;
    }
    __device__ __forceinline__ const char* abase() const { return A; }
    __device__ __forceinline__ const char* bbase(const Unit& u) const { return Bt + (size_t)u.pn * BM * K * 2; }
    __device__ __forceinline__ void aoffs(const Unit& u, int, const int (&R)[2], const int (&C)[2], unsigned (&off)[4]) const {
#pragma unroll
        for (int h = 0; h < 2; ++h)
#pragma unroll
            for (int i = 0; i < 2; ++i) off[h * 2 + i] = (unsigned)((u.pm * BM + h * HALF + R[i]) * K + C[i]) * 2u;
    }
    __device__ __forceinline__ void meta_init(const Unit&, bool, const Unit&, int) const {}
    __device__ __forceinline__ void meta_top(int, bool, const Unit&, bool, const Unit&, int) const {}
};

#define PG8_LAS __attribute__((address_space(3)))
template <class Epi, class Sched, bool ALIGN_EPI>
__device__ __forceinline__ void gemm_phase(PG8_LAS unsigned char* lds, const int K, const Sched& S, const Epi& E, const int wid_  ) {
    const int lane = lane_id(), tid = wid_ * 64 + lane, wid = wid_, wr = wid >> 2, wc = wid & 3, fr = lane & 15, fq = lane >> 4;
    constexpr int ESZ = Epi::FP8 ? 1 : 2;
    const int nt = K * ESZ / (BK * 2);
    unsigned voffB[2];
#pragma unroll
    for (int i = 0; i < 2; ++i) { int R, C; stage_rc(tid * 16 + i * 8192, R, C); const int Rp = Epi::PERM ? ((R & ~31) + perm32(R & 31)) : R; const int Rb = Epi::WIDE == 2 ? ((Rp >> 5) * 64 + ((Rp & 31) >> 3) * 16 + (Rp & 7)) : Epi::WIDE == 1 ? ((Rp >> 5) * 64 + (Rp & 31)) : Rp; voffB[i] = (unsigned)(Rb * K * ESZ + C * 2); }
#define PG8_RC() int sR[2], sC[2]; { int t2_ = tid; asm volatile("" : "+v"(t2_)); _Pragma("unroll") for (int i = 0; i < 2; ++i) stage_rc(t2_ * 16 + i * 8192, sR[i], sC[i]); }
    const size_t kstep = (size_t)(BK * 2);
    const size_t hstepB = (size_t)(Epi::WIDE == 2 ? 8 : Epi::WIDE == 1 ? 32 : HALF) * K * ESZ;
    const unsigned ldsw = (unsigned)wid * 1024u;
    const int aoff = lds_byte(wr * 64 + fr, fq * 8), boff = lds_byte(wc * 32 + fr, fq * 8);
    const char* const gA = S.abase();
#define PG8_SA(b, h) (((b) * 2 + (h)) * HTB)
#define PG8_SB(b, h) ((4 + (b) * 2 + (h)) * HTB)
#define PG8_STAGE(bufoff, gbase, voff) do { _Pragma("unroll") for (int _i = 0; _i < 2; ++_i) \
        __builtin_amdgcn_global_load_lds((const unsigned*)((const char*)(gbase) + (voff)[_i]), (PG8_LAS unsigned*)(lds + (bufoff) + ldsw + _i * 8192), 16, 0, 0); } while (0)
#define PG8_STAGEA(bufoff, offs, h, kb) do { _Pragma("unroll") for (int _i = 0; _i < 2; ++_i) \
        __builtin_amdgcn_global_load_lds((const unsigned*)((gA + (kb)) + (offs)[(h) * 2 + _i]), (PG8_LAS unsigned*)(lds + (bufoff) + ldsw + _i * 8192), 16, 0, 0); } while (0)
#define PG8_LD16(off) (*(const PG8_LAS u32x4*)(lds + (off)))
#define PG8_LDA(dst, b, h) do { _Pragma("unroll") for (int m = 0; m < 4; ++m) dst[m] = __builtin_shufflevector(PG8_LD16(PG8_SA(b, h) + aoff + m * 2048), PG8_LD16(PG8_SA(b, h) + aoff + m * 2048 + 1024), 0, 1, 2, 3, 4, 5, 6, 7); } while (0)
#define PG8_LDB(dst, b, h) do { _Pragma("unroll") for (int n = 0; n < 2; ++n) dst[n] = __builtin_shufflevector(PG8_LD16(PG8_SB(b, h) + boff + n * 2048), PG8_LD16(PG8_SB(b, h) + boff + n * 2048 + 1024), 0, 1, 2, 3, 4, 5, 6, 7); } while (0)
#define PG8_HALF(x, k) __builtin_bit_cast(bf16x8, __builtin_shufflevector(x, x, 4 * (k), 4 * (k) + 1, 4 * (k) + 2, 4 * (k) + 3))
#define PG8_MMA(ai, bj, At, Bt) do { __builtin_amdgcn_s_setprio(1); _Pragma("unroll") for (int m = 0; m < 4; ++m) _Pragma("unroll") for (int n = 0; n < 2; ++n) { \
        if constexpr (Epi::FP8) asm volatile("v_mfma_scale_f32_16x16x128_f8f6f4 %0, %1, %2, %0, %3, %4 op_sel_hi:[0,0,0]" : "+v"(acc[ai][bj][m][n]) : "v"(Bt[n]), "v"(At[m]), "v"(scw), "v"(sca)); \
        else { acc[ai][bj][m][n] = __builtin_amdgcn_mfma_f32_16x16x32_bf16(PG8_HALF(Bt[n], 0), PG8_HALF(At[m], 0), acc[ai][bj][m][n], 0, 0, 0); \
               acc[ai][bj][m][n] = __builtin_amdgcn_mfma_f32_16x16x32_bf16(PG8_HALF(Bt[n], 1), PG8_HALF(At[m], 1), acc[ai][bj][m][n], 0, 0, 0); } } \
        __builtin_amdgcn_s_setprio(0); } while (0)
#define PG8_ACC_INIT(uix) do { f32x4 i_[2][2]; { int l2_ = lane; asm volatile("" : "+v"(l2_)); E.init(i_, (uix), wc, l2_ >> 4); } \
        _Pragma("unroll") for (int a = 0; a < 2; ++a) _Pragma("unroll") for (int b = 0; b < 2; ++b) _Pragma("unroll") for (int m = 0; m < 4; ++m) _Pragma("unroll") for (int n = 0; n < 2; ++n) { \
            acc[a][b][m][n] = i_[b][n]; asm volatile("" : "+v"(acc[a][b][m][n])); } } while (0)
#define PG8_WAIT_V(n) asm volatile("s_waitcnt vmcnt(" #n ")" ::: "memory")
#define PG8_WAIT_L(n) asm volatile("s_waitcnt lgkmcnt(" #n ")" ::: "memory")
#define PG8_BAR __builtin_amdgcn_s_barrier()
#define PG8_SCHED __builtin_amdgcn_sched_barrier(0)
    Unit cur, nxt, nn; int ui = 0;
    if (!S.next(0, cur)) return;
    bool h1 = S.next(1, nxt), h2 = h1 && S.next(2, nn);
    f32x4 acc[2][2][4][2];
    unsigned scw = 0x7A7A7A7Au, sca = 0x7F7F7F7Fu; asm volatile("" : "+v"(scw), "+v"(sca));
    u32x8 At[4], B0[2], B1[2];
    unsigned lO[4], hO[2];
    S.meta_init(cur, h1, nxt, wid);
    { PG8_RC(); S.aoffs(cur, 0, sR, sC, lO); } hO[0] = lO[2]; hO[1] = lO[3];
    PG8_ACC_INIT(0);
    const char* cB = S.bbase(cur);
    PG8_STAGE(PG8_SB(0, 0), cB, voffB); PG8_STAGE(PG8_SB(0, 1), cB + hstepB, voffB); PG8_STAGEA(PG8_SA(0, 0), lO, 0, 0); PG8_STAGEA(PG8_SA(0, 1), lO, 1, 0);
    if (wr == 1) PG8_BAR;
    PG8_WAIT_V(2); PG8_BAR;
    PG8_STAGE(PG8_SB(1, 0), cB + kstep, voffB); PG8_STAGEA(PG8_SA(1, 0), lO, 0, kstep); PG8_STAGE(PG8_SB(1, 1), cB + hstepB + kstep, voffB);
    PG8_WAIT_V(6); PG8_BAR;
    for (;;) {
        const bool has_next = h1;
        const char* nB = has_next ? S.bbase(nxt) : cB;
        S.meta_top(ui, h1, nxt, h2, nn, wid);
#pragma unroll 1
        for (int t = 0; t < nt; t += 2) {
            const bool last = (t == nt - 2);
            if constexpr (Epi::MID) { if (t == nt / 2) { int l2_ = lane; asm volatile("" : "+v"(l2_)); E.mid(acc, cur, wr, l2_ & 15); } }
            if (last && has_next) { PG8_RC(); S.aoffs(nxt, ui + 1, sR, sC, lO); }
            const size_t k1 = (size_t)(t + 1) * kstep;
            const size_t k2 = last ? 0 : (size_t)(t + 2) * kstep, k3 = k2 + kstep;
            const char* b2 = (last ? nB : cB) + k2; const char* b3 = b2 + kstep;
            PG8_LDB(B0, 0, 0); PG8_LDB(B1, 0, 1); PG8_SCHED; PG8_LDA(At, 0, 0); PG8_STAGEA(PG8_SA(1, 1), hO, 0, k1);
            PG8_WAIT_V(8); PG8_WAIT_L(0); PG8_BAR; PG8_MMA(0, 0, At, B0); PG8_MMA(0, 1, At, B1); PG8_BAR; PG8_SCHED;
            PG8_LDA(At, 0, 1); PG8_STAGE(PG8_SB(0, 0), b2, voffB); PG8_STAGE(PG8_SB(0, 1), b2 + hstepB, voffB); PG8_STAGEA(PG8_SA(0, 0), lO, 0, k2);
            PG8_WAIT_V(8); PG8_WAIT_L(0); PG8_BAR; PG8_MMA(1, 0, At, B0); PG8_MMA(1, 1, At, B1); PG8_BAR; PG8_SCHED;
            PG8_LDB(B0, 1, 0); PG8_LDB(B1, 1, 1); PG8_SCHED; PG8_LDA(At, 1, 0); PG8_STAGEA(PG8_SA(0, 1), lO, 1, k2);
            PG8_WAIT_V(8); PG8_WAIT_L(0); PG8_BAR; PG8_MMA(0, 0, At, B0); PG8_MMA(0, 1, At, B1); PG8_BAR; PG8_SCHED;
            PG8_LDA(At, 1, 1); PG8_STAGE(PG8_SB(1, 0), b3, voffB); PG8_STAGE(PG8_SB(1, 1), b3 + hstepB, voffB); PG8_STAGEA(PG8_SA(1, 0), lO, 0, k3);
            PG8_WAIT_V(8); PG8_WAIT_L(0); PG8_BAR; PG8_MMA(1, 0, At, B0); PG8_MMA(1, 1, At, B1); PG8_BAR; PG8_SCHED;
        }
        if constexpr (ALIGN_EPI) { if (wr == 0) PG8_BAR; }
        if constexpr (Epi::FP8) asm volatile("s_nop 15\n\ts_nop 7" ::: "memory");
        { int l2_ = lane; asm volatile("" : "+v"(l2_)); E(acc, cur, ui, wr, wc, l2_ & 15, l2_ >> 4); }
        if (!has_next) break;
        PG8_ACC_INIT(ui + 1);
        cur = nxt; cB = nB; hO[0] = lO[2]; hO[1] = lO[3];
        nxt = nn; h1 = h2; h2 = h1 && S.next(ui + 3, nn);
        ++ui;
        if constexpr (ALIGN_EPI) { if (wr == 1) PG8_BAR; }
    }
    PG8_WAIT_V(0);
    if constexpr (!ALIGN_EPI) { if (wr == 0) PG8_BAR; }
    PG8_BAR;
#undef PG8_SA
#undef PG8_SB
#undef PG8_STAGE
#undef PG8_STAGEA
#undef PG8_LDA
#undef PG8_LDB
#undef PG8_MMA
#undef PG8_ACC_INIT
#undef PG8_RC
#undef PG8_HALF
#undef PG8_LD16
#undef PG8_WAIT_V
#undef PG8_WAIT_L
#undef PG8_BAR
#undef PG8_SCHED
}
}
#define XB_TMO      128
#define XB_XCNT(j)  (256  + 64 * (j))
#define XB_XSUB(j)  (1280 + 64 * (j))
#define XB_XGEN(j)  (2304 + 64 * (j))
#define XB_TOP      3328
#define XB_TOPGEN   3392
#define XCD_BAR_WORDS 3456
#define XB_SPIN_CAP (1u << 18)
__device__ __forceinline__ unsigned xb_ld(unsigned* p)              { return __hip_atomic_load(p, __ATOMIC_RELAXED, __HIP_MEMORY_SCOPE_AGENT); }
__device__ __forceinline__ unsigned xb_add(unsigned* p, unsigned v) { return __hip_atomic_fetch_add(p, v, __ATOMIC_RELAXED, __HIP_MEMORY_SCOPE_AGENT); }
__device__ __forceinline__ unsigned xb_xcc_id() { return (unsigned)__builtin_amdgcn_s_getreg((3 << 11) | 20) & 0xFu; }
#define XB_SPIN(cond, bar) do { unsigned _sp = 0; while (cond) { __builtin_amdgcn_s_sleep(1); \
    if ((++_sp & 255u) == 0u) { if (xb_ld(&(bar)[XB_TMO])) break; if (_sp > XB_SPIN_CAP) { atomicAdd(&(bar)[XB_TMO], 1u); break; } } } } while (0)
struct XcdBarrier { unsigned* bar; unsigned x; volatile LAS unsigned* st; };
__device__ __forceinline__ XcdBarrier xcd_barrier_post(unsigned* bar, volatile LAS unsigned* st, int wave) {
    XcdBarrier b; b.bar = bar; b.x = xb_xcc_id(); b.st = st;
    if (wave == 0 && lane_id() == 0) (void)xb_add(&bar[XB_XCNT(b.x)], 1u);
    return b;
}
__device__ __forceinline__ void xcd_barrier_complete(unsigned* bar, unsigned x, unsigned& nloc, unsigned& nx) {
    const unsigned G = gridDim.x * gridDim.y * gridDim.z;
    unsigned sum, cnt, mine, sp = 0u;
    for (;;) {
        sum = 0u; cnt = 0u; mine = 0u;
#pragma unroll
        for (unsigned j = 0; j < 16; ++j) { const unsigned c = xb_ld(&bar[XB_XCNT(j)]); sum += c; cnt += (c > 0u) ? 1u : 0u; mine = (j == x) ? c : mine; }
        if (sum == G) break;
        __builtin_amdgcn_s_sleep(1);
        if ((++sp & 255u) == 0u) { if (xb_ld(&bar[XB_TMO])) break; if (sp > XB_SPIN_CAP) { atomicAdd(&bar[XB_TMO], 1u); break; } }
    }
    nloc = mine > 0u ? mine : 1u; nx = cnt > 0u ? cnt : 1u;
}
__device__ __forceinline__ void xcd_barrier(const XcdBarrier& b, int wave) {
    asm volatile("s_waitcnt vmcnt(0)" ::: "memory");
    __syncthreads();
    if (wave == 0 && lane_id() == 0) {
        unsigned* bar = b.bar;
        __builtin_amdgcn_s_waitcnt(0);
        unsigned nloc = b.st[0], nx = b.st[1];
        if (nloc == 0u) { xcd_barrier_complete(bar, b.x, nloc, nx); b.st[0] = nloc; b.st[1] = nx; }
        const unsigned old = xb_add(&bar[XB_XSUB(b.x)], 1u);
        const unsigned gen = old / nloc;
        if (old + 1u == (gen + 1u) * nloc) {
            __builtin_amdgcn_fence(__ATOMIC_RELEASE, "agent");
            asm volatile("s_waitcnt vmcnt(0)" ::: "memory");
            const unsigned og = xb_add(&bar[XB_TOP], 1u);
            const unsigned tg = og / nx;
            if (og + 1u == (tg + 1u) * nx) xb_add(&bar[XB_TOPGEN], 1u);
            else XB_SPIN(xb_ld(&bar[XB_TOPGEN]) == tg, bar);
            __builtin_amdgcn_fence(__ATOMIC_ACQUIRE, "agent");
            xb_add(&bar[XB_XGEN(b.x)], 1u);
            asm volatile("s_waitcnt vmcnt(0)" ::: "memory");
        } else {
            XB_SPIN(xb_ld(&bar[XB_XGEN(b.x)]) == gen, bar);
            __builtin_amdgcn_fence(__ATOMIC_ACQUIRE, "agent");
            asm volatile("s_waitcnt vmcnt(0)" ::: "memory");
        }
    }
    __syncthreads();
}

struct Frame {
    LAS unsigned char* lds;
    volatile LAS unsigned* MISC;
    gu32* ctl;
    int tid, lane, wave, vcu, G;
    const float *x, *c, *w_ada, *b_ada, *w_in, *sink, *rpb, *ga, *gb, *w_out, *w_router, *b_router, *w_gu, *b_gu, *w_down, *b_down, *g_final;
    float* out;
    float *mod, *rope, *ssq, *tkg;
    int *tke, *list;
    bf16_t *wr_t, *win_t, *wout_t, *wgu_t, *wd_t, *XN, *PROJ, *O, *YS, *ACT, *DELTA;
};
__device__ __forceinline__ float wave_sum(float v) {
#pragma unroll
    for (int o = 1; o < 64; o <<= 1) v += __shfl_xor(v, o);
    return v;
}

struct P0Item { const float* W; bf16_t* WT; int N, Kd, k0, n0, drow0, gains, fp8; };
__device__ __forceinline__ bool p0_item(const Frame& F, int it, P0Item& I) {
    constexpr int I_IN = 16 * (DIN / 32), I_OUT = 16 * (DM / 32), I_GU1 = 16 * (2 * DFF / 32), I_GU = NE * I_GU1, I_D1 = (DFF / 64) * (DM / 32), I_D = NE * I_D1;
    if (it >= I_IN + I_OUT + I_GU + I_D) return false;
    int r = it; I.gains = 0; I.fp8 = 0;
    if (r < I_IN) { const int nb = r % (DIN / 32), kb = r / (DIN / 32); I.W = F.w_in; I.WT = F.win_t; I.N = DIN; I.Kd = DM; I.k0 = kb * 64; I.n0 = nb * 32; I.drow0 = nb * 32; return true; } r -= I_IN;
    if (r < I_OUT) { const int nb = r % (DM / 32), kb = r / (DM / 32); I.W = F.w_out; I.WT = F.wout_t; I.N = DM; I.Kd = DM; I.k0 = kb * 64; I.n0 = nb * 32; I.drow0 = nb * 32; I.gains = 1; return true; } r -= I_OUT;
    if (r < I_GU) { const int e = r / I_GU1, q = r % I_GU1, nb = q % (2 * DFF / 32), kb = q / (2 * DFF / 32), n0 = nb * 32, f = n0 & (DFF - 1);
        I.W = F.w_gu + (size_t)e * DM * 2 * DFF; I.WT = (bf16_t*)((unsigned char*)F.wgu_t + (size_t)e * 2 * DFF * DM); I.N = 2 * DFF; I.Kd = DM; I.k0 = kb * 64; I.n0 = n0; I.drow0 = (f >> 7) * 256 + (n0 >= DFF ? 128 : 0) + (f & 127); I.fp8 = 1; return true; } r -= I_GU;
    { const int e = r / I_D1, q = r % I_D1, nb = q % (DM / 32), kb = q / (DM / 32);
        I.W = F.w_down + (size_t)e * DFF * DM; I.WT = (bf16_t*)((unsigned char*)F.wd_t + (size_t)e * DM * DFF); I.N = DM; I.Kd = DFF; I.k0 = kb * 64; I.n0 = nb * 32; I.drow0 = nb * 32; I.fp8 = 1; return true; }
}
__device__ __forceinline__ void p0_load(const P0Item& I, f32x4 (&w)[8], int lane) {
#pragma unroll
    for (int i = 0; i < 8; ++i) w[i] = __builtin_nontemporal_load((const GAS f32x4*)(I.W + (size_t)(I.k0 + 8 * i + (lane >> 3)) * I.N + I.n0 + 4 * (lane & 7)));
}
__device__ __forceinline__ void p0_finish(const Frame& F, const P0Item& I, const f32x4 (&w)[8], LAS float* scr, int lane) {
#pragma unroll
    for (int i = 0; i < 8; ++i) { const int kk = 8 * i + (lane >> 3), nn = 4 * (lane & 7); f32x4 v = w[i];
        if (I.gains) { const int k = I.k0 + kk; v = v * (k < 512 ? F.ga[k] : F.gb[k - 512]); }
        scr[kk * 33 + nn] = v.x; scr[kk * 33 + nn + 1] = v.y; scr[kk * 33 + nn + 2] = v.z; scr[kk * 33 + nn + 3] = v.w; }
    LDS_WAIT(); asm volatile("" ::: "memory");
    const int c = lane & 7;
#pragma unroll
    for (int j = 0; j < 4; ++j) { const int n = (lane >> 3) + 8 * j; const LAS float* s = scr + (8 * c) * 33 + n;
        if (I.fp8) { u32x2 o; o.x = pk_fp8x4(s[0 * 33] * W8_SCALE, s[1 * 33] * W8_SCALE, s[2 * 33] * W8_SCALE, s[3 * 33] * W8_SCALE); o.y = pk_fp8x4(s[4 * 33] * W8_SCALE, s[5 * 33] * W8_SCALE, s[6 * 33] * W8_SCALE, s[7 * 33] * W8_SCALE);
            *(GAS u32x2*)((unsigned char*)I.WT + (size_t)(I.drow0 + n) * I.Kd + I.k0 + 8 * c) = o; }
        else { u32x4 o; o.x = pk2(s[0 * 33], s[1 * 33]); o.y = pk2(s[2 * 33], s[3 * 33]); o.z = pk2(s[4 * 33], s[5 * 33]); o.w = pk2(s[6 * 33], s[7 * 33]);
            *(GAS u32x4*)(I.WT + (size_t)(I.drow0 + n) * I.Kd + I.k0 + 8 * c) = o; } }
    LDS_WAIT(); asm volatile("" ::: "memory");
}
__device__ __forceinline__ void p0_prologue(Frame& F) {
    const int gt = blockIdx.x * (NWAVES * 64) + F.tid;
    if (blockIdx.x < 6 * DM / 32) {
        LAS float* sc = (LAS float*)F.lds;
        LAS float* red = (LAS float*)(F.lds + 32768);
        for (int i = F.tid; i < NB * DM; i += NWAVES * 64) { const float v = F.c[i]; sc[i] = v / (1.f + __expf(-v)); }
        const int c4 = F.tid & 7, ks = F.tid >> 3, n0 = blockIdx.x * 32;
        f32x4 w[16];
#pragma unroll
        for (int q = 0; q < 16; ++q) w[q] = __builtin_nontemporal_load((const GAS f32x4*)(F.w_ada + (size_t)(ks * 16 + q) * 6 * DM + n0 + 4 * c4));
        __syncthreads();
        f32x4 a[NB];
#pragma unroll
        for (int b = 0; b < NB; ++b) a[b] = (f32x4){0.f, 0.f, 0.f, 0.f};
#pragma unroll
        for (int q = 0; q < 16; ++q)
#pragma unroll
            for (int b = 0; b < NB; ++b) a[b] += w[q] * sc[b * DM + ks * 16 + q];
#pragma unroll
        for (int b = 0; b < NB; ++b) *(LAS f32x4*)(red + (ks * NB + b) * 32 + 4 * c4) = a[b];
        __syncthreads();
        if (F.tid < 256) { const int b = F.tid >> 5, col = F.tid & 31; float s = F.b_ada[n0 + col];
#pragma unroll 8
            for (int q = 0; q < 64; ++q) s += red[(q * NB + b) * 32 + col];
            F.mod[b * 6 * DM + n0 + col] = s; }
        __syncthreads();
    }
    if (gt < SEQ * 8) {
        const int pos = gt >> 3, i = gt & 7;
        const float invf[8] = {1.0f, 0.1939227432012558f, 0.03760603070259094f, 0.007292664609849453f, 0.0014142135623842478f, 0.00027424818836152554f, 5.3182957344688475e-05f, 1.0313385246263351e-05f};
        float inv = invf[0];
#pragma unroll
        for (int q = 1; q < 8; ++q) inv = (i == q) ? invf[q] : inv;
        const float angf = (float)pos * inv;
        const double ang = (double)angf, twopi = 6.283185307179586476925287;
        const double r = ang - __builtin_rint(ang / twopi) * twopi, r2 = r * r;
        double cs = 1.0, sn = r, tc = 1.0, ts = r;
#pragma unroll 1
        for (int q = 1; q <= 20; ++q) { tc = -tc * r2 / (double)((2 * q - 1) * (2 * q)); ts = -ts * r2 / (double)((2 * q) * (2 * q + 1)); cs += tc; sn += ts; }
        F.rope[gt] = (float)cs; F.rope[SEQ * 8 + gt] = (float)sn;
    }
    if (gt < NE * DM) { const int e = gt >> 10, k = gt & 1023; const float w = F.w_router[k * NE + e]; const unsigned hi = f2bf(w); const unsigned lo = f2bf(w - bf2f(hi));
        F.wr_t[gt] = (bf16_t)hi; F.wr_t[NE * DM + gt] = (bf16_t)lo; }
    if (gt < NTOK * 2) F.ssq[gt] = 0.f;
    LAS float* scr = (LAS float*)(F.lds + F.wave * 16384);
    const int gw = F.vcu * NWAVES + F.wave, NGW = F.G * NWAVES;
    P0Item Ia, Ib; f32x4 wa[8], wb[8];
    bool ha = p0_item(F, gw, Ia), hb;
    if (ha) p0_load(Ia, wa, F.lane);
#pragma unroll 1
    for (int it = gw; ha; it += 2 * NGW) {
        hb = p0_item(F, it + NGW, Ib); if (hb) p0_load(Ib, wb, F.lane);
        p0_finish(F, Ia, wa, scr, F.lane);
        ha = p0_item(F, it + 2 * NGW, Ia); if (ha) p0_load(Ia, wa, F.lane);
        if (hb) p0_finish(F, Ib, wb, scr, F.lane);
    }
}
__device__ __forceinline__ void p1_row(const f32x4 (&v)[4], bf16_t* orow, const f32x4 (&s1)[4], const f32x4 (&sh)[4], int lane) {
    float s = 0.f;
#pragma unroll
    for (int j = 0; j < 4; ++j) s += (v[j].x * v[j].x + v[j].y * v[j].y) + (v[j].z * v[j].z + v[j].w * v[j].w);
    const float rstd = 1.f / sqrtf(wave_sum(s) * (1.f / DM) + EPS);
    GAS unsigned long long* o8 = (GAS unsigned long long*)orow + lane;
#pragma unroll
    for (int j = 0; j < 4; ++j) { const f32x4 h = v[j] * rstd * s1[j] + sh[j];
        o8[64 * j] = (unsigned long long)pk2(h.x, h.y) | ((unsigned long long)pk2(h.z, h.w) << 32); }
}
__device__ __forceinline__ void p1_xn(Frame& F) {
    const int gw = F.vcu * NWAVES + F.wave, NGW = F.G * NWAVES, lane = F.lane;
    for (int chunk = gw; chunk < NTOK / 16; chunk += NGW) {
        const int m0 = chunk * 16, b = m0 / SEQ;
        f32x4 s1[4], sh[4];
#pragma unroll
        for (int j = 0; j < 4; ++j) { s1[j] = *(const GAS f32x4*)(F.mod + b * 6 * DM + DM + 4 * lane + 256 * j) + 1.0f; sh[j] = *(const GAS f32x4*)(F.mod + b * 6 * DM + 4 * lane + 256 * j); }
        f32x4 va[4], vb[4], vc[4];
#define P1_LOAD(dst, r) do { const GAS f32x4* xr_ = (const GAS f32x4*)(F.x + (size_t)(m0 + (r)) * DM) + lane; _Pragma("unroll") for (int j = 0; j < 4; ++j) dst[j] = __builtin_nontemporal_load(xr_ + 64 * j); } while (0)
        P1_LOAD(va, 0); P1_LOAD(vb, 1);
#pragma unroll 1
        for (int r = 0; r < 15; r += 3) {
            P1_LOAD(vc, r + 2); p1_row(va, F.XN + (size_t)(m0 + r) * DM, s1, sh, lane);
            P1_LOAD(va, r + 3); p1_row(vb, F.XN + (size_t)(m0 + r + 1) * DM, s1, sh, lane);
            if (r + 4 < 16) P1_LOAD(vb, r + 4); p1_row(vc, F.XN + (size_t)(m0 + r + 2) * DM, s1, sh, lane);
        }
        p1_row(va, F.XN + (size_t)(m0 + 15) * DM, s1, sh, lane);
#undef P1_LOAD
    }
}
struct EpiProj {
    static constexpr bool PERM = true, MID = false, FP8 = false; static constexpr int WIDE = 1;
    bf16_t* O; const float* rope;
    __device__ __forceinline__ void mid(f32x4 (&)[2][2][4][2], const pg8::Unit&, int, int) const {}
    __device__ __forceinline__ void init(f32x4 (&i)[2][2], int, int, int) const { i[0][0] = i[0][1] = i[1][0] = i[1][1] = (f32x4){0.f, 0.f, 0.f, 0.f}; }
    __device__ __forceinline__ void operator()(const f32x4 (&acc)[2][2][4][2], const pg8::Unit& u, int, int wr, int wc, int fr, int fq) const {
        const int row0 = u.pm * 256 + wr * 64 + fr, col0 = u.pn * 256 + wc * 64 + 8 * fq;
        const float sc = (u.pn < 2 || u.pn == 3 || u.pn == 4) ? C2 : 1.f;
#pragma unroll
        for (int ai = 0; ai < 2; ++ai)
#pragma unroll
            for (int m = 0; m < 4; ++m) { const int row = row0 + ai * 128 + m * 16; bf16_t* rowp = O + (size_t)row * DIN + col0;
#pragma unroll
                for (int bj = 0; bj < 2; ++bj) { f32x4 v0 = acc[ai][bj][m][0], v1 = acc[ai][bj][m][1];
                    const bool rope_tile = (u.pn < 2) || (u.pn == 2 && wc < 2);
                    if (rope_tile && bj == 0) {
                        f32x4 o0, o1;
#pragma unroll
                        for (int q = 0; q < 4; ++q) { o0[q] = __shfl_xor(v0[q], 16); o1[q] = __shfl_xor(v1[q], 16); }
                        if (fq < 2) { const int pos = row & (SEQ - 1);
                            const f32x4 c0 = *(const GAS f32x4*)(rope + pos * 8), c1 = *(const GAS f32x4*)(rope + pos * 8 + 4);
                            const f32x4 s0 = *(const GAS f32x4*)(rope + SEQ * 8 + pos * 8), s1 = *(const GAS f32x4*)(rope + SEQ * 8 + pos * 8 + 4);
                            const float sg = fq == 0 ? -1.f : 1.f;
                            v0 = v0 * c0 + (o0 * sg) * s0; v1 = v1 * c1 + (o1 * sg) * s1; }
                    }
                    v0 = v0 * sc; v1 = v1 * sc;
                    u32x4 w; w.x = cvt_pk_bf16(v0[0], v0[1]); w.y = cvt_pk_bf16(v0[2], v0[3]); w.z = cvt_pk_bf16(v1[0], v1[1]); w.w = cvt_pk_bf16(v1[2], v1[3]);
                    *(GAS u32x4*)(rowp + bj * 32) = w; } }
    }
};
__device__ __forceinline__ int crow(int r, int hi) { return (r & 3) + 8 * (r >> 2) + 4 * hi; }
typedef short v4i16_t __attribute__((ext_vector_type(4)));
__device__ __forceinline__ v4i16_t vtr(const LAS unsigned char* p) { return __builtin_amdgcn_ds_read_tr16_b64_v4i16((LAS v4i16_t*)p); }
__device__ __forceinline__ float max3f(float a, float b, float c) { return __builtin_fmaxf(__builtin_fmaxf(a, b), c); }
__device__ __forceinline__ void dma_k(const bf16_t* Ktile  , LAS unsigned char* slot, int p, int lane) {
    const int row = 8 * p + (lane >> 3), ch = (lane & 7) ^ ((row >> 1) & 7);
    __builtin_amdgcn_global_load_lds((const unsigned*)(Ktile + (size_t)row * DIN + ch * 8), (LAS unsigned*)(slot + p * 1024), 16, 0, 0);
}
__device__ __forceinline__ void dma_v(const bf16_t* Vtile, LAS unsigned char* slot, int p, int lane) {
    __builtin_amdgcn_global_load_lds((const unsigned*)(Vtile + (size_t)(8 * p + ((lane >> 2) & 7)) * DIN + (lane >> 5) * 32 + (lane & 3) * 8), (LAS unsigned*)(slot + p * 1024), 16, 0, 0);
}
struct AttnState { float m, l; f32x16 o[2]; };
template <class MB>
__device__ __forceinline__ void attn_tile(const LAS unsigned char* Ks, const LAS unsigned char* Vs, const bf16x8 (&qr)[4], AttnState& st, int r32, int hi, int lane, const MB& mb) {
    f32x16 p0, p1;
#pragma unroll
    for (int r = 0; r < 16; ++r) { p0[r] = 0.f; p1[r] = 0.f; }
    const LAS unsigned char* kb = Ks + r32 * 128; const int sw = (r32 >> 1) & 7;
#pragma unroll
    for (int d0 = 0; d0 < 4; ++d0) {
        const int ko = ((2 * d0 + hi) ^ sw) << 4;
        const bf16x8 a0 = *(const LAS bf16x8*)(kb + ko), a1 = *(const LAS bf16x8*)(kb + ko + 4096);
        p0 = __builtin_amdgcn_mfma_f32_32x32x16_bf16(a0, qr[d0], p0, 0, 0, 0);
        p1 = __builtin_amdgcn_mfma_f32_32x32x16_bf16(a1, qr[d0], p1, 0, 0, 0);
    }
    mb(p0, p1, r32, hi);
    float a = max3f(p0[0], p0[1], p1[0]), b = max3f(p0[2], p0[3], p1[1]); a = max3f(a, p1[2], p1[3]);
#pragma unroll
    for (int r = 4; r < 16; r += 4) { a = max3f(a, p0[r], p0[r + 1]); b = max3f(b, p0[r + 2], p0[r + 3]); a = max3f(a, p1[r], p1[r + 1]); b = max3f(b, p1[r + 2], p1[r + 3]); }
    float rm = __builtin_fmaxf(a, b);
    rm = __builtin_fmaxf(rm, __shfl_xor(rm, 32));
    if (__any(rm > st.m + 8.0f)) {
        const float mn = __builtin_fmaxf(st.m, rm), f = __builtin_amdgcn_exp2f(st.m - mn);
        st.m = mn; st.l *= f;
#pragma unroll
        for (int r = 0; r < 16; ++r) { st.o[0][r] *= f; st.o[1][r] *= f; }
    }
    const float mref = st.m;
    float ls = 0.f;
#pragma unroll
    for (int r = 0; r < 16; ++r) { p0[r] = __builtin_amdgcn_exp2f(p0[r] - mref); p1[r] = __builtin_amdgcn_exp2f(p1[r] - mref); ls += p0[r] + p1[r]; }
    st.l += ls;
    u32x4 pw[4];
#pragma unroll
    for (int q = 0; q < 4; ++q) { pw[0][q] = cvt_pk_bf16(p0[2 * q], p0[2 * q + 1]); pw[1][q] = cvt_pk_bf16(p0[8 + 2 * q], p0[8 + 2 * q + 1]);
                                  pw[2][q] = cvt_pk_bf16(p1[2 * q], p1[2 * q + 1]); pw[3][q] = cvt_pk_bf16(p1[8 + 2 * q], p1[8 + 2 * q + 1]); }
    const LAS unsigned char* vb = Vs + ((lane >> 4) & 1) * 32 + (lane & 3) * 8 + (4 * hi + ((lane & 15) >> 2)) * 64;
#pragma unroll
    for (int d0 = 0; d0 < 2; ++d0)
#pragma unroll
        for (int s = 0; s < 4; ++s) {
            const v4i16_t lo = vtr(vb + d0 * 512 + s * 2048), hh = vtr(vb + d0 * 512 + s * 2048 + 1024);
            const bf16x8 vf = (bf16x8){lo[0], lo[1], lo[2], lo[3], hh[0], hh[1], hh[2], hh[3]};
            st.o[d0] = __builtin_amdgcn_mfma_f32_32x32x16_bf16(vf, __builtin_bit_cast(bf16x8, pw[s]), st.o[d0], 0, 0, 0);
        }
}
__device__ __forceinline__ void attn_finish(AttnState& st, LAS unsigned char* stg, bf16_t* Obase  , float* ssqp  , int r32, int hi, int lane) {
    float l = st.l; l += __shfl_xor(l, 32);
    const float inv = 1.0f / l;
    float sq = 0.f;
#pragma unroll
    for (int d0 = 0; d0 < 2; ++d0)
#pragma unroll
        for (int rg = 0; rg < 4; ++rg) {
            const float v0 = st.o[d0][4 * rg] * inv, v1 = st.o[d0][4 * rg + 1] * inv, v2 = st.o[d0][4 * rg + 2] * inv, v3 = st.o[d0][4 * rg + 3] * inv;
            sq += (v0 * v0 + v1 * v1) + (v2 * v2 + v3 * v3);
            u32x2 w; w.x = cvt_pk_bf16(v0, v1); w.y = cvt_pk_bf16(v2, v3);
            const int ch = 4 * d0 + rg;
            *(LAS u32x2*)(stg + r32 * 128 + ((ch ^ (r32 & 7)) << 4) + hi * 8) = w;
        }
    sq += __shfl_xor(sq, 32);
    if (hi == 0) atomicAdd(ssqp + r32 * 2, sq);
    asm volatile("s_waitcnt lgkmcnt(0)" ::: "memory");
#pragma unroll
    for (int i = 0; i < 4; ++i) { const int row = i * 8 + (lane >> 3), ch = lane & 7;
        const u32x4 v = *(const LAS u32x4*)(stg + row * 128 + ((ch ^ (row & 7)) << 4));
        *(GAS u32x4*)(Obase + (size_t)row * DM + ch * 8) = v; }
}
struct MbNone { __device__ __forceinline__ void operator()(f32x16&, f32x16&, int, int) const {} };
struct MbBandLo { int qi;
    __device__ __forceinline__ void operator()(f32x16& p0, f32x16& p1, int, int hi) const {
#pragma unroll
        for (int r = 0; r < 16; ++r) { const int kj = crow(r, hi); p0[r] = (kj >= qi) ? p0[r] : -1e30f; p1[r] = (kj + 32 >= qi) ? p1[r] : -1e30f; } } };
struct MbBandHi { int qi;
    __device__ __forceinline__ void operator()(f32x16& p0, f32x16& p1, int, int hi) const {
#pragma unroll
        for (int r = 0; r < 16; ++r) { const int kj = crow(r, hi); p0[r] = (kj <= qi) ? p0[r] : -1e30f; p1[r] = (kj + 32 <= qi) ? p1[r] : -1e30f; } } };
struct MbNeigh { const LAS float* base; const float* ma;
    __device__ __forceinline__ void operator()(f32x16& p0, f32x16& p1, int, int) const {
#pragma unroll
        for (int r = 0; r < 16; ++r) { const int o = (r & 3) + 8 * (r >> 2); p0[r] = (p0[r] + base[o]) + ma[r]; p1[r] = (p1[r] + base[o + 32]) + ma[16 + r]; } } };

__device__ __forceinline__ void attn_a_phase(Frame& F, float* ssq) {
    const int wave = F.wave, lane = F.lane, r32 = lane & 31, hi = lane >> 5, g = wave >> 1, qh = wave & 1;
    constexpr int NQB = SEQ / 64, VOFF = 49152;
    for (int run = F.vcu; run < NB * AKVH * (NQB / 4); run += F.G) {
        const int quad = run % (NQB / 4), kvh = (run / (NQB / 4)) % AKVH, b = run / ((NQB / 4) * AKVH);
        const int j0 = quad * 4, h = kvh * 4 + g;
        const bf16_t* base = F.PROJ + (size_t)b * SEQ * DIN;
        const float sink2 = F.sink[h] * LOG2E;
#define AT_DMA(k) do { const int _s = (((k) + 6) % 6) * 8192; const bf16_t* _r = base + (size_t)((k) * 64) * DIN; \
        dma_k(_r + OFF_KA + kvh * HD, F.lds + _s, wave, lane); dma_v(_r + OFF_VA + kvh * HD, F.lds + VOFF + _s, wave, lane); } while (0)
        asm volatile("s_waitcnt lgkmcnt(0)" ::: "memory"); __builtin_amdgcn_s_barrier();
#pragma unroll
        for (int k = -2; k <= 2; ++k) { if (j0 + k >= 0 && j0 + k < NQB) AT_DMA(j0 + k); }
        bf16x8 qr[4];
        { const bf16_t* qp = base + (size_t)(j0 * 64 + qh * 32 + r32) * DIN + OFF_QA + h * HD + hi * 8;
#pragma unroll
          for (int d0 = 0; d0 < 4; ++d0) qr[d0] = *(const GAS bf16x8*)(qp + d0 * 16); }
#pragma unroll 1
        for (int i = 0; i < 4; ++i) {
            const int j = j0 + i, q0 = j * 64;
            if (i > 0) { asm volatile("s_waitcnt lgkmcnt(0)" ::: "memory"); __builtin_amdgcn_s_barrier(); }
            const bool pf = (i < 3) && (j + 3 < NQB);
            if (pf) AT_DMA(j + 3);
            bf16x8 qn[4];
            if (i < 3) { const bf16_t* qp = base + (size_t)((j + 1) * 64 + qh * 32 + r32) * DIN + OFF_QA + h * HD + hi * 8;
#pragma unroll
                for (int d0 = 0; d0 < 4; ++d0) qn[d0] = *(const GAS bf16x8*)(qp + d0 * 16); }
            if (i == 0) { if (pf) asm volatile("s_waitcnt vmcnt(6)" ::: "memory"); else asm volatile("s_waitcnt vmcnt(4)" ::: "memory"); }
            else if (i < 3) { if (pf) asm volatile("s_waitcnt vmcnt(6)" ::: "memory"); else asm volatile("s_waitcnt vmcnt(4)" ::: "memory"); }
            else asm volatile("s_waitcnt vmcnt(0)" ::: "memory");
            __builtin_amdgcn_s_barrier();
            AttnState st; st.m = sink2; st.l = (hi == 0) ? 1.f : 0.f;
#pragma unroll
            for (int r = 0; r < 16; ++r) { st.o[0][r] = 0.f; st.o[1][r] = 0.f; }
            const int qi = qh * 32 + r32;
#define AT_SLOT(k) (F.lds + (((k) + 6) % 6) * 8192)
            if (j - 2 >= 0) attn_tile(AT_SLOT(j - 2), AT_SLOT(j - 2) + VOFF, qr, st, r32, hi, lane, MbBandLo{qi});
            if (j - 1 >= 0) attn_tile(AT_SLOT(j - 1), AT_SLOT(j - 1) + VOFF, qr, st, r32, hi, lane, MbNone{});
            attn_tile(AT_SLOT(j), AT_SLOT(j) + VOFF, qr, st, r32, hi, lane, MbNone{});
            if (j + 1 < NQB) attn_tile(AT_SLOT(j + 1), AT_SLOT(j + 1) + VOFF, qr, st, r32, hi, lane, MbNone{});
            if (j + 2 < NQB) attn_tile(AT_SLOT(j + 2), AT_SLOT(j + 2) + VOFF, qr, st, r32, hi, lane, MbBandHi{qi});
            const int tok0 = b * SEQ + q0 + qh * 32;
            attn_finish(st, F.lds + 98304 + wave * 4096, F.O + (size_t)tok0 * DM + h * HD, ssq + tok0 * 2, r32, hi, lane);
            if (i < 3) {
#pragma unroll
                for (int d0 = 0; d0 < 4; ++d0) qr[d0] = qn[d0]; }
        }
#undef AT_DMA
#undef AT_SLOT
    }
}
constexpr int NTAB_OFF = LDSCTL_OFF + 2048;
struct NaUnit { int b, head, r0, R0, nst; };
__device__ __forceinline__ bool na_unit(int u, NaUnit& U) {
    if (u >= NB * BH * (GW / 4)) return false;
    const int rg = u % (GW / 4); U.head = (u / (GW / 4)) % BH; U.b = u / ((GW / 4) * BH); U.r0 = rg * 4;
    U.R0 = min(max(U.r0 - NAR / 2, 0), GW - NAR); U.nst = min(max(U.r0 + 3 - NAR / 2, 0), GW - NAR) + NAR - U.R0; return true;
}
__device__ __forceinline__ void attn_b_phase(Frame& F, float* ssq) {
    const int wave = F.wave, lane = F.lane, r32 = lane & 31, hi = lane >> 5, rw = wave >> 1, qh = wave & 1;
    LAS float* tab = (LAS float*)(F.lds + NTAB_OFF);
    const int qc = qh * 32 + r32, cs = min(max(qc - NAC / 2, 0), GW - NAC);
    float ma[32];
#pragma unroll
    for (int q = 0; q < 16; ++q) { const int kc = crow(q, hi); ma[q] = (kc >= cs && kc < cs + 16) ? 0.f : -1e30f; ma[16 + q] = (kc + 32 >= cs && kc + 32 < cs + 16) ? 0.f : -1e30f; }
    NaUnit U, Un; int u = F.vcu;
    if (!na_unit(u, U)) return;
    int gs = 0;
#define NB_DMA(UU, t, pos) do { const int _bs = ((pos) & 3) * 16384; const bf16_t* _kr = F.PROJ + ((size_t)(UU).b * SEQ + (size_t)((UU).R0 + (t)) * GW) * DIN; \
        dma_k(_kr + OFF_KB + (UU).head * HD, F.lds + _bs, wave, lane); dma_v(_kr + OFF_VB + (UU).head * HD, F.lds + _bs + 8192, wave, lane); } while (0)
#define NB_QLOAD(dst, UU) do { const bf16_t* _qp = F.PROJ + ((size_t)(UU).b * SEQ + (size_t)((UU).r0 + rw) * GW + qc) * DIN + OFF_QB + (UU).head * HD + hi * 8; \
        _Pragma("unroll") for (int d0 = 0; d0 < 4; ++d0) dst[d0] = *(const GAS bf16x8*)(_qp + d0 * 16); } while (0)
    asm volatile("s_waitcnt lgkmcnt(0)" ::: "memory"); __builtin_amdgcn_s_barrier();
    NB_DMA(U, 0, 0); NB_DMA(U, 1, 1); NB_DMA(U, 2, 2);
    bf16x8 qr[4], qn[4];
    NB_QLOAD(qr, U);
    int cur_head = -1;
    for (;;) {
        const bool has_next = na_unit(u + F.G, Un);
        const int r = U.r0 + rw, rs = min(max(r - NAR / 2, 0), GW - NAR);
        if (U.head != cur_head) {
            cur_head = U.head;
            for (int i = F.tid; i < 15 * 128; i += NWAVES * 64) { const int d = (i & 127) - 63, ro = i >> 7;
                tab[i] = (d >= -15 && d <= 15) ? F.rpb[(U.head * 15 + ro) * 31 + d + 15] * LOG2E : 0.f; }
            asm volatile("s_waitcnt lgkmcnt(0)" ::: "memory"); }
        AttnState st; st.m = -1e30f; st.l = 0.f;
#pragma unroll
        for (int q = 0; q < 16; ++q) { st.o[0][q] = 0.f; st.o[1][q] = 0.f; }
#pragma unroll 1
        for (int t = 0; t < U.nst; ++t, ++gs) {
            const int ahead = (t + 2 < U.nst || has_next) ? 2 : (U.nst - 1 - t);
            if (ahead >= 2) asm volatile("s_waitcnt vmcnt(4)" ::: "memory"); else if (ahead == 1) asm volatile("s_waitcnt vmcnt(2)" ::: "memory"); else asm volatile("s_waitcnt vmcnt(0)" ::: "memory");
            asm volatile("s_waitcnt lgkmcnt(0)" ::: "memory"); __builtin_amdgcn_s_barrier(); asm volatile("" ::: "memory");
            if (t + 3 < U.nst) NB_DMA(U, t + 3, gs + 3);
            else if (has_next) NB_DMA(Un, t + 3 - U.nst, gs + 3);
            if (t == U.nst - 1 && has_next) NB_QLOAD(qn, Un);
            const int kr = U.R0 + t;
            if (kr >= rs && kr < rs + NAR) {
                const LAS unsigned char* ks = F.lds + (gs & 3) * 16384;
                attn_tile(ks, ks + 8192, qr, st, r32, hi, lane, MbNeigh{tab + (kr - r + NAR - 1) * 128 + (63 - qc + 4 * hi), ma});
            }
        }
        const int tok0 = U.b * SEQ + r * GW + qh * 32;
        attn_finish(st, F.lds + 65536 + wave * 4096, F.O + (size_t)tok0 * DM + AQW + U.head * HD, ssq + tok0 * 2 + 1, r32, hi, lane);
        if (!has_next) break;
        if (Un.head != U.head) { asm volatile("s_waitcnt lgkmcnt(0)" ::: "memory"); __builtin_amdgcn_s_barrier(); }
        U = Un; u += F.G;
#pragma unroll
        for (int d0 = 0; d0 < 4; ++d0) qr[d0] = qn[d0];
    }
#undef NB_DMA
#undef NB_QLOAD
}
struct EpiX1 {
    static constexpr bool PERM = true, MID = true, FP8 = false; static constexpr int WIDE = 1;
    bf16_t* delta; const float* mod; const float* ssq;
    __device__ __forceinline__ void init(f32x4 (&i)[2][2], int, int, int) const { i[0][0] = i[0][1] = i[1][0] = i[1][1] = (f32x4){0.f, 0.f, 0.f, 0.f}; }
    __device__ __forceinline__ void mid(f32x4 (&acc)[2][2][4][2], const pg8::Unit& u, int wr, int fr) const {
#pragma unroll
        for (int ai = 0; ai < 2; ++ai)
#pragma unroll
            for (int m = 0; m < 4; ++m) { const int row = u.pm * 256 + ai * 128 + wr * 64 + m * 16 + fr;
                const f32x2 s = *(const GAS f32x2*)(ssq + row * 2);
                const float f = sqrtf((s.y * (1.f / 512.f) + EPS) / (s.x * (1.f / 512.f) + EPS));
#pragma unroll
                for (int bj = 0; bj < 2; ++bj)
#pragma unroll
                    for (int n = 0; n < 2; ++n) acc[ai][bj][m][n] *= f; }
    }
    __device__ __forceinline__ void operator()(const f32x4 (&acc)[2][2][4][2], const pg8::Unit& u, int, int wr, int wc, int fr, int fq) const {
        const int b = (u.pm * 256) / SEQ, col0 = u.pn * 256 + wc * 64 + 8 * fq;
        f32x4 gm[2][2];
#pragma unroll
        for (int bj = 0; bj < 2; ++bj)
#pragma unroll
            for (int n = 0; n < 2; ++n) gm[bj][n] = *(const GAS f32x4*)(mod + b * 6 * DM + 2 * DM + col0 + bj * 32 + 4 * n);
#pragma unroll
        for (int ai = 0; ai < 2; ++ai)
#pragma unroll
            for (int m = 0; m < 4; ++m) { const int row = u.pm * 256 + ai * 128 + wr * 64 + m * 16 + fr;
                const float rb = 1.0f / sqrtf(ssq[row * 2 + 1] * (1.f / 512.f) + EPS);
                bf16_t* rowp = delta + (size_t)row * DM + col0;
#pragma unroll
                for (int bj = 0; bj < 2; ++bj) { const f32x4 v0 = gm[bj][0] * (acc[ai][bj][m][0] * rb), v1 = gm[bj][1] * (acc[ai][bj][m][1] * rb);
                    u32x4 w; w.x = cvt_pk_bf16(v0[0], v0[1]); w.y = cvt_pk_bf16(v0[2], v0[3]); w.z = cvt_pk_bf16(v1[0], v1[1]); w.w = cvt_pk_bf16(v1[2], v1[3]);
                    *(GAS u32x4*)(rowp + bj * 32) = w; } }
    }
};

__device__ __forceinline__ void router_phase(Frame& F, gu32* cntw) {
    const int wave = F.wave, lane = F.lane, r32 = lane & 31, hi = lane >> 5;
    bf16x8 wh[8], wl[8];
#pragma unroll
    for (int c = 0; c < 8; ++c) { const bf16_t* p = F.wr_t + r32 * DM + 128 * wave + 16 * c + 8 * hi; wh[c] = *(const GAS bf16x8*)p; wl[c] = *(const GAS bf16x8*)(p + NE * DM); }
    LAS unsigned char* imgH = F.lds;
    LAS unsigned char* imgL = F.lds + 65536;
    LAS float* R = (LAS float*)(F.lds);
    LAS float* L = (LAS float*)(F.lds + NTAB_OFF);
    LAS int* lcnt = (LAS int*)(F.lds + NTAB_OFF + 4352);
    for (int it = F.vcu; it < NTOK / 32; it += F.G) {
        const int t0 = it * 32, b = t0 / SEQ;
        { f32x4 s1[4], sh[4];
#pragma unroll
          for (int j = 0; j < 4; ++j) { s1[j] = *(const GAS f32x4*)(F.mod + b * 6 * DM + 4 * DM + 4 * lane + 256 * j) + 1.0f; sh[j] = *(const GAS f32x4*)(F.mod + b * 6 * DM + 3 * DM + 4 * lane + 256 * j); }
#pragma unroll
          for (int pr = 0; pr < 2; ++pr) {
              f32x4 xv[2][4]; u32x2 dv[2][4];
#pragma unroll
              for (int tt = 0; tt < 2; ++tt) { const int tok = t0 + 4 * wave + 2 * pr + tt;
                  const GAS f32x4* xr = (const GAS f32x4*)(F.x + (size_t)tok * DM) + lane; const GAS u32x2* dr = (const GAS u32x2*)(F.DELTA + (size_t)tok * DM) + lane;
#pragma unroll
                  for (int j = 0; j < 4; ++j) { xv[tt][j] = xr[64 * j]; dv[tt][j] = dr[64 * j]; } }
#pragma unroll
              for (int tt = 0; tt < 2; ++tt) { const int tl = 4 * wave + 2 * pr + tt, tok = t0 + tl; float s = 0.f;
#pragma unroll
                  for (int j = 0; j < 4; ++j) { const u32x2 w = dv[tt][j]; xv[tt][j] += (f32x4){bf2f(w.x & 0xffffu), bf2f(w.x >> 16), bf2f(w.y & 0xffffu), bf2f(w.y >> 16)};
                      s += (xv[tt][j].x * xv[tt][j].x + xv[tt][j].y * xv[tt][j].y) + (xv[tt][j].z * xv[tt][j].z + xv[tt][j].w * xv[tt][j].w); }
                  const float rstd = 1.0f / sqrtf(wave_sum(s) * (1.f / DM) + EPS);
                  GAS unsigned* xn = (GAS unsigned*)((unsigned char*)F.XN + (size_t)tok * DM) + lane;
#pragma unroll
                  for (int j = 0; j < 4; ++j) { const f32x4 h = xv[tt][j] * rstd * s1[j] + sh[j];
                      u32x2 hw; hw.x = pk2(h.x, h.y); hw.y = pk2(h.z, h.w);
                      u32x2 lw; lw.x = pk2(h.x - bf2f(hw.x & 0xffffu), h.y - bf2f(hw.x >> 16)); lw.y = pk2(h.z - bf2f(hw.y & 0xffffu), h.w - bf2f(hw.y >> 16));
                      xn[64 * j] = pk_fp8x4(h.x, h.y, h.z, h.w);
                      const int off = tl * 2048 + ((((lane >> 1) + 32 * j) ^ (tl & 15)) << 4) + (lane & 1) * 8;
                      *(LAS u32x2*)(imgH + off) = hw; *(LAS u32x2*)(imgL + off) = lw; } } } }
        asm volatile("s_waitcnt lgkmcnt(0)" ::: "memory"); __builtin_amdgcn_s_barrier(); asm volatile("" ::: "memory");
        f32x16 acc;
#pragma unroll
        for (int r = 0; r < 16; ++r) acc[r] = 0.f;
#pragma unroll
        for (int c = 0; c < 8; ++c) { const int off = r32 * 2048 + (((16 * wave + 2 * c + hi) ^ (r32 & 15)) << 4);
            const bf16x8 hf = *(const LAS bf16x8*)(imgH + off), lf = *(const LAS bf16x8*)(imgL + off);
            acc = __builtin_amdgcn_mfma_f32_32x32x16_bf16(hf, wh[c], acc, 0, 0, 0);
            acc = __builtin_amdgcn_mfma_f32_32x32x16_bf16(lf, wh[c], acc, 0, 0, 0);
            acc = __builtin_amdgcn_mfma_f32_32x32x16_bf16(hf, wl[c], acc, 0, 0, 0);
        }
        asm volatile("s_waitcnt lgkmcnt(0)" ::: "memory"); __builtin_amdgcn_s_barrier(); asm volatile("" ::: "memory");
#pragma unroll
        for (int r = 0; r < 16; ++r) R[wave * 1024 + crow(r, hi) * 32 + r32] = acc[r];
        asm volatile("s_waitcnt lgkmcnt(0)" ::: "memory"); __builtin_amdgcn_s_barrier(); asm volatile("" ::: "memory");
#pragma unroll
        for (int q = 0; q < 2; ++q) { const int idx = F.tid * 2 + q, tk = idx >> 5, e = idx & 31; float v = F.b_router[e];
#pragma unroll
            for (int w = 0; w < 8; ++w) v += R[w * 1024 + idx];
            L[tk * 33 + e] = v; }
        asm volatile("s_waitcnt lgkmcnt(0)" ::: "memory"); __builtin_amdgcn_s_barrier(); asm volatile("" ::: "memory");
        if (wave == 0) {
            if (lane < 32) lcnt[lane] = 0;
            asm volatile("s_waitcnt lgkmcnt(0)" ::: "memory");
            int sel[TOPK]; float gt[TOPK]; int lpos[TOPK];
            if (lane < 32) {
                float v[NE];
#pragma unroll
                for (int j = 0; j < NE; ++j) v[j] = L[lane * 33 + j];
                unsigned used = 0u; float sv[TOPK];
#pragma unroll
                for (int kk = 0; kk < TOPK; ++kk) { float best = -INFINITY; int bi = 0;
#pragma unroll
                    for (int j = 0; j < NE; ++j) { const bool ok = !((used >> j) & 1u) && (v[j] > best); best = ok ? v[j] : best; bi = ok ? j : bi; }
                    used |= 1u << bi; sel[kk] = bi; sv[kk] = best; }
                float den = 0.f;
#pragma unroll
                for (int kk = 0; kk < TOPK; ++kk) { gt[kk] = __expf(sv[kk] - sv[0]); den += gt[kk]; }
                const float rden = 1.0f / den;
#pragma unroll
                for (int kk = 0; kk < TOPK; ++kk) { gt[kk] *= rden; lpos[kk] = __hip_atomic_fetch_add(lcnt + sel[kk], 1, __ATOMIC_RELAXED, __HIP_MEMORY_SCOPE_WORKGROUP); }
            }
            asm volatile("s_waitcnt lgkmcnt(0)" ::: "memory");
            if (lane < 32) { const int n = lcnt[lane]; int base = 0;
                if (n > 0) base = (int)__hip_atomic_fetch_add((unsigned*)(cntw + lane * 64), (unsigned)n, __ATOMIC_RELAXED, __HIP_MEMORY_SCOPE_AGENT);
                lcnt[32 + lane] = base; }
            asm volatile("s_waitcnt vmcnt(0) lgkmcnt(0)" ::: "memory");
            if (lane < 32) {
                const int t = t0 + lane;
#pragma unroll
                for (int kk = 0; kk < TOPK; ++kk) { const int e = sel[kk], pos = lcnt[32 + e] + lpos[kk];
                    F.tkg[t * 4 + kk] = gt[kk]; F.list[e * NTOK + pos] = t * 4 + kk; }
            }
        }
    }
}

__device__ __forceinline__ void moe_table(Frame& F) {
    LAS int* tab = (LAS int*)(F.lds + TAB_OFF);
    if (F.tid == 0) { int s = 0;
        for (int e = 0; e < NE; ++e) { const int c = (int)__hip_atomic_load((unsigned*)(F.ctl + CW_CNT + e * 64), __ATOMIC_RELAXED, __HIP_MEMORY_SCOPE_AGENT); tab[e] = s; tab[40 + e] = c; s += (c + 255) >> 8; }
        tab[32] = s; }
    asm volatile("s_waitcnt vmcnt(0) lgkmcnt(0)" ::: "memory"); __syncthreads();
}
constexpr int META_OFF = NTAB_OFF, META_SLOT = 2048;
template <bool GATHER>
struct MoeOrder {
    const char* A; const char* Bt; const int* list; const float* bias; const LAS int* tab; LAS unsigned char* meta; int K, N, nN, G, c;
    mutable int ec;
    __device__ bool next(int i, pg8::Unit& u) const {
        const int L = i * G + c; if (L >= tab[32] * nN) return false;
        int e = ec;
#pragma unroll 1
        while (L >= tab[e + 1] * nN) ++e;
        ec = e;
        const int nm = tab[e + 1] - tab[e], ql = L - tab[e] * nN;
        u.e = e; u.pn = ql / nm; u.aux = ql % nm; u.pm = tab[e] + u.aux; return true;
    }
    __device__ __forceinline__ const char* abase() const { return A; }
    __device__ __forceinline__ const char* bbase(const pg8::Unit& u) const { return Bt + ((size_t)u.e * N + (size_t)u.pn * 256) * K; }
    __device__ __forceinline__ void dma_list(const pg8::Unit& u, int slot) const {
        const int lane = lane_id();
        __builtin_amdgcn_global_load_lds((const unsigned*)(list + (size_t)u.e * NTOK + u.aux * 256 + 4 * lane), (LAS unsigned*)(meta + slot * META_SLOT), 16, 0, 0);
    }
    __device__ __forceinline__ void dma_bias(const pg8::Unit& u, int slot) const {
        const int lane = lane_id();
        const float* src = GATHER ? bias + (size_t)u.e * 2 * DFF + u.pn * 128 + (lane >> 5) * DFF + 4 * (lane & 31) : bias + (size_t)u.e * DM + u.pn * 256 + 4 * lane;
        __builtin_amdgcn_global_load_lds((const unsigned*)src, (LAS unsigned*)(meta + slot * META_SLOT + 1024), 16, 0, 0);
    }
    __device__ __forceinline__ void meta_init(const pg8::Unit& u0, bool h1, const pg8::Unit& u1, int wid) const {
        if (wid == 0) { dma_list(u0, 0); dma_bias(u0, 0); if (h1) dma_list(u1, 1); }
        asm volatile("s_waitcnt vmcnt(0)" ::: "memory"); __builtin_amdgcn_s_barrier(); asm volatile("" ::: "memory");
    }
    __device__ __forceinline__ void meta_top(int ui, bool has_next, const pg8::Unit& nxt, bool h2, const pg8::Unit& nn, int wid) const {
        if (wid == 0) { if (has_next) dma_bias(nxt, (ui + 1) % 3); if (h2) dma_list(nn, (ui + 2) % 3); }
    }
    __device__ __forceinline__ void aoffs(const pg8::Unit& u, int ui, const int (&R)[2], const int (&C)[2], unsigned (&off)[4]) const {
        if (GATHER) { const int lim = tab[40 + u.e] - 1 - u.aux * 256; const LAS int* lst = (const LAS int*)(meta + (ui % 3) * META_SLOT);
#pragma unroll
            for (int h = 0; h < 2; ++h)
#pragma unroll
                for (int i = 0; i < 2; ++i) { int mi = h * 128 + R[i]; mi = mi < lim ? mi : lim; const int tk = lst[mi] >> 2; off[h * 2 + i] = (unsigned)(tk * K + C[i] * 2); }
        } else {
#pragma unroll
            for (int h = 0; h < 2; ++h)
#pragma unroll
                for (int i = 0; i < 2; ++i) off[h * 2 + i] = (unsigned)((u.pm * 256 + h * 128 + R[i]) * K + C[i] * 2);
        }
    }
};
struct EpiSwiglu {
    static constexpr bool PERM = true, MID = false, FP8 = true; static constexpr int WIDE = 0;
    bf16_t* act; const LAS unsigned char* meta;
    __device__ __forceinline__ void mid(f32x4 (&)[2][2][4][2], const pg8::Unit&, int, int) const {}
    __device__ __forceinline__ void init(f32x4 (&i)[2][2], int ui, int wc, int fq) const {
        const LAS float* bp = (const LAS float*)(meta + (ui % 3) * META_SLOT + 1024) + wc * 32 + 8 * fq;
        i[0][0] = *(const LAS f32x4*)bp; i[0][1] = *(const LAS f32x4*)(bp + 4); i[1][0] = *(const LAS f32x4*)(bp + 128); i[1][1] = *(const LAS f32x4*)(bp + 132);
    }
    __device__ __forceinline__ void operator()(const f32x4 (&acc)[2][2][4][2], const pg8::Unit& u, int, int wr, int wc, int fr, int fq) const {
        const int f0 = u.pn * 128 + wc * 32 + 8 * fq, row0 = u.pm * 256 + wr * 64 + fr;
#pragma unroll
        for (int ai = 0; ai < 2; ++ai)
#pragma unroll
            for (int m = 0; m < 4; ++m) { const int row = row0 + ai * 128 + m * 16;
                float o[8];
#pragma unroll
                for (int q = 0; q < 8; ++q) { float g = (q < 4 ? acc[ai][0][m][0][q] : acc[ai][0][m][1][q - 4]);
                    float up = (q < 4 ? acc[ai][1][m][0][q] : acc[ai][1][m][1][q - 4]);
                    g = __builtin_fminf(g, 7.f); up = __builtin_amdgcn_fmed3f(up, -7.f, 7.f);
                    const float glu = g * __builtin_amdgcn_rcpf(1.f + __builtin_amdgcn_exp2f(-1.702f * LOG2E * g));
                    o[q] = __builtin_fmaf(up, glu, glu); }
                u32x2 w; w.x = pk_fp8x4(o[0], o[1], o[2], o[3]); w.y = pk_fp8x4(o[4], o[5], o[6], o[7]);
                *(GAS u32x2*)((unsigned char*)act + (size_t)row * DFF + f0) = w; }
    }
};
struct EpiNull {
    static constexpr bool PERM = true, MID = false, FP8 = true; static constexpr int WIDE = 0;
    __device__ __forceinline__ void mid(f32x4 (&)[2][2][4][2], const pg8::Unit&, int, int) const {}
    __device__ __forceinline__ void init(f32x4 (&i)[2][2], int, int, int) const { i[0][0] = i[0][1] = i[1][0] = i[1][1] = (f32x4){0.f, 0.f, 0.f, 0.f}; }
    __device__ __forceinline__ void operator()(const f32x4 (&acc)[2][2][4][2], const pg8::Unit&, int, int, int, int, int) const {
#pragma unroll
        for (int a = 0; a < 2; ++a)
#pragma unroll
            for (int b = 0; b < 2; ++b)
#pragma unroll
                for (int m = 0; m < 4; ++m)
#pragma unroll
                    for (int n = 0; n < 2; ++n) asm volatile("" :: "v"(acc[a][b][m][n]));
    }
};
struct EpiDense {
    static constexpr bool PERM = true, MID = false, FP8 = true; static constexpr int WIDE = 0;
    bf16_t* dst;
    __device__ __forceinline__ void mid(f32x4 (&)[2][2][4][2], const pg8::Unit&, int, int) const {}
    __device__ __forceinline__ void init(f32x4 (&i)[2][2], int, int, int) const { i[0][0] = i[0][1] = i[1][0] = i[1][1] = (f32x4){0.f, 0.f, 0.f, 0.f}; }
    __device__ __forceinline__ void operator()(const f32x4 (&acc)[2][2][4][2], const pg8::Unit& u, int, int wr, int wc, int fr, int fq) const {
        const int tid = (wr * 4 + wc) * 64 + fq * 16 + fr;
        unsigned char* base = (unsigned char*)dst + ((size_t)(u.pm * 4 + u.pn) % 512) * 131072 + tid * 16;
#pragma unroll
        for (int ai = 0; ai < 2; ++ai)
#pragma unroll
            for (int m = 0; m < 4; ++m)
#pragma unroll
                for (int bj = 0; bj < 2; ++bj) { const f32x4 v0 = acc[ai][bj][m][0], v1 = acc[ai][bj][m][1];
                    u32x4 w; w.x = cvt_pk_bf16(v0[0], v0[1]); w.y = cvt_pk_bf16(v0[2], v0[3]); w.z = cvt_pk_bf16(v1[0], v1[1]); w.w = cvt_pk_bf16(v1[2], v1[3]);
                    *(GAS u32x4*)(base + ((ai * 4 + m) * 2 + bj) * 8192) = w; }
    }
};
struct EpiYs {
    static constexpr bool PERM = true, MID = false, FP8 = true; static constexpr int WIDE = 2;
    bf16_t* ys; const LAS int* tab; const LAS unsigned char* meta;
    __device__ __forceinline__ void mid(f32x4 (&)[2][2][4][2], const pg8::Unit&, int, int) const {}
    __device__ __forceinline__ void init(f32x4 (&i)[2][2], int ui, int wc, int fq) const {
        const LAS float* bp = (const LAS float*)(meta + (ui % 3) * META_SLOT + 1024) + wc * 64 + 16 * fq;
#pragma unroll
        for (int bj = 0; bj < 2; ++bj)
#pragma unroll
            for (int n = 0; n < 2; ++n) i[bj][n] = *(const LAS f32x4*)(bp + bj * 8 + 4 * n);
    }
    __device__ __forceinline__ void operator()(const f32x4 (&acc)[2][2][4][2], const pg8::Unit& u, int ui, int wr, int wc, int fr, int fq) const {
        const int col0 = u.pn * 256 + wc * 64 + 16 * fq, rl0 = wr * 64 + fr, lim = tab[40 + u.e] - u.aux * 256;
        const LAS int* lst = (const LAS int*)(meta + (ui % 3) * META_SLOT);
        int ent[2][4];
#pragma unroll
        for (int ai = 0; ai < 2; ++ai)
#pragma unroll
            for (int m = 0; m < 4; ++m) { const int rl = rl0 + ai * 128 + m * 16; const int e_ = lst[rl]; ent[ai][m] = (rl < lim) ? e_ : -1; }
#pragma unroll
        for (int ai = 0; ai < 2; ++ai)
#pragma unroll
            for (int m = 0; m < 4; ++m) { if (ent[ai][m] >= 0) {
                    u32x4 w;
                    { const f32x4 v0 = acc[ai][0][m][0], v1 = acc[ai][0][m][1]; w.x = pk_fp8x4(v0[0], v0[1], v0[2], v0[3]); w.y = pk_fp8x4(v1[0], v1[1], v1[2], v1[3]); }
                    { const f32x4 v0 = acc[ai][1][m][0], v1 = acc[ai][1][m][1]; w.z = pk_fp8x4(v0[0], v0[1], v0[2], v0[3]); w.w = pk_fp8x4(v1[0], v1[1], v1[2], v1[3]); }
                    *(GAS u32x4*)((unsigned char*)ys + (size_t)ent[ai][m] * DM + col0) = w; } }
    }
};
struct FinRow { f32x4 x[4]; u32x2 d[4]; unsigned y[TOPK][4]; };
__device__ __forceinline__ void fin_load(FinRow& R, const float* xrow, const bf16_t* drow, const bf16_t* yrow, int lane) {
    const GAS f32x4* xr = (const GAS f32x4*)xrow + lane;
#pragma unroll
    for (int kk = 0; kk < TOPK; ++kk) { const GAS unsigned* yr = (const GAS unsigned*)((const unsigned char*)yrow + (size_t)kk * DM) + lane;
#pragma unroll
        for (int j = 0; j < 4; ++j) R.y[kk][j] = __builtin_nontemporal_load(yr + 64 * j); }
    const GAS u32x2* dr = (const GAS u32x2*)drow + lane;
#pragma unroll
    for (int j = 0; j < 4; ++j) { R.x[j] = xr[64 * j]; R.d[j] = dr[64 * j]; }
}
__device__ __forceinline__ void fin_compute(const FinRow& R, float* drow, float gv, int r, int lane, const f32x4 (&gfm)[4], const f32x4 (&gf)[4]) {
    f32x4 y[4];
#pragma unroll
    for (int j = 0; j < 4; ++j) y[j] = (f32x4){0.f, 0.f, 0.f, 0.f};
#pragma unroll
    for (int kk = 0; kk < TOPK; ++kk) { const float g = __builtin_bit_cast(float, __builtin_amdgcn_readlane(__builtin_bit_cast(int, gv), r * 4 + kk));
#pragma unroll
        for (int j = 0; j < 4; ++j) { const int w = (int)R.y[kk][j]; const f32x2 lo = __builtin_amdgcn_cvt_pk_f32_fp8(w, false), hi = __builtin_amdgcn_cvt_pk_f32_fp8(w, true);
            y[j] += (f32x4){lo.x, lo.y, hi.x, hi.y} * g; } }
    f32x4 v[4]; float s = 0.f;
#pragma unroll
    for (int j = 0; j < 4; ++j) { const u32x2 w = R.d[j]; v[j] = (R.x[j] + (f32x4){bf2f(w.x & 0xffffu), bf2f(w.x >> 16), bf2f(w.y & 0xffffu), bf2f(w.y >> 16)}) + gfm[j] * y[j]; s += (v[j].x * v[j].x + v[j].y * v[j].y) + (v[j].z * v[j].z + v[j].w * v[j].w); }
    const float rstd = 1.f / sqrtf(wave_sum(s) * (1.f / DM) + EPS);
    GAS f32x4* orow = (GAS f32x4*)drow + lane;
#pragma unroll
    for (int j = 0; j < 4; ++j) orow[64 * j] = v[j] * rstd * gf[j];
}
__device__ __forceinline__ void final_phase(Frame& F, float* dst) {
    const int gw = F.vcu * NWAVES + F.wave, NGW = F.G * NWAVES, lane = F.lane;
    f32x4 gf[4];
#pragma unroll
    for (int j = 0; j < 4; ++j) gf[j] = *(const GAS f32x4*)(F.g_final + 4 * lane + 256 * j);
    for (int chunk = gw; chunk < NTOK / 16; chunk += NGW) {
        const int m0 = chunk * 16, b = m0 / SEQ;
        f32x4 gfm[4];
#pragma unroll
        for (int j = 0; j < 4; ++j) gfm[j] = *(const GAS f32x4*)(F.mod + b * 6 * DM + 5 * DM + 4 * lane + 256 * j);
        const float gv = F.tkg[m0 * 4 + lane];
        FinRow A, B;
        fin_load(A, F.x + (size_t)m0 * DM, F.DELTA + (size_t)m0 * DM, (const bf16_t*)((const unsigned char*)F.YS + (size_t)m0 * 4 * DM), lane);
#pragma unroll 1
        for (int r = 0; r < 16; r += 2) {
            fin_load(B, F.x + (size_t)(m0 + r + 1) * DM, F.DELTA + (size_t)(m0 + r + 1) * DM, (const bf16_t*)((const unsigned char*)F.YS + (size_t)(m0 + r + 1) * 4 * DM), lane);
            fin_compute(A, dst + (size_t)(m0 + r) * DM, gv, r, lane, gfm, gf);
            if (r + 2 < 16) fin_load(A, F.x + (size_t)(m0 + r + 2) * DM, F.DELTA + (size_t)(m0 + r + 2) * DM, (const bf16_t*)((const unsigned char*)F.YS + (size_t)(m0 + r + 2) * 4 * DM), lane);
            fin_compute(B, dst + (size_t)(m0 + r + 1) * DM, gv, r + 1, lane, gfm, gf);
        }
    }
}
struct MkArgs { const float* in[17]; float* out; unsigned char* ws; int ph_lo, ph_hi; };
#ifndef DBG_STAGE
#define DBG_STAGE 9
#endif
constexpr int N_PHASES = DBG_STAGE;
__global__ void __launch_bounds__(NWAVES * 64, 2) mk_fwd(MkArgs args) {
    extern __shared__ __attribute__((aligned(16))) unsigned char lds[];
    Frame F;
    F.lds = (LAS unsigned char*)lds;
    F.MISC = (volatile LAS unsigned*)(F.lds + MISC_OFF);
    F.tid = threadIdx.x; F.lane = F.tid & 63; F.wave = __builtin_amdgcn_readfirstlane(F.tid >> 6);
    F.G = gridDim.x; { const int bx = blockIdx.x; F.vcu = (F.G % 8 == 0) ? (bx % 8) * (F.G / 8) + bx / 8 : bx; }
    unsigned char* ws = args.ws;
    F.ctl = (gu32*)(ws + WS_CTL);
    F.x = args.in[0]; F.c = args.in[1]; F.w_ada = args.in[2]; F.b_ada = args.in[3]; F.w_in = args.in[4]; F.sink = args.in[5]; F.rpb = args.in[6]; F.ga = args.in[7]; F.gb = args.in[8];
    F.w_out = args.in[9]; F.w_router = args.in[10]; F.b_router = args.in[11]; F.w_gu = args.in[12]; F.b_gu = args.in[13]; F.w_down = args.in[14]; F.b_down = args.in[15]; F.g_final = args.in[16];
    F.out = args.out;
    F.mod = (float*)(ws + WS_MOD); F.rope = (float*)(ws + WS_ROPE); F.ssq = (float*)(ws + WS_SSQ); F.tkg = (float*)(ws + WS_TKG); F.tke = (int*)(ws + WS_TKE); F.list = (int*)(ws + WS_LIST);
    F.wr_t = (bf16_t*)(ws + WS_WR); F.win_t = (bf16_t*)(ws + WS_WIN); F.wout_t = (bf16_t*)(ws + WS_WOUT); F.wgu_t = (bf16_t*)(ws + WS_WGU); F.wd_t = (bf16_t*)(ws + WS_WD);
    F.XN = (bf16_t*)(ws + WS_XN); F.PROJ = (bf16_t*)(ws + WS_PROJ); F.O = (bf16_t*)(ws + WS_O); F.YS = (bf16_t*)(ws + WS_YS); F.ACT = (bf16_t*)(ws + WS_ACT); F.DELTA = (bf16_t*)(ws + WS_DELTA);
    for (int u = F.tid; u < (LDS_BYTES - LDSCTL_OFF) / 4; u += NWAVES * 64) ((LAS unsigned*)(F.lds + LDSCTL_OFF))[u] = 0u;
    __syncthreads();
    const int lo = args.ph_lo, hi = args.ph_hi;
    XcdBarrier bar; bar.bar = (unsigned*)(F.ctl + CW_BAR); bar.x = 0; bar.st = nullptr;
    if (hi - lo > 1) bar = xcd_barrier_post((unsigned*)(F.ctl + CW_BAR), F.MISC + 8, F.wave);
#define IN(k) (lo <= (k) && (k) < hi)
#define MOE_STAGGER(nN_, ticks_) do { const int tot_ = ((const LAS int*)(F.lds + TAB_OFF))[32] * (nN_); const int maxu_ = (tot_ + F.G - 1) / F.G, mine_ = (tot_ - F.vcu + F.G - 1) / F.G; \
        if (mine_ < maxu_) { const unsigned long long t0_ = __builtin_amdgcn_s_memrealtime(); while (__builtin_amdgcn_s_memrealtime() - t0_ < (ticks_)) __builtin_amdgcn_s_sleep(8); } } while (0)
#define FRESH() do { F.lane = lane_id(); F.tid = F.wave * 64 + F.lane; } while (0)
#if defined(DIAG_A)
    unsigned long long* const ts = (unsigned long long*)(ws + WS_CTL + 512 * 1024);
#define STAMP(k) do { if (blockIdx.x == 0 && F.wave == 0 && lane_id() == 0) ts[k] = __builtin_amdgcn_s_memrealtime(); } while (0)
#else
#define STAMP(k) do {} while (0)
#endif
#define SEAM(k) do { if (IN(k) && IN((k) + 1)) xcd_barrier(bar, F.wave); STAMP((k) + 1); } while (0)
#ifndef PROBE_PH
#define PROBE_PH -1
#endif
#ifndef PROBE_FIN
#define PROBE_FIN 0
#endif
#define REP(k) for (int _rep = (PROBE_PH == (k)) ? 0 : 1; _rep < 2; ++_rep)
    float* const dummy = (float*)(ws + 830 * MiB);
    STAMP(0);
    FRESH();
    if (IN(0)) { REP(0) { __syncthreads(); p0_prologue(F); } } SEAM(0);
    FRESH();
    if (IN(1)) { REP(1) p1_xn(F); } SEAM(1);
    FRESH();
    if (IN(2)) REP(2) {
        pg8::DenseOrder S; S.init(F.XN, F.win_t, NTOK, DIN, DM, F.G, (int)blockIdx.x);
        EpiProj E{F.PROJ, F.rope};
        pg8::gemm_phase<EpiProj, pg8::DenseOrder, true>(F.lds, DM, S, E, F.wave);
    } SEAM(2);
    FRESH();
    if (IN(3)) { if (PROBE_PH == 3) { if (PROBE_FIN != 2) attn_a_phase(F, dummy); if (PROBE_FIN != 1) attn_b_phase(F, dummy); }
                 attn_a_phase(F, F.ssq); attn_b_phase(F, F.ssq); } SEAM(3);
    FRESH();
    if (IN(4)) REP(4) {
        pg8::DenseOrder S; S.init(F.O, F.wout_t, NTOK, DM, DM, F.G, (int)blockIdx.x);
        EpiX1 E{F.DELTA, F.mod, F.ssq};
        pg8::gemm_phase<EpiX1, pg8::DenseOrder, true>(F.lds, DM, S, E, F.wave);
    } SEAM(4);
    FRESH();
    if (IN(5)) REP(5) { router_phase(F, _rep ? F.ctl + CW_CNT : F.ctl + 16384); } SEAM(5);
    FRESH();
    if (IN(6)) {
        moe_table(F);
        MoeOrder<true> S{(const char*)F.XN, (const char*)F.wgu_t, F.list, F.b_gu, (const LAS int*)(F.lds + TAB_OFF), F.lds + META_OFF, DM, 2 * DFF, 2 * DFF / 256, F.G, F.vcu, 0};
        if (PROBE_PH == 6) { EpiNull E0; pg8::gemm_phase<EpiNull, MoeOrder<true>, true>(F.lds, DM, S, E0, F.wave); S.ec = 0; }
        EpiSwiglu E{F.ACT, F.lds + META_OFF};
        pg8::gemm_phase<EpiSwiglu, MoeOrder<true>, true>(F.lds, DM, S, E, F.wave);
    } SEAM(6);
    FRESH();
    if (IN(7)) {
        moe_table(F);
        MoeOrder<false> S{(const char*)F.ACT, (const char*)F.wd_t, F.list, F.b_down, (const LAS int*)(F.lds + TAB_OFF), F.lds + META_OFF, DFF, DM, DM / 256, F.G, F.vcu, 0};
        if (PROBE_PH == 7) { EpiDense E0{(bf16_t*)(ws + 830 * MiB)}; pg8::gemm_phase<EpiDense, MoeOrder<false>, true>(F.lds, DFF, S, E0, F.wave); S.ec = 0; }
        EpiYs E{F.YS, (const LAS int*)(F.lds + TAB_OFF), F.lds + META_OFF};
        pg8::gemm_phase<EpiYs, MoeOrder<false>, true>(F.lds, DFF, S, E, F.wave);
    } SEAM(7);
    FRESH();
    if (IN(8)) REP(8) { final_phase(F, _rep ? F.out : dummy); }
#if defined(DIAG_A)
    xcd_barrier(bar, F.wave); STAMP(9);
    if (blockIdx.x == 0 && F.wave == 0) { asm volatile("s_waitcnt vmcnt(0)" ::: "memory");
        const unsigned long long t9 = __builtin_amdgcn_s_memrealtime(), span = (DIAG_A == 9) ? 0ull : (ts[DIAG_A + 1] - ts[DIAG_A]);
        while (__builtin_amdgcn_s_memrealtime() - t9 < 4ull * span) __builtin_amdgcn_s_sleep(16); }
#endif
#undef IN
#undef SEAM
}

__global__ void br_route(const bf16_t* XN, const int* tke, const unsigned* ctl, float* h, int* cnt, int* list) {
    const int idx = blockIdx.x * 256 + threadIdx.x;
    const int ep = tke[idx]; list[(ep >> 16) * NTOK + (ep & 0xffff)] = idx;
    if (idx < NE) cnt[idx] = (int)ctl[CW_CNT + idx * 64];
    const int t = idx >> 2, q = idx & 3;
    for (int k = q * 256; k < q * 256 + 256; ++k) h[(size_t)t * DM + k] = bf2f(XN[(size_t)t * DM + k]);
}
extern "C" void kernel_launch(void* const* d_in, const int* in_sizes, int n_in, void* d_out, int out_size, void* d_ws, size_t ws_size, hipStream_t stream) {
    static int grid = 0;
    if (grid == 0) {
        if (n_in != 17 || ws_size < (size_t)1001 * MiB) { fprintf(stderr, "kernel_launch: bad n_in %d or ws_size %zu\n", n_in, ws_size); grid = -1; return; }
        int dev = 0, cus = 0, per_cu = 0;
        if (hipGetDevice(&dev) != hipSuccess || hipDeviceGetAttribute(&cus, hipDeviceAttributeMultiprocessorCount, dev) != hipSuccess) { grid = -1; return; }
        if (hipFuncSetAttribute((const void*)mk_fwd, hipFuncAttributeMaxDynamicSharedMemorySize, LDS_BYTES) != hipSuccess) { fprintf(stderr, "kernel_launch: hipFuncSetAttribute failed\n"); grid = -1; return; }
        if (hipOccupancyMaxActiveBlocksPerMultiprocessor(&per_cu, (const void*)mk_fwd, NWAVES * 64, LDS_BYTES) != hipSuccess || per_cu < 1) { fprintf(stderr, "kernel_launch: occupancy query says %d\n", per_cu); }
        (void)hipGetLastError();
        grid = cus;
    }
    if (grid < 0) return;
    const float* x = (const float*)d_in[0]; const float* sink = (const float*)d_in[5]; const float* rpb = (const float*)d_in[6]; const float* ga = (const float*)d_in[7];
    const float* gb = (const float*)d_in[8]; const float* w_out = (const float*)d_in[9]; const float* w_router = (const float*)d_in[10]; const float* b_router = (const float*)d_in[11];
    const float* w_gu = (const float*)d_in[12]; const float* b_gu = (const float*)d_in[13]; const float* w_down = (const float*)d_in[14]; const float* b_down = (const float*)d_in[15];
    const float* g_final = (const float*)d_in[16];
    char* ws = (char*)d_ws; float* out = (float*)d_out;
    (void)hipMemsetAsync(ws + WS_CTL, 0, CTL_ZERO_BYTES, stream);
    MkArgs a{};
    for (int i = 0; i < 17; ++i) a.in[i] = (const float*)d_in[i];
    a.out = out; a.ws = (unsigned char*)d_ws;
#if defined(MK_PER_PHASE)
    for (int ph = 0; ph < N_PHASES; ++ph) { a.ph_lo = ph; a.ph_hi = ph + 1; hipLaunchKernelGGL(mk_fwd, dim3(grid), dim3(NWAVES * 64), LDS_BYTES, stream, a); }
#else
    a.ph_lo = 0; a.ph_hi = N_PHASES; hipLaunchKernelGGL(mk_fwd, dim3(grid), dim3(NWAVES * 64), LDS_BYTES, stream, a);
#endif
#if DBG_STAGE < 9
    float* mod = (float*)(ws + WS_MOD);
    float* h = (float*)(ws + 17 * MiB);
    float* y = (float*)(ws + 337 * MiB);
    float* act = (float*)(ws + 481 * MiB);
    int* cnt = (int*)(ws + 993 * MiB); int* tke = (int*)(ws + 994 * MiB); float* tkg = (float*)(ws + 995 * MiB); int* list = (int*)(ws + 996 * MiB);
    (void)hipMemsetAsync(cnt, 0, 64 * sizeof(int), stream);
    (void)hipMemsetAsync(y, 0, (size_t)NTOK * DM * 4, stream);
#if DBG_STAGE == 5
    nv_norm_mod<<<NTOK, 256, 0, stream>>>(out, mod, 3 * DM, 4 * DM, h);
    nv_router<<<NTOK, 64, 0, stream>>>(h, w_router, b_router, cnt, tke, tkg, list);
#elif DBG_STAGE == 6
    br_route<<<NTOK * 4 / 256, 256, 0, stream>>>((const bf16_t*)(ws + WS_XN), (const int*)(ws + WS_TKE), (const unsigned*)(ws + WS_CTL), h, cnt, list);
    tkg = (float*)(ws + WS_TKG);
#endif
    nv_offsets<<<1, 64, 0, stream>>>(cnt);
    nv_sgemm<true><<<dim3(DFF / 64, NTOK / 64, NE), 256, 0, stream>>>(w_gu, 2 * DFF, DM, RmMoe1{h, list, cnt, (size_t)DM * 2 * DFF}, EpiMoe1{act, cnt, b_gu});
    nv_sgemm<false><<<dim3(DM / 64, NTOK / 64, NE), 256, 0, stream>>>(w_down, DM, DFF, RmMoe2{act, cnt, (size_t)DFF * DM}, EpiMoe2{y, list, cnt, tkg, b_down});
    nv_final<<<NTOK, 256, 0, stream>>>(out, y, mod, g_final, out);
#endif
}
```

```cpp
#define DBG_STAGE 9
#include <hip/hip_runtime.h>
#include <cstdio>
#include <cstdint>
#include <cmath>

constexpr int DM = 1024, NB = 8, SEQ = 4096, NTOK = NB * SEQ;
constexpr int HD = 64, AQH = 8, AKVH = 2, BH = 8;
constexpr int AQW = 512, AKVW = 128, BW = 512, DIN = 2304;
constexpr int OFF_QA = 0, OFF_KA = 512, OFF_VA = 640, OFF_QB = 768, OFF_KB = 1280, OFF_VB = 1792;
constexpr int WIN = 128, GW = 64, NAR = 8, NAC = 16, NE = 32, TOPK = 4, DFF = 1024;
constexpr float EPS = 1e-5f;
constexpr size_t MiB = 1u << 20;

#define GAS __attribute__((address_space(1)))
#define LAS __attribute__((address_space(3)))
typedef unsigned short bf16_t;
typedef short bf16x8 __attribute__((ext_vector_type(8)));
typedef float f32x4 __attribute__((ext_vector_type(4)));
typedef float f32x2 __attribute__((ext_vector_type(2)));
typedef float f32x16 __attribute__((ext_vector_type(16)));
typedef unsigned u32x4 __attribute__((ext_vector_type(4)));
typedef unsigned u32x2 __attribute__((ext_vector_type(2)));
typedef unsigned u32x8 __attribute__((ext_vector_type(8)));
typedef GAS unsigned gu32;
#define RLX_AGENT __ATOMIC_RELAXED, __HIP_MEMORY_SCOPE_AGENT
#define LDS_WAIT() asm volatile("s_waitcnt lgkmcnt(0)" ::: "memory")
#define VM_WAIT() asm volatile("s_waitcnt vmcnt(0)" ::: "memory")
__device__ __forceinline__ unsigned cvt_pk_bf16(float lo, float hi) { unsigned r; asm volatile("v_cvt_pk_bf16_f32 %0, %1, %2" : "=v"(r) : "v"(lo), "v"(hi)); return r; }
__device__ __forceinline__ unsigned f2bf(float f) { unsigned u = __builtin_bit_cast(unsigned, f); return (u + 0x7fffu + ((u >> 16) & 1u)) >> 16; }
__device__ __forceinline__ unsigned pk2(float lo, float hi) { return f2bf(lo) | (f2bf(hi) << 16); }
__device__ __forceinline__ float bf2f(unsigned h) { return __builtin_bit_cast(float, h << 16); }
__device__ __forceinline__ unsigned pk_fp8x4(float a, float b, float c, float d) { int p = __builtin_amdgcn_cvt_pk_fp8_f32(a, b, 0, false); return (unsigned)__builtin_amdgcn_cvt_pk_fp8_f32(c, d, p, true); }
typedef int v8i32 __attribute__((ext_vector_type(8)));
constexpr float W8_SCALE = 32.0f;

constexpr int NWAVES = 8;
__device__ __forceinline__ int lane_id() { int l; asm volatile("v_mbcnt_lo_u32_b32 %0, -1, 0\n\tv_mbcnt_hi_u32_b32 %0, -1, %0" : "=v"(l)); return l; }
constexpr float C2 = 0.125f * 1.4426950408889634f;
constexpr float LOG2E = 1.4426950408889634f;
constexpr int NSLOT_MAX = 139264;

constexpr size_t WS_CTL = 0, CTL_ZERO_BYTES = 128 * 1024;
constexpr size_t WS_MOD = 1 * MiB;
constexpr size_t WS_ROPE = WS_MOD + 256 * 1024;
constexpr size_t WS_WR = WS_ROPE + 256 * 1024;
constexpr size_t WS_SSQ = 2 * MiB;
constexpr size_t WS_TKE = 3 * MiB;
constexpr size_t WS_TKG = 4 * MiB;
constexpr size_t WS_LIST = 5 * MiB;
constexpr size_t WS_WIN = 10 * MiB;
constexpr size_t WS_WOUT = 15 * MiB;
constexpr size_t WS_WGU = 17 * MiB;
constexpr size_t WS_WD = 145 * MiB;
constexpr size_t WS_XN = 209 * MiB;
constexpr size_t WS_PROJ = 273 * MiB;
constexpr size_t WS_O = 417 * MiB;
constexpr size_t WS_YS = 209 * MiB;
constexpr size_t WS_ACT = 481 * MiB;
constexpr size_t WS_DELTA = 760 * MiB;
constexpr size_t WS_MK_END = 824 * MiB;
constexpr int CW_TMO = 0, CW_CNT = 64  , CW_BAR = 4096;

constexpr int RING_BYTES = 131072;
constexpr int LDSCTL_OFF = RING_BYTES, MISC_OFF = LDSCTL_OFF + 320;
constexpr int TAB_OFF = LDSCTL_OFF + 1024;
constexpr int LDS_BYTES = 163840;

namespace pg8 {
constexpr int BM = 256, BK = 64, HALF = 128, HTB = HALF * BK * 2, NXCD = 8, WGM = 8;
__host__ __device__ __forceinline__ int lds_byte(int r, int c) { const int st = (r >> 4) * 2 + (c >> 5), rr = r & 15, cc = c & 31, ob = rr * 64 + cc * 2; return st * 1024 + (ob ^ (((ob >> 9) & 1) << 5)); }
__host__ __device__ __forceinline__ void stage_rc(int b, int& R, int& C) { const int st = b / 1024, sb = b % 1024, swz = sb ^ (((sb >> 9) & 1) << 5); R = (st >> 1) * 16 + swz / 64; C = (st & 1) * 32 + (swz % 64) / 2; }
__host__ __device__ __forceinline__ int perm32(int rho) { const int n = rho >> 4, i = rho & 15; return 8 * (i >> 2) + 4 * n + (i & 3); }

struct Unit { int pm, pn, e, aux; };

struct DenseOrder {
    const char* A; const char* Bt; int K; int nM, nN, nwg, G, c;
    __device__ void init(const void* A_, const void* Bt_, int M, int N, int K_, int G_, int c_) { A = (const char*)A_; Bt = (const char*)Bt_; K = K_; nM = M / BM; nN = N / BM; nwg = nM * nN; G = G_; c = c_; }
    __device__ bool next(int i, Unit& u) const {
        const long L = (long)i * G + c; if (L >= nwg) return false;
        int wgid = (int)L; { const int q = nwg / NXCD, r = nwg % NXCD, xcd = wgid % NXCD, off = wgid / NXCD; wgid = (xcd < r ? xcd * (q + 1) : r * (q + 1) + (xcd - r) * q) + off; }
        const int nig = WGM * nN, gid = wgid / nig, fm = gid * WGM, gsz = (nM - fm) < WGM ? (nM - fm) : WGM;
        u.pm = fm + ((wgid % nig) % gsz); u.pn = (wgid % nig) / gsz; u.e = 0; u.aux = 0; return true;
    }
    __device__ __forceinline__ const char* abase() const { return A; }
    __device__ __forceinline__ const char* bbase(const Unit& u) const { return Bt + (size_t)u.pn * BM * K * 2; }
    __device__ __forceinline__ void aoffs(const Unit& u, int, const int (&R)[2], const int (&C)[2], unsigned (&off)[4]) const {
#pragma unroll
        for (int h = 0; h < 2; ++h)
#pragma unroll
            for (int i = 0; i < 2; ++i) off[h * 2 + i] = (unsigned)((u.pm * BM + h * HALF + R[i]) * K + C[i]) * 2u;
    }
    __device__ __forceinline__ void meta_init(const Unit&, bool, const Unit&, int) const {}
    __device__ __forceinline__ void meta_top(int, bool, const Unit&, bool, const Unit&, int) const {}
};

#define PG8_LAS __attribute__((address_space(3)))
template <class Epi, class Sched, bool ALIGN_EPI>
__device__ __forceinline__ void gemm_phase(PG8_LAS unsigned char* lds, const int K, const Sched& S, const Epi& E, const int wid_  ) {
    const int lane = lane_id(), tid = wid_ * 64 + lane, wid = wid_, wr = wid >> 2, wc = wid & 3, fr = lane & 15, fq = lane >> 4;
    constexpr int ESZ = Epi::FP8 ? 1 : 2;
    const int nt = K * ESZ / (BK * 2);
    unsigned voffB[2];
#pragma unroll
    for (int i = 0; i < 2; ++i) { int R, C; stage_rc(tid * 16 + i * 8192, R, C); const int Rp = Epi::PERM ? ((R & ~31) + perm32(R & 31)) : R; const int Rb = Epi::WIDE == 2 ? ((Rp >> 5) * 64 + ((Rp & 31) >> 3) * 16 + (Rp & 7)) : Epi::WIDE == 1 ? ((Rp >> 5) * 64 + (Rp & 31)) : Rp; voffB[i] = (unsigned)(Rb * K * ESZ + C * 2); }
#define PG8_RC() int sR[2], sC[2]; { int t2_ = tid; asm volatile("" : "+v"(t2_)); _Pragma("unroll") for (int i = 0; i < 2; ++i) stage_rc(t2_ * 16 + i * 8192, sR[i], sC[i]); }
    const size_t kstep = (size_t)(BK * 2);
    const size_t hstepB = (size_t)(Epi::WIDE == 2 ? 8 : Epi::WIDE == 1 ? 32 : HALF) * K * ESZ;
    const unsigned ldsw = (unsigned)wid * 1024u;
    const int aoff = lds_byte(wr * 64 + fr, fq * 8), boff = lds_byte(wc * 32 + fr, fq * 8);
    const char* const gA = S.abase();
#define PG8_SA(b, h) (((b) * 2 + (h)) * HTB)
#define PG8_SB(b, h) ((4 + (b) * 2 + (h)) * HTB)
#define PG8_STAGE(bufoff, gbase, voff) do { _Pragma("unroll") for (int _i = 0; _i < 2; ++_i) \
        __builtin_amdgcn_global_load_lds((const unsigned*)((const char*)(gbase) + (voff)[_i]), (PG8_LAS unsigned*)(lds + (bufoff) + ldsw + _i * 8192), 16, 0, 0); } while (0)
#define PG8_STAGEA(bufoff, offs, h, kb) do { _Pragma("unroll") for (int _i = 0; _i < 2; ++_i) \
        __builtin_amdgcn_global_load_lds((const unsigned*)((gA + (kb)) + (offs)[(h) * 2 + _i]), (PG8_LAS unsigned*)(lds + (bufoff) + ldsw + _i * 8192), 16, 0, 0); } while (0)
#define PG8_LD16(off) (*(const PG8_LAS u32x4*)(lds + (off)))
#define PG8_LDA(dst, b, h) do { _Pragma("unroll") for (int m = 0; m < 4; ++m) dst[m] = __builtin_shufflevector(PG8_LD16(PG8_SA(b, h) + aoff + m * 2048), PG8_LD16(PG8_SA(b, h) + aoff + m * 2048 + 1024), 0, 1, 2, 3, 4, 5, 6, 7); } while (0)
#define PG8_LDB(dst, b, h) do { _Pragma("unroll") for (int n = 0; n < 2; ++n) dst[n] = __builtin_shufflevector(PG8_LD16(PG8_SB(b, h) + boff + n * 2048), PG8_LD16(PG8_SB(b, h) + boff + n * 2048 + 1024), 0, 1, 2, 3, 4, 5, 6, 7); } while (0)
#define PG8_HALF(x, k) __builtin_bit_cast(bf16x8, __builtin_shufflevector(x, x, 4 * (k), 4 * (k) + 1, 4 * (k) + 2, 4 * (k) + 3))
#define PG8_MMA(ai, bj, At, Bt) do { __builtin_amdgcn_s_setprio(1); _Pragma("unroll") for (int m = 0; m < 4; ++m) _Pragma("unroll") for (int n = 0; n < 2; ++n) { \
        if constexpr (Epi::FP8) asm volatile("v_mfma_scale_f32_16x16x128_f8f6f4 %0, %1, %2, %0, %3, %4 op_sel_hi:[0,0,0]" : "+v"(acc[ai][bj][m][n]) : "v"(Bt[n]), "v"(At[m]), "v"(scw), "v"(sca)); \
        else { acc[ai][bj][m][n] = __builtin_amdgcn_mfma_f32_16x16x32_bf16(PG8_HALF(Bt[n], 0), PG8_HALF(At[m], 0), acc[ai][bj][m][n], 0, 0, 0); \
               acc[ai][bj][m][n] = __builtin_amdgcn_mfma_f32_16x16x32_bf16(PG8_HALF(Bt[n], 1), PG8_HALF(At[m], 1), acc[ai][bj][m][n], 0, 0, 0); } } \
        __builtin_amdgcn_s_setprio(0); } while (0)
#define PG8_ACC_INIT(uix) do { f32x4 i_[2][2]; { int l2_ = lane; asm volatile("" : "+v"(l2_)); E.init(i_, (uix), wc, l2_ >> 4); } \
        _Pragma("unroll") for (int a = 0; a < 2; ++a) _Pragma("unroll") for (int b = 0; b < 2; ++b) _Pragma("unroll") for (int m = 0; m < 4; ++m) _Pragma("unroll") for (int n = 0; n < 2; ++n) { \
            acc[a][b][m][n] = i_[b][n]; asm volatile("" : "+v"(acc[a][b][m][n])); } } while (0)
#define PG8_WAIT_V(n) asm volatile("s_waitcnt vmcnt(" #n ")" ::: "memory")
#define PG8_WAIT_L(n) asm volatile("s_waitcnt lgkmcnt(" #n ")" ::: "memory")
#define PG8_BAR __builtin_amdgcn_s_barrier()
#define PG8_SCHED __builtin_amdgcn_sched_barrier(0)
    Unit cur, nxt, nn; int ui = 0;
    if (!S.next(0, cur)) return;
    bool h1 = S.next(1, nxt), h2 = h1 && S.next(2, nn);
    f32x4 acc[2][2][4][2];
    unsigned scw = 0x7A7A7A7Au, sca = 0x7F7F7F7Fu; asm volatile("" : "+v"(scw), "+v"(sca));
    u32x8 At[4], B0[2], B1[2];
    unsigned lO[4], hO[2];
    S.meta_init(cur, h1, nxt, wid);
    { PG8_RC(); S.aoffs(cur, 0, sR, sC, lO); } hO[0] = lO[2]; hO[1] = lO[3];
    PG8_ACC_INIT(0);
    const char* cB = S.bbase(cur);
    PG8_STAGE(PG8_SB(0, 0), cB, voffB); PG8_STAGE(PG8_SB(0, 1), cB + hstepB, voffB); PG8_STAGEA(PG8_SA(0, 0), lO, 0, 0); PG8_STAGEA(PG8_SA(0, 1), lO, 1, 0);
    if (wr == 1) PG8_BAR;
    PG8_WAIT_V(2); PG8_BAR;
    PG8_STAGE(PG8_SB(1, 0), cB + kstep, voffB); PG8_STAGEA(PG8_SA(1, 0), lO, 0, kstep); PG8_STAGE(PG8_SB(1, 1), cB + hstepB + kstep, voffB);
    PG8_WAIT_V(6); PG8_BAR;
    for (;;) {
        const bool has_next = h1;
        const char* nB = has_next ? S.bbase(nxt) : cB;
        S.meta_top(ui, h1, nxt, h2, nn, wid);
#pragma unroll 1
        for (int t = 0; t < nt; t += 2) {
            const bool last = (t == nt - 2);
            if constexpr (Epi::MID) { if (t == nt / 2) { int l2_ = lane; asm volatile("" : "+v"(l2_)); E.mid_u(acc, ui, wr, l2_ & 15); } }
            if (last && has_next) { PG8_RC(); S.aoffs(nxt, ui + 1, sR, sC, lO); }
            const size_t k1 = (size_t)(t + 1) * kstep;
            const size_t k2 = last ? 0 : (size_t)(t + 2) * kstep, k3 = k2 + kstep;
            const char* b2 = (last ? nB : cB) + k2; const char* b3 = b2 + kstep;
            PG8_LDB(B0, 0, 0); PG8_LDB(B1, 0, 1); PG8_SCHED; PG8_LDA(At, 0, 0); PG8_STAGEA(PG8_SA(1, 1), hO, 0, k1);
            PG8_WAIT_V(8); PG8_WAIT_L(0); PG8_BAR; PG8_MMA(0, 0, At, B0); PG8_MMA(0, 1, At, B1); PG8_BAR; PG8_SCHED;
            PG8_LDA(At, 0, 1); PG8_STAGE(PG8_SB(0, 0), b2, voffB); PG8_STAGE(PG8_SB(0, 1), b2 + hstepB, voffB); PG8_STAGEA(PG8_SA(0, 0), lO, 0, k2);
            PG8_WAIT_V(8); PG8_WAIT_L(0); PG8_BAR; PG8_MMA(1, 0, At, B0); PG8_MMA(1, 1, At, B1); PG8_BAR; PG8_SCHED;
            PG8_LDB(B0, 1, 0); PG8_LDB(B1, 1, 1); PG8_SCHED; PG8_LDA(At, 1, 0); PG8_STAGEA(PG8_SA(0, 1), lO, 1, k2);
            PG8_WAIT_V(8); PG8_WAIT_L(0); PG8_BAR; PG8_MMA(0, 0, At, B0); PG8_MMA(0, 1, At, B1); PG8_BAR; PG8_SCHED;
            PG8_LDA(At, 1, 1); PG8_STAGE(PG8_SB(1, 0), b3, voffB); PG8_STAGE(PG8_SB(1, 1), b3 + hstepB, voffB); PG8_STAGEA(PG8_SA(1, 0), lO, 0, k3);
            PG8_WAIT_V(8); PG8_WAIT_L(0); PG8_BAR; PG8_MMA(1, 0, At, B0); PG8_MMA(1, 1, At, B1); PG8_BAR; PG8_SCHED;
        }
        if constexpr (ALIGN_EPI) { if (wr == 0) PG8_BAR; }
        if constexpr (Epi::FP8) asm volatile("s_nop 15\n\ts_nop 7" ::: "memory");
        { int l2_ = lane; asm volatile("" : "+v"(l2_)); E(acc, cur, ui, wr, wc, l2_ & 15, l2_ >> 4); }
        if (!has_next) break;
        PG8_ACC_INIT(ui + 1);
        cur = nxt; cB = nB; hO[0] = lO[2]; hO[1] = lO[3];
        nxt = nn; h1 = h2; h2 = h1 && S.next(ui + 3, nn);
        ++ui;
        if constexpr (ALIGN_EPI) { if (wr == 1) PG8_BAR; }
    }
    PG8_WAIT_V(0);
    if constexpr (!ALIGN_EPI) { if (wr == 0) PG8_BAR; }
    PG8_BAR;
#undef PG8_SA
#undef PG8_SB
#undef PG8_STAGE
#undef PG8_STAGEA
#undef PG8_LDA
#undef PG8_LDB
#undef PG8_MMA
#undef PG8_ACC_INIT
#undef PG8_RC
#undef PG8_HALF
#undef PG8_LD16
#undef PG8_WAIT_V
#undef PG8_WAIT_L
#undef PG8_BAR
#undef PG8_SCHED
}
}
#define XB_TMO      128
#define XB_XCNT(j)  (256  + 64 * (j))
#define XB_XSUB(j)  (1280 + 64 * (j))
#define XB_XGEN(j)  (2304 + 64 * (j))
#define XB_TOP      3328
#define XB_TOPGEN   3392
#define XCD_BAR_WORDS 3456
#define XB_SPIN_CAP (1u << 18)
__device__ __forceinline__ unsigned xb_ld(unsigned* p)              { return __hip_atomic_load(p, __ATOMIC_RELAXED, __HIP_MEMORY_SCOPE_AGENT); }
__device__ __forceinline__ unsigned xb_add(unsigned* p, unsigned v) { return __hip_atomic_fetch_add(p, v, __ATOMIC_RELAXED, __HIP_MEMORY_SCOPE_AGENT); }
__device__ __forceinline__ unsigned xb_xcc_id() { return (unsigned)__builtin_amdgcn_s_getreg((3 << 11) | 20) & 0xFu; }
#define XB_SPIN(cond, bar) do { unsigned _sp = 0; while (cond) { __builtin_amdgcn_s_sleep(1); \
    if ((++_sp & 255u) == 0u) { if (xb_ld(&(bar)[XB_TMO])) break; if (_sp > XB_SPIN_CAP) { atomicAdd(&(bar)[XB_TMO], 1u); break; } } } } while (0)
struct XcdBarrier { unsigned* bar; unsigned x; volatile LAS unsigned* st; };
__device__ __forceinline__ XcdBarrier xcd_barrier_post(unsigned* bar, volatile LAS unsigned* st, int wave) {
    XcdBarrier b; b.bar = bar; b.x = xb_xcc_id(); b.st = st;
    if (wave == 0 && lane_id() == 0) (void)xb_add(&bar[XB_XCNT(b.x)], 1u);
    return b;
}
__device__ __forceinline__ void xcd_barrier_complete(unsigned* bar, unsigned x, unsigned& nloc, unsigned& nx) {
    const unsigned G = gridDim.x * gridDim.y * gridDim.z;
    unsigned sum, cnt, mine, sp = 0u;
    for (;;) {
        sum = 0u; cnt = 0u; mine = 0u;
#pragma unroll
        for (unsigned j = 0; j < 16; ++j) { const unsigned c = xb_ld(&bar[XB_XCNT(j)]); sum += c; cnt += (c > 0u) ? 1u : 0u; mine = (j == x) ? c : mine; }
        if (sum == G) break;
        __builtin_amdgcn_s_sleep(1);
        if ((++sp & 255u) == 0u) { if (xb_ld(&bar[XB_TMO])) break; if (sp > XB_SPIN_CAP) { atomicAdd(&bar[XB_TMO], 1u); break; } }
    }
    nloc = mine > 0u ? mine : 1u; nx = cnt > 0u ? cnt : 1u;
}
__device__ __forceinline__ void xcd_barrier(const XcdBarrier& b, int wave) {
    asm volatile("s_waitcnt vmcnt(0)" ::: "memory");
    __syncthreads();
    if (wave == 0 && lane_id() == 0) {
        unsigned* bar = b.bar;
        __builtin_amdgcn_s_waitcnt(0);
        unsigned nloc = b.st[0], nx = b.st[1];
        if (nloc == 0u) { xcd_barrier_complete(bar, b.x, nloc, nx); b.st[0] = nloc; b.st[1] = nx; }
        const unsigned old = xb_add(&bar[XB_XSUB(b.x)], 1u);
        const unsigned gen = old / nloc;
        if (old + 1u == (gen + 1u) * nloc) {
            __builtin_amdgcn_fence(__ATOMIC_RELEASE, "agent");
            asm volatile("s_waitcnt vmcnt(0)" ::: "memory");
            const unsigned og = xb_add(&bar[XB_TOP], 1u);
            const unsigned tg = og / nx;
            if (og + 1u == (tg + 1u) * nx) xb_add(&bar[XB_TOPGEN], 1u);
            else XB_SPIN(xb_ld(&bar[XB_TOPGEN]) == tg, bar);
            __builtin_amdgcn_fence(__ATOMIC_ACQUIRE, "agent");
            xb_add(&bar[XB_XGEN(b.x)], 1u);
            asm volatile("s_waitcnt vmcnt(0)" ::: "memory");
        } else {
            XB_SPIN(xb_ld(&bar[XB_XGEN(b.x)]) == gen, bar);
            __builtin_amdgcn_fence(__ATOMIC_ACQUIRE, "agent");
            asm volatile("s_waitcnt vmcnt(0)" ::: "memory");
        }
    }
    __syncthreads();
}

struct Frame {
    LAS unsigned char* lds;
    volatile LAS unsigned* MISC;
    gu32* ctl;
    int tid, lane, wave, vcu, G;
    const float *x, *c, *w_ada, *b_ada, *w_in, *sink, *rpb, *ga, *gb, *w_out, *w_router, *b_router, *w_gu, *b_gu, *w_down, *b_down, *g_final;
    float* out;
    float *mod, *rope, *ssq, *tkg;
    int *tke, *list;
    bf16_t *wr_t, *win_t, *wout_t, *wgu_t, *wd_t, *XN, *PROJ, *O, *YS, *ACT, *DELTA;
};
__device__ __forceinline__ float wave_sum(float v) {
#pragma unroll
    for (int o = 1; o < 64; o <<= 1) v += __shfl_xor(v, o);
    return v;
}

struct P0Item { const float* W; bf16_t* WT; int N, Kd, k0, n0, drow0, gains, fp8; };
__device__ __forceinline__ bool p0_item(const Frame& F, int it, P0Item& I) {
    constexpr int I_IN = 16 * (DIN / 32), I_OUT = 16 * (DM / 32), I_GU1 = 16 * (2 * DFF / 32), I_GU = NE * I_GU1, I_D1 = (DFF / 64) * (DM / 32), I_D = NE * I_D1;
    if (it >= I_IN + I_OUT + I_GU + I_D) return false;
    int r = it; I.gains = 0; I.fp8 = 0;
    if (r < I_IN) { const int nb = r % (DIN / 32), kb = r / (DIN / 32); I.W = F.w_in; I.WT = F.win_t; I.N = DIN; I.Kd = DM; I.k0 = kb * 64; I.n0 = nb * 32; I.drow0 = nb * 32; return true; } r -= I_IN;
    if (r < I_OUT) { const int nb = r % (DM / 32), kb = r / (DM / 32); I.W = F.w_out; I.WT = F.wout_t; I.N = DM; I.Kd = DM; I.k0 = kb * 64; I.n0 = nb * 32; I.drow0 = nb * 32; I.gains = 1; return true; } r -= I_OUT;
    if (r < I_GU) { const int e = r / I_GU1, q = r % I_GU1, nb = q % (2 * DFF / 32), kb = q / (2 * DFF / 32), n0 = nb * 32, f = n0 & (DFF - 1);
        I.W = F.w_gu + (size_t)e * DM * 2 * DFF; I.WT = (bf16_t*)((unsigned char*)F.wgu_t + (size_t)e * 2 * DFF * DM); I.N = 2 * DFF; I.Kd = DM; I.k0 = kb * 64; I.n0 = n0; I.drow0 = (f >> 7) * 256 + (n0 >= DFF ? 128 : 0) + (f & 127); I.fp8 = 1; return true; } r -= I_GU;
    { const int e = r / I_D1, q = r % I_D1, nb = q % (DM / 32), kb = q / (DM / 32);
        I.W = F.w_down + (size_t)e * DFF * DM; I.WT = (bf16_t*)((unsigned char*)F.wd_t + (size_t)e * DM * DFF); I.N = DM; I.Kd = DFF; I.k0 = kb * 64; I.n0 = nb * 32; I.drow0 = nb * 32; I.fp8 = 1; return true; }
}
__device__ __forceinline__ void p0_load(const P0Item& I, f32x4 (&w)[8], int lane) {
#pragma unroll
    for (int i = 0; i < 8; ++i) w[i] = __builtin_nontemporal_load((const GAS f32x4*)(I.W + (size_t)(I.k0 + 8 * i + (lane >> 3)) * I.N + I.n0 + 4 * (lane & 7)));
}
__device__ __forceinline__ void p0_finish(const Frame& F, const P0Item& I, const f32x4 (&w)[8], LAS float* scr, int lane) {
#pragma unroll
    for (int i = 0; i < 8; ++i) { const int kk = 8 * i + (lane >> 3), nn = 4 * (lane & 7); f32x4 v = w[i];
        if (I.gains) { const int k = I.k0 + kk; v = v * (k < 512 ? F.ga[k] : F.gb[k - 512]); }
        scr[kk * 33 + nn] = v.x; scr[kk * 33 + nn + 1] = v.y; scr[kk * 33 + nn + 2] = v.z; scr[kk * 33 + nn + 3] = v.w; }
    LDS_WAIT(); asm volatile("" ::: "memory");
    const int c = lane & 7;
#pragma unroll
    for (int j = 0; j < 4; ++j) { const int n = (lane >> 3) + 8 * j; const LAS float* s = scr + (8 * c) * 33 + n;
        if (I.fp8) { u32x2 o; o.x = pk_fp8x4(s[0 * 33] * W8_SCALE, s[1 * 33] * W8_SCALE, s[2 * 33] * W8_SCALE, s[3 * 33] * W8_SCALE); o.y = pk_fp8x4(s[4 * 33] * W8_SCALE, s[5 * 33] * W8_SCALE, s[6 * 33] * W8_SCALE, s[7 * 33] * W8_SCALE);
            *(GAS u32x2*)((unsigned char*)I.WT + (size_t)(I.drow0 + n) * I.Kd + I.k0 + 8 * c) = o; }
        else { u32x4 o; o.x = pk2(s[0 * 33], s[1 * 33]); o.y = pk2(s[2 * 33], s[3 * 33]); o.z = pk2(s[4 * 33], s[5 * 33]); o.w = pk2(s[6 * 33], s[7 * 33]);
            *(GAS u32x4*)(I.WT + (size_t)(I.drow0 + n) * I.Kd + I.k0 + 8 * c) = o; } }
    LDS_WAIT(); asm volatile("" ::: "memory");
}
__device__ __forceinline__ void p0_prologue(Frame& F) {
    const int gt = blockIdx.x * (NWAVES * 64) + F.tid;
    if (blockIdx.x < 6 * DM / 32) {
        LAS float* sc = (LAS float*)F.lds;
        LAS float* red = (LAS float*)(F.lds + 32768);
        for (int i = F.tid; i < NB * DM; i += NWAVES * 64) { const float v = F.c[i]; sc[i] = v / (1.f + __expf(-v)); }
        const int c4 = F.tid & 7, ks = F.tid >> 3, n0 = blockIdx.x * 32;
        f32x4 w[16];
#pragma unroll
        for (int q = 0; q < 16; ++q) w[q] = __builtin_nontemporal_load((const GAS f32x4*)(F.w_ada + (size_t)(ks * 16 + q) * 6 * DM + n0 + 4 * c4));
        __syncthreads();
        f32x4 a[NB];
#pragma unroll
        for (int b = 0; b < NB; ++b) a[b] = (f32x4){0.f, 0.f, 0.f, 0.f};
#pragma unroll
        for (int q = 0; q < 16; ++q)
#pragma unroll
            for (int b = 0; b < NB; ++b) a[b] += w[q] * sc[b * DM + ks * 16 + q];
#pragma unroll
        for (int b = 0; b < NB; ++b) *(LAS f32x4*)(red + (ks * NB + b) * 32 + 4 * c4) = a[b];
        __syncthreads();
        if (F.tid < 256) { const int b = F.tid >> 5, col = F.tid & 31; float s = F.b_ada[n0 + col];
#pragma unroll 8
            for (int q = 0; q < 64; ++q) s += red[(q * NB + b) * 32 + col];
            F.mod[b * 6 * DM + n0 + col] = s; }
        __syncthreads();
    }
    if (gt < SEQ * 8) {
        const int pos = gt >> 3, i = gt & 7;
        const float invf[8] = {1.0f, 0.1939227432012558f, 0.03760603070259094f, 0.007292664609849453f, 0.0014142135623842478f, 0.00027424818836152554f, 5.3182957344688475e-05f, 1.0313385246263351e-05f};
        float inv = invf[0];
#pragma unroll
        for (int q = 1; q < 8; ++q) inv = (i == q) ? invf[q] : inv;
        const float angf = (float)pos * inv;
        const double ang = (double)angf, twopi = 6.283185307179586476925287;
        const double r = ang - __builtin_rint(ang / twopi) * twopi, r2 = r * r;
        double cs = 1.0, sn = r, tc = 1.0, ts = r;
#pragma unroll 1
        for (int q = 1; q <= 20; ++q) { tc = -tc * r2 / (double)((2 * q - 1) * (2 * q)); ts = -ts * r2 / (double)((2 * q) * (2 * q + 1)); cs += tc; sn += ts; }
        F.rope[gt] = (float)cs; F.rope[SEQ * 8 + gt] = (float)sn;
    }
    if (gt < NE * DM) { const int e = gt >> 10, k = gt & 1023; const float w = F.w_router[k * NE + e]; const unsigned hi = f2bf(w); const unsigned lo = f2bf(w - bf2f(hi));
        F.wr_t[gt] = (bf16_t)hi; F.wr_t[NE * DM + gt] = (bf16_t)lo; }
    if (gt < NTOK * 2) F.ssq[gt] = 0.f;
    LAS float* scr = (LAS float*)(F.lds + F.wave * 16384);
    const int gw = F.vcu * NWAVES + F.wave, NGW = F.G * NWAVES;
    P0Item Ia, Ib; f32x4 wa[8], wb[8];
    bool ha = p0_item(F, gw, Ia), hb;
    if (ha) p0_load(Ia, wa, F.lane);
#pragma unroll 1
    for (int it = gw; ha; it += 2 * NGW) {
        hb = p0_item(F, it + NGW, Ib); if (hb) p0_load(Ib, wb, F.lane);
        p0_finish(F, Ia, wa, scr, F.lane);
        ha = p0_item(F, it + 2 * NGW, Ia); if (ha) p0_load(Ia, wa, F.lane);
        if (hb) p0_finish(F, Ib, wb, scr, F.lane);
    }
}
__device__ __forceinline__ void p1_row(const f32x4 (&v)[4], bf16_t* orow, const f32x4 (&s1)[4], const f32x4 (&sh)[4], int lane) {
    float s = 0.f;
#pragma unroll
    for (int j = 0; j < 4; ++j) s += (v[j].x * v[j].x + v[j].y * v[j].y) + (v[j].z * v[j].z + v[j].w * v[j].w);
    const float rstd = 1.f / sqrtf(wave_sum(s) * (1.f / DM) + EPS);
    GAS unsigned long long* o8 = (GAS unsigned long long*)orow + lane;
#pragma unroll
    for (int j = 0; j < 4; ++j) { const f32x4 h = v[j] * rstd * s1[j] + sh[j];
        o8[64 * j] = (unsigned long long)pk2(h.x, h.y) | ((unsigned long long)pk2(h.z, h.w) << 32); }
}
__device__ __forceinline__ void p1_xn(Frame& F) {
    const int gw = F.vcu * NWAVES + F.wave, NGW = F.G * NWAVES, lane = F.lane;
    for (int chunk = gw; chunk < NTOK / 16; chunk += NGW) {
        const int m0 = chunk * 16, b = m0 / SEQ;
        f32x4 s1[4], sh[4];
#pragma unroll
        for (int j = 0; j < 4; ++j) { s1[j] = *(const GAS f32x4*)(F.mod + b * 6 * DM + DM + 4 * lane + 256 * j) + 1.0f; sh[j] = *(const GAS f32x4*)(F.mod + b * 6 * DM + 4 * lane + 256 * j); }
        f32x4 va[4], vb[4], vc[4];
#define P1_LOAD(dst, r) do { const GAS f32x4* xr_ = (const GAS f32x4*)(F.x + (size_t)(m0 + (r)) * DM) + lane; _Pragma("unroll") for (int j = 0; j < 4; ++j) dst[j] = __builtin_nontemporal_load(xr_ + 64 * j); } while (0)
        P1_LOAD(va, 0); P1_LOAD(vb, 1);
#pragma unroll 1
        for (int r = 0; r < 15; r += 3) {
            P1_LOAD(vc, r + 2); p1_row(va, F.XN + (size_t)(m0 + r) * DM, s1, sh, lane);
            P1_LOAD(va, r + 3); p1_row(vb, F.XN + (size_t)(m0 + r + 1) * DM, s1, sh, lane);
            if (r + 4 < 16) P1_LOAD(vb, r + 4); p1_row(vc, F.XN + (size_t)(m0 + r + 2) * DM, s1, sh, lane);
        }
        p1_row(va, F.XN + (size_t)(m0 + 15) * DM, s1, sh, lane);
#undef P1_LOAD
    }
}
struct EpiProj {
    static constexpr bool PERM = true, MID = false, FP8 = false; static constexpr int WIDE = 1;
    bf16_t* O; const float* rope;
    __device__ __forceinline__ void mid(f32x4 (&)[2][2][4][2], const pg8::Unit&, int, int) const {}
    __device__ __forceinline__ void init(f32x4 (&i)[2][2], int, int, int) const { i[0][0] = i[0][1] = i[1][0] = i[1][1] = (f32x4){0.f, 0.f, 0.f, 0.f}; }
    __device__ __forceinline__ void operator()(const f32x4 (&acc)[2][2][4][2], const pg8::Unit& u, int, int wr, int wc, int fr, int fq) const {
        const int row0 = u.pm * 256 + wr * 64 + fr, col0 = u.pn * 256 + wc * 64 + 8 * fq;
        const float sc = (u.pn < 2 || u.pn == 3 || u.pn == 4) ? C2 : 1.f;
#pragma unroll
        for (int ai = 0; ai < 2; ++ai)
#pragma unroll
            for (int m = 0; m < 4; ++m) { const int row = row0 + ai * 128 + m * 16; bf16_t* rowp = O + (size_t)row * DIN + col0;
#pragma unroll
                for (int bj = 0; bj < 2; ++bj) { f32x4 v0 = acc[ai][bj][m][0], v1 = acc[ai][bj][m][1];
                    const bool rope_tile = (u.pn < 2) || (u.pn == 2 && wc < 2);
                    if (rope_tile && bj == 0) {
                        f32x4 o0, o1;
#pragma unroll
                        for (int q = 0; q < 4; ++q) { o0[q] = __shfl_xor(v0[q], 16); o1[q] = __shfl_xor(v1[q], 16); }
                        if (fq < 2) { const int pos = row & (SEQ - 1);
                            const f32x4 c0 = *(const GAS f32x4*)(rope + pos * 8), c1 = *(const GAS f32x4*)(rope + pos * 8 + 4);
                            const f32x4 s0 = *(const GAS f32x4*)(rope + SEQ * 8 + pos * 8), s1 = *(const GAS f32x4*)(rope + SEQ * 8 + pos * 8 + 4);
                            const float sg = fq == 0 ? -1.f : 1.f;
                            v0 = v0 * c0 + (o0 * sg) * s0; v1 = v1 * c1 + (o1 * sg) * s1; }
                    }
                    v0 = v0 * sc; v1 = v1 * sc;
                    u32x4 w; w.x = cvt_pk_bf16(v0[0], v0[1]); w.y = cvt_pk_bf16(v0[2], v0[3]); w.z = cvt_pk_bf16(v1[0], v1[1]); w.w = cvt_pk_bf16(v1[2], v1[3]);
                    *(GAS u32x4*)(rowp + bj * 32) = w; } }
    }
};
__device__ __forceinline__ int crow(int r, int hi) { return (r & 3) + 8 * (r >> 2) + 4 * hi; }
typedef short v4i16_t __attribute__((ext_vector_type(4)));
__device__ __forceinline__ v4i16_t vtr(const LAS unsigned char* p) { return __builtin_amdgcn_ds_read_tr16_b64_v4i16((LAS v4i16_t*)p); }
__device__ __forceinline__ float max3f(float a, float b, float c) { return __builtin_fmaxf(__builtin_fmaxf(a, b), c); }
__device__ __forceinline__ void glds16(const void* gsrc, LAS unsigned char* dst) {
    const unsigned lds_dst = (unsigned)__builtin_amdgcn_readfirstlane((int)(unsigned)(unsigned long)dst); unsigned keep;
    asm volatile("s_mov_b32 %0, m0\n\ts_mov_b32 m0, %2\n\ts_nop 0\n\tglobal_load_lds_dwordx4 %1, off\n\ts_mov_b32 m0, %0" : "=&s"(keep) : "v"(gsrc), "s"(lds_dst) : "memory");
}
__device__ __forceinline__ void dma_k(const bf16_t* Ktile  , LAS unsigned char* slot, int p, int lane) {
    const int row = 8 * p + (lane >> 3), ch = (lane & 7) ^ ((row >> 1) & 7);
    glds16(Ktile + (size_t)row * DIN + ch * 8, slot + p * 1024);
}
__device__ __forceinline__ void dma_v(const bf16_t* Vtile, LAS unsigned char* slot, int p, int lane) {
    glds16(Vtile + (size_t)(8 * p + ((lane >> 2) & 7)) * DIN + (lane >> 5) * 32 + (lane & 3) * 8, slot + p * 1024);
}
template <int NC> struct AttnState { float m, l; f32x16 o[2]; float cin[NC]; };
template <int NC, class MB>
__device__ __forceinline__ void attn_tile(const bool FIRST  , const LAS unsigned char* Ks, const LAS unsigned char* Vs, const bf16x8 (&qr)[4], AttnState<NC>& st, int r32, int hi, int lane, const MB& mb) {
    f32x16 p0, p1;
#pragma unroll
    for (int r = 0; r < 16; ++r) { p0[r] = st.cin[NC == 1 ? 0 : r]; p1[r] = st.cin[NC == 1 ? 0 : 16 + r]; }
    const LAS unsigned char* kb = Ks + r32 * 128; const int sw = (r32 >> 1) & 7;
    bf16x8 kf[8];
#pragma unroll
    for (int d0 = 0; d0 < 4; ++d0) { const int ko = ((2 * d0 + hi) ^ sw) << 4; kf[2 * d0] = *(const LAS bf16x8*)(kb + ko); kf[2 * d0 + 1] = *(const LAS bf16x8*)(kb + ko + 4096); }
    __builtin_amdgcn_sched_barrier(0);
#pragma unroll
    for (int d0 = 0; d0 < 4; ++d0) {
        p0 = __builtin_amdgcn_mfma_f32_32x32x16_bf16(kf[2 * d0], qr[d0], p0, 0, 0, 0);
        p1 = __builtin_amdgcn_mfma_f32_32x32x16_bf16(kf[2 * d0 + 1], qr[d0], p1, 0, 0, 0);
    }
    __builtin_amdgcn_sched_barrier(0);
    const LAS unsigned char* vb = Vs + ((lane >> 4) & 1) * 32 + (lane & 3) * 8 + (4 * hi + ((lane & 15) >> 2)) * 64;
    v4i16_t vlo[8], vhh[8];
#pragma unroll
    for (int d0 = 0; d0 < 2; ++d0)
#pragma unroll
        for (int s = 0; s < 4; ++s) { vlo[d0 * 4 + s] = vtr(vb + d0 * 512 + s * 2048); vhh[d0 * 4 + s] = vtr(vb + d0 * 512 + s * 2048 + 1024); }
    typename MB::Pre pre; mb.prefetch(pre);
    __builtin_amdgcn_sched_barrier(0);
    mb(p0, p1, pre, r32, hi);
    float a = max3f(p0[0], p0[1], p1[0]), b = max3f(p0[2], p0[3], p1[1]); a = max3f(a, p1[2], p1[3]);
#pragma unroll
    for (int r = 4; r < 16; r += 4) { a = max3f(a, p0[r], p0[r + 1]); b = max3f(b, p0[r + 2], p0[r + 3]); a = max3f(a, p1[r], p1[r + 1]); b = max3f(b, p1[r + 2], p1[r + 3]); }
    float rm = __builtin_fmaxf(a, b);
    rm = __builtin_fmaxf(rm, __shfl_xor(rm, 32));
    if (FIRST || __any(rm > 8.0f)) {
        const float d = FIRST ? rm : __builtin_fmaxf(rm, 0.f), f = __builtin_amdgcn_exp2f(-d);
        st.m += d; st.l *= f;
#pragma unroll
        for (int r = 0; r < 16; ++r) { st.o[0][r] *= f; st.o[1][r] *= f; p0[r] -= d; p1[r] -= d; }
#pragma unroll
        for (int r = 0; r < NC; ++r) st.cin[r] -= d;
    }
    float ls = 0.f;
#pragma unroll
    for (int r = 0; r < 16; ++r) { p0[r] = __builtin_amdgcn_exp2f(p0[r]); p1[r] = __builtin_amdgcn_exp2f(p1[r]); ls += p0[r] + p1[r]; }
    st.l += ls;
    u32x4 pw[4];
#pragma unroll
    for (int q = 0; q < 4; ++q) { pw[0][q] = cvt_pk_bf16(p0[2 * q], p0[2 * q + 1]); pw[1][q] = cvt_pk_bf16(p0[8 + 2 * q], p0[8 + 2 * q + 1]);
                                  pw[2][q] = cvt_pk_bf16(p1[2 * q], p1[2 * q + 1]); pw[3][q] = cvt_pk_bf16(p1[8 + 2 * q], p1[8 + 2 * q + 1]); }
    __builtin_amdgcn_sched_barrier(0);
#pragma unroll
    for (int d0 = 0; d0 < 2; ++d0)
#pragma unroll
        for (int s = 0; s < 4; ++s) {
            const v4i16_t lo = vlo[d0 * 4 + s], hh = vhh[d0 * 4 + s];
            const bf16x8 vf = (bf16x8){lo[0], lo[1], lo[2], lo[3], hh[0], hh[1], hh[2], hh[3]};
            st.o[d0] = __builtin_amdgcn_mfma_f32_32x32x16_bf16(vf, __builtin_bit_cast(bf16x8, pw[s]), st.o[d0], 0, 0, 0);
        }
    __builtin_amdgcn_sched_barrier(0);
}
template <int NC> __device__ __forceinline__ void attn_finish(AttnState<NC>& st, LAS unsigned char* stg, bf16_t* Obase  , float* ssqp  , int r32, int hi, int lane) {
    float l = st.l; l += __shfl_xor(l, 32);
    const float inv = 1.0f / l;
    float sq = 0.f;
#pragma unroll
    for (int d0 = 0; d0 < 2; ++d0)
#pragma unroll
        for (int rg = 0; rg < 4; ++rg) {
            const float v0 = st.o[d0][4 * rg] * inv, v1 = st.o[d0][4 * rg + 1] * inv, v2 = st.o[d0][4 * rg + 2] * inv, v3 = st.o[d0][4 * rg + 3] * inv;
            sq += (v0 * v0 + v1 * v1) + (v2 * v2 + v3 * v3);
            u32x2 w; w.x = cvt_pk_bf16(v0, v1); w.y = cvt_pk_bf16(v2, v3);
            const int ch = 4 * d0 + rg;
            *(LAS u32x2*)(stg + r32 * 128 + ((ch ^ (r32 & 7)) << 4) + hi * 8) = w;
        }
    sq += __shfl_xor(sq, 32);
    if (hi == 0) atomicAdd(ssqp + r32 * 2, sq);
    asm volatile("s_waitcnt lgkmcnt(0)" ::: "memory");
#pragma unroll
    for (int i = 0; i < 4; ++i) { const int row = i * 8 + (lane >> 3), ch = lane & 7;
        const u32x4 v = *(const LAS u32x4*)(stg + row * 128 + ((ch ^ (row & 7)) << 4));
        *(GAS u32x4*)(Obase + (size_t)row * DM + ch * 8) = v; }
}
template <int NC> __device__ __forceinline__ void attn_finish_direct(AttnState<NC>& st, bf16_t* Orow  , float* ssqp, int hi) {
    float l = st.l; l += __shfl_xor(l, 32);
    const float inv = 1.0f / l;
    float sq = 0.f;
#pragma unroll
    for (int d0 = 0; d0 < 2; ++d0)
#pragma unroll
        for (int rg = 0; rg < 4; ++rg) {
            const float v0 = st.o[d0][4 * rg] * inv, v1 = st.o[d0][4 * rg + 1] * inv, v2 = st.o[d0][4 * rg + 2] * inv, v3 = st.o[d0][4 * rg + 3] * inv;
            sq += (v0 * v0 + v1 * v1) + (v2 * v2 + v3 * v3);
            u32x2 w; w.x = cvt_pk_bf16(v0, v1); w.y = cvt_pk_bf16(v2, v3);
            *(GAS u32x2*)(Orow + 32 * d0 + 8 * rg + 4 * hi) = w;
        }
    sq += __shfl_xor(sq, 32);
    if (hi == 0) atomicAdd(ssqp, sq);
}
struct MbNone { struct Pre {}; __device__ __forceinline__ void prefetch(Pre&) const {} __device__ __forceinline__ void operator()(f32x16&, f32x16&, const Pre&, int, int) const {} };
struct MbBandLo { int qi;
    struct Pre {}; __device__ __forceinline__ void prefetch(Pre&) const {}
    __device__ __forceinline__ void operator()(f32x16& p0, f32x16& p1, const Pre&, int, int hi) const {
#pragma unroll
        for (int r = 0; r < 16; ++r) { const int kj = crow(r, hi); p0[r] = (kj >= qi) ? p0[r] : -1e30f; p1[r] = (kj + 32 >= qi) ? p1[r] : -1e30f; } } };
struct MbBandHi { int qi;
    struct Pre {}; __device__ __forceinline__ void prefetch(Pre&) const {}
    __device__ __forceinline__ void operator()(f32x16& p0, f32x16& p1, const Pre&, int, int hi) const {
#pragma unroll
        for (int r = 0; r < 16; ++r) { const int kj = crow(r, hi); p0[r] = (kj <= qi) ? p0[r] : -1e30f; p1[r] = (kj + 32 <= qi) ? p1[r] : -1e30f; } } };
struct MbNeigh { const LAS float* base;
    struct Pre { float b[32]; };
    __device__ __forceinline__ void prefetch(Pre& P) const {
        const unsigned a = (unsigned)(unsigned long)base;
#define NB_RD16(B, OFF) asm volatile( \
            "ds_read_b32 %0, %16 offset:" #OFF "+0\n\tds_read_b32 %1, %16 offset:" #OFF "+4\n\tds_read_b32 %2, %16 offset:" #OFF "+8\n\tds_read_b32 %3, %16 offset:" #OFF "+12\n\t" \
            "ds_read_b32 %4, %16 offset:" #OFF "+32\n\tds_read_b32 %5, %16 offset:" #OFF "+36\n\tds_read_b32 %6, %16 offset:" #OFF "+40\n\tds_read_b32 %7, %16 offset:" #OFF "+44\n\t" \
            "ds_read_b32 %8, %16 offset:" #OFF "+64\n\tds_read_b32 %9, %16 offset:" #OFF "+68\n\tds_read_b32 %10, %16 offset:" #OFF "+72\n\tds_read_b32 %11, %16 offset:" #OFF "+76\n\t" \
            "ds_read_b32 %12, %16 offset:" #OFF "+96\n\tds_read_b32 %13, %16 offset:" #OFF "+100\n\tds_read_b32 %14, %16 offset:" #OFF "+104\n\tds_read_b32 %15, %16 offset:" #OFF "+108\n\t" \
            "s_waitcnt lgkmcnt(0)" \
            : "=&v"(P.b[B + 0]), "=&v"(P.b[B + 1]), "=&v"(P.b[B + 2]), "=&v"(P.b[B + 3]), "=&v"(P.b[B + 4]), "=&v"(P.b[B + 5]), "=&v"(P.b[B + 6]), "=&v"(P.b[B + 7]), \
              "=&v"(P.b[B + 8]), "=&v"(P.b[B + 9]), "=&v"(P.b[B + 10]), "=&v"(P.b[B + 11]), "=&v"(P.b[B + 12]), "=&v"(P.b[B + 13]), "=&v"(P.b[B + 14]), "=&v"(P.b[B + 15]) : "v"(a) : "memory")
        NB_RD16(0, 0); NB_RD16(16, 128);
#undef NB_RD16
    }
    __device__ __forceinline__ void operator()(f32x16& p0, f32x16& p1, const Pre& P, int, int) const {
#pragma unroll
        for (int r = 0; r < 16; ++r) { p0[r] += P.b[r]; p1[r] += P.b[16 + r]; } } };

__device__ __forceinline__ void attn_a_phase(Frame& F, float* ssq) {
    const int wave = F.wave, lane = F.lane, r32 = lane & 31, hi = lane >> 5, g = wave >> 1, qh = wave & 1;
    constexpr int NQB = SEQ / 64, VOFF = 49152;
    for (int run = F.vcu; run < NB * AKVH * (NQB / 4); run += F.G) {
        const int quad = run % (NQB / 4), kvh = (run / (NQB / 4)) % AKVH, b = run / ((NQB / 4) * AKVH);
        const int j0 = quad * 4, h = kvh * 4 + g;
        const bf16_t* base = F.PROJ + (size_t)b * SEQ * DIN;
        const float sink2 = F.sink[h] * LOG2E;
#define AT_DMA(k) do { const int _s = (((k) + 6) % 6) * 8192; const bf16_t* _r = base + (size_t)((k) * 64) * DIN; \
        dma_k(_r + OFF_KA + kvh * HD, F.lds + _s, wave, lane); dma_v(_r + OFF_VA + kvh * HD, F.lds + VOFF + _s, wave, lane); } while (0)
        asm volatile("s_waitcnt lgkmcnt(0)" ::: "memory"); __builtin_amdgcn_s_barrier();
#pragma unroll
        for (int k = -2; k <= 2; ++k) { if (j0 + k >= 0 && j0 + k < NQB) AT_DMA(j0 + k); }
        bf16x8 qr[4];
        { const bf16_t* qp = base + (size_t)(j0 * 64 + qh * 32 + r32) * DIN + OFF_QA + h * HD + hi * 8;
#pragma unroll
          for (int d0 = 0; d0 < 4; ++d0) qr[d0] = *(const GAS bf16x8*)(qp + d0 * 16); }
#pragma unroll 1
        for (int i = 0; i < 4; ++i) {
            const int j = j0 + i, q0 = j * 64;
            if (i > 0) { asm volatile("s_waitcnt lgkmcnt(0)" ::: "memory"); __builtin_amdgcn_s_barrier(); }
            const bool pf = (i < 3) && (j + 3 < NQB);
            if (pf) AT_DMA(j + 3);
            if (pf) asm volatile("s_waitcnt vmcnt(2)" ::: "memory"); else asm volatile("s_waitcnt vmcnt(0)" ::: "memory");
            __builtin_amdgcn_s_barrier();
            AttnState<1> st; st.m = sink2; st.l = (hi == 0) ? 1.f : 0.f;
#pragma unroll
            for (int r = 0; r < 16; ++r) { st.o[0][r] = 0.f; st.o[1][r] = 0.f; }
            st.cin[0] = -sink2;
            const int qi = qh * 32 + r32;
#define AT_SLOT(k) (F.lds + (((k) + 6) % 6) * 8192)
            if (j - 2 >= 0) attn_tile(false, AT_SLOT(j - 2), AT_SLOT(j - 2) + VOFF, qr, st, r32, hi, lane, MbBandLo{qi});
            if (j - 1 >= 0) attn_tile(false, AT_SLOT(j - 1), AT_SLOT(j - 1) + VOFF, qr, st, r32, hi, lane, MbNone{});
            attn_tile(false, AT_SLOT(j), AT_SLOT(j) + VOFF, qr, st, r32, hi, lane, MbNone{});
            if (j + 1 < NQB) attn_tile(false, AT_SLOT(j + 1), AT_SLOT(j + 1) + VOFF, qr, st, r32, hi, lane, MbNone{});
            if (j + 2 < NQB) attn_tile(false, AT_SLOT(j + 2), AT_SLOT(j + 2) + VOFF, qr, st, r32, hi, lane, MbBandHi{qi});
            const int tok0 = b * SEQ + q0 + qh * 32;
            attn_finish(st, F.lds + 98304 + wave * 4096, F.O + (size_t)tok0 * DM + h * HD, ssq + tok0 * 2, r32, hi, lane);
            if (i < 3) { const bf16_t* qp = base + (size_t)((j + 1) * 64 + qh * 32 + r32) * DIN + OFF_QA + h * HD + hi * 8;
#pragma unroll
                for (int d0 = 0; d0 < 4; ++d0) qr[d0] = *(const GAS bf16x8*)(qp + d0 * 16); }
        }
#undef AT_DMA
#undef AT_SLOT
    }
}
constexpr int NTAB_OFF = LDSCTL_OFF + 2048;
__device__ __forceinline__ int na_rs(int r) { return min(max(r - NAR / 2, 0), GW - NAR); }
__device__ __forceinline__ void attn_b_phase(Frame& F, float* ssq) {
    const int wave = F.wave, lane = lane_id()  , r32 = lane & 31, hi = lane >> 5, rw = wave >> 1, qh = wave & 1;
    LAS float* tab = (LAS float*)(F.lds + NTAB_OFF);
    const int qc = qh * 32 + r32, cs = min(max(qc - NAC / 2, 0), GW - NAC);
    constexpr int RUNROWS = 16, NRUN = NB * BH * (GW / RUNROWS);
#define NB_DMA(t) do { const int _bs = ((t) & 7) * 16384; const bf16_t* _kr = F.PROJ + ((size_t)rb * SEQ + (size_t)(t) * GW) * DIN; int _l = lane; asm volatile("" : "+v"(_l));   \
        dma_k(_kr + OFF_KB + rhead * HD, F.lds + _bs, wave, _l); dma_v(_kr + OFF_VB + rhead * HD, F.lds + _bs + 8192, wave, _l); } while (0)
#define NB_QLOAD(dst, row) do { const bf16_t* _qp = F.PROJ + ((size_t)rb * SEQ + (size_t)(row) * GW + qc) * DIN + OFF_QB + rhead * HD + hi * 8; \
        _Pragma("unroll") for (int d0 = 0; d0 < 4; ++d0) dst[d0] = *(const GAS bf16x8*)(_qp + d0 * 16); } while (0)
    int cur_head = -1;
    for (int run = F.vcu; run < NRUN; run += F.G) {
        const int rbase = (run % (GW / RUNROWS)) * RUNROWS, rhead = (run / (GW / RUNROWS)) % BH, rb = run / ((GW / RUNROWS) * BH);
        const int Thi = na_rs(rbase + RUNROWS - 1) + NAR - 1;
        asm volatile("s_waitcnt vmcnt(0) lgkmcnt(0)" ::: "memory"); __builtin_amdgcn_s_barrier();
        if (rhead != cur_head) {
            cur_head = rhead;
            for (int i = wave * 64 + lane_id(); i < 15 * 128; i += NWAVES * 64) { const int d = (i & 127) - 63, ro = i >> 7;
                tab[i] = (d >= -15 && d <= 15) ? F.rpb[(rhead * 15 + ro) * 31 + d + 15] * LOG2E : 0.f; }
            asm volatile("s_waitcnt lgkmcnt(0)" ::: "memory"); }
        int nxt = na_rs(rbase);
        { const int lim = min(min(na_rs(rbase), na_rs(rbase + 4)) + 7, Thi);
#pragma unroll 1
          for (; nxt <= lim; ++nxt) NB_DMA(nxt); }
        bf16x8 qr[4];
        NB_QLOAD(qr, rbase + rw);
#pragma unroll 1
        for (int ui = 0; ui < RUNROWS / 4; ++ui) {
            const int r0u = rbase + 4 * ui, r = r0u + rw, rs = na_rs(r);
            const int Lb = na_rs(r0u), Hb = na_rs(r0u + 3), Ln = (ui < RUNROWS / 4 - 1) ? na_rs(r0u + 4) : 1 << 20;
            AttnState<32> st; st.m = 0.f; st.l = 0.f;
#pragma unroll
            for (int q = 0; q < 16; ++q) { st.o[0][q] = 0.f; st.o[1][q] = 0.f; }
            { int cs_ = cs; asm volatile("" : "+v"(cs_));
#pragma unroll
              for (int q = 0; q < 16; ++q) { const int kc = crow(q, hi); st.cin[q] = (kc >= cs_ && kc < cs_ + 16) ? 0.f : -1e30f; st.cin[16 + q] = (kc + 32 >= cs_ && kc + 32 < cs_ + 16) ? 0.f : -1e30f; } }
            asm volatile("" : "+v"(qr[0]), "+v"(qr[1]), "+v"(qr[2]), "+v"(qr[3]));
#pragma unroll 1
            for (int s = 0; s < NAR; ++s) {
                switch (nxt - 1 - (Hb + s)) { case 7: asm volatile("s_waitcnt vmcnt(14)" ::: "memory"); break; case 6: asm volatile("s_waitcnt vmcnt(12)" ::: "memory"); break;
                                 case 5: asm volatile("s_waitcnt vmcnt(10)" ::: "memory"); break; case 4: asm volatile("s_waitcnt vmcnt(8)" ::: "memory"); break;
                                 case 3: asm volatile("s_waitcnt vmcnt(6)" ::: "memory"); break;  case 2: asm volatile("s_waitcnt vmcnt(4)" ::: "memory"); break;
                                 case 1: asm volatile("s_waitcnt vmcnt(2)" ::: "memory"); break;  default: asm volatile("s_waitcnt vmcnt(0)" ::: "memory"); break; }
                asm volatile("s_waitcnt lgkmcnt(0)" ::: "memory"); __builtin_amdgcn_s_barrier(); asm volatile("" ::: "memory");
                { const int lim = min(min(Lb + s, Ln) + 7, Thi);
#pragma unroll 1
                  for (; nxt <= lim; ++nxt) NB_DMA(nxt); }
#ifndef NB_SLEEP
#define NB_SLEEP 12
#endif
                if (wave >= 4) __builtin_amdgcn_s_sleep(NB_SLEEP);
                const int kr = rs + s;
                const LAS unsigned char* ks = F.lds + (kr & 7) * 16384;
                const MbNeigh mbn{tab + (kr - r + NAR - 1) * 128 + (63 - qc + 4 * hi)};
                attn_tile(s == 0, ks, ks + 8192, qr, st, r32, hi, lane, mbn);
            }
            const int tok = rb * SEQ + r * GW + qc;
            attn_finish_direct(st, F.O + (size_t)tok * DM + AQW + rhead * HD, ssq + tok * 2 + 1, hi);
            if (ui < RUNROWS / 4 - 1) NB_QLOAD(qr, r + 4);
        }
    }
#undef NB_DMA
#undef NB_QLOAD
}
constexpr int P4_MAXU = 4, P4_TAB_OFF = NTAB_OFF;
struct EpiX1 {
    static constexpr bool PERM = true, MID = true, FP8 = false; static constexpr int WIDE = 1;
    bf16_t* delta; const LAS unsigned char* tabs;
    __device__ __forceinline__ void init(f32x4 (&i)[2][2], int, int, int) const { i[0][0] = i[0][1] = i[1][0] = i[1][1] = (f32x4){0.f, 0.f, 0.f, 0.f}; }
    __device__ __forceinline__ void mid_u(f32x4 (&acc)[2][2][4][2], int ui, int wr, int fr) const {
        const LAS f32x2* rt = (const LAS f32x2*)(tabs + (ui % P4_MAXU) * 3072);
#pragma unroll
        for (int ai = 0; ai < 2; ++ai)
#pragma unroll
            for (int m = 0; m < 4; ++m) { const float f = rt[ai * 128 + wr * 64 + m * 16 + fr].x;
#pragma unroll
                for (int bj = 0; bj < 2; ++bj)
#pragma unroll
                    for (int n = 0; n < 2; ++n) acc[ai][bj][m][n] *= f; }
    }
    __device__ __forceinline__ void operator()(const f32x4 (&acc)[2][2][4][2], const pg8::Unit& u, int ui, int wr, int wc, int fr, int fq) const {
        const int c0 = wc * 64 + 8 * fq, col0 = u.pn * 256 + c0;
        const LAS f32x2* rt = (const LAS f32x2*)(tabs + (ui % P4_MAXU) * 3072); const LAS float* gt = (const LAS float*)(tabs + (ui % P4_MAXU) * 3072 + 2048) + c0;
        f32x4 gm[2][2];
#pragma unroll
        for (int bj = 0; bj < 2; ++bj)
#pragma unroll
            for (int n = 0; n < 2; ++n) gm[bj][n] = *(const LAS f32x4*)(gt + bj * 32 + 4 * n);
#pragma unroll
        for (int ai = 0; ai < 2; ++ai)
#pragma unroll
            for (int m = 0; m < 4; ++m) { const int rl = ai * 128 + wr * 64 + m * 16 + fr; const float rb = rt[rl].y;
                bf16_t* rowp = delta + (size_t)(u.pm * 256 + rl) * DM + col0;
#pragma unroll
                for (int bj = 0; bj < 2; ++bj) { const f32x4 v0 = gm[bj][0] * (acc[ai][bj][m][0] * rb), v1 = gm[bj][1] * (acc[ai][bj][m][1] * rb);
                    u32x4 w; w.x = cvt_pk_bf16(v0[0], v0[1]); w.y = cvt_pk_bf16(v0[2], v0[3]); w.z = cvt_pk_bf16(v1[0], v1[1]); w.w = cvt_pk_bf16(v1[2], v1[3]);
                    *(GAS u32x4*)(rowp + bj * 32) = w; } }
    }
};
__device__ __forceinline__ void p4_tables(Frame& F, const pg8::DenseOrder& S) {
    pg8::Unit u;
    for (int i = 0; i < P4_MAXU && S.next(i, u); ++i) {
        LAS unsigned char* tb = F.lds + P4_TAB_OFF + i * 3072;
        if (F.tid < 256) { const int row = u.pm * 256 + F.tid; const f32x2 s = *(const GAS f32x2*)(F.ssq + row * 2);
            const float ia = s.x * (1.f / 512.f) + EPS, ib = s.y * (1.f / 512.f) + EPS;
            ((LAS f32x2*)tb)[F.tid] = (f32x2){sqrtf(ib / ia), 1.0f / sqrtf(ib)}; }
        else { const int c = F.tid - 256; ((LAS float*)(tb + 2048))[c] = F.mod[((u.pm * 256) / SEQ) * 6 * DM + 2 * DM + u.pn * 256 + c]; }
    }
    asm volatile("s_waitcnt vmcnt(0) lgkmcnt(0)" ::: "memory"); __syncthreads();
}

__device__ __forceinline__ void router_phase(Frame& F, gu32* cntw) {
    const int wave = F.wave, lane = F.lane, r32 = lane & 31, hi = lane >> 5;
    bf16x8 wh[8], wl[8];
#pragma unroll
    for (int c = 0; c < 8; ++c) { const bf16_t* p = F.wr_t + r32 * DM + 128 * wave + 16 * c + 8 * hi; wh[c] = *(const GAS bf16x8*)p; wl[c] = *(const GAS bf16x8*)(p + NE * DM); }
    LAS unsigned char* imgH = F.lds;
    LAS unsigned char* imgL = F.lds + 65536;
    LAS float* R = (LAS float*)(F.lds);
    LAS float* L = (LAS float*)(F.lds + NTAB_OFF);
    LAS int* lcnt = (LAS int*)(F.lds + NTAB_OFF + 4352);
    for (int it = F.vcu; it < NTOK / 32; it += F.G) {
        const int t0 = it * 32, b = t0 / SEQ;
        { f32x4 s1[4], sh[4];
#pragma unroll
          for (int j = 0; j < 4; ++j) { s1[j] = *(const GAS f32x4*)(F.mod + b * 6 * DM + 4 * DM + 4 * lane + 256 * j) + 1.0f; sh[j] = *(const GAS f32x4*)(F.mod + b * 6 * DM + 3 * DM + 4 * lane + 256 * j); }
#pragma unroll
          for (int pr = 0; pr < 2; ++pr) {
              f32x4 xv[2][4]; u32x2 dv[2][4];
#pragma unroll
              for (int tt = 0; tt < 2; ++tt) { const int tok = t0 + 4 * wave + 2 * pr + tt;
                  const GAS f32x4* xr = (const GAS f32x4*)(F.x + (size_t)tok * DM) + lane; const GAS u32x2* dr = (const GAS u32x2*)(F.DELTA + (size_t)tok * DM) + lane;
#pragma unroll
                  for (int j = 0; j < 4; ++j) { xv[tt][j] = xr[64 * j]; dv[tt][j] = dr[64 * j]; } }
#pragma unroll
              for (int tt = 0; tt < 2; ++tt) { const int tl = 4 * wave + 2 * pr + tt, tok = t0 + tl; float s = 0.f;
#pragma unroll
                  for (int j = 0; j < 4; ++j) { const u32x2 w = dv[tt][j]; xv[tt][j] += (f32x4){bf2f(w.x & 0xffffu), bf2f(w.x >> 16), bf2f(w.y & 0xffffu), bf2f(w.y >> 16)};
                      s += (xv[tt][j].x * xv[tt][j].x + xv[tt][j].y * xv[tt][j].y) + (xv[tt][j].z * xv[tt][j].z + xv[tt][j].w * xv[tt][j].w); }
                  const float rstd = 1.0f / sqrtf(wave_sum(s) * (1.f / DM) + EPS);
                  GAS unsigned* xn = (GAS unsigned*)((unsigned char*)F.XN + (size_t)tok * DM) + lane;
#pragma unroll
                  for (int j = 0; j < 4; ++j) { const f32x4 h = xv[tt][j] * rstd * s1[j] + sh[j];
                      u32x2 hw; hw.x = pk2(h.x, h.y); hw.y = pk2(h.z, h.w);
                      u32x2 lw; lw.x = pk2(h.x - bf2f(hw.x & 0xffffu), h.y - bf2f(hw.x >> 16)); lw.y = pk2(h.z - bf2f(hw.y & 0xffffu), h.w - bf2f(hw.y >> 16));
                      xn[64 * j] = pk_fp8x4(h.x, h.y, h.z, h.w);
                      const int off = tl * 2048 + ((((lane >> 1) + 32 * j) ^ (tl & 15)) << 4) + (lane & 1) * 8;
                      *(LAS u32x2*)(imgH + off) = hw; *(LAS u32x2*)(imgL + off) = lw; } } } }
        asm volatile("s_waitcnt lgkmcnt(0)" ::: "memory"); __builtin_amdgcn_s_barrier(); asm volatile("" ::: "memory");
        f32x16 acc;
#pragma unroll
        for (int r = 0; r < 16; ++r) acc[r] = 0.f;
#pragma unroll
        for (int c = 0; c < 8; ++c) { const int off = r32 * 2048 + (((16 * wave + 2 * c + hi) ^ (r32 & 15)) << 4);
            const bf16x8 hf = *(const LAS bf16x8*)(imgH + off), lf = *(const LAS bf16x8*)(imgL + off);
            acc = __builtin_amdgcn_mfma_f32_32x32x16_bf16(hf, wh[c], acc, 0, 0, 0);
            acc = __builtin_amdgcn_mfma_f32_32x32x16_bf16(lf, wh[c], acc, 0, 0, 0);
            acc = __builtin_amdgcn_mfma_f32_32x32x16_bf16(hf, wl[c], acc, 0, 0, 0);
        }
        asm volatile("s_waitcnt lgkmcnt(0)" ::: "memory"); __builtin_amdgcn_s_barrier(); asm volatile("" ::: "memory");
#pragma unroll
        for (int r = 0; r < 16; ++r) R[wave * 1024 + crow(r, hi) * 32 + r32] = acc[r];
        asm volatile("s_waitcnt lgkmcnt(0)" ::: "memory"); __builtin_amdgcn_s_barrier(); asm volatile("" ::: "memory");
#pragma unroll
        for (int q = 0; q < 2; ++q) { const int idx = F.tid * 2 + q, tk = idx >> 5, e = idx & 31; float v = F.b_router[e];
#pragma unroll
            for (int w = 0; w < 8; ++w) v += R[w * 1024 + idx];
            L[tk * 33 + e] = v; }
        asm volatile("s_waitcnt lgkmcnt(0)" ::: "memory"); __builtin_amdgcn_s_barrier(); asm volatile("" ::: "memory");
        if (wave == 0) {
            if (lane < 32) lcnt[lane] = 0;
            asm volatile("s_waitcnt lgkmcnt(0)" ::: "memory");
            int sel[TOPK]; float gt[TOPK]; int lpos[TOPK];
            if (lane < 32) {
                float v[NE];
#pragma unroll
                for (int j = 0; j < NE; ++j) v[j] = L[lane * 33 + j];
                unsigned used = 0u; float sv[TOPK];
#pragma unroll
                for (int kk = 0; kk < TOPK; ++kk) { float best = -INFINITY; int bi = 0;
#pragma unroll
                    for (int j = 0; j < NE; ++j) { const bool ok = !((used >> j) & 1u) && (v[j] > best); best = ok ? v[j] : best; bi = ok ? j : bi; }
                    used |= 1u << bi; sel[kk] = bi; sv[kk] = best; }
                float den = 0.f;
#pragma unroll
                for (int kk = 0; kk < TOPK; ++kk) { gt[kk] = __expf(sv[kk] - sv[0]); den += gt[kk]; }
                const float rden = 1.0f / den;
#pragma unroll
                for (int kk = 0; kk < TOPK; ++kk) { gt[kk] *= rden; lpos[kk] = __hip_atomic_fetch_add(lcnt + sel[kk], 1, __ATOMIC_RELAXED, __HIP_MEMORY_SCOPE_WORKGROUP); }
            }
            asm volatile("s_waitcnt lgkmcnt(0)" ::: "memory");
            if (lane < 32) { const int n = lcnt[lane]; int base = 0;
                if (n > 0) base = (int)__hip_atomic_fetch_add((unsigned*)(cntw + lane * 64), (unsigned)n, __ATOMIC_RELAXED, __HIP_MEMORY_SCOPE_AGENT);
                lcnt[32 + lane] = base; }
            asm volatile("s_waitcnt vmcnt(0) lgkmcnt(0)" ::: "memory");
            if (lane < 32) {
                const int t = t0 + lane;
#pragma unroll
                for (int kk = 0; kk < TOPK; ++kk) { const int e = sel[kk], pos = lcnt[32 + e] + lpos[kk];
                    F.tkg[t * 4 + kk] = gt[kk]; F.list[e * NTOK + pos] = t * 4 + kk; }
            }
        }
    }
}

__device__ __forceinline__ void moe_table(Frame& F) {
    LAS int* tab = (LAS int*)(F.lds + TAB_OFF);
    if (F.tid == 0) { int s = 0;
        for (int e = 0; e < NE; ++e) { const int c = (int)__hip_atomic_load((unsigned*)(F.ctl + CW_CNT + e * 64), __ATOMIC_RELAXED, __HIP_MEMORY_SCOPE_AGENT); tab[e] = s; tab[40 + e] = c; s += (c + 255) >> 8; }
        tab[32] = s; }
    asm volatile("s_waitcnt vmcnt(0) lgkmcnt(0)" ::: "memory"); __syncthreads();
}
constexpr int META_OFF = NTAB_OFF, META_SLOT = 2048;
template <bool GATHER>
struct MoeOrder {
    const char* A; const char* Bt; const int* list; const float* bias; const LAS int* tab; LAS unsigned char* meta; int K, N, nN, G, c;
    mutable int ec;
    __device__ bool next(int i, pg8::Unit& u) const {
        const int L = i * G + c; if (L >= tab[32] * nN) return false;
        int e = ec;
#pragma unroll 1
        while (L >= tab[e + 1] * nN) ++e;
        ec = e;
        const int nm = tab[e + 1] - tab[e], ql = L - tab[e] * nN;
        u.e = e; u.pn = ql / nm; u.aux = ql % nm; u.pm = tab[e] + u.aux; return true;
    }
    __device__ __forceinline__ const char* abase() const { return A; }
    __device__ __forceinline__ const char* bbase(const pg8::Unit& u) const { return Bt + ((size_t)u.e * N + (size_t)u.pn * 256) * K; }
    __device__ __forceinline__ void dma_list(const pg8::Unit& u, int slot) const {
        const int lane = lane_id();
        __builtin_amdgcn_global_load_lds((const unsigned*)(list + (size_t)u.e * NTOK + u.aux * 256 + 4 * lane), (LAS unsigned*)(meta + slot * META_SLOT), 16, 0, 0);
    }
    __device__ __forceinline__ void dma_bias(const pg8::Unit& u, int slot) const {
        const int lane = lane_id();
        const float* src = GATHER ? bias + (size_t)u.e * 2 * DFF + u.pn * 128 + (lane >> 5) * DFF + 4 * (lane & 31) : bias + (size_t)u.e * DM + u.pn * 256 + 4 * lane;
        __builtin_amdgcn_global_load_lds((const unsigned*)src, (LAS unsigned*)(meta + slot * META_SLOT + 1024), 16, 0, 0);
    }
    __device__ __forceinline__ void meta_init(const pg8::Unit& u0, bool h1, const pg8::Unit& u1, int wid) const {
        if (wid == 0) { dma_list(u0, 0); dma_bias(u0, 0); if (h1) dma_list(u1, 1); }
        asm volatile("s_waitcnt vmcnt(0)" ::: "memory"); __builtin_amdgcn_s_barrier(); asm volatile("" ::: "memory");
    }
    __device__ __forceinline__ void meta_top(int ui, bool has_next, const pg8::Unit& nxt, bool h2, const pg8::Unit& nn, int wid) const {
        if (wid == 0) { if (has_next) dma_bias(nxt, (ui + 1) % 3); if (h2) dma_list(nn, (ui + 2) % 3); }
    }
    __device__ __forceinline__ void aoffs(const pg8::Unit& u, int ui, const int (&R)[2], const int (&C)[2], unsigned (&off)[4]) const {
        if (GATHER) { const int lim = tab[40 + u.e] - 1 - u.aux * 256; const LAS int* lst = (const LAS int*)(meta + (ui % 3) * META_SLOT);
#pragma unroll
            for (int h = 0; h < 2; ++h)
#pragma unroll
                for (int i = 0; i < 2; ++i) { int mi = h * 128 + R[i]; mi = mi < lim ? mi : lim; const int tk = lst[mi] >> 2; off[h * 2 + i] = (unsigned)(tk * K + C[i] * 2); }
        } else {
#pragma unroll
            for (int h = 0; h < 2; ++h)
#pragma unroll
                for (int i = 0; i < 2; ++i) off[h * 2 + i] = (unsigned)((u.pm * 256 + h * 128 + R[i]) * K + C[i] * 2);
        }
    }
};
struct EpiSwiglu {
    static constexpr bool PERM = true, MID = false, FP8 = true; static constexpr int WIDE = 0;
    bf16_t* act; const LAS unsigned char* meta;
    __device__ __forceinline__ void mid(f32x4 (&)[2][2][4][2], const pg8::Unit&, int, int) const {}
    __device__ __forceinline__ void init(f32x4 (&i)[2][2], int ui, int wc, int fq) const {
        const LAS float* bp = (const LAS float*)(meta + (ui % 3) * META_SLOT + 1024) + wc * 32 + 8 * fq;
        i[0][0] = *(const LAS f32x4*)bp; i[0][1] = *(const LAS f32x4*)(bp + 4); i[1][0] = *(const LAS f32x4*)(bp + 128); i[1][1] = *(const LAS f32x4*)(bp + 132);
    }
    __device__ __forceinline__ void operator()(const f32x4 (&acc)[2][2][4][2], const pg8::Unit& u, int, int wr, int wc, int fr, int fq) const {
        const int f0 = u.pn * 128 + wc * 32 + 8 * fq, row0 = u.pm * 256 + wr * 64 + fr;
#pragma unroll
        for (int ai = 0; ai < 2; ++ai)
#pragma unroll
            for (int m = 0; m < 4; ++m) { const int row = row0 + ai * 128 + m * 16;
                float o[8];
#pragma unroll
                for (int q = 0; q < 8; ++q) { float g = (q < 4 ? acc[ai][0][m][0][q] : acc[ai][0][m][1][q - 4]);
                    float up = (q < 4 ? acc[ai][1][m][0][q] : acc[ai][1][m][1][q - 4]);
                    g = __builtin_fminf(g, 7.f); up = __builtin_amdgcn_fmed3f(up, -7.f, 7.f);
                    const float glu = g * __builtin_amdgcn_rcpf(1.f + __builtin_amdgcn_exp2f(-1.702f * LOG2E * g));
                    o[q] = __builtin_fmaf(up, glu, glu); }
                u32x2 w; w.x = pk_fp8x4(o[0], o[1], o[2], o[3]); w.y = pk_fp8x4(o[4], o[5], o[6], o[7]);
                *(GAS u32x2*)((unsigned char*)act + (size_t)row * DFF + f0) = w; }
    }
};
struct EpiNull {
    static constexpr bool PERM = true, MID = false, FP8 = true; static constexpr int WIDE = 0;
    __device__ __forceinline__ void mid(f32x4 (&)[2][2][4][2], const pg8::Unit&, int, int) const {}
    __device__ __forceinline__ void init(f32x4 (&i)[2][2], int, int, int) const { i[0][0] = i[0][1] = i[1][0] = i[1][1] = (f32x4){0.f, 0.f, 0.f, 0.f}; }
    __device__ __forceinline__ void operator()(const f32x4 (&acc)[2][2][4][2], const pg8::Unit&, int, int, int, int, int) const {
#pragma unroll
        for (int a = 0; a < 2; ++a)
#pragma unroll
            for (int b = 0; b < 2; ++b)
#pragma unroll
                for (int m = 0; m < 4; ++m)
#pragma unroll
                    for (int n = 0; n < 2; ++n) asm volatile("" :: "v"(acc[a][b][m][n]));
    }
};
struct EpiDense {
    static constexpr bool PERM = true, MID = false, FP8 = true; static constexpr int WIDE = 0;
    bf16_t* dst;
    __device__ __forceinline__ void mid(f32x4 (&)[2][2][4][2], const pg8::Unit&, int, int) const {}
    __device__ __forceinline__ void init(f32x4 (&i)[2][2], int, int, int) const { i[0][0] = i[0][1] = i[1][0] = i[1][1] = (f32x4){0.f, 0.f, 0.f, 0.f}; }
    __device__ __forceinline__ void operator()(const f32x4 (&acc)[2][2][4][2], const pg8::Unit& u, int, int wr, int wc, int fr, int fq) const {
        const int tid = (wr * 4 + wc) * 64 + fq * 16 + fr;
        unsigned char* base = (unsigned char*)dst + ((size_t)(u.pm * 4 + u.pn) % 512) * 131072 + tid * 16;
#pragma unroll
        for (int ai = 0; ai < 2; ++ai)
#pragma unroll
            for (int m = 0; m < 4; ++m)
#pragma unroll
                for (int bj = 0; bj < 2; ++bj) { const f32x4 v0 = acc[ai][bj][m][0], v1 = acc[ai][bj][m][1];
                    u32x4 w; w.x = cvt_pk_bf16(v0[0], v0[1]); w.y = cvt_pk_bf16(v0[2], v0[3]); w.z = cvt_pk_bf16(v1[0], v1[1]); w.w = cvt_pk_bf16(v1[2], v1[3]);
                    *(GAS u32x4*)(base + ((ai * 4 + m) * 2 + bj) * 8192) = w; }
    }
};
struct EpiYs {
    static constexpr bool PERM = true, MID = false, FP8 = true; static constexpr int WIDE = 2;
    bf16_t* ys; const LAS int* tab; const LAS unsigned char* meta;
    __device__ __forceinline__ void mid(f32x4 (&)[2][2][4][2], const pg8::Unit&, int, int) const {}
    __device__ __forceinline__ void init(f32x4 (&i)[2][2], int ui, int wc, int fq) const {
        const LAS float* bp = (const LAS float*)(meta + (ui % 3) * META_SLOT + 1024) + wc * 64 + 16 * fq;
#pragma unroll
        for (int bj = 0; bj < 2; ++bj)
#pragma unroll
            for (int n = 0; n < 2; ++n) i[bj][n] = *(const LAS f32x4*)(bp + bj * 8 + 4 * n);
    }
    __device__ __forceinline__ void operator()(const f32x4 (&acc)[2][2][4][2], const pg8::Unit& u, int ui, int wr, int wc, int fr, int fq) const {
        const int col0 = u.pn * 256 + wc * 64 + 16 * fq, rl0 = wr * 64 + fr, lim = tab[40 + u.e] - u.aux * 256;
        const LAS int* lst = (const LAS int*)(meta + (ui % 3) * META_SLOT);
        int ent[2][4];
#pragma unroll
        for (int ai = 0; ai < 2; ++ai)
#pragma unroll
            for (int m = 0; m < 4; ++m) { const int rl = rl0 + ai * 128 + m * 16; const int e_ = lst[rl]; ent[ai][m] = (rl < lim) ? e_ : -1; }
#pragma unroll
        for (int ai = 0; ai < 2; ++ai)
#pragma unroll
            for (int m = 0; m < 4; ++m) { if (ent[ai][m] >= 0) {
                    u32x4 w;
                    { const f32x4 v0 = acc[ai][0][m][0], v1 = acc[ai][0][m][1]; w.x = pk_fp8x4(v0[0], v0[1], v0[2], v0[3]); w.y = pk_fp8x4(v1[0], v1[1], v1[2], v1[3]); }
                    { const f32x4 v0 = acc[ai][1][m][0], v1 = acc[ai][1][m][1]; w.z = pk_fp8x4(v0[0], v0[1], v0[2], v0[3]); w.w = pk_fp8x4(v1[0], v1[1], v1[2], v1[3]); }
                    *(GAS u32x4*)((unsigned char*)ys + (size_t)ent[ai][m] * DM + col0) = w; } }
    }
};
struct FinRow { f32x4 x[4]; u32x2 d[4]; unsigned y[TOPK][4]; };
__device__ __forceinline__ void fin_load(FinRow& R, const float* xrow, const bf16_t* drow, const bf16_t* yrow, int lane) {
    const GAS f32x4* xr = (const GAS f32x4*)xrow + lane;
#pragma unroll
    for (int kk = 0; kk < TOPK; ++kk) { const GAS unsigned* yr = (const GAS unsigned*)((const unsigned char*)yrow + (size_t)kk * DM) + lane;
#pragma unroll
        for (int j = 0; j < 4; ++j) R.y[kk][j] = __builtin_nontemporal_load(yr + 64 * j); }
    const GAS u32x2* dr = (const GAS u32x2*)drow + lane;
#pragma unroll
    for (int j = 0; j < 4; ++j) { R.x[j] = xr[64 * j]; R.d[j] = dr[64 * j]; }
}
__device__ __forceinline__ void fin_compute(const FinRow& R, float* drow, float gv, int r, int lane, const f32x4 (&gfm)[4], const f32x4 (&gf)[4]) {
    f32x4 y[4];
#pragma unroll
    for (int j = 0; j < 4; ++j) y[j] = (f32x4){0.f, 0.f, 0.f, 0.f};
#pragma unroll
    for (int kk = 0; kk < TOPK; ++kk) { const float g = __builtin_bit_cast(float, __builtin_amdgcn_readlane(__builtin_bit_cast(int, gv), r * 4 + kk));
#pragma unroll
        for (int j = 0; j < 4; ++j) { const int w = (int)R.y[kk][j]; const f32x2 lo = __builtin_amdgcn_cvt_pk_f32_fp8(w, false), hi = __builtin_amdgcn_cvt_pk_f32_fp8(w, true);
            y[j] += (f32x4){lo.x, lo.y, hi.x, hi.y} * g; } }
    f32x4 v[4]; float s = 0.f;
#pragma unroll
    for (int j = 0; j < 4; ++j) { const u32x2 w = R.d[j]; v[j] = (R.x[j] + (f32x4){bf2f(w.x & 0xffffu), bf2f(w.x >> 16), bf2f(w.y & 0xffffu), bf2f(w.y >> 16)}) + gfm[j] * y[j]; s += (v[j].x * v[j].x + v[j].y * v[j].y) + (v[j].z * v[j].z + v[j].w * v[j].w); }
    const float rstd = 1.f / sqrtf(wave_sum(s) * (1.f / DM) + EPS);
    GAS f32x4* orow = (GAS f32x4*)drow + lane;
#pragma unroll
    for (int j = 0; j < 4; ++j) orow[64 * j] = v[j] * rstd * gf[j];
}
__device__ __forceinline__ void final_phase(Frame& F, float* dst) {
    const int gw = F.vcu * NWAVES + F.wave, NGW = F.G * NWAVES, lane = F.lane;
    f32x4 gf[4];
#pragma unroll
    for (int j = 0; j < 4; ++j) gf[j] = *(const GAS f32x4*)(F.g_final + 4 * lane + 256 * j);
    for (int chunk = gw; chunk < NTOK / 16; chunk += NGW) {
        const int m0 = chunk * 16, b = m0 / SEQ;
        f32x4 gfm[4];
#pragma unroll
        for (int j = 0; j < 4; ++j) gfm[j] = *(const GAS f32x4*)(F.mod + b * 6 * DM + 5 * DM + 4 * lane + 256 * j);
        const float gv = F.tkg[m0 * 4 + lane];
        FinRow A, B;
        fin_load(A, F.x + (size_t)m0 * DM, F.DELTA + (size_t)m0 * DM, (const bf16_t*)((const unsigned char*)F.YS + (size_t)m0 * 4 * DM), lane);
#pragma unroll 1
        for (int r = 0; r < 16; r += 2) {
            fin_load(B, F.x + (size_t)(m0 + r + 1) * DM, F.DELTA + (size_t)(m0 + r + 1) * DM, (const bf16_t*)((const unsigned char*)F.YS + (size_t)(m0 + r + 1) * 4 * DM), lane);
            fin_compute(A, dst + (size_t)(m0 + r) * DM, gv, r, lane, gfm, gf);
            if (r + 2 < 16) fin_load(A, F.x + (size_t)(m0 + r + 2) * DM, F.DELTA + (size_t)(m0 + r + 2) * DM, (const bf16_t*)((const unsigned char*)F.YS + (size_t)(m0 + r + 2) * 4 * DM), lane);
            fin_compute(B, dst + (size_t)(m0 + r + 1) * DM, gv, r + 1, lane, gfm, gf);
        }
    }
}
struct MkArgs { const float* in[17]; float* out; unsigned char* ws; int ph_lo, ph_hi; };
#ifndef DBG_STAGE
#define DBG_STAGE 9
#endif
constexpr int N_PHASES = DBG_STAGE;
__global__ void __launch_bounds__(NWAVES * 64, 2) mk_fwd(MkArgs args) {
    extern __shared__ __attribute__((aligned(16))) unsigned char lds[];
    Frame F;
    F.lds = (LAS unsigned char*)lds;
    F.MISC = (volatile LAS unsigned*)(F.lds + MISC_OFF);
    F.tid = threadIdx.x; F.lane = F.tid & 63; F.wave = __builtin_amdgcn_readfirstlane(F.tid >> 6);
    F.G = gridDim.x; { const int bx = blockIdx.x; F.vcu = (F.G % 8 == 0) ? (bx % 8) * (F.G / 8) + bx / 8 : bx; }
    unsigned char* ws = args.ws;
    F.ctl = (gu32*)(ws + WS_CTL);
    F.x = args.in[0]; F.c = args.in[1]; F.w_ada = args.in[2]; F.b_ada = args.in[3]; F.w_in = args.in[4]; F.sink = args.in[5]; F.rpb = args.in[6]; F.ga = args.in[7]; F.gb = args.in[8];
    F.w_out = args.in[9]; F.w_router = args.in[10]; F.b_router = args.in[11]; F.w_gu = args.in[12]; F.b_gu = args.in[13]; F.w_down = args.in[14]; F.b_down = args.in[15]; F.g_final = args.in[16];
    F.out = args.out;
    F.mod = (float*)(ws + WS_MOD); F.rope = (float*)(ws + WS_ROPE); F.ssq = (float*)(ws + WS_SSQ); F.tkg = (float*)(ws + WS_TKG); F.tke = (int*)(ws + WS_TKE); F.list = (int*)(ws + WS_LIST);
    F.wr_t = (bf16_t*)(ws + WS_WR); F.win_t = (bf16_t*)(ws + WS_WIN); F.wout_t = (bf16_t*)(ws + WS_WOUT); F.wgu_t = (bf16_t*)(ws + WS_WGU); F.wd_t = (bf16_t*)(ws + WS_WD);
    F.XN = (bf16_t*)(ws + WS_XN); F.PROJ = (bf16_t*)(ws + WS_PROJ); F.O = (bf16_t*)(ws + WS_O); F.YS = (bf16_t*)(ws + WS_YS); F.ACT = (bf16_t*)(ws + WS_ACT); F.DELTA = (bf16_t*)(ws + WS_DELTA);
    for (int u = F.tid; u < (LDS_BYTES - LDSCTL_OFF) / 4; u += NWAVES * 64) ((LAS unsigned*)(F.lds + LDSCTL_OFF))[u] = 0u;
    __syncthreads();
    const int lo = args.ph_lo, hi = args.ph_hi;
    XcdBarrier bar; bar.bar = (unsigned*)(F.ctl + CW_BAR); bar.x = 0; bar.st = nullptr;
    if (hi - lo > 1) bar = xcd_barrier_post((unsigned*)(F.ctl + CW_BAR), F.MISC + 8, F.wave);
#define IN(k) (lo <= (k) && (k) < hi)
#define MOE_STAGGER(nN_, ticks_) do { const int tot_ = ((const LAS int*)(F.lds + TAB_OFF))[32] * (nN_); const int maxu_ = (tot_ + F.G - 1) / F.G, mine_ = (tot_ - F.vcu + F.G - 1) / F.G; \
        if (mine_ < maxu_) { const unsigned long long t0_ = __builtin_amdgcn_s_memrealtime(); while (__builtin_amdgcn_s_memrealtime() - t0_ < (ticks_)) __builtin_amdgcn_s_sleep(8); } } while (0)
#define FRESH() do { F.lane = lane_id(); F.tid = F.wave * 64 + F.lane; } while (0)
#if defined(DIAG_A)
    unsigned long long* const ts = (unsigned long long*)(ws + WS_CTL + 96 * 1024);
#define STAMP(k) do { if (blockIdx.x == 0 && F.wave == 0 && lane_id() == 0) ts[k] = __builtin_amdgcn_s_memrealtime(); } while (0)
#define MSTAMP(k) do { if (F.wave == 0 && lane_id() == 0) { const unsigned long long t_ = __builtin_amdgcn_s_memrealtime(); atomicMax(&ts[k], t_); atomicMax(&ts[(k) + 1], (1ull << 62) - t_); } } while (0)
#else
#define STAMP(k) do {} while (0)
#define MSTAMP(k) do {} while (0)
#endif
#define SEAM(k) do { if (IN(k) && IN((k) + 1)) xcd_barrier(bar, F.wave); STAMP((k) + 1); } while (0)
#ifndef PROBE_PH
#define PROBE_PH -1
#endif
#ifndef PROBE_FIN
#define PROBE_FIN 0
#endif
#define REP(k) for (int _rep = (PROBE_PH == (k)) ? 0 : 1; _rep < 2; ++_rep)
    float* const dummy = (float*)(ws + 830 * MiB);
    STAMP(0);
    FRESH();
    if (IN(0)) { REP(0) { __syncthreads(); p0_prologue(F); } } SEAM(0);
    FRESH();
    if (IN(1)) { REP(1) p1_xn(F); } SEAM(1);
    FRESH();
    if (IN(2)) REP(2) {
        pg8::DenseOrder S; S.init(F.XN, F.win_t, NTOK, DIN, DM, F.G, (int)blockIdx.x);
        EpiProj E{F.PROJ, F.rope};
        pg8::gemm_phase<EpiProj, pg8::DenseOrder, true>(F.lds, DM, S, E, F.wave);
    } SEAM(2);
    FRESH();
    if (IN(3)) { if (PROBE_PH == 3) { if (PROBE_FIN != 2) attn_a_phase(F, dummy); if (PROBE_FIN != 1) attn_b_phase(F, dummy); }
                 attn_a_phase(F, F.ssq); STAMP(10); MSTAMP(16); attn_b_phase(F, F.ssq); MSTAMP(18); } SEAM(3);
    FRESH();
    if (IN(4)) REP(4) {
        pg8::DenseOrder S; S.init(F.O, F.wout_t, NTOK, DM, DM, F.G, (int)blockIdx.x);
        p4_tables(F, S);
        EpiX1 E{F.DELTA, F.lds + P4_TAB_OFF};
        pg8::gemm_phase<EpiX1, pg8::DenseOrder, true>(F.lds, DM, S, E, F.wave);
    } SEAM(4);
    FRESH();
    if (IN(5)) REP(5) { router_phase(F, _rep ? F.ctl + CW_CNT : F.ctl + 16384); } SEAM(5);
    FRESH();
    if (IN(6)) {
        moe_table(F);
        MoeOrder<true> S{(const char*)F.XN, (const char*)F.wgu_t, F.list, F.b_gu, (const LAS int*)(F.lds + TAB_OFF), F.lds + META_OFF, DM, 2 * DFF, 2 * DFF / 256, F.G, F.vcu, 0};
        if (PROBE_PH == 6) { EpiNull E0; pg8::gemm_phase<EpiNull, MoeOrder<true>, true>(F.lds, DM, S, E0, F.wave); S.ec = 0; }
        EpiSwiglu E{F.ACT, F.lds + META_OFF};
        pg8::gemm_phase<EpiSwiglu, MoeOrder<true>, true>(F.lds, DM, S, E, F.wave);
    } SEAM(6);
    FRESH();
    if (IN(7)) {
        moe_table(F);
        MoeOrder<false> S{(const char*)F.ACT, (const char*)F.wd_t, F.list, F.b_down, (const LAS int*)(F.lds + TAB_OFF), F.lds + META_OFF, DFF, DM, DM / 256, F.G, F.vcu, 0};
        if (PROBE_PH == 7) { EpiDense E0{(bf16_t*)(ws + 830 * MiB)}; pg8::gemm_phase<EpiDense, MoeOrder<false>, true>(F.lds, DFF, S, E0, F.wave); S.ec = 0; }
        EpiYs E{F.YS, (const LAS int*)(F.lds + TAB_OFF), F.lds + META_OFF};
        pg8::gemm_phase<EpiYs, MoeOrder<false>, true>(F.lds, DFF, S, E, F.wave);
    } SEAM(7);
    FRESH();
    if (IN(8)) REP(8) { final_phase(F, _rep ? F.out : dummy); }
#if defined(DIAG_A)
    xcd_barrier(bar, F.wave); STAMP(9);
    if (blockIdx.x == 0 && F.wave == 0) { asm volatile("s_waitcnt vmcnt(0)" ::: "memory");
        const unsigned long long t9 = __builtin_amdgcn_s_memrealtime(), span = (DIAG_A == 9) ? 0ull : (DIAG_A == 10) ? (ts[10] - ts[3]) : (DIAG_A == 11 || DIAG_A == 12) ? ts[DIAG_A] : (DIAG_A == 13) ? (ts[16] - ts[3]) : (DIAG_A == 14) ? ((1ull << 62) - ts[17] - ts[3]) : (DIAG_A == 15) ? (ts[18] - ts[3]) : (DIAG_A == 16) ? ((1ull << 62) - ts[19] - ts[3]) : (ts[DIAG_A + 1] - ts[DIAG_A]);
        while (__builtin_amdgcn_s_memrealtime() - t9 < 4ull * span) __builtin_amdgcn_s_sleep(16); }
#endif
#undef IN
#undef SEAM
}

__global__ void br_route(const bf16_t* XN, const int* tke, const unsigned* ctl, float* h, int* cnt, int* list) {
    const int idx = blockIdx.x * 256 + threadIdx.x;
    const int ep = tke[idx]; list[(ep >> 16) * NTOK + (ep & 0xffff)] = idx;
    if (idx < NE) cnt[idx] = (int)ctl[CW_CNT + idx * 64];
    const int t = idx >> 2, q = idx & 3;
    for (int k = q * 256; k < q * 256 + 256; ++k) h[(size_t)t * DM + k] = bf2f(XN[(size_t)t * DM + k]);
}
extern "C" void kernel_launch(void* const* d_in, const int* in_sizes, int n_in, void* d_out, int out_size, void* d_ws, size_t ws_size, hipStream_t stream) {
    static int grid = 0;
    if (grid == 0) {
        if (n_in != 17 || ws_size < (size_t)1001 * MiB) { fprintf(stderr, "kernel_launch: bad n_in %d or ws_size %zu\n", n_in, ws_size); grid = -1; return; }
        int dev = 0, cus = 0, per_cu = 0;
        if (hipGetDevice(&dev) != hipSuccess || hipDeviceGetAttribute(&cus, hipDeviceAttributeMultiprocessorCount, dev) != hipSuccess) { grid = -1; return; }
        if (hipFuncSetAttribute((const void*)mk_fwd, hipFuncAttributeMaxDynamicSharedMemorySize, LDS_BYTES) != hipSuccess) { fprintf(stderr, "kernel_launch: hipFuncSetAttribute failed\n"); grid = -1; return; }
        if (hipOccupancyMaxActiveBlocksPerMultiprocessor(&per_cu, (const void*)mk_fwd, NWAVES * 64, LDS_BYTES) != hipSuccess || per_cu < 1) { fprintf(stderr, "kernel_launch: occupancy query says %d\n", per_cu); }
        (void)hipGetLastError();
        grid = cus;
    }
    if (grid < 0) return;
    const float* x = (const float*)d_in[0]; const float* sink = (const float*)d_in[5]; const float* rpb = (const float*)d_in[6]; const float* ga = (const float*)d_in[7];
    const float* gb = (const float*)d_in[8]; const float* w_out = (const float*)d_in[9]; const float* w_router = (const float*)d_in[10]; const float* b_router = (const float*)d_in[11];
    const float* w_gu = (const float*)d_in[12]; const float* b_gu = (const float*)d_in[13]; const float* w_down = (const float*)d_in[14]; const float* b_down = (const float*)d_in[15];
    const float* g_final = (const float*)d_in[16];
    char* ws = (char*)d_ws; float* out = (float*)d_out;
    (void)hipMemsetAsync(ws + WS_CTL, 0, CTL_ZERO_BYTES, stream);
    MkArgs a{};
    for (int i = 0; i < 17; ++i) a.in[i] = (const float*)d_in[i];
    a.out = out; a.ws = (unsigned char*)d_ws;
#if defined(MK_PER_PHASE)
    for (int ph = 0; ph < N_PHASES; ++ph) { a.ph_lo = ph; a.ph_hi = ph + 1; hipLaunchKernelGGL(mk_fwd, dim3(grid), dim3(NWAVES * 64), LDS_BYTES, stream, a); }
#else
    a.ph_lo = 0; a.ph_hi = N_PHASES; hipLaunchKernelGGL(mk_fwd, dim3(grid), dim3(NWAVES * 64), LDS_BYTES, stream, a);
#endif
#if DBG_STAGE < 9
    float* mod = (float*)(ws + WS_MOD);
    float* h = (float*)(ws + 17 * MiB);
    float* y = (float*)(ws + 337 * MiB);
    float* act = (float*)(ws + 481 * MiB);
    int* cnt = (int*)(ws + 993 * MiB); int* tke = (int*)(ws + 994 * MiB); float* tkg = (float*)(ws + 995 * MiB); int* list = (int*)(ws + 996 * MiB);
    (void)hipMemsetAsync(cnt, 0, 64 * sizeof(int), stream);
    (void)hipMemsetAsync(y, 0, (size_t)NTOK * DM * 4, stream);
#if DBG_STAGE == 5
    nv_norm_mod<<<NTOK, 256, 0, stream>>>(out, mod, 3 * DM, 4 * DM, h);
    nv_router<<<NTOK, 64, 0, stream>>>(h, w_router, b_router, cnt, tke, tkg, list);
#elif DBG_STAGE == 6
    br_route<<<NTOK * 4 / 256, 256, 0, stream>>>((const bf16_t*)(ws + WS_XN), (const int*)(ws + WS_TKE), (const unsigned*)(ws + WS_CTL), h, cnt, list);
    tkg = (float*)(ws + WS_TKG);
#endif
    nv_offsets<<<1, 64, 0, stream>>>(cnt);
    nv_sgemm<true><<<dim3(DFF / 64, NTOK / 64, NE), 256, 0, stream>>>(w_gu, 2 * DFF, DM, RmMoe1{h, list, cnt, (size_t)DM * 2 * DFF}, EpiMoe1{act, cnt, b_gu});
    nv_sgemm<false><<<dim3(DM / 64, NTOK / 64, NE), 256, 0, stream>>>(w_down, DM, DFF, RmMoe2{act, cnt, (size_t)DFF * DM}, EpiMoe2{y, list, cnt, tkg, b_down});
    nv_final<<<NTOK, 256, 0, stream>>>(out, y, mod, g_final, out);
#endif
}
```

```cpp
#define DBG_STAGE 9
#include <hip/hip_runtime.h>
#include <cstdio>
#include <cstdint>
#include <cmath>

constexpr int DM = 1024, NB = 8, SEQ = 4096, NTOK = NB * SEQ;
constexpr int HD = 64, AQH = 8, AKVH = 2, BH = 8;
constexpr int AQW = 512, AKVW = 128, BW = 512, DIN = 2304;
constexpr int OFF_QA = 0, OFF_KA = 512, OFF_VA = 640, OFF_QB = 768, OFF_KB = 1280, OFF_VB = 1792;
constexpr int WIN = 128, GW = 64, NAR = 8, NAC = 16, NE = 32, TOPK = 4, DFF = 1024;
constexpr float EPS = 1e-5f;
constexpr size_t MiB = 1u << 20;

#define GAS __attribute__((address_space(1)))
#define LAS __attribute__((address_space(3)))
typedef unsigned short bf16_t;
typedef short bf16x8 __attribute__((ext_vector_type(8)));
typedef float f32x4 __attribute__((ext_vector_type(4)));
typedef float f32x2 __attribute__((ext_vector_type(2)));
typedef float f32x16 __attribute__((ext_vector_type(16)));
typedef unsigned u32x4 __attribute__((ext_vector_type(4)));
typedef unsigned u32x2 __attribute__((ext_vector_type(2)));
typedef unsigned u32x8 __attribute__((ext_vector_type(8)));
typedef GAS unsigned gu32;
#define RLX_AGENT __ATOMIC_RELAXED, __HIP_MEMORY_SCOPE_AGENT
#define LDS_WAIT() asm volatile("s_waitcnt lgkmcnt(0)" ::: "memory")
#define VM_WAIT() asm volatile("s_waitcnt vmcnt(0)" ::: "memory")
__device__ __forceinline__ unsigned cvt_pk_bf16(float lo, float hi) { unsigned r; asm volatile("v_cvt_pk_bf16_f32 %0, %1, %2" : "=v"(r) : "v"(lo), "v"(hi)); return r; }
__device__ __forceinline__ unsigned f2bf(float f) { unsigned u = __builtin_bit_cast(unsigned, f); return (u + 0x7fffu + ((u >> 16) & 1u)) >> 16; }
__device__ __forceinline__ unsigned pk2(float lo, float hi) { return f2bf(lo) | (f2bf(hi) << 16); }
__device__ __forceinline__ float bf2f(unsigned h) { return __builtin_bit_cast(float, h << 16); }
__device__ __forceinline__ unsigned pk_fp8x4(float a, float b, float c, float d) { int p = __builtin_amdgcn_cvt_pk_fp8_f32(a, b, 0, false); return (unsigned)__builtin_amdgcn_cvt_pk_fp8_f32(c, d, p, true); }
typedef int v8i32 __attribute__((ext_vector_type(8)));
constexpr float W8_SCALE = 32.0f;

constexpr int NWAVES = 8;
__device__ __forceinline__ int lane_id() { int l; asm volatile("v_mbcnt_lo_u32_b32 %0, -1, 0\n\tv_mbcnt_hi_u32_b32 %0, -1, %0" : "=v"(l)); return l; }
constexpr float C2 = 0.125f * 1.4426950408889634f;
constexpr float LOG2E = 1.4426950408889634f;
constexpr int NSLOT_MAX = 139264;

constexpr size_t WS_CTL = 0, CTL_ZERO_BYTES = 128 * 1024;
constexpr size_t WS_MOD = 1 * MiB;
constexpr size_t WS_ROPE = WS_MOD + 256 * 1024;
constexpr size_t WS_WR = WS_ROPE + 256 * 1024;
constexpr size_t WS_SSQ = 2 * MiB;
constexpr size_t WS_TKE = 3 * MiB;
constexpr size_t WS_TKG = 4 * MiB;
constexpr size_t WS_LIST = 5 * MiB;
constexpr size_t WS_WIN = 10 * MiB;
constexpr size_t WS_WOUT = 15 * MiB;
constexpr size_t WS_WGU = 17 * MiB;
constexpr size_t WS_WD = 145 * MiB;
constexpr size_t WS_XN = 209 * MiB;
constexpr size_t WS_PROJ = 273 * MiB;
constexpr size_t WS_O = 417 * MiB;
constexpr size_t WS_YS = 209 * MiB;
constexpr size_t WS_ACT = 481 * MiB;
constexpr size_t WS_DELTA = 760 * MiB;
constexpr size_t WS_MK_END = 824 * MiB;
constexpr int CW_TMO = 0, CW_CNT = 64  , CW_BAR = 4096;

constexpr int RING_BYTES = 131072;
constexpr int LDSCTL_OFF = RING_BYTES, MISC_OFF = LDSCTL_OFF + 320;
constexpr int TAB_OFF = LDSCTL_OFF + 1024;
constexpr int LDS_BYTES = 163840;

#ifndef WT_STORES
#define WT_STORES 0
#endif
__device__ __forceinline__ void st16_out(void* p, const u32x4& v) { asm volatile("global_store_dwordx4 %0, %1, off sc1\n\ts_nop 1" :: "v"(p), "v"(v) : "memory"); }
__device__ __forceinline__ void st16_wt(void* p, const u32x4& v) {
    if (WT_STORES) asm volatile("global_store_dwordx4 %0, %1, off sc1\n\ts_nop 1" :: "v"(p), "v"(v) : "memory");
    else *(__attribute__((address_space(1))) u32x4*)p = v;
}
namespace pg8 {
constexpr int BM = 256, BK = 64, HALF = 128, HTB = HALF * BK * 2, NXCD = 8, WGM = 8;
__host__ __device__ __forceinline__ int lds_byte(int r, int c) { const int st = (r >> 4) * 2 + (c >> 5), rr = r & 15, cc = c & 31, ob = rr * 64 + cc * 2; return st * 1024 + (ob ^ (((ob >> 9) & 1) << 5)); }
__host__ __device__ __forceinline__ void stage_rc(int b, int& R, int& C) { const int st = b / 1024, sb = b % 1024, swz = sb ^ (((sb >> 9) & 1) << 5); R = (st >> 1) * 16 + swz / 64; C = (st & 1) * 32 + (swz % 64) / 2; }
__host__ __device__ __forceinline__ int perm32(int rho) { const int n = rho >> 4, i = rho & 15; return 8 * (i >> 2) + 4 * n + (i & 3); }

struct Unit { int pm, pn, e, aux; };

struct DenseOrder {
    const char* A; const char* Bt; int K; int nM, nN, nwg, G, c;
    __device__ void init(const void* A_, const void* Bt_, int M, int N, int K_, int G_, int c_) { A = (const char*)A_; Bt = (const char*)Bt_; K = K_; nM = M / BM; nN = N / BM; nwg = nM * nN; G = G_; c = c_; }
    __device__ bool next(int i, Unit& u) const {
        const long L = (long)i * G + c; if (L >= nwg) return false;
        int wgid = (int)L; { const int q = nwg / NXCD, r = nwg % NXCD, xcd = wgid % NXCD, off = wgid / NXCD; wgid = (xcd < r ? xcd * (q + 1) : r * (q + 1) + (xcd - r) * q) + off; }
        const int nig = WGM * nN, gid = wgid / nig, fm = gid * WGM, gsz = (nM - fm) < WGM ? (nM - fm) : WGM;
        u.pm = fm + ((wgid % nig) % gsz); u.pn = (wgid % nig) / gsz; u.e = 0; u.aux = 0; return true;
    }
    __device__ __forceinline__ const char* abase() const { return A; }
    __device__ __forceinline__ const char* bbase(const Unit& u) const { return Bt + (size_t)u.pn * BM * K * 2; }
    __device__ __forceinline__ void aoffs(const Unit& u, int, const int (&R)[2], const int (&C)[2], unsigned (&off)[4]) const {
#pragma unroll
        for (int h = 0; h < 2; ++h)
#pragma unroll
            for (int i = 0; i < 2; ++i) off[h * 2 + i] = (unsigned)((u.pm * BM + h * HALF + R[i]) * K + C[i]) * 2u;
    }
    __device__ __forceinline__ void meta_init(const Unit&, bool, const Unit&, int) const {}
    __device__ __forceinline__ void meta_top(int, bool, const Unit&, bool, const Unit&, int) const {}
};

#define PG8_LAS __attribute__((address_space(3)))
template <class Epi, class Sched, bool ALIGN_EPI, int HALFMODE = 0  >
__device__ __forceinline__ void gemm_phase(PG8_LAS unsigned char* lds, const int K, const Sched& S, const Epi& E, const int wid_  ) {
    const int lane = lane_id(), tid = wid_ * 64 + lane, wid = wid_, wr = wid >> 2, wc = wid & 3, fr = lane & 15, fq = lane >> 4;
    constexpr int ESZ = Epi::FP8 ? 1 : 2;
    const int nt = K * ESZ / (BK * 2);
    unsigned voffB[2];
#pragma unroll
    for (int i = 0; i < 2; ++i) { int R, C; stage_rc(tid * 16 + i * 8192, R, C); const int Rp = Epi::PERM ? ((R & ~31) + perm32(R & 31)) : R; const int Rb = Epi::WIDE == 2 ? ((Rp >> 5) * 64 + ((Rp & 31) >> 3) * 16 + (Rp & 7)) : Epi::WIDE == 1 ? ((Rp >> 5) * 64 + (Rp & 31)) : Rp; voffB[i] = (unsigned)(Rb * K * ESZ + C * 2); }
#define PG8_RC() int sR[2], sC[2]; { int t2_ = tid; asm volatile("" : "+v"(t2_)); _Pragma("unroll") for (int i = 0; i < 2; ++i) stage_rc(t2_ * 16 + i * 8192, sR[i], sC[i]); }
    const size_t kstep = (size_t)(BK * 2);
    const size_t hstepB = (size_t)(Epi::WIDE == 2 ? 8 : Epi::WIDE == 1 ? 32 : HALF) * K * ESZ;
    const unsigned ldsw = (unsigned)wid * 1024u;
    const int aoff = lds_byte(wr * 64 + fr, fq * 8), boff = lds_byte(wc * 32 + fr, fq * 8);
    const char* const gA = S.abase();
#define PG8_SA(b, h) (((b) * 2 + (h)) * HTB)
#define PG8_SB(b, h) ((4 + (b) * 2 + (h)) * HTB)
#ifndef PG8_A_AUX
#define PG8_A_AUX 0
#endif
#ifndef PG8_B_AUX
#define PG8_B_AUX 0
#endif
#define PG8_STAGE(bufoff, gbase, voff) do { _Pragma("unroll") for (int _i = 0; _i < 2; ++_i) \
        __builtin_amdgcn_global_load_lds((const unsigned*)((const char*)(gbase) + (voff)[_i]), (PG8_LAS unsigned*)(lds + (bufoff) + ldsw + _i * 8192), 16, 0, Epi::FP8 ? PG8_B_AUX : 0); } while (0)
#define PG8_STAGEA(bufoff, offs, h, kb) do { _Pragma("unroll") for (int _i = 0; _i < 2; ++_i) \
        __builtin_amdgcn_global_load_lds((const unsigned*)((gA + (kb)) + (offs)[(h) * 2 + _i]), (PG8_LAS unsigned*)(lds + (bufoff) + ldsw + _i * 8192), 16, 0, Epi::FP8 ? PG8_A_AUX : 0); } while (0)
#define PG8_LD16(off) (*(const PG8_LAS u32x4*)(lds + (off)))
#define PG8_LDA(dst, b, h) do { _Pragma("unroll") for (int m = 0; m < 4; ++m) dst[m] = __builtin_shufflevector(PG8_LD16(PG8_SA(b, h) + aoff + m * 2048), PG8_LD16(PG8_SA(b, h) + aoff + m * 2048 + 1024), 0, 1, 2, 3, 4, 5, 6, 7); } while (0)
#define PG8_LDB(dst, b, h) do { _Pragma("unroll") for (int n = 0; n < 2; ++n) dst[n] = __builtin_shufflevector(PG8_LD16(PG8_SB(b, h) + boff + n * 2048), PG8_LD16(PG8_SB(b, h) + boff + n * 2048 + 1024), 0, 1, 2, 3, 4, 5, 6, 7); } while (0)
#define PG8_HALF(x, k) __builtin_bit_cast(bf16x8, __builtin_shufflevector(x, x, 4 * (k), 4 * (k) + 1, 4 * (k) + 2, 4 * (k) + 3))
#ifndef PG8_BIAS_PRIO
#define PG8_BIAS_PRIO 0
#endif
#ifndef PG8_STATIC_PRIO
#define PG8_STATIC_PRIO 0
#endif
#define PG8_MMA(ai, bj, At, Bt) do { if (PG8_BIAS_PRIO) { if (wid >= 4) __builtin_amdgcn_s_setprio(2); else __builtin_amdgcn_s_setprio(1); } else if (!PG8_STATIC_PRIO) __builtin_amdgcn_s_setprio(1); _Pragma("unroll") for (int m = 0; m < 4; ++m) _Pragma("unroll") for (int n = 0; n < 2; ++n) { \
        if constexpr (Epi::FP8) asm volatile("v_mfma_scale_f32_16x16x128_f8f6f4 %0, %1, %2, %0, %3, %4 op_sel_hi:[0,0,0]" : "+v"(acc[ai][bj][m][n]) : "v"(Bt[n]), "v"(At[m]), "v"(scw), "v"(sca)); \
        else { acc[ai][bj][m][n] = __builtin_amdgcn_mfma_f32_16x16x32_bf16(PG8_HALF(Bt[n], 0), PG8_HALF(At[m], 0), acc[ai][bj][m][n], 0, 0, 0); \
               acc[ai][bj][m][n] = __builtin_amdgcn_mfma_f32_16x16x32_bf16(PG8_HALF(Bt[n], 1), PG8_HALF(At[m], 1), acc[ai][bj][m][n], 0, 0, 0); } } \
        if (PG8_BIAS_PRIO) { if (wid >= 4) __builtin_amdgcn_s_setprio(1); else __builtin_amdgcn_s_setprio(0); } else if (!PG8_STATIC_PRIO) __builtin_amdgcn_s_setprio(0); } while (0)
#define PG8_ACC_INIT(uix) do { f32x4 i_[2][2]; { int l2_ = lane; asm volatile("" : "+v"(l2_)); E.init(i_, (uix), wc, l2_ >> 4); } \
        _Pragma("unroll") for (int a = 0; a < 2; ++a) _Pragma("unroll") for (int b = 0; b < 2; ++b) _Pragma("unroll") for (int m = 0; m < 4; ++m) _Pragma("unroll") for (int n = 0; n < 2; ++n) { \
            acc[a][b][m][n] = i_[b][n]; asm volatile("" : "+v"(acc[a][b][m][n])); } } while (0)
#define PG8_WAIT_V(n) asm volatile("s_waitcnt vmcnt(" #n ")" ::: "memory")
#define PG8_WAIT_VR(rx, b8, b4) do { if ((rx) == 8) PG8_WAIT_V(b8); else if ((rx) == 4) PG8_WAIT_V(b4); else PG8_WAIT_V(8); } while (0)
#define PG8_WAIT_L(n) asm volatile("s_waitcnt lgkmcnt(" #n ")" ::: "memory")
#define PG8_BAR __builtin_amdgcn_s_barrier()
#define PG8_SCHED __builtin_amdgcn_sched_barrier(0)
    int pend = 0;
    if (PG8_STATIC_PRIO && wid >= 4) __builtin_amdgcn_s_setprio(1);
    Unit cur, nxt, nn; int ui = 0;
    if (!S.next(0, cur)) return;
    bool h1 = S.next(1, nxt), h2 = h1 && S.next(2, nn);
    f32x4 acc[2][2][4][2];
    unsigned scw = 0x7A7A7A7Au, sca = 0x7F7F7F7Fu; asm volatile("" : "+v"(scw), "+v"(sca));
    u32x8 At[4], B0[2], B1[2];
    unsigned lO[4], hO[2];
    S.meta_init(cur, h1, nxt, wid);
    { PG8_RC(); S.aoffs(cur, 0, sR, sC, lO); } hO[0] = lO[2]; hO[1] = lO[3];
    PG8_ACC_INIT(0);
    const char* cB = S.bbase(cur);
    PG8_STAGE(PG8_SB(0, 0), cB, voffB); PG8_STAGE(PG8_SB(0, 1), cB + hstepB, voffB); PG8_STAGEA(PG8_SA(0, 0), lO, 0, 0); PG8_STAGEA(PG8_SA(0, 1), lO, 1, 0);
    if (wr == 1) PG8_BAR;
    PG8_WAIT_V(2); PG8_BAR;
    PG8_STAGE(PG8_SB(1, 0), cB + kstep, voffB); PG8_STAGEA(PG8_SA(1, 0), lO, 0, kstep); PG8_STAGE(PG8_SB(1, 1), cB + hstepB + kstep, voffB);
    PG8_WAIT_V(6); PG8_BAR;
    for (;;) {
        const bool has_next = h1;
        const char* nB = has_next ? S.bbase(nxt) : cB;
        S.meta_top(ui, h1, nxt, h2, nn, wid);
        bool half = false; if constexpr (HALFMODE == 1) half = S.is_half(cur); else if constexpr (HALFMODE == 2) half = true;
#pragma unroll 1
        for (int t = 0; t < nt; t += 2) {
            const bool last = (t == nt - 2);
            if constexpr (Epi::MID) { if (t == nt / 2) { int l2_ = lane; asm volatile("" : "+v"(l2_)); E.mid_u(acc, ui, wr, l2_ & 15); } }
            if (last && has_next) { PG8_RC(); S.aoffs(nxt, ui + 1, sR, sC, lO); }
            const size_t k1 = (size_t)(t + 1) * kstep;
            const size_t k2 = last ? 0 : (size_t)(t + 2) * kstep, k3 = k2 + kstep;
            const char* b2 = (last ? nB : cB) + k2; const char* b3 = b2 + kstep;
#define PG8_ITER(W1, W2, W3) do { \
              \
            PG8_LDB(B0, 0, 0); PG8_LDB(B1, 0, 1); PG8_SCHED; PG8_LDA(At, 0, 0); PG8_STAGEA(PG8_SA(1, 1), hO, 0, k1); \
            PG8_WAIT_V(W1); PG8_WAIT_L(0); PG8_BAR; PG8_MMA(0, 0, At, B0); PG8_MMA(0, 1, At, B1); PG8_BAR; PG8_SCHED; \
              \
            PG8_LDA(At, 0, 1); PG8_STAGE(PG8_SB(0, 0), b2, voffB); PG8_STAGE(PG8_SB(0, 1), b2 + hstepB, voffB); PG8_STAGEA(PG8_SA(0, 0), lO, 0, k2); \
            PG8_WAIT_V(W2); PG8_WAIT_L(0); PG8_BAR; if (!half) { PG8_MMA(1, 0, At, B0); PG8_MMA(1, 1, At, B1); } PG8_BAR; PG8_SCHED; \
              \
            PG8_LDB(B0, 1, 0); PG8_LDB(B1, 1, 1); PG8_SCHED; PG8_LDA(At, 1, 0); PG8_STAGEA(PG8_SA(0, 1), lO, 1, k2); \
            PG8_WAIT_V(W3); PG8_WAIT_L(0); PG8_BAR; PG8_MMA(0, 0, At, B0); PG8_MMA(0, 1, At, B1); PG8_BAR; PG8_SCHED; \
              \
            PG8_LDA(At, 1, 1); PG8_STAGE(PG8_SB(1, 0), b3, voffB); PG8_STAGE(PG8_SB(1, 1), b3 + hstepB, voffB); PG8_STAGEA(PG8_SA(1, 0), lO, 0, k3); \
            PG8_WAIT_V(8); PG8_WAIT_L(0); PG8_BAR; if (!half) { PG8_MMA(1, 0, At, B0); PG8_MMA(1, 1, At, B1); } PG8_BAR; PG8_SCHED; } while (0)
            PG8_ITER(8, 8, 8);
#undef PG8_ITER
        }
        if constexpr (ALIGN_EPI) { if (wr == 0) PG8_BAR; }
        if constexpr (Epi::FP8) asm volatile("s_nop 15\n\ts_nop 7" ::: "memory");
        { int l2_ = lane; asm volatile("" : "+v"(l2_)); E(acc, cur, ui, wr, wc, l2_ & 15, l2_ >> 4); }
        if (!has_next) break;
        pend = E.nstores(cur);
        PG8_ACC_INIT(ui + 1);
        cur = nxt; cB = nB; hO[0] = lO[2]; hO[1] = lO[3];
        nxt = nn; h1 = h2; h2 = h1 && S.next(ui + 3, nn);
        ++ui;
        if constexpr (ALIGN_EPI) { if (wr == 1) PG8_BAR; }
    }
    PG8_WAIT_V(0);
    if constexpr (!ALIGN_EPI) { if (wr == 0) PG8_BAR; }
    PG8_BAR;
    if (PG8_STATIC_PRIO || PG8_BIAS_PRIO) __builtin_amdgcn_s_setprio(0);
#undef PG8_SA
#undef PG8_SB
#undef PG8_STAGE
#undef PG8_STAGEA
#undef PG8_LDA
#undef PG8_LDB
#undef PG8_MMA
#undef PG8_ACC_INIT
#undef PG8_RC
#undef PG8_HALF
#undef PG8_LD16
#undef PG8_WAIT_V
#undef PG8_WAIT_L
#undef PG8_BAR
#undef PG8_SCHED
}
}
#define XB_TMO      128
#define XB_XCNT(j)  (256  + 64 * (j))
#define XB_XSUB(j)  (1280 + 64 * (j))
#define XB_XGEN(j)  (2304 + 64 * (j))
#define XB_TOP      3328
#define XB_TOPGEN   3392
#define XCD_BAR_WORDS 3456
#define XB_SPIN_CAP (1u << 18)
__device__ __forceinline__ unsigned xb_ld(unsigned* p)              { return __hip_atomic_load(p, __ATOMIC_RELAXED, __HIP_MEMORY_SCOPE_AGENT); }
__device__ __forceinline__ unsigned xb_add(unsigned* p, unsigned v) { return __hip_atomic_fetch_add(p, v, __ATOMIC_RELAXED, __HIP_MEMORY_SCOPE_AGENT); }
__device__ __forceinline__ unsigned xb_xcc_id() { return (unsigned)__builtin_amdgcn_s_getreg((3 << 11) | 20) & 0xFu; }
#define XB_SPIN(cond, bar) do { unsigned _sp = 0; while (cond) { __builtin_amdgcn_s_sleep(1); \
    if ((++_sp & 255u) == 0u) { if (xb_ld(&(bar)[XB_TMO])) break; if (_sp > XB_SPIN_CAP) { atomicAdd(&(bar)[XB_TMO], 1u); break; } } } } while (0)
struct XcdBarrier { unsigned* bar; unsigned x; volatile LAS unsigned* st; };
__device__ __forceinline__ XcdBarrier xcd_barrier_post(unsigned* bar, volatile LAS unsigned* st, int wave) {
    XcdBarrier b; b.bar = bar; b.x = xb_xcc_id(); b.st = st;
    if (wave == 0 && lane_id() == 0) (void)xb_add(&bar[XB_XCNT(b.x)], 1u);
    return b;
}
__device__ __forceinline__ void xcd_barrier_complete(unsigned* bar, unsigned x, unsigned& nloc, unsigned& nx) {
    const unsigned G = gridDim.x * gridDim.y * gridDim.z;
    unsigned sum, cnt, mine, sp = 0u;
    for (;;) {
        sum = 0u; cnt = 0u; mine = 0u;
#pragma unroll
        for (unsigned j = 0; j < 16; ++j) { const unsigned c = xb_ld(&bar[XB_XCNT(j)]); sum += c; cnt += (c > 0u) ? 1u : 0u; mine = (j == x) ? c : mine; }
        if (sum == G) break;
        __builtin_amdgcn_s_sleep(1);
        if ((++sp & 255u) == 0u) { if (xb_ld(&bar[XB_TMO])) break; if (sp > XB_SPIN_CAP) { atomicAdd(&bar[XB_TMO], 1u); break; } }
    }
    nloc = mine > 0u ? mine : 1u; nx = cnt > 0u ? cnt : 1u;
}
__device__ __forceinline__ void xcd_barrier(const XcdBarrier& b, int wave) {
    asm volatile("s_waitcnt vmcnt(0)" ::: "memory");
    __syncthreads();
    if (wave == 0 && lane_id() == 0) {
        unsigned* bar = b.bar;
        __builtin_amdgcn_s_waitcnt(0);
        unsigned nloc = b.st[0], nx = b.st[1];
        if (nloc == 0u) { xcd_barrier_complete(bar, b.x, nloc, nx); b.st[0] = nloc; b.st[1] = nx; }
#ifdef XB_EARLY_RELEASE
        __builtin_amdgcn_fence(__ATOMIC_RELEASE, "agent");
        asm volatile("s_waitcnt vmcnt(0)" ::: "memory");
#endif
        const unsigned old = xb_add(&bar[XB_XSUB(b.x)], 1u);
        const unsigned gen = old / nloc;
        if (old + 1u == (gen + 1u) * nloc) {
#ifndef XB_EARLY_RELEASE
            __builtin_amdgcn_fence(__ATOMIC_RELEASE, "agent");
            asm volatile("s_waitcnt vmcnt(0)" ::: "memory");
#endif
            const unsigned og = xb_add(&bar[XB_TOP], 1u);
            const unsigned tg = og / nx;
            if (og + 1u == (tg + 1u) * nx) xb_add(&bar[XB_TOPGEN], 1u);
            else XB_SPIN(xb_ld(&bar[XB_TOPGEN]) == tg, bar);
            __builtin_amdgcn_fence(__ATOMIC_ACQUIRE, "agent");
            xb_add(&bar[XB_XGEN(b.x)], 1u);
            asm volatile("s_waitcnt vmcnt(0)" ::: "memory");
        } else {
            XB_SPIN(xb_ld(&bar[XB_XGEN(b.x)]) == gen, bar);
            __builtin_amdgcn_fence(__ATOMIC_ACQUIRE, "agent");
            asm volatile("s_waitcnt vmcnt(0)" ::: "memory");
        }
    }
    __syncthreads();
}

struct Frame {
    LAS unsigned char* lds;
    volatile LAS unsigned* MISC;
    gu32* ctl;
    int tid, lane, wave, vcu, G, p0mode;
    const float *x, *c, *w_ada, *b_ada, *w_in, *sink, *rpb, *ga, *gb, *w_out, *w_router, *b_router, *w_gu, *b_gu, *w_down, *b_down, *g_final;
    float* out;
    float *mod, *rope, *ssq, *tkg;
    int *tke, *list;
    bf16_t *wr_t, *win_t, *wout_t, *wgu_t, *wd_t, *XN, *PROJ, *O, *YS, *ACT, *DELTA;
};
__device__ __forceinline__ float wave_sum(float v) {
#pragma unroll
    for (int o = 1; o < 64; o <<= 1) v += __shfl_xor(v, o);
    return v;
}

struct P0Item { const float* W; bf16_t* WT; int N, Kd, k0, n0, drow0, gains, fp8; };
constexpr int P0_NITEMS = 16 * (DIN / 32) + 16 * (DM / 32) + NE * 16 * (2 * DFF / 32) + NE * (DFF / 64) * (DM / 32);
#ifndef P0_DEFER
#define P2_SPLIT 1
#define P0_DEFER 24576
#endif
#ifndef P0_DEFER6
#define P0_DEFER6 0
#endif
constexpr int P0_ND6 = P0_DEFER6;
#ifndef P0_DEFER4
#define P0_DEFER4 24576
#endif
constexpr int P0_ND = P0_DEFER + P0_DEFER6 + P0_DEFER4;
__device__ __forceinline__ bool p0_item(const Frame& F, int it, P0Item& I, int limit = P0_NITEMS) {
    if (it >= limit) return false;
    constexpr int I_IN = 16 * (DIN / 32), I_OUT = 16 * (DM / 32), I_GU1 = 16 * (2 * DFF / 32), I_GU = NE * I_GU1, I_D1 = (DFF / 64) * (DM / 32), I_D = NE * I_D1;
    int r = it; I.gains = 0; I.fp8 = 0;
    if (r < I_IN) { const int nb = r % (DIN / 32), kb = r / (DIN / 32); I.W = F.w_in; I.WT = F.win_t; I.N = DIN; I.Kd = DM; I.k0 = kb * 64; I.n0 = nb * 32; I.drow0 = nb * 32; return true; } r -= I_IN;
    if (r < I_OUT) { const int nb = r % (DM / 32), kb = r / (DM / 32); I.W = F.w_out; I.WT = F.wout_t; I.N = DM; I.Kd = DM; I.k0 = kb * 64; I.n0 = nb * 32; I.drow0 = nb * 32; I.gains = 1; return true; } r -= I_OUT;
    if (r < I_GU) { const int e = r / I_GU1, q = r % I_GU1, nb = q % (2 * DFF / 32), kb = q / (2 * DFF / 32), n0 = nb * 32, f = n0 & (DFF - 1);
        I.W = F.w_gu + (size_t)e * DM * 2 * DFF; I.WT = (bf16_t*)((unsigned char*)F.wgu_t + (size_t)e * 2 * DFF * DM); I.N = 2 * DFF; I.Kd = DM; I.k0 = kb * 64; I.n0 = n0; I.drow0 = (f >> 7) * 256 + (n0 >= DFF ? 128 : 0) + (f & 127); I.fp8 = 1; return true; } r -= I_GU;
    { const int e = r / I_D1, q = r % I_D1, nb = q % (DM / 32), kb = q / (DM / 32);
        I.W = F.w_down + (size_t)e * DFF * DM; I.WT = (bf16_t*)((unsigned char*)F.wd_t + (size_t)e * DM * DFF); I.N = DM; I.Kd = DFF; I.k0 = kb * 64; I.n0 = nb * 32; I.drow0 = nb * 32; I.fp8 = 1; return true; }
}
__device__ __forceinline__ void p0_load(const P0Item& I, f32x4 (&w)[8], int lane) {
#pragma unroll
    for (int i = 0; i < 8; ++i) w[i] = __builtin_nontemporal_load((const GAS f32x4*)(I.W + (size_t)(I.k0 + 8 * i + (lane >> 3)) * I.N + I.n0 + 4 * (lane & 7)));
}
#ifndef P0_PROBE
#define P0_PROBE 0
#endif
__device__ __forceinline__ void p0_finish(const Frame& F, const P0Item& I, const f32x4 (&w)[8], LAS float* scr, int lane) {
    if (P0_PROBE && F.p0mode == 2) {
#pragma unroll
        for (int i = 0; i < 8; ++i) asm volatile("" :: "v"(w[i]));
        return; }
#pragma unroll
    for (int i = 0; i < 8; ++i) { const int kk = 8 * i + (lane >> 3), nn = 4 * (lane & 7); f32x4 v = w[i];
        if (I.gains) { const int k = I.k0 + kk; v = v * (k < 512 ? F.ga[k] : F.gb[k - 512]); }
        scr[kk * 33 + nn] = v.x; scr[kk * 33 + nn + 1] = v.y; scr[kk * 33 + nn + 2] = v.z; scr[kk * 33 + nn + 3] = v.w; }
    LDS_WAIT(); asm volatile("" ::: "memory");
    const int c = lane & 7;
#pragma unroll
    for (int j = 0; j < 4; ++j) { const int n = (lane >> 3) + 8 * j; const LAS float* s = scr + (8 * c) * 33 + n;
        if (I.fp8) { u32x2 o; o.x = pk_fp8x4(s[0 * 33] * W8_SCALE, s[1 * 33] * W8_SCALE, s[2 * 33] * W8_SCALE, s[3 * 33] * W8_SCALE); o.y = pk_fp8x4(s[4 * 33] * W8_SCALE, s[5 * 33] * W8_SCALE, s[6 * 33] * W8_SCALE, s[7 * 33] * W8_SCALE);
            if (P0_PROBE && F.p0mode == 1) asm volatile("" :: "v"(o)); else *(GAS u32x2*)((unsigned char*)I.WT + (size_t)(I.drow0 + n) * I.Kd + I.k0 + 8 * c) = o; }
        else { u32x4 o; o.x = pk2(s[0 * 33], s[1 * 33]); o.y = pk2(s[2 * 33], s[3 * 33]); o.z = pk2(s[4 * 33], s[5 * 33]); o.w = pk2(s[6 * 33], s[7 * 33]);
            if (P0_PROBE && F.p0mode == 1) asm volatile("" :: "v"(o)); else *(GAS u32x4*)(I.WT + (size_t)(I.drow0 + n) * I.Kd + I.k0 + 8 * c) = o; } }
    LDS_WAIT(); asm volatile("" ::: "memory");
}
__device__ __forceinline__ void p0_deferred(Frame& F, int first, int lim, int rank, int nidle);
__device__ __forceinline__ void p0_prologue(Frame& F) {
    const int gw = F.vcu * NWAVES + F.wave, NGW = F.G * NWAVES;
#ifndef P0_EXTRA
#define P0_EXTRA 0
#endif
    constexpr int LIM = P0_NITEMS - P0_ND - P0_EXTRA;
    P0Item Ia, Ib; f32x4 wa[8], wb[8];
    bool ha = p0_item(F, gw, Ia, LIM), hb = p0_item(F, gw + NGW, Ib, LIM);
    if (ha) p0_load(Ia, wa, F.lane);
    if (hb) p0_load(Ib, wb, F.lane);
    constexpr int NBA = 6 * DM / 32;
    const int gt = ((int)gridDim.x >= NBA + 64 ? ((int)blockIdx.x >= NBA ? (int)blockIdx.x - NBA : (int)blockIdx.x + 64) : (int)blockIdx.x) * (NWAVES * 64) + F.tid;
    if (blockIdx.x < 6 * DM / 32) {
        LAS float* sc = (LAS float*)F.lds;
        LAS float* red = (LAS float*)(F.lds + 32768);
        float cv[NB * DM / (NWAVES * 64)];
#pragma unroll
        for (int q = 0; q < NB * DM / (NWAVES * 64); ++q) cv[q] = F.c[F.tid + q * NWAVES * 64];
        const int c4 = F.tid & 7, ks = F.tid >> 3, n0 = blockIdx.x * 32;
        f32x4 w[16];
#pragma unroll
        for (int q = 0; q < 16; ++q) w[q] = __builtin_nontemporal_load((const GAS f32x4*)(F.w_ada + (size_t)(ks * 16 + q) * 6 * DM + n0 + 4 * c4));
#pragma unroll
        for (int q = 0; q < NB * DM / (NWAVES * 64); ++q) { const float v = cv[q]; sc[F.tid + q * NWAVES * 64] = v / (1.f + __expf(-v)); }
        __syncthreads();
        f32x4 a[NB];
#pragma unroll
        for (int b = 0; b < NB; ++b) a[b] = (f32x4){0.f, 0.f, 0.f, 0.f};
#pragma unroll
        for (int q = 0; q < 16; ++q)
#pragma unroll
            for (int b = 0; b < NB; ++b) a[b] += w[q] * sc[b * DM + ks * 16 + q];
#pragma unroll
        for (int b = 0; b < NB; ++b) *(LAS f32x4*)(red + (ks * NB + b) * 32 + 4 * c4) = a[b];
        __syncthreads();
        if (F.tid < 256) { const int b = F.tid >> 5, col = F.tid & 31; float s = F.b_ada[n0 + col];
#pragma unroll 8
            for (int q = 0; q < 64; ++q) s += red[(q * NB + b) * 32 + col];
            F.mod[b * 6 * DM + n0 + col] = s; }
        __syncthreads();
    }
    if (gt < SEQ * 8) {
        const int pos = gt >> 3, i = gt & 7;
        const float invf[8] = {1.0f, 0.1939227432012558f, 0.03760603070259094f, 0.007292664609849453f, 0.0014142135623842478f, 0.00027424818836152554f, 5.3182957344688475e-05f, 1.0313385246263351e-05f};
        float inv = invf[0];
#pragma unroll
        for (int q = 1; q < 8; ++q) inv = (i == q) ? invf[q] : inv;
        const float angf = (float)pos * inv;
        const double ang = (double)angf, twopi = 6.283185307179586476925287;
        const double r = ang - __builtin_rint(ang / twopi) * twopi, r2 = r * r;
        double cs = 1.0, sn = r, tc = 1.0, ts = r;
#pragma unroll 1
        for (int q = 1; q <= 20; ++q) { tc = -tc * r2 / (double)((2 * q - 1) * (2 * q)); ts = -ts * r2 / (double)((2 * q) * (2 * q + 1)); cs += tc; sn += ts; }
        F.rope[gt] = (float)cs; F.rope[SEQ * 8 + gt] = (float)sn;
    }
    if (gt < NE * DM) { const int e = gt >> 10, k = gt & 1023; const float w = F.w_router[k * NE + e]; const unsigned hi = f2bf(w); const unsigned lo = f2bf(w - bf2f(hi));
        F.wr_t[gt] = (bf16_t)hi; F.wr_t[NE * DM + gt] = (bf16_t)lo; }
    if (gt < NTOK * 2) F.ssq[gt] = 0.f;
#if defined(DIAG_A)
    if (blockIdx.x == 0 && F.wave == 0 && lane_id() == 0) ((unsigned long long*)((unsigned char*)F.ctl + 96 * 1024))[20] = __builtin_amdgcn_s_memrealtime();
#endif
    LAS float* scr = (LAS float*)(F.lds + F.wave * 16384);
    P0Item Ic, Id; f32x4 wc[8], wd[8];
    bool hc = hb && p0_item(F, gw + 2 * NGW, Ic, LIM), hd;
    if (hc) p0_load(Ic, wc, F.lane);
    hd = hc && p0_item(F, gw + 3 * NGW, Id, LIM);
    if (hd) p0_load(Id, wd, F.lane);
#pragma unroll 1
    for (int it = gw; ha; it += 4 * NGW) {
        p0_finish(F, Ia, wa, scr, F.lane);
        ha = hd && p0_item(F, it + 4 * NGW, Ia, LIM); if (ha) p0_load(Ia, wa, F.lane);
        if (hb) p0_finish(F, Ib, wb, scr, F.lane);
        hb = ha && p0_item(F, it + 5 * NGW, Ib, LIM); if (hb) p0_load(Ib, wb, F.lane);
        if (hc) p0_finish(F, Ic, wc, scr, F.lane);
        hc = hb && p0_item(F, it + 6 * NGW, Ic, LIM); if (hc) p0_load(Ic, wc, F.lane);
        if (hd) p0_finish(F, Id, wd, scr, F.lane);
        hd = hc && p0_item(F, it + 7 * NGW, Id, LIM); if (hd) p0_load(Id, wd, F.lane);
    }
    if ((int)gridDim.x >= NBA + 64) { if ((int)blockIdx.x >= NBA) p0_deferred(F, LIM, LIM + P0_EXTRA, (int)blockIdx.x - NBA, (int)gridDim.x - NBA); }
    else p0_deferred(F, LIM, LIM + P0_EXTRA, F.vcu, F.G);
}
__device__ __forceinline__ void p0_deferred(Frame& F, int first, int lim, int rank, int nidle) {
    if (first >= lim) return;
    const int lane = lane_id();
    LAS float* scr = (LAS float*)(F.lds + F.wave * 16384);
    const int gw = first + rank * NWAVES + F.wave, NGW = nidle * NWAVES;
    P0Item Ia, Ib, Ic, Id; f32x4 wa[8], wb[8], wc[8], wd[8];
    bool ha = p0_item(F, gw, Ia, lim), hb = ha && p0_item(F, gw + NGW, Ib, lim), hc = hb && p0_item(F, gw + 2 * NGW, Ic, lim), hd = hc && p0_item(F, gw + 3 * NGW, Id, lim);
    if (ha) p0_load(Ia, wa, lane);
    if (hb) p0_load(Ib, wb, lane);
    if (hc) p0_load(Ic, wc, lane);
    if (hd) p0_load(Id, wd, lane);
#pragma unroll 1
    for (int it = gw; ha; it += 4 * NGW) {
        p0_finish(F, Ia, wa, scr, lane);
        ha = hd && p0_item(F, it + 4 * NGW, Ia, lim); if (ha) p0_load(Ia, wa, lane);
        if (hb) p0_finish(F, Ib, wb, scr, lane);
        hb = ha && p0_item(F, it + 5 * NGW, Ib, lim); if (hb) p0_load(Ib, wb, lane);
        if (hc) p0_finish(F, Ic, wc, scr, lane);
        hc = hb && p0_item(F, it + 6 * NGW, Ic, lim); if (hc) p0_load(Ic, wc, lane);
        if (hd) p0_finish(F, Id, wd, scr, lane);
        hd = hc && p0_item(F, it + 7 * NGW, Id, lim); if (hd) p0_load(Id, wd, lane);
    }
}
__device__ __forceinline__ void p1_row(const f32x4 (&v)[4], bf16_t* orow, const f32x4 (&s1)[4], const f32x4 (&sh)[4], int lane) {
    float s = 0.f;
#pragma unroll
    for (int j = 0; j < 4; ++j) s += (v[j].x * v[j].x + v[j].y * v[j].y) + (v[j].z * v[j].z + v[j].w * v[j].w);
    const float rstd = 1.f / sqrtf(wave_sum(s) * (1.f / DM) + EPS);
    GAS unsigned long long* o8 = (GAS unsigned long long*)orow + lane;
#pragma unroll
    for (int j = 0; j < 4; ++j) { const f32x4 h = v[j] * rstd * s1[j] + sh[j];
        o8[64 * j] = (unsigned long long)pk2(h.x, h.y) | ((unsigned long long)pk2(h.z, h.w) << 32); }
}
__device__ __forceinline__ void p1_xn(Frame& F) {
    const int gw = F.vcu * NWAVES + F.wave, NGW = F.G * NWAVES, lane = F.lane;
    for (int chunk = gw; chunk < NTOK / 16; chunk += NGW) {
        const int m0 = chunk * 16, b = m0 / SEQ;
        f32x4 s1[4], sh[4];
#pragma unroll
        for (int j = 0; j < 4; ++j) { s1[j] = *(const GAS f32x4*)(F.mod + b * 6 * DM + DM + 4 * lane + 256 * j) + 1.0f; sh[j] = *(const GAS f32x4*)(F.mod + b * 6 * DM + 4 * lane + 256 * j); }
        f32x4 va[4], vb[4], vc[4];
#define P1_LOAD(dst, r) do { const GAS f32x4* xr_ = (const GAS f32x4*)(F.x + (size_t)(m0 + (r)) * DM) + lane; _Pragma("unroll") for (int j = 0; j < 4; ++j) dst[j] = __builtin_nontemporal_load(xr_ + 64 * j); } while (0)
        P1_LOAD(va, 0); P1_LOAD(vb, 1);
#pragma unroll 1
        for (int r = 0; r < 15; r += 3) {
            P1_LOAD(vc, r + 2); p1_row(va, F.XN + (size_t)(m0 + r) * DM, s1, sh, lane);
            P1_LOAD(va, r + 3); p1_row(vb, F.XN + (size_t)(m0 + r + 1) * DM, s1, sh, lane);
            if (r + 4 < 16) P1_LOAD(vb, r + 4); p1_row(vc, F.XN + (size_t)(m0 + r + 2) * DM, s1, sh, lane);
        }
        p1_row(va, F.XN + (size_t)(m0 + 15) * DM, s1, sh, lane);
#undef P1_LOAD
    }
}
struct EpiProj {
    static constexpr bool PERM = true, MID = false, FP8 = false; static constexpr int WIDE = 1;
    static constexpr int NST = 0;
    __device__ __forceinline__ int nstores(const pg8::Unit&) const { return 0; }
    bf16_t* O; const float* rope;
    __device__ __forceinline__ void mid(f32x4 (&)[2][2][4][2], const pg8::Unit&, int, int) const {}
    __device__ __forceinline__ void init(f32x4 (&i)[2][2], int, int, int) const { i[0][0] = i[0][1] = i[1][0] = i[1][1] = (f32x4){0.f, 0.f, 0.f, 0.f}; }
    __device__ __forceinline__ void operator()(const f32x4 (&acc)[2][2][4][2], const pg8::Unit& u, int, int wr, int wc, int fr, int fq) const {
        const int row0 = u.pm * 256 + wr * 64 + fr, col0 = u.pn * 256 + wc * 64 + 8 * fq;
        const float sc = (u.pn < 2 || u.pn == 3 || u.pn == 4) ? C2 : 1.f;
#pragma unroll
        for (int ai = 0; ai < 2; ++ai)
#pragma unroll
            for (int m = 0; m < 4; ++m) { const int row = row0 + ai * 128 + m * 16; bf16_t* rowp = O + (size_t)row * DIN + col0;
#pragma unroll
                for (int bj = 0; bj < 2; ++bj) { f32x4 v0 = acc[ai][bj][m][0], v1 = acc[ai][bj][m][1];
                    const bool rope_tile = (u.pn < 2) || (u.pn == 2 && wc < 2);
                    if (rope_tile && bj == 0) {
                        f32x4 o0, o1;
#pragma unroll
                        for (int q = 0; q < 4; ++q) { o0[q] = __shfl_xor(v0[q], 16); o1[q] = __shfl_xor(v1[q], 16); }
                        if (fq < 2) { const int pos = row & (SEQ - 1);
                            const f32x4 c0 = *(const GAS f32x4*)(rope + pos * 8), c1 = *(const GAS f32x4*)(rope + pos * 8 + 4);
                            const f32x4 s0 = *(const GAS f32x4*)(rope + SEQ * 8 + pos * 8), s1 = *(const GAS f32x4*)(rope + SEQ * 8 + pos * 8 + 4);
                            const float sg = fq == 0 ? -1.f : 1.f;
                            v0 = v0 * c0 + (o0 * sg) * s0; v1 = v1 * c1 + (o1 * sg) * s1; }
                    }
                    v0 = v0 * sc; v1 = v1 * sc;
                    u32x4 w; w.x = cvt_pk_bf16(v0[0], v0[1]); w.y = cvt_pk_bf16(v0[2], v0[3]); w.z = cvt_pk_bf16(v1[0], v1[1]); w.w = cvt_pk_bf16(v1[2], v1[3]);
                    st16_wt(rowp + bj * 32, w); } }
    }
};
__device__ __forceinline__ int crow(int r, int hi) { return (r & 3) + 8 * (r >> 2) + 4 * hi; }
typedef short v4i16_t __attribute__((ext_vector_type(4)));
__device__ __forceinline__ v4i16_t vtr(const LAS unsigned char* p) { return __builtin_amdgcn_ds_read_tr16_b64_v4i16((LAS v4i16_t*)p); }
__device__ __forceinline__ float max3f(float a, float b, float c) { return __builtin_fmaxf(__builtin_fmaxf(a, b), c); }
__device__ __forceinline__ void glds16(const void* gsrc, LAS unsigned char* dst) {
    const unsigned lds_dst = (unsigned)__builtin_amdgcn_readfirstlane((int)(unsigned)(unsigned long)dst); unsigned keep;
    asm volatile("s_mov_b32 %0, m0\n\ts_mov_b32 m0, %2\n\ts_nop 0\n\tglobal_load_lds_dwordx4 %1, off\n\ts_mov_b32 m0, %0" : "=&s"(keep) : "v"(gsrc), "s"(lds_dst) : "memory");
}
__device__ __forceinline__ void dma_k(const bf16_t* Ktile  , LAS unsigned char* slot, int p, int lane) {
    const int row = 8 * p + (lane >> 3), ch = (lane & 7) ^ ((row >> 1) & 7);
    glds16(Ktile + (size_t)row * DIN + ch * 8, slot + p * 1024);
}
__device__ __forceinline__ void dma_v(const bf16_t* Vtile, LAS unsigned char* slot, int p, int lane) {
    glds16(Vtile + (size_t)(8 * p + ((lane >> 2) & 7)) * DIN + (lane >> 5) * 32 + (lane & 3) * 8, slot + p * 1024);
}
template <int NC> struct AttnState { float m, l; f32x16 o[2]; float cin[NC]; };
__device__ __forceinline__ float xor32_max(float v) { float a = v, b = v; asm volatile("s_nop 1\n\tv_permlane32_swap_b32 %0, %1" : "+v"(a), "+v"(b)); return __builtin_fmaxf(a, b); }
__device__ __forceinline__ float xor32_sum(float v) { float a = v, b = v; asm volatile("s_nop 1\n\tv_permlane32_swap_b32 %0, %1" : "+v"(a), "+v"(b)); return a + b; }
template <int NC, class MB>
__device__ __forceinline__ void attn_tile(const bool FIRST  , const LAS unsigned char* Ks, const LAS unsigned char* Vs, const bf16x8 (&qr)[4], AttnState<NC>& st, int r32, int hi, int lane, const MB& mb) {
    f32x16 p0, p1;
#pragma unroll
    for (int r = 0; r < 16; ++r) { p0[r] = st.cin[NC == 1 ? 0 : r]; p1[r] = st.cin[NC == 1 ? 0 : 16 + r]; }
    const LAS unsigned char* kb = Ks + r32 * 128; const int sw = (r32 >> 1) & 7;
    bf16x8 kf[8];
#pragma unroll
    for (int d0 = 0; d0 < 4; ++d0) { const int ko = ((2 * d0 + hi) ^ sw) << 4; kf[2 * d0] = *(const LAS bf16x8*)(kb + ko); kf[2 * d0 + 1] = *(const LAS bf16x8*)(kb + ko + 4096); }
    __builtin_amdgcn_sched_barrier(0);
#pragma unroll
    for (int d0 = 0; d0 < 4; ++d0) {
        p0 = __builtin_amdgcn_mfma_f32_32x32x16_bf16(kf[2 * d0], qr[d0], p0, 0, 0, 0);
        p1 = __builtin_amdgcn_mfma_f32_32x32x16_bf16(kf[2 * d0 + 1], qr[d0], p1, 0, 0, 0);
    }
    __builtin_amdgcn_sched_barrier(0);
    const LAS unsigned char* vb = Vs + ((lane >> 4) & 1) * 32 + (lane & 3) * 8 + (4 * hi + ((lane & 15) >> 2)) * 64;
    v4i16_t vlo[8], vhh[8];
#pragma unroll
    for (int d0 = 0; d0 < 2; ++d0)
#pragma unroll
        for (int s = 0; s < 4; ++s) { vlo[d0 * 4 + s] = vtr(vb + d0 * 512 + s * 2048); vhh[d0 * 4 + s] = vtr(vb + d0 * 512 + s * 2048 + 1024); }
    typename MB::Pre pre; mb.prefetch(pre);
    __builtin_amdgcn_sched_barrier(0);
    mb(p0, p1, pre, r32, hi);
    float a = max3f(p0[0], p0[1], p1[0]), b = max3f(p0[2], p0[3], p1[1]); a = max3f(a, p1[2], p1[3]);
#pragma unroll
    for (int r = 4; r < 16; r += 4) { a = max3f(a, p0[r], p0[r + 1]); b = max3f(b, p0[r + 2], p0[r + 3]); a = max3f(a, p1[r], p1[r + 1]); b = max3f(b, p1[r + 2], p1[r + 3]); }
    float rm = __builtin_fmaxf(a, b);
    rm = xor32_max(rm);
    if (FIRST || __any(rm > 8.0f)) {
        const float d = FIRST ? rm : __builtin_fmaxf(rm, 0.f), f = __builtin_amdgcn_exp2f(-d);
        st.m += d; st.l *= f;
#pragma unroll
        for (int r = 0; r < 16; ++r) { st.o[0][r] *= f; st.o[1][r] *= f; p0[r] -= d; p1[r] -= d; }
#pragma unroll
        for (int r = 0; r < NC; ++r) st.cin[r] -= d;
    }
    float ls = 0.f;
#pragma unroll
    for (int r = 0; r < 16; ++r) { p0[r] = __builtin_amdgcn_exp2f(p0[r]); p1[r] = __builtin_amdgcn_exp2f(p1[r]); ls += p0[r] + p1[r]; }
    st.l += ls;
    u32x4 pw[4];
#pragma unroll
    for (int q = 0; q < 4; ++q) { pw[0][q] = cvt_pk_bf16(p0[2 * q], p0[2 * q + 1]); pw[1][q] = cvt_pk_bf16(p0[8 + 2 * q], p0[8 + 2 * q + 1]);
                                  pw[2][q] = cvt_pk_bf16(p1[2 * q], p1[2 * q + 1]); pw[3][q] = cvt_pk_bf16(p1[8 + 2 * q], p1[8 + 2 * q + 1]); }
    __builtin_amdgcn_sched_barrier(0);
#pragma unroll
    for (int d0 = 0; d0 < 2; ++d0)
#pragma unroll
        for (int s = 0; s < 4; ++s) {
            const v4i16_t lo = vlo[d0 * 4 + s], hh = vhh[d0 * 4 + s];
            const bf16x8 vf = (bf16x8){lo[0], lo[1], lo[2], lo[3], hh[0], hh[1], hh[2], hh[3]};
            st.o[d0] = __builtin_amdgcn_mfma_f32_32x32x16_bf16(vf, __builtin_bit_cast(bf16x8, pw[s]), st.o[d0], 0, 0, 0);
        }
    __builtin_amdgcn_sched_barrier(0);
}
template <int NC> __device__ __forceinline__ void attn_finish(AttnState<NC>& st, LAS unsigned char* stg, bf16_t* Obase  , float* ssqp  , int r32, int hi, int lane) {
    float l = xor32_sum(st.l);
    const float inv = 1.0f / l;
    float sq = 0.f;
#pragma unroll
    for (int d0 = 0; d0 < 2; ++d0)
#pragma unroll
        for (int rg = 0; rg < 4; ++rg) {
            const float v0 = st.o[d0][4 * rg] * inv, v1 = st.o[d0][4 * rg + 1] * inv, v2 = st.o[d0][4 * rg + 2] * inv, v3 = st.o[d0][4 * rg + 3] * inv;
            sq += (v0 * v0 + v1 * v1) + (v2 * v2 + v3 * v3);
            u32x2 w; w.x = cvt_pk_bf16(v0, v1); w.y = cvt_pk_bf16(v2, v3);
            const int ch = 4 * d0 + rg;
            *(LAS u32x2*)(stg + r32 * 128 + ((ch ^ (r32 & 7)) << 4) + hi * 8) = w;
        }
    sq = xor32_sum(sq);
    if (hi == 0) atomicAdd(ssqp + r32 * 2, sq);
    asm volatile("s_waitcnt lgkmcnt(0)" ::: "memory");
#pragma unroll
    for (int i = 0; i < 4; ++i) { const int row = i * 8 + (lane >> 3), ch = lane & 7;
        const u32x4 v = *(const LAS u32x4*)(stg + row * 128 + ((ch ^ (row & 7)) << 4));
        st16_wt(Obase + (size_t)row * DM + ch * 8, v); }
}
template <int NC> __device__ __forceinline__ void attn_tile_s(const LAS unsigned char* Ks, const bf16x8 (&qr)[4], const AttnState<NC>& st, int r32, int hi, f32x16& p0, f32x16& p1) {
#pragma unroll
    for (int r = 0; r < 16; ++r) { p0[r] = st.cin[NC == 1 ? 0 : r]; p1[r] = st.cin[NC == 1 ? 0 : 16 + r]; }
    const LAS unsigned char* kb = Ks + r32 * 128; const int sw = (r32 >> 1) & 7;
    bf16x8 kf[8];
#pragma unroll
    for (int d0 = 0; d0 < 4; ++d0) { const int ko = ((2 * d0 + hi) ^ sw) << 4; kf[2 * d0] = *(const LAS bf16x8*)(kb + ko); kf[2 * d0 + 1] = *(const LAS bf16x8*)(kb + ko + 4096); }
    __builtin_amdgcn_sched_barrier(0);
#pragma unroll
    for (int d0 = 0; d0 < 4; ++d0) {
        p0 = __builtin_amdgcn_mfma_f32_32x32x16_bf16(kf[2 * d0], qr[d0], p0, 0, 0, 0);
        p1 = __builtin_amdgcn_mfma_f32_32x32x16_bf16(kf[2 * d0 + 1], qr[d0], p1, 0, 0, 0);
    }
    __builtin_amdgcn_sched_barrier(0);
}
template <int NC, class MB>
__device__ __forceinline__ void attn_tile_pv(const bool FIRST  , const LAS unsigned char* Vs, AttnState<NC>& st, f32x16& p0, f32x16& p1, int r32, int hi, int lane, const MB& mb) {
    const LAS unsigned char* vb = Vs + ((lane >> 4) & 1) * 32 + (lane & 3) * 8 + (4 * hi + ((lane & 15) >> 2)) * 64;
    v4i16_t vlo[8], vhh[8];
#pragma unroll
    for (int d0 = 0; d0 < 2; ++d0)
#pragma unroll
        for (int s = 0; s < 4; ++s) { vlo[d0 * 4 + s] = vtr(vb + d0 * 512 + s * 2048); vhh[d0 * 4 + s] = vtr(vb + d0 * 512 + s * 2048 + 1024); }
    typename MB::Pre pre; mb.prefetch(pre);
    __builtin_amdgcn_sched_barrier(0);
    mb(p0, p1, pre, r32, hi);
    float a = max3f(p0[0], p0[1], p1[0]), b = max3f(p0[2], p0[3], p1[1]); a = max3f(a, p1[2], p1[3]);
#pragma unroll
    for (int r = 4; r < 16; r += 4) { a = max3f(a, p0[r], p0[r + 1]); b = max3f(b, p0[r + 2], p0[r + 3]); a = max3f(a, p1[r], p1[r + 1]); b = max3f(b, p1[r + 2], p1[r + 3]); }
    float rm = __builtin_fmaxf(a, b);
    rm = xor32_max(rm);
    if (FIRST || __any(rm > 8.0f)) {
        const float d = FIRST ? rm : __builtin_fmaxf(rm, 0.f), f = __builtin_amdgcn_exp2f(-d);
        st.m += d; st.l *= f;
#pragma unroll
        for (int r = 0; r < 16; ++r) { st.o[0][r] *= f; st.o[1][r] *= f; p0[r] -= d; p1[r] -= d; }
#pragma unroll
        for (int r = 0; r < NC; ++r) st.cin[r] -= d;
    }
    float ls = 0.f;
#pragma unroll
    for (int r = 0; r < 16; ++r) { p0[r] = __builtin_amdgcn_exp2f(p0[r]); p1[r] = __builtin_amdgcn_exp2f(p1[r]); ls += p0[r] + p1[r]; }
    st.l += ls;
    u32x4 pw[4];
#pragma unroll
    for (int q = 0; q < 4; ++q) { pw[0][q] = cvt_pk_bf16(p0[2 * q], p0[2 * q + 1]); pw[1][q] = cvt_pk_bf16(p0[8 + 2 * q], p0[8 + 2 * q + 1]);
                                  pw[2][q] = cvt_pk_bf16(p1[2 * q], p1[2 * q + 1]); pw[3][q] = cvt_pk_bf16(p1[8 + 2 * q], p1[8 + 2 * q + 1]); }
    __builtin_amdgcn_sched_barrier(0);
#pragma unroll
    for (int d0 = 0; d0 < 2; ++d0)
#pragma unroll
        for (int s = 0; s < 4; ++s) {
            const v4i16_t lo = vlo[d0 * 4 + s], hh = vhh[d0 * 4 + s];
            const bf16x8 vf = (bf16x8){lo[0], lo[1], lo[2], lo[3], hh[0], hh[1], hh[2], hh[3]};
            st.o[d0] = __builtin_amdgcn_mfma_f32_32x32x16_bf16(vf, __builtin_bit_cast(bf16x8, pw[s]), st.o[d0], 0, 0, 0);
        }
    __builtin_amdgcn_sched_barrier(0);
}
template <int NC> __device__ __forceinline__ void attn_finish_direct(AttnState<NC>& st, bf16_t* Orow  , float* ssqp, int hi) {
    float l = xor32_sum(st.l);
    const float inv = 1.0f / l;
    float sq = 0.f;
#pragma unroll
    for (int d0 = 0; d0 < 2; ++d0)
#pragma unroll
        for (int rg = 0; rg < 4; rg += 2) {
            u32x2 wp[2];
#pragma unroll
            for (int j = 0; j < 2; ++j) {
                const float v0 = st.o[d0][4 * (rg + j)] * inv, v1 = st.o[d0][4 * (rg + j) + 1] * inv, v2 = st.o[d0][4 * (rg + j) + 2] * inv, v3 = st.o[d0][4 * (rg + j) + 3] * inv;
                sq += (v0 * v0 + v1 * v1) + (v2 * v2 + v3 * v3);
                wp[j].x = cvt_pk_bf16(v0, v1); wp[j].y = cvt_pk_bf16(v2, v3); }
            const auto sx = __builtin_amdgcn_permlane32_swap(wp[0].x, wp[1].x, false, false), sy = __builtin_amdgcn_permlane32_swap(wp[0].y, wp[1].y, false, false);
            u32x4 w; w.x = sx[0]; w.y = sy[0]; w.z = sx[1]; w.w = sy[1];
            st16_wt(Orow + 32 * d0 + 8 * (rg + hi), w);
        }
    sq = xor32_sum(sq);
    if (hi == 0) atomicAdd(ssqp, sq);
}
struct MbNone { struct Pre {}; __device__ __forceinline__ void prefetch(Pre&) const {} __device__ __forceinline__ void operator()(f32x16&, f32x16&, const Pre&, int, int) const {} };
struct MbBandLo { int qi;
    struct Pre {}; __device__ __forceinline__ void prefetch(Pre&) const {}
    __device__ __forceinline__ void operator()(f32x16& p0, f32x16& p1, const Pre&, int, int hi) const {
#pragma unroll
        for (int r = 0; r < 16; ++r) { const int kj = crow(r, hi); p0[r] = (kj >= qi) ? p0[r] : -1e30f; p1[r] = (kj + 32 >= qi) ? p1[r] : -1e30f; } } };
struct MbBandHi { int qi;
    struct Pre {}; __device__ __forceinline__ void prefetch(Pre&) const {}
    __device__ __forceinline__ void operator()(f32x16& p0, f32x16& p1, const Pre&, int, int hi) const {
#pragma unroll
        for (int r = 0; r < 16; ++r) { const int kj = crow(r, hi); p0[r] = (kj <= qi) ? p0[r] : -1e30f; p1[r] = (kj + 32 <= qi) ? p1[r] : -1e30f; } } };
struct MbNeigh { const LAS float* base;
    struct Pre { float b[32]; };
    __device__ __forceinline__ void prefetch(Pre& P) const {
        const unsigned a = (unsigned)(unsigned long)base;
#define NB_RD16(B, OFF) asm volatile( \
            "ds_read_b32 %0, %16 offset:" #OFF "+0\n\tds_read_b32 %1, %16 offset:" #OFF "+4\n\tds_read_b32 %2, %16 offset:" #OFF "+8\n\tds_read_b32 %3, %16 offset:" #OFF "+12\n\t" \
            "ds_read_b32 %4, %16 offset:" #OFF "+32\n\tds_read_b32 %5, %16 offset:" #OFF "+36\n\tds_read_b32 %6, %16 offset:" #OFF "+40\n\tds_read_b32 %7, %16 offset:" #OFF "+44\n\t" \
            "ds_read_b32 %8, %16 offset:" #OFF "+64\n\tds_read_b32 %9, %16 offset:" #OFF "+68\n\tds_read_b32 %10, %16 offset:" #OFF "+72\n\tds_read_b32 %11, %16 offset:" #OFF "+76\n\t" \
            "ds_read_b32 %12, %16 offset:" #OFF "+96\n\tds_read_b32 %13, %16 offset:" #OFF "+100\n\tds_read_b32 %14, %16 offset:" #OFF "+104\n\tds_read_b32 %15, %16 offset:" #OFF "+108\n\t" \
            "s_waitcnt lgkmcnt(0)" \
            : "=&v"(P.b[B + 0]), "=&v"(P.b[B + 1]), "=&v"(P.b[B + 2]), "=&v"(P.b[B + 3]), "=&v"(P.b[B + 4]), "=&v"(P.b[B + 5]), "=&v"(P.b[B + 6]), "=&v"(P.b[B + 7]), \
              "=&v"(P.b[B + 8]), "=&v"(P.b[B + 9]), "=&v"(P.b[B + 10]), "=&v"(P.b[B + 11]), "=&v"(P.b[B + 12]), "=&v"(P.b[B + 13]), "=&v"(P.b[B + 14]), "=&v"(P.b[B + 15]) : "v"(a) : "memory")
        NB_RD16(0, 0); NB_RD16(16, 128);
#undef NB_RD16
    }
    __device__ __forceinline__ void operator()(f32x16& p0, f32x16& p1, const Pre& P, int, int) const {
#pragma unroll
        for (int r = 0; r < 16; ++r) { p0[r] += P.b[r]; p1[r] += P.b[16 + r]; } } };

__device__ __forceinline__ void attn_a_phase(Frame& F, float* ssq) {
    const int wave = F.wave, lane = F.lane, r32 = lane & 31, hi = lane >> 5, g = wave >> 1, qh = wave & 1;
    constexpr int NQB = SEQ / 64, VOFF = 49152;
    for (int run = F.vcu; run < NB * AKVH * (NQB / 4); run += F.G) {
        const int quad = run % (NQB / 4), kvh = (run / (NQB / 4)) % AKVH, b = run / ((NQB / 4) * AKVH);
        const int j0 = quad * 4, h = kvh * 4 + g;
        const bf16_t* base = F.PROJ + (size_t)b * SEQ * DIN;
        const float sink2 = F.sink[h] * LOG2E;
#define AT_DMA(k) do { const int _s = (((k) + 6) % 6) * 8192; const bf16_t* _r = base + (size_t)((k) * 64) * DIN; \
        dma_k(_r + OFF_KA + kvh * HD, F.lds + _s, wave, lane); dma_v(_r + OFF_VA + kvh * HD, F.lds + VOFF + _s, wave, lane); } while (0)
        asm volatile("s_waitcnt lgkmcnt(0)" ::: "memory"); __builtin_amdgcn_s_barrier();
#pragma unroll
        for (int k = -2; k <= 2; ++k) { if (j0 + k >= 0 && j0 + k < NQB) AT_DMA(j0 + k); }
        bf16x8 qr[4];
        { const bf16_t* qp = base + (size_t)(j0 * 64 + qh * 32 + r32) * DIN + OFF_QA + h * HD + hi * 8;
#pragma unroll
          for (int d0 = 0; d0 < 4; ++d0) qr[d0] = *(const GAS bf16x8*)(qp + d0 * 16); }
#pragma unroll 1
        for (int i = 0; i < 4; ++i) {
            const int j = j0 + i, q0 = j * 64;
            if (i > 0) { asm volatile("s_waitcnt lgkmcnt(0)" ::: "memory"); __builtin_amdgcn_s_barrier(); }
            const bool pf = (i < 3) && (j + 3 < NQB);
            if (pf) AT_DMA(j + 3);
            if (pf) asm volatile("s_waitcnt vmcnt(2)" ::: "memory"); else asm volatile("s_waitcnt vmcnt(0)" ::: "memory");
            __builtin_amdgcn_s_barrier();
#ifdef AT_SLEEP
            if (wave >= 4) __builtin_amdgcn_s_sleep(AT_SLEEP);
#endif
            AttnState<1> st; st.m = sink2; st.l = (hi == 0) ? 1.f : 0.f;
#pragma unroll
            for (int r = 0; r < 16; ++r) { st.o[0][r] = 0.f; st.o[1][r] = 0.f; }
            st.cin[0] = -sink2;
            const int qi = qh * 32 + r32;
#define AT_SLOT(k) (F.lds + (((k) + 6) % 6) * 8192)
            if (j - 2 >= 0) attn_tile(false, AT_SLOT(j - 2), AT_SLOT(j - 2) + VOFF, qr, st, r32, hi, lane, MbBandLo{qi});
            if (j - 1 >= 0) attn_tile(false, AT_SLOT(j - 1), AT_SLOT(j - 1) + VOFF, qr, st, r32, hi, lane, MbNone{});
            attn_tile(false, AT_SLOT(j), AT_SLOT(j) + VOFF, qr, st, r32, hi, lane, MbNone{});
            if (j + 1 < NQB) attn_tile(false, AT_SLOT(j + 1), AT_SLOT(j + 1) + VOFF, qr, st, r32, hi, lane, MbNone{});
            if (j + 2 < NQB) attn_tile(false, AT_SLOT(j + 2), AT_SLOT(j + 2) + VOFF, qr, st, r32, hi, lane, MbBandHi{qi});
            const int tok0 = b * SEQ + q0 + qh * 32;
            attn_finish(st, F.lds + 98304 + wave * 4096, F.O + (size_t)tok0 * DM + h * HD, ssq + tok0 * 2, r32, hi, lane);
            if (i < 3) { const bf16_t* qp = base + (size_t)((j + 1) * 64 + qh * 32 + r32) * DIN + OFF_QA + h * HD + hi * 8;
#pragma unroll
                for (int d0 = 0; d0 < 4; ++d0) qr[d0] = *(const GAS bf16x8*)(qp + d0 * 16); }
        }
#undef AT_DMA
#undef AT_SLOT
    }
}
static_assert(GW == 64 && NAC == 16, "the elided ranges are derived for a 64-wide grid and 16-column windows");
template <int QH> __device__ __forceinline__ constexpr bool nb_act0(int r) { return QH == 0 || r >= 12; }
template <int QH> __device__ __forceinline__ constexpr bool nb_act1(int r) { return QH == 1 || r < 4; }
__device__ __forceinline__ void nb_tile_k(const LAS unsigned char* Ks, int r32, int hi, bf16x8 (&kf)[8]) {
    const LAS unsigned char* kb = Ks + r32 * 128; const int sw = (r32 >> 1) & 7;
#pragma unroll
    for (int d0 = 0; d0 < 4; ++d0) { const int ko = ((2 * d0 + hi) ^ sw) << 4; kf[2 * d0] = *(const LAS bf16x8*)(kb + ko); kf[2 * d0 + 1] = *(const LAS bf16x8*)(kb + ko + 4096); }
}
template <int QH> __device__ __forceinline__ void nb_tile_s(const bf16x8 (&kf)[8], const bf16x8 (&qr)[4], const AttnState<32>& st, f32x16& p0, f32x16& p1) {
#pragma unroll
    for (int r = 0; r < 16; ++r) { p0[r] = nb_act0<QH>(r) ? st.cin[r] : 0.f; p1[r] = nb_act1<QH>(r) ? st.cin[16 + r] : 0.f; }
    __builtin_amdgcn_sched_barrier(0);
#pragma unroll
    for (int d0 = 0; d0 < 4; ++d0) {
        p0 = __builtin_amdgcn_mfma_f32_32x32x16_bf16(kf[2 * d0], qr[d0], p0, 0, 0, 0);
        p1 = __builtin_amdgcn_mfma_f32_32x32x16_bf16(kf[2 * d0 + 1], qr[d0], p1, 0, 0, 0);
    }
    __builtin_amdgcn_sched_barrier(0);
}
struct NbFrags { v4i16_t vlo[8], vhh[8]; float b[32]; };
template <int QH> __device__ __forceinline__ void nb_tile_ld(const LAS unsigned char* Vs, int hi, int lane, const LAS float* bias  , NbFrags& G) {
    constexpr int SKIP = QH ? 0 : 3;
    const LAS unsigned char* vb = Vs + ((lane >> 4) & 1) * 32 + (lane & 3) * 8 + (4 * hi + ((lane & 15) >> 2)) * 64;
    v4i16_t (&vlo)[8] = G.vlo; v4i16_t (&vhh)[8] = G.vhh; float (&b)[32] = G.b;
#pragma unroll
    for (int d0 = 0; d0 < 2; ++d0)
#pragma unroll
        for (int s = 0; s < 4; ++s) if (s != SKIP) { vlo[d0 * 4 + s] = vtr(vb + d0 * 512 + s * 2048); vhh[d0 * 4 + s] = vtr(vb + d0 * 512 + s * 2048 + 1024); }
    { const unsigned a = (unsigned)(unsigned long)bias;
#define NB_RD16(B, OFF) asm volatile( \
            "ds_read_b32 %0, %16 offset:" #OFF "+0\n\tds_read_b32 %1, %16 offset:" #OFF "+4\n\tds_read_b32 %2, %16 offset:" #OFF "+8\n\tds_read_b32 %3, %16 offset:" #OFF "+12\n\t" \
            "ds_read_b32 %4, %16 offset:" #OFF "+32\n\tds_read_b32 %5, %16 offset:" #OFF "+36\n\tds_read_b32 %6, %16 offset:" #OFF "+40\n\tds_read_b32 %7, %16 offset:" #OFF "+44\n\t" \
            "ds_read_b32 %8, %16 offset:" #OFF "+64\n\tds_read_b32 %9, %16 offset:" #OFF "+68\n\tds_read_b32 %10, %16 offset:" #OFF "+72\n\tds_read_b32 %11, %16 offset:" #OFF "+76\n\t" \
            "ds_read_b32 %12, %16 offset:" #OFF "+96\n\tds_read_b32 %13, %16 offset:" #OFF "+100\n\tds_read_b32 %14, %16 offset:" #OFF "+104\n\tds_read_b32 %15, %16 offset:" #OFF "+108\n\t" \
            "s_waitcnt lgkmcnt(0)" \
            : "=&v"(b[B + 0]), "=&v"(b[B + 1]), "=&v"(b[B + 2]), "=&v"(b[B + 3]), "=&v"(b[B + 4]), "=&v"(b[B + 5]), "=&v"(b[B + 6]), "=&v"(b[B + 7]), \
              "=&v"(b[B + 8]), "=&v"(b[B + 9]), "=&v"(b[B + 10]), "=&v"(b[B + 11]), "=&v"(b[B + 12]), "=&v"(b[B + 13]), "=&v"(b[B + 14]), "=&v"(b[B + 15]) : "v"(a) : "memory")
#define NB_RD4(B, OFF) asm volatile( \
            "ds_read_b32 %0, %4 offset:" #OFF "+0\n\tds_read_b32 %1, %4 offset:" #OFF "+4\n\tds_read_b32 %2, %4 offset:" #OFF "+8\n\tds_read_b32 %3, %4 offset:" #OFF "+12\n\t" \
            "s_waitcnt lgkmcnt(0)" \
            : "=&v"(b[B + 0]), "=&v"(b[B + 1]), "=&v"(b[B + 2]), "=&v"(b[B + 3]) : "v"(a) : "memory")
      if constexpr (QH == 0) { NB_RD16(0, 0); NB_RD4(16, 128); } else { NB_RD4(12, 96); NB_RD16(16, 128); }
#undef NB_RD16
#undef NB_RD4
    }
    __builtin_amdgcn_sched_barrier(0);
}
template <int QH> __device__ __forceinline__ void nb_tile_pv(const bool FIRST  , AttnState<32>& st, f32x16& p0, f32x16& p1, const NbFrags& G) {
    constexpr int SKIP = QH ? 0 : 3;
    const v4i16_t (&vlo)[8] = G.vlo; const v4i16_t (&vhh)[8] = G.vhh; const float (&b)[32] = G.b;
    float a = -INFINITY, bm = -INFINITY;
#pragma unroll
    for (int r = 0; r < 16; r += 2) {
        if (nb_act0<QH>(r)) { p0[r] += b[r]; p0[r + 1] += b[r + 1]; a = max3f(a, p0[r], p0[r + 1]); }
        if (nb_act1<QH>(r)) { p1[r] += b[16 + r]; p1[r + 1] += b[16 + r + 1]; bm = max3f(bm, p1[r], p1[r + 1]); } }
    float rm = __builtin_fmaxf(a, bm);
    rm = xor32_max(rm);
    if (FIRST || __any(rm > 8.0f)) {
        const float d = FIRST ? rm : __builtin_fmaxf(rm, 0.f), f = __builtin_amdgcn_exp2f(-d);
        st.m += d; st.l *= f;
#pragma unroll
        for (int r = 0; r < 16; ++r) { st.o[0][r] *= f; st.o[1][r] *= f; if (nb_act0<QH>(r)) { p0[r] -= d; st.cin[r] -= d; } if (nb_act1<QH>(r)) { p1[r] -= d; st.cin[16 + r] -= d; } }
    }
    float ls = 0.f;
#pragma unroll
    for (int r = 0; r < 16; ++r) { if (nb_act0<QH>(r)) { p0[r] = __builtin_amdgcn_exp2f(p0[r]); ls += p0[r]; } else p0[r] = 0.f;
                                   if (nb_act1<QH>(r)) { p1[r] = __builtin_amdgcn_exp2f(p1[r]); ls += p1[r]; } else p1[r] = 0.f; }
    st.l += ls;
    u32x4 pw[4];
#pragma unroll
    for (int q = 0; q < 4; ++q) { pw[0][q] = cvt_pk_bf16(p0[2 * q], p0[2 * q + 1]); pw[1][q] = nb_act0<QH>(8 + 2 * q) ? cvt_pk_bf16(p0[8 + 2 * q], p0[8 + 2 * q + 1]) : 0u;
                                  pw[2][q] = nb_act1<QH>(2 * q) ? cvt_pk_bf16(p1[2 * q], p1[2 * q + 1]) : 0u; pw[3][q] = cvt_pk_bf16(p1[8 + 2 * q], p1[8 + 2 * q + 1]); }
    __builtin_amdgcn_sched_barrier(0);
#pragma unroll
    for (int d0 = 0; d0 < 2; ++d0)
#pragma unroll
        for (int s = 0; s < 4; ++s) if (s != SKIP) {
            const v4i16_t lo = vlo[d0 * 4 + s], hh = vhh[d0 * 4 + s];
            const bf16x8 vf = (bf16x8){lo[0], lo[1], lo[2], lo[3], hh[0], hh[1], hh[2], hh[3]};
            st.o[d0] = __builtin_amdgcn_mfma_f32_32x32x16_bf16(vf, __builtin_bit_cast(bf16x8, pw[s]), st.o[d0], 0, 0, 0);
        }
    __builtin_amdgcn_sched_barrier(0);
}
constexpr int NTAB_OFF = LDSCTL_OFF + 2048;
__device__ __forceinline__ int na_rs(int r) { return min(max(r - NAR / 2, 0), GW - NAR); }
template <int QH> __device__ __forceinline__ void attn_b_phase_q(Frame& F, float* ssq) {
    const int wave = F.wave, lane = lane_id()  , r32 = lane & 31, hi = lane >> 5, rw = wave >> 1, qh = QH;
    LAS float* tab = (LAS float*)(F.lds + NTAB_OFF);
    const int qc = qh * 32 + r32, cs = min(max(qc - NAC / 2, 0), GW - NAC);
    constexpr int RUNROWS = 16, NRUN = NB * BH * (GW / RUNROWS);
#define NB_DMA(t) do { const int _bs = ((t) & 7) * 16384; const bf16_t* _kr = F.PROJ + ((size_t)rb * SEQ + (size_t)(t) * GW) * DIN; int _l = lane; asm volatile("" : "+v"(_l));   \
        dma_k(_kr + OFF_KB + rhead * HD, F.lds + _bs, wave, _l); dma_v(_kr + OFF_VB + rhead * HD, F.lds + _bs + 8192, wave, _l); } while (0)
#define NB_QLOAD(dst, row) do { const bf16_t* _qp = F.PROJ + ((size_t)rb * SEQ + (size_t)(row) * GW + qc) * DIN + OFF_QB + rhead * HD + hi * 8; \
        _Pragma("unroll") for (int d0 = 0; d0 < 4; ++d0) dst[d0] = *(const GAS bf16x8*)(_qp + d0 * 16); } while (0)
    int cur_head = -1;
    for (int run = F.vcu; run < NRUN; run += F.G) {
        const int rbase = (run % (GW / RUNROWS)) * RUNROWS, rhead = (run / (GW / RUNROWS)) % BH, rb = run / ((GW / RUNROWS) * BH);
        const int Thi = na_rs(rbase + RUNROWS - 1) + NAR - 1;
        asm volatile("s_waitcnt vmcnt(0) lgkmcnt(0)" ::: "memory"); __builtin_amdgcn_s_barrier();
        int nxt = na_rs(rbase);
        { const int lim = min(min(na_rs(rbase), na_rs(rbase + 4)) + 7, Thi);
#pragma unroll 1
          for (; nxt <= lim; ++nxt) NB_DMA(nxt); }
        bf16x8 qr[4];
        NB_QLOAD(qr, rbase + rw);
        if (rhead != cur_head) {
            cur_head = rhead;
            for (int i = wave * 64 + lane_id(); i < 15 * 128; i += NWAVES * 64) { const int d = (i & 127) - 63, ro = i >> 7;
                tab[i] = (d >= -15 && d <= 15) ? F.rpb[(rhead * 15 + ro) * 31 + d + 15] * LOG2E : 0.f; }
            asm volatile("s_waitcnt lgkmcnt(0)" ::: "memory"); }
#pragma unroll 1
        for (int ui = 0; ui < RUNROWS / 4; ++ui) {
            const int r0u = rbase + 4 * ui, r = r0u + rw, rs = na_rs(r);
            const int Lb = na_rs(r0u), Hb = na_rs(r0u + 3), Ln = (ui < RUNROWS / 4 - 1) ? na_rs(r0u + 4) : 1 << 20;
            AttnState<32> st; st.m = 0.f; st.l = 0.f;
#pragma unroll
            for (int q = 0; q < 16; ++q) { st.o[0][q] = 0.f; st.o[1][q] = 0.f; }
            { int cs_ = cs; asm volatile("" : "+v"(cs_));
#pragma unroll
              for (int q = 0; q < 16; ++q) { const int kc = crow(q, hi); st.cin[q] = (kc >= cs_ && kc < cs_ + 16) ? 0.f : -1e30f; st.cin[16 + q] = (kc + 32 >= cs_ && kc + 32 < cs_ + 16) ? 0.f : -1e30f; } }
            asm volatile("" : "+v"(qr[0]), "+v"(qr[1]), "+v"(qr[2]), "+v"(qr[3]));
#ifndef NB_MODE
#define NB_MODE 1
#endif
            const bool late = (NB_MODE == 1) && wave >= 4;
            const int Ll = na_rs(r0u + 2) - 1;
            f32x16 p0, p1; NbFrags G;
#pragma unroll 1
            for (int s = 0; s <= NAR; ++s) {
                if (s < NAR) {
                    if (s > 0) switch (nxt - 1 - (Hb + s)) { case 7: asm volatile("s_waitcnt vmcnt(14)" ::: "memory"); break; case 6: asm volatile("s_waitcnt vmcnt(12)" ::: "memory"); break;
                                     case 5: asm volatile("s_waitcnt vmcnt(10)" ::: "memory"); break; case 4: asm volatile("s_waitcnt vmcnt(8)" ::: "memory"); break;
                                     case 3: asm volatile("s_waitcnt vmcnt(6)" ::: "memory"); break;  case 2: asm volatile("s_waitcnt vmcnt(4)" ::: "memory"); break;
                                     case 1: asm volatile("s_waitcnt vmcnt(2)" ::: "memory"); break;  default: asm volatile("s_waitcnt vmcnt(0)" ::: "memory"); break; }
                    asm volatile("s_waitcnt lgkmcnt(0)" ::: "memory"); __builtin_amdgcn_s_barrier(); asm volatile("" ::: "memory");
                }
                if (late && s > 0) nb_tile_pv<QH>(s == 1, st, p0, p1, G);
                if (s < NAR) { const int kr = rs + s;
                    { bf16x8 kf[8]; nb_tile_k(F.lds + (kr & 7) * 16384, r32, hi, kf);
                      nb_tile_s<QH>(kf, qr, st, p0, p1); }
                    nb_tile_ld<QH>(F.lds + (kr & 7) * 16384 + 8192, hi, lane, tab + (kr - r + NAR - 1) * 128 + (63 - qc + 4 * hi), G);
                    { const int Ld = (s > 0) ? min(min(Lb + s, Ln), Ll + s) : min(Lb, Ln), lim = min(Ld + 7, Thi);
#pragma unroll 1
                      for (; nxt <= lim; ++nxt) NB_DMA(nxt); }
                    if (s == NAR - 1 && ui < RUNROWS / 4 - 1) NB_QLOAD(qr, r + 4);
                    if (!late) nb_tile_pv<QH>(s == 0, st, p0, p1, G);
                }
            }
            const int tok = rb * SEQ + r * GW + qc;
            attn_finish_direct(st, F.O + (size_t)tok * DM + AQW + rhead * HD, ssq + tok * 2 + 1, hi);
        }
    }
#undef NB_DMA
#undef NB_QLOAD
}
__device__ __forceinline__ void attn_b_phase(Frame& F, float* ssq) { if (F.wave & 1) attn_b_phase_q<1>(F, ssq); else attn_b_phase_q<0>(F, ssq); }
constexpr int P4_MAXU = 4, P4_TAB_OFF = NTAB_OFF;
struct EpiX1 {
    static constexpr bool PERM = true, MID = true, FP8 = false; static constexpr int WIDE = 1;
    static constexpr int NST = 0;
    __device__ __forceinline__ int nstores(const pg8::Unit&) const { return 0; }
    bf16_t* delta; const LAS unsigned char* tabs;
    __device__ __forceinline__ void init(f32x4 (&i)[2][2], int, int, int) const { i[0][0] = i[0][1] = i[1][0] = i[1][1] = (f32x4){0.f, 0.f, 0.f, 0.f}; }
    __device__ __forceinline__ void mid_u(f32x4 (&acc)[2][2][4][2], int ui, int wr, int fr) const {
        const LAS f32x2* rt = (const LAS f32x2*)(tabs + (ui % P4_MAXU) * 3072);
#pragma unroll
        for (int ai = 0; ai < 2; ++ai)
#pragma unroll
            for (int m = 0; m < 4; ++m) { const float f = rt[ai * 128 + wr * 64 + m * 16 + fr].x;
#pragma unroll
                for (int bj = 0; bj < 2; ++bj)
#pragma unroll
                    for (int n = 0; n < 2; ++n) acc[ai][bj][m][n] *= f; }
    }
    __device__ __forceinline__ void operator()(const f32x4 (&acc)[2][2][4][2], const pg8::Unit& u, int ui, int wr, int wc, int fr, int fq) const {
        const int c0 = wc * 64 + 8 * fq, col0 = u.pn * 256 + c0;
        const LAS f32x2* rt = (const LAS f32x2*)(tabs + (ui % P4_MAXU) * 3072); const LAS float* gt = (const LAS float*)(tabs + (ui % P4_MAXU) * 3072 + 2048) + c0;
        f32x4 gm[2][2];
#pragma unroll
        for (int bj = 0; bj < 2; ++bj)
#pragma unroll
            for (int n = 0; n < 2; ++n) gm[bj][n] = *(const LAS f32x4*)(gt + bj * 32 + 4 * n);
#pragma unroll
        for (int ai = 0; ai < 2; ++ai)
#pragma unroll
            for (int m = 0; m < 4; ++m) { const int rl = ai * 128 + wr * 64 + m * 16 + fr; const float rb = rt[rl].y;
                bf16_t* rowp = delta + (size_t)(u.pm * 256 + rl) * DM + col0;
#pragma unroll
                for (int bj = 0; bj < 2; ++bj) { const f32x4 v0 = gm[bj][0] * (acc[ai][bj][m][0] * rb), v1 = gm[bj][1] * (acc[ai][bj][m][1] * rb);
                    u32x4 w; w.x = cvt_pk_bf16(v0[0], v0[1]); w.y = cvt_pk_bf16(v0[2], v0[3]); w.z = cvt_pk_bf16(v1[0], v1[1]); w.w = cvt_pk_bf16(v1[2], v1[3]);
                    st16_wt(rowp + bj * 32, w); } }
    }
};
__device__ __forceinline__ void p4_tables(Frame& F, const pg8::DenseOrder& S) {
    pg8::Unit u;
    for (int i = 0; i < P4_MAXU && S.next(i, u); ++i) {
        LAS unsigned char* tb = F.lds + P4_TAB_OFF + i * 3072;
        if (F.tid < 256) { const int row = u.pm * 256 + F.tid; const f32x2 s = *(const GAS f32x2*)(F.ssq + row * 2);
            const float ia = s.x * (1.f / 512.f) + EPS, ib = s.y * (1.f / 512.f) + EPS;
            ((LAS f32x2*)tb)[F.tid] = (f32x2){sqrtf(ib / ia), 1.0f / sqrtf(ib)}; }
        else { const int c = F.tid - 256; ((LAS float*)(tb + 2048))[c] = F.mod[((u.pm * 256) / SEQ) * 6 * DM + 2 * DM + u.pn * 256 + c]; }
    }
    asm volatile("s_waitcnt vmcnt(0) lgkmcnt(0)" ::: "memory"); __syncthreads();
}

__device__ __forceinline__ void router_phase(Frame& F, gu32* cntw) {
    const int wave = F.wave, lane = F.lane, r32 = lane & 31, hi = lane >> 5;
    bf16x8 wh[8], wl[8];
#pragma unroll
    for (int c = 0; c < 8; ++c) { const bf16_t* p = F.wr_t + r32 * DM + 128 * wave + 16 * c + 8 * hi; wh[c] = *(const GAS bf16x8*)p; wl[c] = *(const GAS bf16x8*)(p + NE * DM); }
    LAS unsigned char* imgH = F.lds;
    LAS unsigned char* imgL = F.lds + 65536;
    LAS float* R = (LAS float*)(F.lds);
    LAS float* L = (LAS float*)(F.lds + NTAB_OFF);
    LAS int* lcnt = (LAS int*)(F.lds + NTAB_OFF + 4352);
    int sel[TOPK] = {0, 0, 0, 0}; float gt[TOPK] = {0.f, 0.f, 0.f, 0.f}; int lpos[TOPK] = {0, 0, 0, 0}; int pbase = 0, pt0 = 0; bool pend = false;
    for (int it = F.vcu; it < NTOK / 32; it += F.G) {
        const int t0 = it * 32, b = t0 / SEQ;
        { f32x4 s1[4], sh[4];
#pragma unroll
          for (int j = 0; j < 4; ++j) { s1[j] = *(const GAS f32x4*)(F.mod + b * 6 * DM + 4 * DM + 4 * lane + 256 * j) + 1.0f; sh[j] = *(const GAS f32x4*)(F.mod + b * 6 * DM + 3 * DM + 4 * lane + 256 * j); }
#pragma unroll
          for (int pr = 0; pr < 2; ++pr) {
              f32x4 xv[2][4]; u32x2 dv[2][4];
#pragma unroll
              for (int tt = 0; tt < 2; ++tt) { const int tok = t0 + 4 * wave + 2 * pr + tt;
                  const GAS f32x4* xr = (const GAS f32x4*)(F.x + (size_t)tok * DM) + lane; const GAS u32x2* dr = (const GAS u32x2*)(F.DELTA + (size_t)tok * DM) + lane;
#pragma unroll
                  for (int j = 0; j < 4; ++j) { xv[tt][j] = xr[64 * j]; dv[tt][j] = dr[64 * j]; } }
#pragma unroll
              for (int tt = 0; tt < 2; ++tt) { const int tl = 4 * wave + 2 * pr + tt, tok = t0 + tl; float s = 0.f;
                  GAS u32x2* x1r = (GAS u32x2*)(F.DELTA + (size_t)tok * DM) + lane;
#pragma unroll
                  for (int j = 0; j < 4; ++j) { const u32x2 w = dv[tt][j]; xv[tt][j] += (f32x4){bf2f(w.x & 0xffffu), bf2f(w.x >> 16), bf2f(w.y & 0xffffu), bf2f(w.y >> 16)};
                      u32x2 xw; xw.x = pk2(xv[tt][j].x, xv[tt][j].y); xw.y = pk2(xv[tt][j].z, xv[tt][j].w); x1r[64 * j] = xw;
                      s += (xv[tt][j].x * xv[tt][j].x + xv[tt][j].y * xv[tt][j].y) + (xv[tt][j].z * xv[tt][j].z + xv[tt][j].w * xv[tt][j].w); }
                  const float rstd = 1.0f / sqrtf(wave_sum(s) * (1.f / DM) + EPS);
                  GAS unsigned* xn = (GAS unsigned*)((unsigned char*)F.XN + (size_t)tok * DM) + lane;
#pragma unroll
                  for (int j = 0; j < 4; ++j) { const f32x4 h = xv[tt][j] * rstd * s1[j] + sh[j];
                      u32x2 hw; hw.x = pk2(h.x, h.y); hw.y = pk2(h.z, h.w);
                      u32x2 lw; lw.x = pk2(h.x - bf2f(hw.x & 0xffffu), h.y - bf2f(hw.x >> 16)); lw.y = pk2(h.z - bf2f(hw.y & 0xffffu), h.w - bf2f(hw.y >> 16));
                      xn[64 * j] = pk_fp8x4(h.x, h.y, h.z, h.w);
                      const int off = tl * 2048 + ((((lane >> 1) + 32 * j) ^ (tl & 15)) << 4) + (lane & 1) * 8;
                      *(LAS u32x2*)(imgH + off) = hw; *(LAS u32x2*)(imgL + off) = lw; } } } }
        asm volatile("s_waitcnt lgkmcnt(0)" ::: "memory"); __builtin_amdgcn_s_barrier(); asm volatile("" ::: "memory");
        f32x16 acc;
#pragma unroll
        for (int r = 0; r < 16; ++r) acc[r] = 0.f;
#pragma unroll
        for (int c = 0; c < 8; ++c) { const int off = r32 * 2048 + (((16 * wave + 2 * c + hi) ^ (r32 & 15)) << 4);
            const bf16x8 hf = *(const LAS bf16x8*)(imgH + off), lf = *(const LAS bf16x8*)(imgL + off);
            acc = __builtin_amdgcn_mfma_f32_32x32x16_bf16(hf, wh[c], acc, 0, 0, 0);
            acc = __builtin_amdgcn_mfma_f32_32x32x16_bf16(lf, wh[c], acc, 0, 0, 0);
            acc = __builtin_amdgcn_mfma_f32_32x32x16_bf16(hf, wl[c], acc, 0, 0, 0);
        }
        asm volatile("s_waitcnt lgkmcnt(0)" ::: "memory"); __builtin_amdgcn_s_barrier(); asm volatile("" ::: "memory");
#pragma unroll
        for (int r = 0; r < 16; ++r) R[wave * 1024 + crow(r, hi) * 32 + r32] = acc[r];
        asm volatile("s_waitcnt lgkmcnt(0)" ::: "memory"); __builtin_amdgcn_s_barrier(); asm volatile("" ::: "memory");
#pragma unroll
        for (int q = 0; q < 2; ++q) { const int idx = F.tid * 2 + q, tk = idx >> 5, e = idx & 31; float v = F.b_router[e];
#pragma unroll
            for (int w = 0; w < 8; ++w) v += R[w * 1024 + idx];
            L[tk * 33 + e] = v; }
        asm volatile("s_waitcnt lgkmcnt(0)" ::: "memory"); __builtin_amdgcn_s_barrier(); asm volatile("" ::: "memory");
        if (wave == 0) {
            if (pend) { if (lane < 32) lcnt[32 + lane] = pbase;
                asm volatile("s_waitcnt lgkmcnt(0)" ::: "memory");
                if (lane < 32) { const int t = pt0 + lane;
#pragma unroll
                    for (int kk = 0; kk < TOPK; ++kk) { const int e = sel[kk], pos = lcnt[32 + e] + lpos[kk];
                        F.tkg[t * 4 + kk] = gt[kk]; F.list[e * NTOK + pos] = t * 4 + kk; } }
                asm volatile("s_waitcnt lgkmcnt(0)" ::: "memory"); }
            if (lane < 32) lcnt[lane] = 0;
            asm volatile("s_waitcnt lgkmcnt(0)" ::: "memory");
            if (lane < 32) {
                float v[NE];
#pragma unroll
                for (int j = 0; j < NE; ++j) v[j] = L[lane * 33 + j];
                unsigned used = 0u; float sv[TOPK];
#pragma unroll
                for (int kk = 0; kk < TOPK; ++kk) { float best = -INFINITY; int bi = 0;
#pragma unroll
                    for (int j = 0; j < NE; ++j) { const bool ok = !((used >> j) & 1u) && (v[j] > best); best = ok ? v[j] : best; bi = ok ? j : bi; }
                    used |= 1u << bi; sel[kk] = bi; sv[kk] = best; }
                float den = 0.f;
#pragma unroll
                for (int kk = 0; kk < TOPK; ++kk) { gt[kk] = __expf(sv[kk] - sv[0]); den += gt[kk]; }
                const float rden = 1.0f / den;
#pragma unroll
                for (int kk = 0; kk < TOPK; ++kk) { gt[kk] *= rden; lpos[kk] = __hip_atomic_fetch_add(lcnt + sel[kk], 1, __ATOMIC_RELAXED, __HIP_MEMORY_SCOPE_WORKGROUP); }
            }
            asm volatile("s_waitcnt lgkmcnt(0)" ::: "memory");
            pbase = 0;
            if (lane < 32) { const int n = lcnt[lane];
                if (n > 0) pbase = (int)__hip_atomic_fetch_add((unsigned*)(cntw + lane * 64), (unsigned)n, __ATOMIC_RELAXED, __HIP_MEMORY_SCOPE_AGENT); }
            pt0 = t0; pend = true;
        }
    }
    if (wave == 0 && pend) {
        if (lane < 32) lcnt[32 + lane] = pbase;
        asm volatile("s_waitcnt lgkmcnt(0)" ::: "memory");
        if (lane < 32) { const int t = pt0 + lane;
#pragma unroll
            for (int kk = 0; kk < TOPK; ++kk) { const int e = sel[kk], pos = lcnt[32 + e] + lpos[kk];
                F.tkg[t * 4 + kk] = gt[kk]; F.list[e * NTOK + pos] = t * 4 + kk; } }
    }
}

__device__ __forceinline__ void moe_table(Frame& F) {
    LAS int* tab = (LAS int*)(F.lds + TAB_OFF);
    if (F.tid == 0) { int s = 0;
        for (int e = 0; e < NE; ++e) { const int c = (int)__hip_atomic_load((unsigned*)(F.ctl + CW_CNT + e * 64), __ATOMIC_RELAXED, __HIP_MEMORY_SCOPE_AGENT); tab[e] = s; tab[40 + e] = c; s += (c + 255) >> 8; }
        tab[32] = s; }
    asm volatile("s_waitcnt vmcnt(0) lgkmcnt(0)" ::: "memory"); __syncthreads();
}
constexpr int META_OFF = NTAB_OFF, META_SLOT = 2048;
#ifndef MOE_BLOCKED
#define MOE_BLOCKED 1
#define MOE_AFFINE 1
#define MOE_PNB 8
#endif
template <bool GATHER>
struct MoeOrder {
    const char* A; const char* Bt; const int* list; const float* bias; const LAS int* tab; LAS unsigned char* meta; int K, N, nN, G, c;
    mutable int ec;
    __device__ bool next(int i, pg8::Unit& u) const {
#if MOE_AFFINE
        const int tot = tab[32] * nN;
        int L;
        if (G == 256) { const int x = c >> 5, j = c & 31; const int s0 = (int)(((long)x * tot) >> 3), s1 = (int)(((long)(x + 1) * tot) >> 3); L = s0 + j + 32 * i; if (L >= s1) return false; }
        else { L = i * G + c; if (L >= tot) return false; }
#else
        const int L = i * G + c; if (L >= tab[32] * nN) return false;
#endif
        int e = ec;
#pragma unroll 1
        while (L >= tab[e + 1] * nN) ++e;
        ec = e;
        const int nm = tab[e + 1] - tab[e], ql = L - tab[e] * nN;
#if MOE_BLOCKED
        { const int PNB = MOE_PNB < nN ? MOE_PNB : nN, PMB = 32 / PNB;
          const int g = ql / (PMB * nN), r = ql - g * PMB * nN, sg = (nm - PMB * g) < PMB ? (nm - PMB * g) : PMB, pb = r / (sg * PNB), r2 = r - pb * sg * PNB;
          u.e = e; u.pn = pb * PNB + r2 / sg; u.aux = PMB * g + r2 % sg; u.pm = tab[e] + u.aux; }
        return true;
#else
        u.e = e; u.pn = ql / nm; u.aux = ql % nm; u.pm = tab[e] + u.aux; return true;
#endif
    }
    __device__ __forceinline__ const char* abase() const { return A; }
    __device__ __forceinline__ const char* bbase(const pg8::Unit& u) const { return Bt + ((size_t)u.e * N + (size_t)u.pn * 256) * K; }
    __device__ __forceinline__ void dma_list(const pg8::Unit& u, int slot) const {
        const int lane = lane_id();
        __builtin_amdgcn_global_load_lds((const unsigned*)(list + (size_t)u.e * NTOK + u.aux * 256 + 4 * lane), (LAS unsigned*)(meta + slot * META_SLOT), 16, 0, 0);
    }
    __device__ __forceinline__ void dma_bias(const pg8::Unit& u, int slot) const {
        const int lane = lane_id();
        const float* src = GATHER ? bias + (size_t)u.e * 2 * DFF + u.pn * 128 + (lane >> 5) * DFF + 4 * (lane & 31) : bias + (size_t)u.e * DM + u.pn * 256 + 4 * lane;
        __builtin_amdgcn_global_load_lds((const unsigned*)src, (LAS unsigned*)(meta + slot * META_SLOT + 1024), 16, 0, 0);
    }
    __device__ __forceinline__ void meta_init(const pg8::Unit& u0, bool h1, const pg8::Unit& u1, int wid) const {
        if (wid == 0) { dma_list(u0, 0); dma_bias(u0, 0); if (h1) dma_list(u1, 1); }
        asm volatile("s_waitcnt vmcnt(0)" ::: "memory"); __builtin_amdgcn_s_barrier(); asm volatile("" ::: "memory");
    }
    __device__ __forceinline__ void meta_top(int ui, bool has_next, const pg8::Unit& nxt, bool h2, const pg8::Unit& nn, int wid) const {
        if (wid == 0) { if (has_next) dma_bias(nxt, (ui + 1) % 3); if (h2) dma_list(nn, (ui + 2) % 3); }
    }
    __device__ __forceinline__ void aoffs(const pg8::Unit& u, int ui, const int (&R)[2], const int (&C)[2], unsigned (&off)[4]) const {
        if (GATHER) { const int lim = tab[40 + u.e] - 1 - u.aux * 256; const LAS int* lst = (const LAS int*)(meta + (ui % 3) * META_SLOT);
#pragma unroll
            for (int h = 0; h < 2; ++h)
#pragma unroll
                for (int i = 0; i < 2; ++i) { int mi = h * 128 + R[i]; mi = mi < lim ? mi : lim; const int tk = lst[mi] >> 2; off[h * 2 + i] = (unsigned)(tk * K + C[i] * 2); }
        } else {
#pragma unroll
            for (int h = 0; h < 2; ++h)
#pragma unroll
                for (int i = 0; i < 2; ++i) off[h * 2 + i] = (unsigned)((u.pm * 256 + h * 128 + R[i]) * K + C[i] * 2);
        }
    }
};
template <int PV> struct EpiSwigluT {
    static constexpr bool PERM = true, MID = false, FP8 = true; static constexpr int WIDE = 0;
    static constexpr int NST = 4;
    __device__ __forceinline__ int nstores(const pg8::Unit&) const { return PV == 3 ? 0 : 4; }
    bf16_t* act; const LAS unsigned char* meta;
    __device__ __forceinline__ void mid(f32x4 (&)[2][2][4][2], const pg8::Unit&, int, int) const {}
    __device__ __forceinline__ void init(f32x4 (&i)[2][2], int ui, int wc, int fq) const {
        const LAS float* bp = (const LAS float*)(meta + (ui % 3) * META_SLOT + 1024) + wc * 32 + 8 * fq;
        i[0][0] = *(const LAS f32x4*)bp; i[0][1] = *(const LAS f32x4*)(bp + 4); i[1][0] = *(const LAS f32x4*)(bp + 128); i[1][1] = *(const LAS f32x4*)(bp + 132);
    }
    __device__ __forceinline__ u32x2 glu8(const f32x4 (&acc)[2][2][4][2], int ai, int m) const {
        float o[8];
#pragma unroll
        for (int q = 0; q < 8; q += 2) {
            typedef float f32x2_ __attribute__((ext_vector_type(2)));
            f32x2_ g, up;
            g.x = (q < 4 ? acc[ai][0][m][0][q] : acc[ai][0][m][1][q - 4]); g.y = (q < 4 ? acc[ai][0][m][0][q + 1] : acc[ai][0][m][1][q - 3]);
            up.x = (q < 4 ? acc[ai][1][m][0][q] : acc[ai][1][m][1][q - 4]); up.y = (q < 4 ? acc[ai][1][m][0][q + 1] : acc[ai][1][m][1][q - 3]);
            g.x = __builtin_amdgcn_fmed3f(g.x, -3.0e38f, 7.f); g.y = __builtin_amdgcn_fmed3f(g.y, -3.0e38f, 7.f);
            up.x = __builtin_amdgcn_fmed3f(up.x, -7.f, 7.f); up.y = __builtin_amdgcn_fmed3f(up.y, -7.f, 7.f);
            const f32x2_ t = g * (f32x2_){-1.702f * LOG2E, -1.702f * LOG2E};
            f32x2_ e; if constexpr (PV == 2) { e = t * t; } else { e.x = __builtin_amdgcn_exp2f(t.x); e.y = __builtin_amdgcn_exp2f(t.y); }
            e = e + (f32x2_){1.f, 1.f};
            f32x2_ r; if constexpr (PV == 2) { r = e * (f32x2_){0.5f, 0.5f}; } else { r.x = __builtin_amdgcn_rcpf(e.x); r.y = __builtin_amdgcn_rcpf(e.y); }
            const f32x2_ glu = g * r;
            f32x2_ ov = up * glu + glu;
            if constexpr (PV == 4) { ov.x = g.x + up.x; ov.y = g.y + up.y; }
            o[q] = ov.x; o[q + 1] = ov.y; }
        u32x2 w; w.x = pk_fp8x4(o[0], o[1], o[2], o[3]); w.y = pk_fp8x4(o[4], o[5], o[6], o[7]);
        return w;
    }
    __device__ __forceinline__ void operator()(const f32x4 (&acc)[2][2][4][2], const pg8::Unit& u, int, int wr, int wc, int fr, int fq) const {
        const int f0 = u.pn * 128 + wc * 32 + 8 * (fq & 2), row0 = u.pm * 256 + wr * 64 + fr + (fq & 1) * 16;
#pragma unroll
        for (int ai = 0; ai < 2; ++ai)
#pragma unroll
            for (int m = 0; m < 4; m += 2) { const int row = row0 + ai * 128 + m * 16;
                const u32x2 wa = glu8(acc, ai, m), wb = glu8(acc, ai, m + 1);
                const auto sx = __builtin_amdgcn_permlane16_swap(wa.x, wb.x, false, false), sy = __builtin_amdgcn_permlane16_swap(wa.y, wb.y, false, false);
                u32x4 w; w.x = sx[0]; w.y = sy[0]; w.z = sx[1]; w.w = sy[1];
                if constexpr (PV == 3) asm volatile("" :: "v"(w)); else st16_wt((unsigned char*)act + (size_t)row * DFF + f0, w); }
    }
};
typedef EpiSwigluT<0> EpiSwiglu;
struct EpiNull {
    static constexpr bool PERM = true, MID = false, FP8 = true; static constexpr int WIDE = 0;
    static constexpr int NST = 0;
    __device__ __forceinline__ int nstores(const pg8::Unit&) const { return 0; }
    __device__ __forceinline__ void mid(f32x4 (&)[2][2][4][2], const pg8::Unit&, int, int) const {}
    __device__ __forceinline__ void init(f32x4 (&i)[2][2], int, int, int) const { i[0][0] = i[0][1] = i[1][0] = i[1][1] = (f32x4){0.f, 0.f, 0.f, 0.f}; }
    __device__ __forceinline__ void operator()(const f32x4 (&acc)[2][2][4][2], const pg8::Unit&, int, int, int, int, int) const {
#pragma unroll
        for (int a = 0; a < 2; ++a)
#pragma unroll
            for (int b = 0; b < 2; ++b)
#pragma unroll
                for (int m = 0; m < 4; ++m)
#pragma unroll
                    for (int n = 0; n < 2; ++n) asm volatile("" :: "v"(acc[a][b][m][n]));
    }
};
struct EpiDense {
    static constexpr bool PERM = true, MID = false, FP8 = true; static constexpr int WIDE = 0;
    static constexpr int NST = 0;
    __device__ __forceinline__ int nstores(const pg8::Unit&) const { return 0; }
    bf16_t* dst;
    __device__ __forceinline__ void mid(f32x4 (&)[2][2][4][2], const pg8::Unit&, int, int) const {}
    __device__ __forceinline__ void init(f32x4 (&i)[2][2], int, int, int) const { i[0][0] = i[0][1] = i[1][0] = i[1][1] = (f32x4){0.f, 0.f, 0.f, 0.f}; }
    __device__ __forceinline__ void operator()(const f32x4 (&acc)[2][2][4][2], const pg8::Unit& u, int, int wr, int wc, int fr, int fq) const {
        const int tid = (wr * 4 + wc) * 64 + fq * 16 + fr;
        unsigned char* base = (unsigned char*)dst + ((size_t)(u.pm * 4 + u.pn) % 512) * 131072 + tid * 16;
#pragma unroll
        for (int ai = 0; ai < 2; ++ai)
#pragma unroll
            for (int m = 0; m < 4; ++m)
#pragma unroll
                for (int bj = 0; bj < 2; ++bj) { const f32x4 v0 = acc[ai][bj][m][0], v1 = acc[ai][bj][m][1];
                    u32x4 w; w.x = cvt_pk_bf16(v0[0], v0[1]); w.y = cvt_pk_bf16(v0[2], v0[3]); w.z = cvt_pk_bf16(v1[0], v1[1]); w.w = cvt_pk_bf16(v1[2], v1[3]);
                    *(GAS u32x4*)(base + ((ai * 4 + m) * 2 + bj) * 8192) = w; }
    }
};
template <int PV> struct EpiYsT {
    static constexpr bool PERM = true, MID = false, FP8 = true; static constexpr int WIDE = 2;
    static constexpr int NST = 8;
    __device__ __forceinline__ int nstores(const pg8::Unit& u) const { return (tab[40 + u.e] - u.aux * 256 >= 256) ? 8 : 0; }
    bf16_t* ys; const LAS int* tab; const LAS unsigned char* meta;
    __device__ __forceinline__ void mid(f32x4 (&)[2][2][4][2], const pg8::Unit&, int, int) const {}
    __device__ __forceinline__ void init(f32x4 (&i)[2][2], int ui, int wc, int fq) const {
        const LAS float* bp = (const LAS float*)(meta + (ui % 3) * META_SLOT + 1024) + wc * 64 + 16 * fq;
#pragma unroll
        for (int bj = 0; bj < 2; ++bj)
#pragma unroll
            for (int n = 0; n < 2; ++n) i[bj][n] = *(const LAS f32x4*)(bp + bj * 8 + 4 * n);
    }
    __device__ __forceinline__ void operator()(const f32x4 (&acc)[2][2][4][2], const pg8::Unit& u, int ui, int wr, int wc, int fr, int fq) const {
        const int col0 = u.pn * 256 + wc * 64 + 16 * fq, rl0 = wr * 64 + fr, lim = tab[40 + u.e] - u.aux * 256;
        const LAS int* lst = (const LAS int*)(meta + (ui % 3) * META_SLOT);
        int ent[2][4];
#pragma unroll
        for (int ai = 0; ai < 2; ++ai)
#pragma unroll
            for (int m = 0; m < 4; ++m) { const int rl = rl0 + ai * 128 + m * 16; const int e_ = (PV == 1) ? (u.pm * 256 + rl) : lst[rl]; ent[ai][m] = (rl < lim) ? e_ : -1; }
#pragma unroll
        for (int ai = 0; ai < 2; ++ai)
#pragma unroll
            for (int m = 0; m < 4; ++m) { if (ent[ai][m] >= 0) {
                    u32x4 w;
                    { const f32x4 v0 = acc[ai][0][m][0], v1 = acc[ai][0][m][1]; w.x = pk_fp8x4(v0[0], v0[1], v0[2], v0[3]); w.y = pk_fp8x4(v1[0], v1[1], v1[2], v1[3]); }
                    { const f32x4 v0 = acc[ai][1][m][0], v1 = acc[ai][1][m][1]; w.z = pk_fp8x4(v0[0], v0[1], v0[2], v0[3]); w.w = pk_fp8x4(v1[0], v1[1], v1[2], v1[3]); }
                    if constexpr (PV == 5) *(GAS u32x4*)((unsigned char*)ys + ((size_t)(u.pm * 4 + u.pn) % 512) * 65536 + (wr * 4 + wc) * 8192 + (ai * 4 + m) * 1024 + (fq * 16 + fr) * 16) = w;
                    else if constexpr (PV == 3) asm volatile("" :: "v"(w)); else if constexpr (PV == 4) { if (ai == 0 && m == 0) *(GAS u32x4*)((unsigned char*)ys + (size_t)ent[ai][m] * DM + col0) = w; else asm volatile("" :: "v"(w)); }
                    else *(GAS u32x4*)((unsigned char*)ys + (size_t)ent[ai][m] * DM + col0) = w; } }
    }
};
typedef EpiYsT<0> EpiYs;
struct FinRow { u32x2 d[4]; unsigned y[TOPK][4]; };
__device__ __forceinline__ void fin_load(FinRow& R, const float* xrow, const bf16_t* drow, const bf16_t* yrow, int lane) {
#pragma unroll
    for (int kk = 0; kk < TOPK; ++kk) { const GAS unsigned* yr = (const GAS unsigned*)((const unsigned char*)yrow + (size_t)kk * DM) + lane;
#pragma unroll
        for (int j = 0; j < 4; ++j) R.y[kk][j] = __builtin_nontemporal_load(yr + 64 * j); }
    const GAS u32x2* dr = (const GAS u32x2*)drow + lane;
#pragma unroll
    for (int j = 0; j < 4; ++j) R.d[j] = dr[64 * j];
}
__device__ __forceinline__ void fin_compute(const FinRow& R, float* drow, float gv, int r, int lane, const f32x4 (&gfm)[4], const f32x4 (&gf)[4]) {
    f32x4 y[4];
#pragma unroll
    for (int j = 0; j < 4; ++j) y[j] = (f32x4){0.f, 0.f, 0.f, 0.f};
#pragma unroll
    for (int kk = 0; kk < TOPK; ++kk) { const float g = __builtin_bit_cast(float, __builtin_amdgcn_readlane(__builtin_bit_cast(int, gv), r * 4 + kk));
#pragma unroll
        for (int j = 0; j < 4; ++j) { const int w = (int)R.y[kk][j]; const f32x2 lo = __builtin_amdgcn_cvt_pk_f32_fp8(w, false), hi = __builtin_amdgcn_cvt_pk_f32_fp8(w, true);
            y[j] += (f32x4){lo.x, lo.y, hi.x, hi.y} * g; } }
    f32x4 v[4]; float s = 0.f;
#pragma unroll
    for (int j = 0; j < 4; ++j) { const u32x2 w = R.d[j]; v[j] = (f32x4){bf2f(w.x & 0xffffu), bf2f(w.x >> 16), bf2f(w.y & 0xffffu), bf2f(w.y >> 16)} + gfm[j] * y[j]; s += (v[j].x * v[j].x + v[j].y * v[j].y) + (v[j].z * v[j].z + v[j].w * v[j].w); }
    const float rstd = 1.f / sqrtf(wave_sum(s) * (1.f / DM) + EPS);
    GAS f32x4* orow = (GAS f32x4*)drow + lane;
#pragma unroll
    for (int j = 0; j < 4; ++j) orow[64 * j] = v[j] * rstd * gf[j];
}
__device__ __forceinline__ void final_phase(Frame& F, float* dst) {
    const int gw = F.vcu * NWAVES + F.wave, NGW = F.G * NWAVES, lane = F.lane;
    f32x4 gf[4];
#pragma unroll
    for (int j = 0; j < 4; ++j) gf[j] = *(const GAS f32x4*)(F.g_final + 4 * lane + 256 * j);
    for (int chunk = gw; chunk < NTOK / 16; chunk += NGW) {
        const int m0 = chunk * 16, b = m0 / SEQ;
        f32x4 gfm[4];
#pragma unroll
        for (int j = 0; j < 4; ++j) gfm[j] = *(const GAS f32x4*)(F.mod + b * 6 * DM + 5 * DM + 4 * lane + 256 * j);
        const float gv = F.tkg[m0 * 4 + lane];
        FinRow A, B;
        fin_load(A, F.x + (size_t)m0 * DM, F.DELTA + (size_t)m0 * DM, (const bf16_t*)((const unsigned char*)F.YS + (size_t)m0 * 4 * DM), lane);
#pragma unroll 1
        for (int r = 0; r < 16; r += 2) {
            fin_load(B, F.x + (size_t)(m0 + r + 1) * DM, F.DELTA + (size_t)(m0 + r + 1) * DM, (const bf16_t*)((const unsigned char*)F.YS + (size_t)(m0 + r + 1) * 4 * DM), lane);
            fin_compute(A, dst + (size_t)(m0 + r) * DM, gv, r, lane, gfm, gf);
            if (r + 2 < 16) fin_load(A, F.x + (size_t)(m0 + r + 2) * DM, F.DELTA + (size_t)(m0 + r + 2) * DM, (const bf16_t*)((const unsigned char*)F.YS + (size_t)(m0 + r + 2) * 4 * DM), lane);
            fin_compute(B, dst + (size_t)(m0 + r + 1) * DM, gv, r + 1, lane, gfm, gf);
        }
    }
}
struct MkArgs { const float* in[17]; float* out; unsigned char* ws; int ph_lo, ph_hi; };
#ifndef DBG_STAGE
#define DBG_STAGE 9
#endif
constexpr int N_PHASES = DBG_STAGE;
__global__ void __launch_bounds__(NWAVES * 64, 2) mk_fwd(MkArgs args) {
    extern __shared__ __attribute__((aligned(16))) unsigned char lds[];
    Frame F;
    F.lds = (LAS unsigned char*)lds;
    F.MISC = (volatile LAS unsigned*)(F.lds + MISC_OFF);
    F.tid = threadIdx.x; F.lane = F.tid & 63; F.wave = __builtin_amdgcn_readfirstlane(F.tid >> 6);
    F.G = gridDim.x; { const int bx = blockIdx.x; F.vcu = (F.G % 8 == 0) ? (bx % 8) * (F.G / 8) + bx / 8 : bx; }
    unsigned char* ws = args.ws;
    F.ctl = (gu32*)(ws + WS_CTL);
    F.x = args.in[0]; F.c = args.in[1]; F.w_ada = args.in[2]; F.b_ada = args.in[3]; F.w_in = args.in[4]; F.sink = args.in[5]; F.rpb = args.in[6]; F.ga = args.in[7]; F.gb = args.in[8];
    F.w_out = args.in[9]; F.w_router = args.in[10]; F.b_router = args.in[11]; F.w_gu = args.in[12]; F.b_gu = args.in[13]; F.w_down = args.in[14]; F.b_down = args.in[15]; F.g_final = args.in[16];
    F.out = args.out;
    F.mod = (float*)(ws + WS_MOD); F.rope = (float*)(ws + WS_ROPE); F.ssq = (float*)(ws + WS_SSQ); F.tkg = (float*)(ws + WS_TKG); F.tke = (int*)(ws + WS_TKE); F.list = (int*)(ws + WS_LIST);
    F.wr_t = (bf16_t*)(ws + WS_WR); F.win_t = (bf16_t*)(ws + WS_WIN); F.wout_t = (bf16_t*)(ws + WS_WOUT); F.wgu_t = (bf16_t*)(ws + WS_WGU); F.wd_t = (bf16_t*)(ws + WS_WD);
    F.XN = (bf16_t*)(ws + WS_XN); F.PROJ = (bf16_t*)(ws + WS_PROJ); F.O = (bf16_t*)(ws + WS_O); F.YS = (bf16_t*)(ws + WS_YS); F.ACT = (bf16_t*)(ws + WS_ACT); F.DELTA = (bf16_t*)(ws + WS_DELTA);
    for (int u = F.tid; u < (LDS_BYTES - LDSCTL_OFF) / 4; u += NWAVES * 64) ((LAS unsigned*)(F.lds + LDSCTL_OFF))[u] = 0u;
    __syncthreads();
    const int lo = args.ph_lo, hi = args.ph_hi;
    XcdBarrier bar; bar.bar = (unsigned*)(F.ctl + CW_BAR); bar.x = 0; bar.st = nullptr;
    if (hi - lo > 1) bar = xcd_barrier_post((unsigned*)(F.ctl + CW_BAR), F.MISC + 8, F.wave);
#define IN(k) (lo <= (k) && (k) < hi)
#define MOE_STAGGER(nN_, ticks_) do { const int tot_ = ((const LAS int*)(F.lds + TAB_OFF))[32] * (nN_); const int maxu_ = (tot_ + F.G - 1) / F.G, mine_ = (tot_ - F.vcu + F.G - 1) / F.G; \
        if (mine_ < maxu_) { const unsigned long long t0_ = __builtin_amdgcn_s_memrealtime(); while (__builtin_amdgcn_s_memrealtime() - t0_ < (ticks_)) __builtin_amdgcn_s_sleep(8); } } while (0)
#ifndef MOE_C
#define MOE_C (F.vcu)
#endif
#define FRESH() do { F.lane = lane_id(); F.tid = F.wave * 64 + F.lane; } while (0)
#if defined(DIAG_A)
    unsigned long long* const ts = (unsigned long long*)(ws + WS_CTL + 96 * 1024);
#define STAMP(k) do { if (blockIdx.x == 0 && F.wave == 0 && lane_id() == 0) ts[k] = __builtin_amdgcn_s_memrealtime(); } while (0)
#define MSTAMP(k) do { if (F.wave == 0 && lane_id() == 0) { const unsigned long long t_ = __builtin_amdgcn_s_memrealtime(); atomicMax(&ts[k], t_); atomicMax(&ts[(k) + 1], (1ull << 62) - t_); } } while (0)
#else
#define STAMP(k) do {} while (0)
#define MSTAMP(k) do {} while (0)
#endif
#define SEAM(k) do { if (IN(k) && IN((k) + 1)) xcd_barrier(bar, F.wave); STAMP((k) + 1); } while (0)
#ifndef PROBE_PH
#define PROBE_PH -1
#endif
#ifndef PROBE_FIN
#define PROBE_FIN 0
#endif
#define REP(k) for (int _rep = (PROBE_PH == (k)) ? 0 : 1; _rep < 2; ++_rep)
    float* const dummy = (float*)(ws + 830 * MiB);
    STAMP(0);
    FRESH();
    F.p0mode = 0;
    if (IN(0)) { REP(0) { __syncthreads(); F.p0mode = _rep ? 0 : PROBE_FIN; p0_prologue(F); } } SEAM(0);
    FRESH();
    if (IN(1)) { REP(1) p1_xn(F); } SEAM(1);
    FRESH();
    if (IN(2)) REP(2) {
#if P2_SPLIT
        const int NG = ((int)gridDim.x == 256) ? 192 : (int)gridDim.x;
        if ((int)blockIdx.x < NG) {
            pg8::DenseOrder S; S.init(F.XN, F.win_t, NTOK, DIN, DM, NG, (int)blockIdx.x);
            EpiProj E{F.PROJ, F.rope};
            pg8::gemm_phase<EpiProj, pg8::DenseOrder, true>(F.lds, DM, S, E, F.wave);
            if (_rep && NG == (int)gridDim.x) p0_deferred(F, P0_NITEMS - P0_DEFER, P0_NITEMS, (int)blockIdx.x, NG);
        } else if (_rep) p0_deferred(F, P0_NITEMS - P0_DEFER, P0_NITEMS, (int)blockIdx.x - NG, (int)gridDim.x - NG);
#else
        pg8::DenseOrder S; S.init(F.XN, F.win_t, NTOK, DIN, DM, F.G, (int)blockIdx.x);
        EpiProj E{F.PROJ, F.rope};
        pg8::gemm_phase<EpiProj, pg8::DenseOrder, true>(F.lds, DM, S, E, F.wave);
        { const int mx = (S.nwg + F.G - 1) / F.G, first_idle = S.nwg - (mx - 1) * F.G, c = (int)blockIdx.x;
          if (_rep && first_idle < F.G) { if (c >= first_idle) p0_deferred(F, P0_NITEMS - P0_DEFER, P0_NITEMS, c - first_idle, F.G - first_idle); }
          else if (_rep) p0_deferred(F, P0_NITEMS - P0_DEFER, P0_NITEMS, c, F.G); }
#endif
    } SEAM(2);
    FRESH();
    if (IN(3)) { if (PROBE_PH == 3) { if (PROBE_FIN != 2) attn_a_phase(F, dummy); if (PROBE_FIN != 1) attn_b_phase(F, dummy); }
                 if (F.wave >= 4) __builtin_amdgcn_s_setprio(1);
                 attn_a_phase(F, F.ssq); STAMP(10); MSTAMP(16); attn_b_phase(F, F.ssq); MSTAMP(18); __builtin_amdgcn_s_setprio(0); } SEAM(3);
    FRESH();
    if (IN(4)) REP(4) {
        const int NG4 = (P0_DEFER4 > 0 && (int)gridDim.x == 256) ? 176 : (int)gridDim.x;
        if ((int)blockIdx.x < NG4) {
            pg8::DenseOrder S; S.init(F.O, F.wout_t, NTOK, DM, DM, NG4, (int)blockIdx.x);
            p4_tables(F, S);
            EpiX1 E{F.DELTA, F.lds + P4_TAB_OFF};
            pg8::gemm_phase<EpiX1, pg8::DenseOrder, true>(F.lds, DM, S, E, F.wave);
            if (_rep && NG4 == (int)gridDim.x) p0_deferred(F, P0_NITEMS - P0_ND, P0_NITEMS - P0_DEFER - P0_DEFER6, (int)blockIdx.x, NG4);
        } else if (_rep) p0_deferred(F, P0_NITEMS - P0_ND, P0_NITEMS - P0_DEFER - P0_DEFER6, (int)blockIdx.x - NG4, (int)gridDim.x - NG4);
    } SEAM(4);
    FRESH();
    if (IN(5)) REP(5) { router_phase(F, _rep ? F.ctl + CW_CNT : F.ctl + 16384); } SEAM(5);
    FRESH();
    if (IN(6)) {
        moe_table(F);
        MoeOrder<true> S{(const char*)F.XN, (const char*)F.wgu_t, F.list, F.b_gu, (const LAS int*)(F.lds + TAB_OFF), F.lds + META_OFF, DM, 2 * DFF, 2 * DFF / 256, F.G, MOE_C, 0};
        if (PROBE_PH == 6) { if constexpr (PROBE_FIN == 0) { EpiNull E0; pg8::gemm_phase<EpiNull, MoeOrder<true>, true>(F.lds, DM, S, E0, F.wave); }
                             else if constexpr (PROBE_FIN == 8) { struct HotOrder : MoeOrder<true> { __device__ bool next(int i, pg8::Unit& u) const { const bool ok = MoeOrder<true>::next(i, u); u.e = 0; u.pn = 0; u.aux = 0; u.pm = 0; return ok; } };
                                 HotOrder SH{S}; EpiNull E0; pg8::gemm_phase<EpiNull, HotOrder, true>(F.lds, DM, SH, E0, F.wave); }
                             else if constexpr (PROBE_FIN == 9) { EpiNull E0; pg8::gemm_phase<EpiNull, MoeOrder<true>, true, 2>(F.lds, DM, S, E0, F.wave); }
                             else { EpiSwigluT<PROBE_FIN> E0{(bf16_t*)(ws + 830 * MiB), F.lds + META_OFF}; pg8::gemm_phase<EpiSwigluT<PROBE_FIN>, MoeOrder<true>, true>(F.lds, DM, S, E0, F.wave); }
                             S.ec = 0; }
        EpiSwiglu E{F.ACT, F.lds + META_OFF};
        pg8::gemm_phase<EpiSwiglu, MoeOrder<true>, true>(F.lds, DM, S, E, F.wave);
        { const int tot = ((const LAS int*)(F.lds + TAB_OFF))[32] * (2 * DFF / 256), mx = (tot + F.G - 1) / F.G, first_idle = tot - (mx - 1) * F.G;
          if (F.G - first_idle >= F.G / 4) { if (F.vcu >= first_idle) p0_deferred(F, P0_NITEMS - P0_DEFER - P0_DEFER6, P0_NITEMS - P0_DEFER, F.vcu - first_idle, F.G - first_idle); }
          else p0_deferred(F, P0_NITEMS - P0_DEFER - P0_DEFER6, P0_NITEMS - P0_DEFER, F.vcu, F.G); }
    } SEAM(6);
    FRESH();
    if (IN(7)) {
        moe_table(F);
        MoeOrder<false> S{(const char*)F.ACT, (const char*)F.wd_t, F.list, F.b_down, (const LAS int*)(F.lds + TAB_OFF), F.lds + META_OFF, DFF, DM, DM / 256, F.G, MOE_C, 0};
#ifdef P7_STAG
        { const int tot_ = ((const LAS int*)(F.lds + TAB_OFF))[32] * (DM / 256); const int maxu_ = (tot_ + F.G - 1) / F.G, mine_ = (tot_ - F.vcu + F.G - 1) / F.G;
          if (F.vcu & 1) { const unsigned long long t0_ = __builtin_amdgcn_s_memrealtime(); while (__builtin_amdgcn_s_memrealtime() - t0_ < (P7_STAG)) __builtin_amdgcn_s_sleep(8); } }
#endif
        if (PROBE_PH == 7) { if constexpr (PROBE_FIN == 0) { EpiNull E0; pg8::gemm_phase<EpiNull, MoeOrder<false>, true>(F.lds, DFF, S, E0, F.wave); }
                             else { constexpr int PVV = (PROBE_FIN == 1 ? 1 : PROBE_FIN == 3 ? 3 : PROBE_FIN == 4 ? 4 : PROBE_FIN == 5 ? 5 : 0); EpiYsT<PVV> E0{(bf16_t*)(ws + 830 * MiB), (const LAS int*)(F.lds + TAB_OFF), F.lds + META_OFF}; pg8::gemm_phase<EpiYsT<PVV>, MoeOrder<false>, true>(F.lds, DFF, S, E0, F.wave); }
                             S.ec = 0; }
        EpiYs E{F.YS, (const LAS int*)(F.lds + TAB_OFF), F.lds + META_OFF};
        pg8::gemm_phase<EpiYs, MoeOrder<false>, true>(F.lds, DFF, S, E, F.wave);
    } SEAM(7);
    FRESH();
    if (IN(8)) REP(8) { final_phase(F, _rep ? F.out : dummy); }
#if defined(DIAG_A)
    xcd_barrier(bar, F.wave); STAMP(9);
    if (blockIdx.x == 0 && F.wave == 0) { asm volatile("s_waitcnt vmcnt(0)" ::: "memory");
        const unsigned long long t9 = __builtin_amdgcn_s_memrealtime(), span = (DIAG_A == 9) ? 0ull : (DIAG_A == 10) ? (ts[10] - ts[3]) : (DIAG_A == 11 || DIAG_A == 12) ? ts[DIAG_A] : (DIAG_A == 17) ? (ts[20] - ts[0]) : (DIAG_A == 13) ? (ts[16] - ts[3]) : (DIAG_A == 14) ? ((1ull << 62) - ts[17] - ts[3]) : (DIAG_A == 15) ? (ts[18] - ts[3]) : (DIAG_A == 16) ? ((1ull << 62) - ts[19] - ts[3]) : (ts[DIAG_A + 1] - ts[DIAG_A]);
        while (__builtin_amdgcn_s_memrealtime() - t9 < 4ull * span) __builtin_amdgcn_s_sleep(16); }
#endif
#undef IN
#undef SEAM
}

__global__ void br_route(const bf16_t* XN, const int* tke, const unsigned* ctl, float* h, int* cnt, int* list) {
    const int idx = blockIdx.x * 256 + threadIdx.x;
    const int ep = tke[idx]; list[(ep >> 16) * NTOK + (ep & 0xffff)] = idx;
    if (idx < NE) cnt[idx] = (int)ctl[CW_CNT + idx * 64];
    const int t = idx >> 2, q = idx & 3;
    for (int k = q * 256; k < q * 256 + 256; ++k) h[(size_t)t * DM + k] = bf2f(XN[(size_t)t * DM + k]);
}
extern "C" void kernel_launch(void* const* d_in, const int* in_sizes, int n_in, void* d_out, int out_size, void* d_ws, size_t ws_size, hipStream_t stream) {
    static int grid = 0;
    if (grid == 0) {
        if (n_in != 17 || ws_size < (size_t)1001 * MiB) { fprintf(stderr, "kernel_launch: bad n_in %d or ws_size %zu\n", n_in, ws_size); grid = -1; return; }
        int dev = 0, cus = 0, per_cu = 0;
        if (hipGetDevice(&dev) != hipSuccess || hipDeviceGetAttribute(&cus, hipDeviceAttributeMultiprocessorCount, dev) != hipSuccess) { grid = -1; return; }
        if (hipFuncSetAttribute((const void*)mk_fwd, hipFuncAttributeMaxDynamicSharedMemorySize, LDS_BYTES) != hipSuccess) { fprintf(stderr, "kernel_launch: hipFuncSetAttribute failed\n"); grid = -1; return; }
        if (hipOccupancyMaxActiveBlocksPerMultiprocessor(&per_cu, (const void*)mk_fwd, NWAVES * 64, LDS_BYTES) != hipSuccess || per_cu < 1) { fprintf(stderr, "kernel_launch: occupancy query says %d\n", per_cu); }
        (void)hipGetLastError();
        grid = cus;
    }
    if (grid < 0) return;
    const float* x = (const float*)d_in[0]; const float* sink = (const float*)d_in[5]; const float* rpb = (const float*)d_in[6]; const float* ga = (const float*)d_in[7];
    const float* gb = (const float*)d_in[8]; const float* w_out = (const float*)d_in[9]; const float* w_router = (const float*)d_in[10]; const float* b_router = (const float*)d_in[11];
    const float* w_gu = (const float*)d_in[12]; const float* b_gu = (const float*)d_in[13]; const float* w_down = (const float*)d_in[14]; const float* b_down = (const float*)d_in[15];
    const float* g_final = (const float*)d_in[16];
    char* ws = (char*)d_ws; float* out = (float*)d_out;
    (void)hipMemsetAsync(ws + WS_CTL, 0, CTL_ZERO_BYTES, stream);
    MkArgs a{};
    for (int i = 0; i < 17; ++i) a.in[i] = (const float*)d_in[i];
    a.out = out; a.ws = (unsigned char*)d_ws;
#if defined(MK_PER_PHASE)
    for (int ph = 0; ph < N_PHASES; ++ph) { a.ph_lo = ph; a.ph_hi = ph + 1; hipLaunchKernelGGL(mk_fwd, dim3(grid), dim3(NWAVES * 64), LDS_BYTES, stream, a); }
#else
    a.ph_lo = 0; a.ph_hi = N_PHASES; hipLaunchKernelGGL(mk_fwd, dim3(grid), dim3(NWAVES * 64), LDS_BYTES, stream, a);
#endif
#if DBG_STAGE < 9
    float* mod = (float*)(ws + WS_MOD);
    float* h = (float*)(ws + 17 * MiB);
    float* y = (float*)(ws + 337 * MiB);
    float* act = (float*)(ws + 481 * MiB);
    int* cnt = (int*)(ws + 993 * MiB); int* tke = (int*)(ws + 994 * MiB); float* tkg = (float*)(ws + 995 * MiB); int* list = (int*)(ws + 996 * MiB);
    (void)hipMemsetAsync(cnt, 0, 64 * sizeof(int), stream);
    (void)hipMemsetAsync(y, 0, (size_t)NTOK * DM * 4, stream);
#if DBG_STAGE == 5
    nv_norm_mod<<<NTOK, 256, 0, stream>>>(out, mod, 3 * DM, 4 * DM, h);
    nv_router<<<NTOK, 64, 0, stream>>>(h, w_router, b_router, cnt, tke, tkg, list);
#elif DBG_STAGE == 6
    br_route<<<NTOK * 4 / 256, 256, 0, stream>>>((const bf16_t*)(ws + WS_XN), (const int*)(ws + WS_TKE), (const unsigned*)(ws + WS_CTL), h, cnt, list);
    tkg = (float*)(ws + WS_TKG);
#endif
    nv_offsets<<<1, 64, 0, stream>>>(cnt);
    nv_sgemm<true><<<dim3(DFF / 64, NTOK / 64, NE), 256, 0, stream>>>(w_gu, 2 * DFF, DM, RmMoe1{h, list, cnt, (size_t)DM * 2 * DFF}, EpiMoe1{act, cnt, b_gu});
    nv_sgemm<false><<<dim3(DM / 64, NTOK / 64, NE), 256, 0, stream>>>(w_down, DM, DFF, RmMoe2{act, cnt, (size_t)DFF * DM}, EpiMoe2{y, list, cnt, tkg, b_down});
    nv_final<<<NTOK, 256, 0, stream>>>(out, y, mod, g_final, out);
#endif
}
```
